# Optimizing an MI355X kernel written in HIP

```python
import math
import jax, jax.numpy as jnp
from jax import lax
import numpy as np

D_MODEL = 1024
BATCH = 16
SEQ = 4096
DEPTH = 4

HEAD_DIM = 64
MIX_WIDTH = D_MODEL
DIFF_WIDTH = MIX_WIDTH // 2
DIFF_HEADS = DIFF_WIDTH // (2 * HEAD_DIM)
SWA_WIDTH = MIX_WIDTH - DIFF_WIDTH
SWA_Q_HEADS = SWA_WIDTH // HEAD_DIM
SWA_KV_HEADS = 2
SWA_GROUP = SWA_Q_HEADS // SWA_KV_HEADS
WINDOW = 128
BLOCK = 128
D_FF = ((8 * D_MODEL // 3 + 127) // 128) * 128
ROPE_THETA = 10000.0
ALPHA = (2.0 * DEPTH) ** 0.25
BETA = (8.0 * DEPTH) ** -0.25
LN_EPS = 1e-5
RMS_EPS = 1e-5

DQ = DIFF_HEADS * 2 * HEAD_DIM
DK = DIFF_HEADS * 2 * HEAD_DIM
DV = DIFF_HEADS * 2 * HEAD_DIM
SQ = SWA_Q_HEADS * HEAD_DIM
SK = SWA_KV_HEADS * HEAD_DIM
SV = SWA_KV_HEADS * HEAD_DIM
IN_COLS = DQ + DK + DV + SQ + SK + SV

kernel_name = "hymba_diffattn_swa_macaron_deepnorm_encoder"


def layer_norm(x, g, b):
    xf = x.astype(jnp.float32)
    mu = jnp.mean(xf, axis=-1, keepdims=True)
    var = jnp.mean(jnp.square(xf - mu), axis=-1, keepdims=True)
    y = (xf - mu) * lax.rsqrt(var + LN_EPS) * g.astype(jnp.float32) + b.astype(jnp.float32)
    return y.astype(x.dtype)


def swiglu(x, w_in, w_out):
    h = x @ w_in
    gate, up = h[..., :D_FF], h[..., D_FF:]
    return (jax.nn.silu(gate) * up) @ w_out


def rope_tables(positions):
    inv = jnp.power(ROPE_THETA, -jnp.arange(0, HEAD_DIM, 2, dtype=jnp.float32) / HEAD_DIM)
    ang = positions.astype(jnp.float32)[..., None] * inv
    ang = jnp.concatenate([ang, ang], axis=-1)[:, :, None, :]
    return jnp.cos(ang), jnp.sin(ang)


def apply_rope(t, cos, sin):
    half = HEAD_DIM // 2
    t1, t2 = t[..., :half], t[..., half:]
    rot = jnp.concatenate([-t2, t1], axis=-1)
    return (t * cos.astype(t.dtype) + rot * sin.astype(t.dtype)).astype(t.dtype)


def diff_attention(q, k, v, lam, subln_g, lambda_init):
    B, S = q.shape[0], q.shape[1]
    nb = S // BLOCK
    scale = HEAD_DIM ** -0.5
    qb = q.reshape(B, nb, BLOCK, DIFF_HEADS, 2, HEAD_DIM).transpose(1, 0, 2, 3, 4, 5)

    def one_block(q_blk):
        s = jnp.einsum('bqhcd,bkhcd->bhcqk', q_blk, k).astype(jnp.float32) * scale
        p = jax.nn.softmax(s, axis=-1)
        a = p[:, :, 0] - lam * p[:, :, 1]
        return jnp.einsum('bhqk,bkhe->bqhe', a.astype(v.dtype), v)

    o = lax.map(one_block, qb)
    o = o.transpose(1, 0, 2, 3, 4).reshape(B, S, DIFF_HEADS, 2 * HEAD_DIM)
    of = o.astype(jnp.float32)
    of = of * lax.rsqrt(jnp.mean(jnp.square(of), axis=-1, keepdims=True) + RMS_EPS)
    of = of * subln_g.astype(jnp.float32) * (1.0 - lambda_init)
    return of.astype(v.dtype).reshape(B, S, DIFF_WIDTH)


def band_mask(S):
    nb = S // BLOCK
    qpos = jnp.arange(nb)[:, None, None] * BLOCK + jnp.arange(BLOCK)[None, :, None]
    kpos = (jnp.arange(nb)[:, None, None] - 1) * BLOCK + jnp.arange(3 * BLOCK)[None, None, :]
    return (jnp.abs(qpos - kpos) <= WINDOW) & (kpos >= 0) & (kpos < S)


def swa_sink_attention(q, k, v, sink, mask):
    B, S = q.shape[0], q.shape[1]
    nb = S // BLOCK
    scale = HEAD_DIM ** -0.5
    qb = q.reshape(B, nb, BLOCK, SWA_KV_HEADS, SWA_GROUP, HEAD_DIM)

    def band(t):
        tp = jnp.pad(t, ((0, 0), (BLOCK, BLOCK), (0, 0), (0, 0)))
        tp = tp.reshape(B, nb + 2, BLOCK, SWA_KV_HEADS, HEAD_DIM)
        return jnp.concatenate([tp[:, :-2], tp[:, 1:-1], tp[:, 2:]], axis=2)

    kb, vb = band(k), band(v)
    s = jnp.einsum('bnqhgd,bnkhd->bnhgqk', qb, kb).astype(jnp.float32) * scale
    s = jnp.where(mask[None, :, None, None, :, :], s, -jnp.inf)
    sk = sink.astype(jnp.float32).reshape(1, 1, SWA_KV_HEADS, SWA_GROUP, 1, 1)
    m = jnp.maximum(jnp.max(s, axis=-1, keepdims=True), sk)
    e = jnp.exp(s - m)
    p = e / (jnp.sum(e, axis=-1, keepdims=True) + jnp.exp(sk - m))
    o = jnp.einsum('bnhgqk,bnkhd->bnqhgd', p.astype(v.dtype), vb)
    return o.reshape(B, S, SWA_WIDTH)


def hybrid_mixer(x, cos, sin, mask, w_in, w_out, lam_vec, subln_g, sink, lambda_init):
    B, S = x.shape[0], x.shape[1]
    h = x @ w_in
    o0 = 0
    dq = h[..., o0:o0 + DQ]; o0 += DQ
    dk = h[..., o0:o0 + DK]; o0 += DK
    dv = h[..., o0:o0 + DV]; o0 += DV
    sq = h[..., o0:o0 + SQ]; o0 += SQ
    sk = h[..., o0:o0 + SK]; o0 += SK
    sv = h[..., o0:o0 + SV]

    dq = apply_rope(dq.reshape(B, S, 2 * DIFF_HEADS, HEAD_DIM), cos, sin)
    dk = apply_rope(dk.reshape(B, S, 2 * DIFF_HEADS, HEAD_DIM), cos, sin)
    dq = dq.reshape(B, S, DIFF_HEADS, 2, HEAD_DIM)
    dk = dk.reshape(B, S, DIFF_HEADS, 2, HEAD_DIM)
    dv = dv.reshape(B, S, DIFF_HEADS, 2 * HEAD_DIM)
    lv = lam_vec.astype(jnp.float32)
    lam = jnp.exp(jnp.sum(lv[0] * lv[1])) - jnp.exp(jnp.sum(lv[2] * lv[3])) + lambda_init
    y_diff = diff_attention(dq, dk, dv, lam, subln_g, lambda_init)

    sq = apply_rope(sq.reshape(B, S, SWA_Q_HEADS, HEAD_DIM), cos, sin)
    sk = apply_rope(sk.reshape(B, S, SWA_KV_HEADS, HEAD_DIM), cos, sin)
    sv = sv.reshape(B, S, SWA_KV_HEADS, HEAD_DIM)
    y_swa = swa_sink_attention(sq, sk, sv, sink, mask)

    return jnp.concatenate([y_diff, y_swa], axis=-1) @ w_out


def setup_inputs(seed: int = 0) -> dict:
    key = jax.random.key(seed)
    ks = jax.random.split(key, 14)
    f32 = jnp.float32
    x = jax.random.normal(ks[0], (BATCH, SEQ, D_MODEL), f32)
    positions = jnp.broadcast_to(jnp.arange(SEQ, dtype=jnp.int32)[None, :], (BATCH, SEQ))
    col_scale = jnp.concatenate([
        jnp.ones((DQ + DK,), f32), jnp.full((DV,), BETA, f32),
        jnp.ones((SQ + SK,), f32), jnp.full((SV,), BETA, f32)])
    w_in = jax.random.normal(ks[1], (DEPTH, D_MODEL, IN_COLS), f32) * (D_MODEL ** -0.5) * col_scale
    w_out = jax.random.normal(ks[2], (DEPTH, MIX_WIDTH, D_MODEL), f32) * (MIX_WIDTH ** -0.5) * BETA
    diff_lambda = jax.random.normal(ks[3], (DEPTH, 4, HEAD_DIM), f32) * 0.1
    diff_subln_g = 1.0 + 0.02 * jax.random.normal(ks[4], (DEPTH, 2 * HEAD_DIM), f32)
    swa_sink = 0.5 * jax.random.normal(ks[5], (DEPTH, SWA_Q_HEADS), f32)
    ffn1_w_in = jax.random.normal(ks[6], (DEPTH, D_MODEL, 2 * D_FF), f32) * (D_MODEL ** -0.5)
    ffn1_w_out = jax.random.normal(ks[7], (DEPTH, D_FF, D_MODEL), f32) * (D_FF ** -0.5) * BETA
    ffn2_w_in = jax.random.normal(ks[8], (DEPTH, D_MODEL, 2 * D_FF), f32) * (D_MODEL ** -0.5)
    ffn2_w_out = jax.random.normal(ks[9], (DEPTH, D_FF, D_MODEL), f32) * (D_FF ** -0.5) * BETA
    ln_g = 1.0 + 0.02 * jax.random.normal(ks[10], (DEPTH, 3, D_MODEL), f32)
    ln_b = 0.02 * jax.random.normal(ks[11], (DEPTH, 3, D_MODEL), f32)
    return {"x": x, "positions": positions, "w_in": w_in, "w_out": w_out,
            "diff_lambda": diff_lambda, "diff_subln_g": diff_subln_g, "swa_sink": swa_sink,
            "ffn1_w_in": ffn1_w_in, "ffn1_w_out": ffn1_w_out,
            "ffn2_w_in": ffn2_w_in, "ffn2_w_out": ffn2_w_out,
            "ln_g": ln_g, "ln_b": ln_b}


def reference(x, positions, w_in, w_out, diff_lambda, diff_subln_g, swa_sink,
              ffn1_w_in, ffn1_w_out, ffn2_w_in, ffn2_w_out, ln_g, ln_b):
    S = x.shape[1]
    cos, sin = rope_tables(positions)
    mask = band_mask(S)
    for l in range(DEPTH):
        lambda_init = 0.8 - 0.6 * math.exp(-0.3 * l)
        x = layer_norm(ALPHA * x + 0.5 * swiglu(x, ffn1_w_in[l], ffn1_w_out[l]), ln_g[l, 0], ln_b[l, 0])
        mix = hybrid_mixer(x, cos, sin, mask, w_in[l], w_out[l], diff_lambda[l],
                           diff_subln_g[l], swa_sink[l], lambda_init)
        x = layer_norm(ALPHA * x + mix, ln_g[l, 1], ln_b[l, 1])
        x = layer_norm(ALPHA * x + 0.5 * swiglu(x, ffn2_w_in[l], ffn2_w_out[l]), ln_g[l, 2], ln_b[l, 2])
    return x
```

```cpp
#include <hip/hip_runtime.h>
#include <hip/hip_cooperative_groups.h>
#include <cstdio>
#include <cstdint>
#include <cmath>
namespace cg = cooperative_groups;
namespace pg8 {
#define PG8_LAS __attribute__((address_space(3)))
typedef unsigned short bf16_t;
typedef short bf16x8 __attribute__((ext_vector_type(8)));
typedef float f32x4 __attribute__((ext_vector_type(4)));
typedef unsigned u32x4 __attribute__((ext_vector_type(4)));
constexpr int BM = 256, BK = 64, HALF = 128, HTB = HALF * BK * 2  , STAGE_BYTES = 8 * HTB, NXCD = 8, WGM = 8;

__host__ __device__ __forceinline__ int lds_byte(int r, int c) { const int st = (r >> 4) * 2 + (c >> 5), rr = r & 15, cc = c & 31, ob = rr * 64 + cc * 2; return st * 1024 + (ob ^ (((ob >> 9) & 1) << 5)); }
__host__ __device__ __forceinline__ void stage_rc(int b, int& R, int& C) { const int st = b / 1024, sb = b % 1024, swz = sb ^ (((sb >> 9) & 1) << 5); R = (st >> 1) * 16 + swz / 64; C = (st & 1) * 32 + (swz % 64) / 2; }
__host__ __device__ __forceinline__ int perm32(int rho) { const int n = rho >> 4, i = rho & 15; return 8 * (i >> 2) + 4 * n + (i & 3); }

struct Unit { int pm, pn; };
struct Gemm { const bf16_t* A; const bf16_t* Bt; int M, N, K; };

struct StaticOrder {
    int nM, nN, nwg, G, c;
    __host__ __device__ void init(int M, int N, int G_, int c_) { nM = M / BM; nN = N / BM; nwg = nM * nN; G = G_; c = c_; }
    __host__ __device__ bool next(int i, Unit& u) const {
        const long L = (long)i * G + c; if (L >= nwg) return false;
        int wgid = (int)L; { const int q = nwg / NXCD, r = nwg % NXCD, xcd = wgid % NXCD, off = wgid / NXCD; wgid = (xcd < r ? xcd * (q + 1) : r * (q + 1) + (xcd - r) * q) + off; }
        const int nig = WGM * nN, gid = wgid / nig, fm = gid * WGM, gsz = (nM - fm) < WGM ? (nM - fm) : WGM;
        u.pm = fm + ((wgid % nig) % gsz); u.pn = (wgid % nig) / gsz; return true;
    }
    __device__ __forceinline__ void a_ready(const Unit&) const {}
    __device__ __forceinline__ void done(const Unit&) const {}
};

typedef float f32x2_t __attribute__((ext_vector_type(2))); typedef __bf16 bf16x2_t __attribute__((ext_vector_type(2)));
__device__ __forceinline__ unsigned cvtpk(float lo, float hi) { f32x2_t v = {lo, hi}; bf16x2_t b = __builtin_convertvector(v, bf16x2_t); return __builtin_bit_cast(unsigned, b); }
__device__ __forceinline__ float silu_f(float g) { return g * __builtin_amdgcn_rcpf(1.0f + __builtin_amdgcn_exp2f(-1.4426950408889634f * g)); }

struct EpiSwiGLU {
    static constexpr bool PERM = true, AFTER_DRAIN = false;
    bf16_t* H; int ldh;
    __device__ __forceinline__ void operator()(const f32x4 (&acc)[2][2][4][2], const Unit& u, int wr, int wc, int fr, int fq) const {
        const int row0 = u.pm * BM + wr * 64 + fr, col0 = u.pn * HALF + wc * 32 + 8 * fq;
#pragma unroll
        for (int ai = 0; ai < 2; ++ai)
#pragma unroll
            for (int m = 0; m < 4; ++m) {
                const f32x4 g0 = acc[ai][0][m][0], g1 = acc[ai][0][m][1], u0 = acc[ai][1][m][0], u1 = acc[ai][1][m][1];
                u32x4 w;
                w.x = cvtpk(silu_f(g0[0]) * u0[0], silu_f(g0[1]) * u0[1]); w.y = cvtpk(silu_f(g0[2]) * u0[2], silu_f(g0[3]) * u0[3]);
                w.z = cvtpk(silu_f(g1[0]) * u1[0], silu_f(g1[1]) * u1[1]); w.w = cvtpk(silu_f(g1[2]) * u1[2], silu_f(g1[3]) * u1[3]);
                *(u32x4*)(H + (size_t)(row0 + ai * HALF + m * 16) * ldh + col0) = w;
                if (m & 1) asm volatile("" ::: "memory");
            }
    }
};
struct EpiRes {
    static constexpr bool PERM = true, AFTER_DRAIN = false;
    const float* xin; float* yout; float alpha, s;
    __device__ __forceinline__ void operator()(const f32x4 (&acc)[2][2][4][2], const Unit& u, int wr, int wc, int fr, int fq) const {
        const int row0 = u.pm * BM + wr * 64 + fr, col0 = u.pn * BM + wc * 32 + 8 * fq;
#pragma unroll
        for (int ai = 0; ai < 2; ++ai)
#pragma unroll
            for (int m = 0; m < 4; ++m) {
                const size_t off = (size_t)(row0 + ai * HALF + m * 16) * 1024 + col0;
                const f32x4 x00 = *(const f32x4*)(xin + off), x01 = *(const f32x4*)(xin + off + 4), x10 = *(const f32x4*)(xin + off + HALF), x11 = *(const f32x4*)(xin + off + HALF + 4);
                *(f32x4*)(yout + off) = x00 * alpha + acc[ai][0][m][0] * s; *(f32x4*)(yout + off + 4) = x01 * alpha + acc[ai][0][m][1] * s;
                *(f32x4*)(yout + off + HALF) = x10 * alpha + acc[ai][1][m][0] * s; *(f32x4*)(yout + off + HALF + 4) = x11 * alpha + acc[ai][1][m][1] * s;
                if (m & 1) asm volatile("" ::: "memory");
            }
    }
};
struct EpiQKV {
    static constexpr bool PERM = true, AFTER_DRAIN = false;
    bf16_t* O; const float* rope; float qscale;
    __device__ __forceinline__ void operator()(const f32x4 (&acc)[2][2][4][2], const Unit& u, int wr, int wc, int fr, int fq) const {
        const int pn = u.pn, row0 = u.pm * BM + wr * 64 + fr, col0 = pn * BM + wc * 32 + 8 * fq, i0 = 16 * (wc & 1) + 4 * fq;
        const bool anyrope = (pn != 4 && pn != 5);
        const float sc = (pn < 2 || pn == 6 || pn == 7) ? qscale : 1.0f;
#pragma unroll
        for (int ai = 0; ai < 2; ++ai)
#pragma unroll
            for (int m = 0; m < 4; ++m) {
                const int row = row0 + ai * HALF + m * 16;
                f32x4 cs = (f32x4){1.f, 1.f, 1.f, 1.f}, sn = (f32x4){0.f, 0.f, 0.f, 0.f};
                if (anyrope) { cs = *(const f32x4*)(rope + (size_t)row * 64 + i0); sn = *(const f32x4*)(rope + (size_t)row * 64 + 32 + i0); }
#pragma unroll
                for (int bj = 0; bj < 2; ++bj) {
                    const bool rp = anyrope && !(pn == 8 && bj == 1);
                    f32x4 v0 = acc[ai][bj][m][0], v1 = acc[ai][bj][m][1];
                    if (rp) {
                        const f32x4 a0 = v0, a1 = v1;
                        v0[0] = a0[0] * cs[0] - a0[1] * sn[0]; v0[1] = a0[1] * cs[0] + a0[0] * sn[0];
                        v0[2] = a0[2] * cs[1] - a0[3] * sn[1]; v0[3] = a0[3] * cs[1] + a0[2] * sn[1];
                        v1[0] = a1[0] * cs[2] - a1[1] * sn[2]; v1[1] = a1[1] * cs[2] + a1[0] * sn[2];
                        v1[2] = a1[2] * cs[3] - a1[3] * sn[3]; v1[3] = a1[3] * cs[3] + a1[2] * sn[3];
                    }
                    v0 = v0 * sc; v1 = v1 * sc;
                    u32x4 w; w.x = cvtpk(v0[0], v0[1]); w.y = cvtpk(v0[2], v0[3]); w.z = cvtpk(v1[0], v1[1]); w.w = cvtpk(v1[2], v1[3]);
                    *(u32x4*)(O + (size_t)row * 2304 + col0 + bj * HALF) = w;
                }
            }
    }
};

template <class Epi, class Sched, bool ALIGN_EPI = false, bool SP2 = false>
__device__ __forceinline__ void gemm_phase(PG8_LAS unsigned char* lds, const Gemm g, const Sched& S, const Epi& E) {
    int tid_ = threadIdx.x; asm volatile("" : "+v"(tid_));
    const int tid = tid_, wid = __builtin_amdgcn_readfirstlane(tid >> 6), lane = tid & 63, wr = wid >> 2, wc = wid & 3, fr = lane & 15, fq = lane >> 4;
    const int K = g.K, nt = K / BK;
    unsigned voffA[2], voffB[2];
#pragma unroll
    for (int i = 0; i < 2; ++i) { int R, C; stage_rc(tid * 16 + i * 8192, R, C); const int Rb = Epi::PERM ? ((R & ~31) + perm32(R & 31)) : R;
        voffA[i] = (unsigned)(R * K + C) * 2u; voffB[i] = (unsigned)(Rb * K + C) * 2u; }
    const size_t kstep = (size_t)(BK * 2);
    const size_t hstep = (size_t)HALF * K * 2;
    const size_t tstep = 2 * hstep;
    const unsigned ldsw = (unsigned)wid * 1024u;
    const int aoff = lds_byte(wr * 64 + fr, fq * 8), boff = lds_byte(wc * 32 + fr, fq * 8);
#define PG8_SA(b, h) (((b) * 2 + (h)) * HTB)
#define PG8_SB(b, h) ((4 + (b) * 2 + (h)) * HTB)
#define PG8_STAGE(bufoff, gbase, voff) do { _Pragma("unroll") for (int _i = 0; _i < 2; ++_i) \
        __builtin_amdgcn_global_load_lds((const unsigned*)((const char*)(gbase) + (voff)[_i]), (PG8_LAS unsigned*)(lds + (bufoff) + ldsw + _i * 8192), 16, 0, 0); } while (0)
#define PG8_LDA(dst, b, h) do { _Pragma("unroll") for (int m = 0; m < 4; ++m) _Pragma("unroll") for (int k = 0; k < 2; ++k) dst[m][k] = *(const PG8_LAS bf16x8*)(lds + PG8_SA(b, h) + aoff + m * 2048 + k * 1024); } while (0)
#define PG8_LDB(dst, b, h) do { _Pragma("unroll") for (int n = 0; n < 2; ++n) _Pragma("unroll") for (int k = 0; k < 2; ++k) dst[n][k] = *(const PG8_LAS bf16x8*)(lds + PG8_SB(b, h) + boff + n * 2048 + k * 1024); } while (0)
#define PG8_MMA(ai, bj, At, Bt) do { __builtin_amdgcn_s_setprio(1); _Pragma("unroll") for (int m = 0; m < 4; ++m) _Pragma("unroll") for (int n = 0; n < 2; ++n) _Pragma("unroll") for (int k = 0; k < 2; ++k) \
        acc[ai][bj][m][n] = __builtin_amdgcn_mfma_f32_16x16x32_bf16(Bt[n][k], At[m][k], acc[ai][bj][m][n], 0, 0, 0); __builtin_amdgcn_s_setprio(0); } while (0)
#define PG8_WAIT_V(n) asm volatile("s_waitcnt vmcnt(" #n ")" ::: "memory")
#define PG8_WAIT_L(n) asm volatile("s_waitcnt lgkmcnt(" #n ")" ::: "memory")
#define PG8_BAR __builtin_amdgcn_s_barrier()
#define PG8_SCHED __builtin_amdgcn_sched_barrier(0)
    Unit cur, nxt; int ui = 0;
    if (!S.next(0, cur)) return;
    f32x4 acc[2][2][4][2];
#pragma unroll
    for (int a = 0; a < 2; ++a)
#pragma unroll
        for (int b = 0; b < 2; ++b)
#pragma unroll
            for (int m = 0; m < 4; ++m)
#pragma unroll
                for (int n = 0; n < 2; ++n) acc[a][b][m][n] = (f32x4){0.f, 0.f, 0.f, 0.f};
    bf16x8 At[4][2], B0[2][2], B1[2][2];
    const char* cA = (const char*)g.A + (size_t)cur.pm * tstep; const char* cB = (const char*)g.Bt + (size_t)cur.pn * tstep;
    S.a_ready(cur);
    if constexpr (SP2) {
        PG8_STAGE(PG8_SB(0, 0), cB, voffB); PG8_STAGE(PG8_SB(0, 1), cB + hstep, voffB); PG8_STAGE(PG8_SA(0, 0), cA, voffA); PG8_STAGE(PG8_SA(0, 1), cA + hstep, voffA);
        if (wr == 1) PG8_BAR;
        PG8_WAIT_V(2); PG8_BAR;
        PG8_STAGE(PG8_SB(1, 0), cB + kstep, voffB); PG8_STAGE(PG8_SA(1, 0), cA + kstep, voffA); PG8_STAGE(PG8_SB(1, 1), cB + hstep + kstep, voffB);
        PG8_WAIT_V(6); PG8_BAR;
    } else {
        PG8_STAGE(PG8_SB(0, 0), cB, voffB); PG8_STAGE(PG8_SA(0, 0), cA, voffA); PG8_STAGE(PG8_SB(0, 1), cB + hstep, voffB); PG8_STAGE(PG8_SA(0, 1), cA + hstep, voffA);
        if (wr == 1) PG8_BAR;
        PG8_WAIT_V(4); PG8_BAR;
        PG8_STAGE(PG8_SB(1, 0), cB + kstep, voffB); PG8_STAGE(PG8_SA(1, 0), cA + kstep, voffA); PG8_STAGE(PG8_SB(1, 1), cB + hstep + kstep, voffB);
        PG8_WAIT_V(6); PG8_BAR;
    }
    for (;;) {
        const bool has_next = S.next(ui + 1, nxt);
        const char* nA = has_next ? (const char*)g.A + (size_t)nxt.pm * tstep : cA; const char* nB = has_next ? (const char*)g.Bt + (size_t)nxt.pn * tstep : cB;
        for (int t = 0; t < nt; t += 2) {
            const bool last = (t == nt - 2);
            const char* a1 = cA + (size_t)(t + 1) * kstep;
            const char* a2 = last ? nA : cA + (size_t)(t + 2) * kstep; const char* b2 = last ? nB : cB + (size_t)(t + 2) * kstep;
            const char* a3 = a2 + kstep; const char* b3 = b2 + kstep;
            if (last && has_next) S.a_ready(nxt);
            if constexpr (SP2) {
            PG8_LDB(B0, 0, 0); PG8_LDB(B1, 0, 1); PG8_SCHED; PG8_LDA(At, 0, 0); PG8_STAGE(PG8_SA(1, 1), a1 + hstep, voffA);
            PG8_WAIT_V(8); PG8_WAIT_L(0); PG8_BAR; PG8_MMA(0, 0, At, B0); PG8_MMA(0, 1, At, B1); PG8_BAR; PG8_SCHED;
            PG8_LDA(At, 0, 1); PG8_STAGE(PG8_SB(0, 0), b2, voffB); PG8_STAGE(PG8_SB(0, 1), b2 + hstep, voffB); PG8_STAGE(PG8_SA(0, 0), a2, voffA);
            PG8_WAIT_V(8); PG8_WAIT_L(0); PG8_BAR; PG8_MMA(1, 0, At, B0); PG8_MMA(1, 1, At, B1); PG8_BAR; PG8_SCHED;
            PG8_LDB(B0, 1, 0); PG8_LDB(B1, 1, 1); PG8_SCHED; PG8_LDA(At, 1, 0); PG8_STAGE(PG8_SA(0, 1), a2 + hstep, voffA);
            PG8_WAIT_V(8); PG8_WAIT_L(0); PG8_BAR; PG8_MMA(0, 0, At, B0); PG8_MMA(0, 1, At, B1); PG8_BAR; PG8_SCHED;
            PG8_LDA(At, 1, 1); PG8_STAGE(PG8_SB(1, 0), b3, voffB); PG8_STAGE(PG8_SB(1, 1), b3 + hstep, voffB); PG8_STAGE(PG8_SA(1, 0), a3, voffA);
            PG8_WAIT_V(8); PG8_WAIT_L(0); PG8_BAR; PG8_MMA(1, 0, At, B0); PG8_MMA(1, 1, At, B1); PG8_BAR; PG8_SCHED;
            } else {
            PG8_LDB(B0, 0, 0); PG8_SCHED; PG8_LDA(At, 0, 0); PG8_STAGE(PG8_SA(1, 1), a1 + hstep, voffA);
            PG8_WAIT_L(8); PG8_BAR; PG8_WAIT_L(0); PG8_MMA(0, 0, At, B0); PG8_BAR; PG8_SCHED;
            PG8_LDB(B1, 0, 1); PG8_STAGE(PG8_SB(0, 0), b2, voffB);
            PG8_BAR; PG8_WAIT_L(0); PG8_MMA(0, 1, At, B1); PG8_BAR;
            PG8_LDA(At, 0, 1); PG8_STAGE(PG8_SA(0, 0), a2, voffA);
            PG8_BAR; PG8_WAIT_L(0); PG8_MMA(1, 0, At, B0); PG8_BAR; PG8_SCHED;
            PG8_STAGE(PG8_SB(0, 1), b2 + hstep, voffB);
            PG8_WAIT_V(6); PG8_BAR; PG8_MMA(1, 1, At, B1); PG8_BAR;
            PG8_LDB(B0, 1, 0); PG8_SCHED; PG8_LDA(At, 1, 0); PG8_STAGE(PG8_SA(0, 1), a2 + hstep, voffA);
            PG8_WAIT_L(8); PG8_BAR; PG8_WAIT_L(0); PG8_MMA(0, 0, At, B0); PG8_BAR; PG8_SCHED;
            PG8_LDB(B1, 1, 1); PG8_STAGE(PG8_SB(1, 0), b3, voffB);
            PG8_BAR; PG8_WAIT_L(0); PG8_MMA(0, 1, At, B1); PG8_BAR;
            PG8_LDA(At, 1, 1); PG8_STAGE(PG8_SA(1, 0), a3, voffA);
            PG8_BAR; PG8_WAIT_L(0); PG8_MMA(1, 0, At, B0); PG8_BAR; PG8_SCHED;
            PG8_STAGE(PG8_SB(1, 1), b3 + hstep, voffB);
            PG8_WAIT_V(6); PG8_BAR; PG8_MMA(1, 1, At, B1); PG8_BAR;
            }
        }
        if constexpr (ALIGN_EPI) { if (wr == 0) PG8_BAR; }
        if constexpr (!Epi::AFTER_DRAIN) { E(acc, cur, wr, wc, fr, fq); S.done(cur); }
        if (!has_next) break;
#pragma unroll
        for (int a = 0; a < 2; ++a)
#pragma unroll
            for (int b = 0; b < 2; ++b)
#pragma unroll
                for (int m = 0; m < 4; ++m)
#pragma unroll
                    for (int n = 0; n < 2; ++n) acc[a][b][m][n] = (f32x4){0.f, 0.f, 0.f, 0.f};
        cur = nxt; cA = nA; cB = nB; ++ui;
        if constexpr (ALIGN_EPI) { if (wr == 1) PG8_BAR; }
    }
    PG8_WAIT_V(0);
    if constexpr (!ALIGN_EPI) { if (wr == 0) PG8_BAR; }
    PG8_BAR;
    if constexpr (Epi::AFTER_DRAIN) { E.fused(acc, cur, wr, wc, fr, fq, lds, wid, lane); S.done(cur); }
#undef PG8_SA
#undef PG8_SB
#undef PG8_STAGE
#undef PG8_LDA
#undef PG8_LDB
#undef PG8_MMA
#undef PG8_WAIT_V
#undef PG8_WAIT_L
#undef PG8_BAR
#undef PG8_SCHED
}
}

namespace att {
using pg8::bf16_t; using pg8::bf16x8; using pg8::f32x4; using pg8::u32x4; using pg8::cvtpk;
#define ALDS __attribute__((address_space(3)))
typedef float f32x16 __attribute__((ext_vector_type(16)));
typedef short s16x4 __attribute__((ext_vector_type(4)));
typedef unsigned u32x2 __attribute__((ext_vector_type(2)));
constexpr int PITCH = 2304;
constexpr float THR = 8.0f;
__device__ __forceinline__ void glds16(const void* gsrc, unsigned lds_dst) { unsigned keep;
    asm volatile("s_mov_b32 %0, m0\n\ts_mov_b32 m0, %2\n\ts_nop 0\n\tglobal_load_lds_dwordx4 %1, off\n\ts_mov_b32 m0, %0" : "=&s"(keep) : "v"(gsrc), "s"(lds_dst) : "memory"); }
__device__ __forceinline__ unsigned rfl(unsigned v) { return (unsigned)__builtin_amdgcn_readfirstlane((int)v); }
__device__ __forceinline__ int pi23(int x) { return (x & ~12) | ((x & 4) << 1) | ((x & 8) >> 1); }
__device__ __forceinline__ s16x4 vtr(const ALDS unsigned char* p) { return __builtin_bit_cast(s16x4, __builtin_amdgcn_ds_read_tr16_b64_v4i16((ALDS s16x4*)p)); }
__device__ __forceinline__ float halfswap_max(float v) { auto rr = __builtin_amdgcn_permlane32_swap(__float_as_uint(v), __float_as_uint(v), false, false); return fmaxf(__uint_as_float(rr[0]), __uint_as_float(rr[1])); }
__device__ __forceinline__ float halfswap_sum(float v) { auto rr = __builtin_amdgcn_permlane32_swap(__float_as_uint(v), __float_as_uint(v), false, false); return __uint_as_float(rr[0]) + __uint_as_float(rr[1]); }

template <int DV, bool BAND>
__device__ __forceinline__ float attn_core(ALDS unsigned char* ring, const int wid, const int lane,
                                           const bf16_t* Qw, const bf16_t* ksrc, const bf16_t* vsrc, const int koff,
                                           const int t0, const int t1, const int tq, const int qpos, const float m_init, float l, f32x16 (&o)[DV / 32]) {
    constexpr int NDB = DV / 32, SLOT = (DV == 128) ? 32768 : 16384, VOFF = (DV == 128) ? 16384 : 8192, ROWB = DV * 2, NP = (DV == 128) ? 4 : 2;
    const int r32 = lane & 31, hi = lane >> 5;
    const unsigned ring_a = (unsigned)(uintptr_t)ring;
    bf16x8 qr[4];
#pragma unroll
    for (int d0 = 0; d0 < 4; ++d0) qr[d0] = *(const bf16x8*)(Qw + (size_t)r32 * PITCH + d0 * 16 + hi * 8);
#define ATT_ISSUE(t_, so_) do { const size_t go_ = (size_t)(t_) * (64 * PITCH); const unsigned d_ = ring_a + (unsigned)(so_) + (unsigned)wid * 1024u; \
        glds16(ksrc + go_, rfl(d_)); \
        if (DV == 128) { glds16(ksrc + go_ + 64, rfl(d_ + 8192u)); glds16(vsrc + go_, rfl(ring_a + (unsigned)(so_) + (unsigned)VOFF + (unsigned)wid * 2048u)); \
                         glds16(vsrc + go_ + 4 * PITCH, rfl(ring_a + (unsigned)(so_) + (unsigned)VOFF + (unsigned)wid * 2048u + 1024u)); } \
        else { glds16(vsrc + go_, rfl(d_ + (unsigned)VOFF)); } } while (0)
    ATT_ISSUE(t0, 0);
    { const int tn = (t0 + 1 < t1) ? t0 + 1 : t1 - 1; ATT_ISSUE(tn, SLOT); }
    const int g = (lane >> 4) & 1, q4 = (lane & 15) >> 2, p = lane & 3, sw = (DV == 128) ? q4 : (q4 >> 1);
    int va[NDB];
#pragma unroll
    for (int db = 0; db < NDB; ++db) va[db] = VOFF + (8 * hi + q4) * ROWB + ((db ^ sw) << 6) + (2 * g + (p >> 1)) * 16 + 8 * (p & 1);
    const int ka = koff + hi * 1024 + r32 * 16;
    float m = m_init;
    f32x16 negm;
#pragma unroll
    for (int r = 0; r < 16; ++r) negm[r] = -m;
#pragma unroll
    for (int db = 0; db < NDB; ++db)
#pragma unroll
        for (int r = 0; r < 16; ++r) o[db][r] = 0.f;
    int s_cur = 0, s_n2 = 2 * SLOT;
    for (int t = t0; t < t1; ++t) {
        asm volatile("s_waitcnt vmcnt(%0)" :: "n"(NP) : "memory");
        asm volatile("s_waitcnt lgkmcnt(0)\n\ts_barrier" ::: "memory");
        { const int tn = (t + 2 < t1) ? t + 2 : t1 - 1; ATT_ISSUE(tn, s_n2); }
        const ALDS unsigned char* sb = ring + s_cur;
        f32x16 p0 = negm, p1 = negm;
#pragma unroll
        for (int d0 = 0; d0 < 4; ++d0) {
            const bf16x8 k0 = *(const ALDS bf16x8*)(sb + ka + d0 * 2048), k1 = *(const ALDS bf16x8*)(sb + ka + d0 * 2048 + 512);
            p0 = __builtin_amdgcn_mfma_f32_32x32x16_bf16(k0, qr[d0], p0, 0, 0, 0);
            p1 = __builtin_amdgcn_mfma_f32_32x32x16_bf16(k1, qr[d0], p1, 0, 0, 0);
        }
        if (BAND) {
            if (t == tq - 2 || t == tq + 2) {
                const int rel0 = t * 64 + 8 * hi - qpos;
#pragma unroll
                for (int r = 0; r < 16; ++r) { const int rel = rel0 + 16 * (r >> 3) + (r & 7);
                    if (rel < -128 || rel > 128) p0[r] = -INFINITY;
                    if (rel + 32 < -128 || rel + 32 > 128) p1[r] = -INFINITY; }
            }
        }
        float mx = fmaxf(p0[0], p1[0]);
#pragma unroll
        for (int r = 1; r < 16; ++r) mx = fmaxf(fmaxf(mx, p0[r]), p1[r]);
        mx = halfswap_max(mx);
        const bool first = (!BAND) && (t == t0);
        const float dl = first ? mx : ((mx > THR) ? mx : 0.f);
        if (__any(dl != 0.f)) {
            m += dl;
#pragma unroll
            for (int r = 0; r < 16; ++r) { p0[r] -= dl; p1[r] -= dl; negm[r] = -m; }
            const float f = first ? 1.f : __builtin_amdgcn_exp2f(-dl);
            l *= f;
#pragma unroll
            for (int db = 0; db < NDB; ++db)
#pragma unroll
                for (int r = 0; r < 16; ++r) o[db][r] *= f;
        }
        float s0 = 0.f, s1 = 0.f;
#pragma unroll
        for (int r = 0; r < 16; ++r) { p0[r] = __builtin_amdgcn_exp2f(p0[r]); p1[r] = __builtin_amdgcn_exp2f(p1[r]); s0 += p0[r]; s1 += p1[r]; }
        l += s0 + s1;
        bf16x8 pf[4];
        { u32x4 w;
          w.x = cvtpk(p0[0], p0[1]); w.y = cvtpk(p0[2], p0[3]); w.z = cvtpk(p0[4], p0[5]); w.w = cvtpk(p0[6], p0[7]); pf[0] = __builtin_bit_cast(bf16x8, w);
          w.x = cvtpk(p0[8], p0[9]); w.y = cvtpk(p0[10], p0[11]); w.z = cvtpk(p0[12], p0[13]); w.w = cvtpk(p0[14], p0[15]); pf[1] = __builtin_bit_cast(bf16x8, w);
          w.x = cvtpk(p1[0], p1[1]); w.y = cvtpk(p1[2], p1[3]); w.z = cvtpk(p1[4], p1[5]); w.w = cvtpk(p1[6], p1[7]); pf[2] = __builtin_bit_cast(bf16x8, w);
          w.x = cvtpk(p1[8], p1[9]); w.y = cvtpk(p1[10], p1[11]); w.z = cvtpk(p1[12], p1[13]); w.w = cvtpk(p1[14], p1[15]); pf[3] = __builtin_bit_cast(bf16x8, w); }
#pragma unroll
        for (int db = 0; db < NDB; ++db)
#pragma unroll
            for (int ks = 0; ks < 4; ++ks) {
                const s16x4 lo = vtr(sb + va[db] + ks * (16 * ROWB)), hh = vtr(sb + va[db] + ks * (16 * ROWB) + 4 * ROWB);
                const bf16x8 vf = (bf16x8){lo[0], lo[1], lo[2], lo[3], hh[0], hh[1], hh[2], hh[3]};
                o[db] = __builtin_amdgcn_mfma_f32_32x32x16_bf16(vf, pf[ks], o[db], 0, 0, 0);
            }
        s_cur = (s_cur == 2 * SLOT) ? 0 : s_cur + SLOT; s_n2 = (s_n2 == 2 * SLOT) ? 0 : s_n2 + SLOT;
    }
    asm volatile("s_waitcnt vmcnt(0) lgkmcnt(0)\n\ts_barrier" ::: "memory");
#undef ATT_ISSUE
    return l;
}

__device__ __forceinline__ void diff_unit(ALDS unsigned char* ring, const int wid, int lane, const bf16_t* qkv, bf16_t* ymix, const int u, const float lam, const float post, const float* subg) {
    asm volatile("" : "+v"(lane));
    const int bh = u >> 5, qb = u & 31, b = bh >> 2, h = bh & 3, comp = wid >> 2, wq = wid & 3, r32 = lane & 31, hi = lane >> 5;
    const size_t rowbase = (size_t)b * 4096;
    const int q0 = qb * 128 + wq * 32;
    const bf16_t* Qw = qkv + (rowbase + q0) * PITCH + h * 128 + comp * 64;
    const bf16_t* ksrc = qkv + (rowbase + pi23(lane)) * PITCH + 512 + h * 128 + wid * 8;
    const bf16_t* vsrc = qkv + (rowbase + 8 * wid + (lane >> 4)) * PITCH + 1024 + h * 128 + (((lane & 15) ^ ((lane >> 4) << 2)) * 8);
    f32x16 o[4];
    float l = attn_core<128, false>(ring, wid, lane, Qw, ksrc, vsrc, comp * 8192, 0, 64, 0, 0, 0.f, 0.f, o);
    l = halfswap_sum(l);
    const float inv = 1.0f / l;
    ALDS f32x4* X = (ALDS f32x4*)ring + (size_t)wq * (16 * 64);
    if (comp == 1) {
#pragma unroll
        for (int db = 0; db < 4; ++db)
#pragma unroll
            for (int rq = 0; rq < 4; ++rq) X[(db * 4 + rq) * 64 + lane] = (f32x4){o[db][4 * rq] * inv, o[db][4 * rq + 1] * inv, o[db][4 * rq + 2] * inv, o[db][4 * rq + 3] * inv};
    }
    asm volatile("s_waitcnt lgkmcnt(0)\n\ts_barrier" ::: "memory");
    if (comp == 0) {
        float ss = 0.f;
#pragma unroll
        for (int db = 0; db < 4; ++db)
#pragma unroll
            for (int rq = 0; rq < 4; ++rq) { const f32x4 o2 = X[(db * 4 + rq) * 64 + lane];
#pragma unroll
                for (int e = 0; e < 4; ++e) { const float d = o[db][4 * rq + e] * inv - lam * o2[e]; o[db][4 * rq + e] = d; ss += d * d; } }
        ss = halfswap_sum(ss);
        const float rs = rsqrtf(ss * (1.0f / 128.0f) + 1e-5f) * post;
        bf16_t* orow = ymix + (rowbase + q0 + r32) * 1024 + h * 128 + 4 * hi;
#pragma unroll
        for (int db = 0; db < 4; ++db)
#pragma unroll
            for (int rq = 0; rq < 4; ++rq) { const f32x4 gv = *(const f32x4*)(subg + 32 * db + 8 * rq + 4 * hi);
                u32x2 w; w.x = cvtpk(o[db][4 * rq] * rs * gv[0], o[db][4 * rq + 1] * rs * gv[1]); w.y = cvtpk(o[db][4 * rq + 2] * rs * gv[2], o[db][4 * rq + 3] * rs * gv[3]);
                *(u32x2*)(orow + 32 * db + 8 * rq) = w; }
    }
    asm volatile("s_waitcnt lgkmcnt(0)\n\ts_barrier" ::: "memory");
}

__device__ __forceinline__ void swa_unit(ALDS unsigned char* ring, const int wid, int lane, const bf16_t* qkv, bf16_t* ymix, const int u, const float* sink) {
    asm volatile("" : "+v"(lane));
    const int bkv = u >> 6, qblk = u & 63, b = bkv >> 1, kvh = bkv & 1, head = kvh * 4 + (wid >> 1), r32 = lane & 31, hi = lane >> 5;
    const size_t rowbase = (size_t)b * 4096;
    const int q0 = qblk * 64 + (wid & 1) * 32;
    const bf16_t* Qw = qkv + (rowbase + q0) * PITCH + 1536 + head * 64;
    const bf16_t* ksrc = qkv + (rowbase + pi23(lane)) * PITCH + 2048 + kvh * 64 + wid * 8;
    const bf16_t* vsrc = qkv + (rowbase + 8 * wid + (lane >> 3)) * PITCH + 2176 + kvh * 64 + (((lane & 7) ^ (((lane >> 4) & 1) << 2)) * 8);
    const int t0 = (qblk - 2 > 0) ? qblk - 2 : 0, t1 = ((qblk + 2 < 63) ? qblk + 2 : 63) + 1;
    f32x16 o[2];
    float l = attn_core<64, true>(ring, wid, lane, Qw, ksrc, vsrc, 0, t0, t1, qblk, q0 + r32, sink[head] * 1.4426950408889634f, (hi == 0) ? 1.0f : 0.0f, o);
    l = halfswap_sum(l);
    const float inv = 1.0f / l;
    bf16_t* orow = ymix + (rowbase + q0 + r32) * 1024 + 512 + head * 64 + 4 * hi;
#pragma unroll
    for (int db = 0; db < 2; ++db)
#pragma unroll
        for (int rq = 0; rq < 4; ++rq) { u32x2 w; w.x = cvtpk(o[db][4 * rq] * inv, o[db][4 * rq + 1] * inv); w.y = cvtpk(o[db][4 * rq + 2] * inv, o[db][4 * rq + 3] * inv);
            *(u32x2*)(orow + 32 * db + 8 * rq) = w; }
}
}

constexpr int NWAVES = 8;
constexpr int M = 65536, D = 1024, FF = 2816, NIN = 2304, SEQ = 4096, DEPTH = 4;
constexpr size_t MiB = 1u << 20;
constexpr size_t W1_OFF = 0, W1_B = (size_t)2 * FF * D * 2, W2_OFF = W1_OFF + W1_B, W2_B = (size_t)D * FF * 2, WIN_OFF = W2_OFF + W2_B, WIN_B = (size_t)NIN * D * 2,
                 WO_OFF = WIN_OFF + WIN_B, WO_B = (size_t)D * D * 2, W3_OFF = WO_OFF + WO_B, W4_OFF = W3_OFF + W1_B, WL_STRIDE = W4_OFF + W2_B;
constexpr size_t WS_W = 0, WS_ROPE = 160 * MiB, WS_XB = 176 * MiB, WS_H = 304 * MiB, WS_YM = 656 * MiB, WS_END = 784 * MiB;
static_assert(WL_STRIDE * DEPTH <= WS_ROPE && WS_ROPE + (size_t)M * 64 * 4 <= WS_XB && WS_XB + (size_t)M * D * 2 <= WS_H && WS_H + (size_t)M * FF * 2 <= WS_YM && WS_YM + (size_t)M * D * 2 <= WS_END, "d_ws map");
constexpr int LDS_BYTES = 147456;
constexpr float ALPHA = 1.681792830507429f;
constexpr float QSCALE = 0.125f * 1.4426950408889634f;

typedef unsigned short bf16;
typedef float f32x4 __attribute__((ext_vector_type(4)));
typedef unsigned v4u __attribute__((ext_vector_type(4)));
typedef unsigned v2u __attribute__((ext_vector_type(2)));
using pg8::cvtpk;

struct Args { const float* in[13]; float* out; unsigned char* ws; float inv[32]; float lam_init[4]; };

__device__ __forceinline__ float wave_sum(float v) {
#pragma unroll
    for (int o = 1; o < 64; o <<= 1) v += __shfl_xor(v, o);
    return v;
}
__device__ __forceinline__ int src_col(int type, int n) {
    if (type == 1) { const int pn = n >> 8, w = n & 255; return (w < 128) ? (128 * pn + w) : (FF + 128 * pn + (w - 128)); }
    if (type == 2) { const bool rp = (n < 1024) || (n >= 1536 && n < 2176); return rp ? ((n & ~63) + ((n & 63) >> 1) + 32 * (n & 1)) : n; }
    return n;
}
__device__ __forceinline__ void transpose_item(const float* W, int K, int N, int type, bf16* WT, ALDS float* scr, int item, int lane) {
    const int nblk = N / 32, kb = item / nblk, nb = item % nblk, k0 = 64 * kb, n0 = 32 * nb;
    const int sc = src_col(type, n0 + (lane & 31));
#pragma unroll 8
    for (int i = 0; i < 32; ++i) { const int kk = 2 * i + (lane >> 5); scr[kk * 33 + (lane & 31)] = W[(size_t)(k0 + kk) * N + sc]; }
    asm volatile("s_waitcnt lgkmcnt(0)" ::: "memory");
    const int c = lane & 7;
#pragma unroll
    for (int j = 0; j < 4; ++j) { const int n = (lane >> 3) + 8 * j; const ALDS float* s = scr + (8 * c) * 33 + n;
        v4u o; o.x = cvtpk(s[0 * 33], s[1 * 33]); o.y = cvtpk(s[2 * 33], s[3 * 33]); o.z = cvtpk(s[4 * 33], s[5 * 33]); o.w = cvtpk(s[6 * 33], s[7 * 33]);
        *(v4u*)(WT + (size_t)(n0 + n) * K + k0 + 8 * c) = o; }
    asm volatile("s_waitcnt lgkmcnt(0)" ::: "memory");
}
__device__ __forceinline__ void sincos_f32angle(float ang, float& c, float& s) {
    const double a = (double)ang, k = __builtin_rint(a * 0.63661977236758134308);
    double r = __builtin_fma(-k, 1.57079632679489655800e+00, a); r = __builtin_fma(-k, 6.12323399573676603587e-17, r);
    const double r2 = r * r;
    double sp = -1.0 / 1307674368000.0; sp = sp * r2 + 1.0 / 6227020800.0; sp = sp * r2 - 1.0 / 39916800.0; sp = sp * r2 + 1.0 / 362880.0; sp = sp * r2 - 1.0 / 5040.0; sp = sp * r2 + 1.0 / 120.0; sp = sp * r2 - 1.0 / 6.0;
    const double sn = r + r * r2 * sp;
    double cp = 1.0 / 20922789888000.0; cp = cp * r2 - 1.0 / 87178291200.0; cp = cp * r2 + 1.0 / 479001600.0; cp = cp * r2 - 1.0 / 3628800.0; cp = cp * r2 + 1.0 / 40320.0; cp = cp * r2 - 1.0 / 720.0; cp = cp * r2 + 1.0 / 24.0; cp = cp * r2 - 0.5;
    const double cn = 1.0 + r2 * cp;
    const int q = ((int)k) & 3;
    const double cc = (q == 0) ? cn : (q == 1) ? -sn : (q == 2) ? -cn : sn;
    const double ss = (q == 0) ? sn : (q == 1) ? cn : (q == 2) ? -sn : -cn;
    c = (float)cc; s = (float)ss;
}
__device__ __forceinline__ void ln_row(const float* xrow, const float* g, const float* bta, float* orow, bf16* brow, int lane) {
    asm volatile("" : "+v"(lane));
    const f32x4* xr = (const f32x4*)xrow + lane;
    f32x4 v[4]; float s = 0.f;
#pragma unroll
    for (int j = 0; j < 4; ++j) { v[j] = xr[64 * j]; s += (v[j][0] + v[j][1]) + (v[j][2] + v[j][3]); }
    const float mean = wave_sum(s) * (1.f / D); float s2 = 0.f;
#pragma unroll
    for (int j = 0; j < 4; ++j) { v[j] = v[j] - mean; s2 += (v[j][0] * v[j][0] + v[j][1] * v[j][1]) + (v[j][2] * v[j][2] + v[j][3] * v[j][3]); }
    const float rstd = 1.0f / sqrtf(wave_sum(s2) * (1.f / D) + 1e-5f);
#pragma unroll
    for (int j = 0; j < 4; ++j) { const f32x4 gg = *((const f32x4*)g + lane + 64 * j), bb = *((const f32x4*)bta + lane + 64 * j);
        const f32x4 y = v[j] * rstd * gg + bb;
        *((f32x4*)orow + lane + 64 * j) = y;
        v2u w; w.x = cvtpk(y[0], y[1]); w.y = cvtpk(y[2], y[3]); *((v2u*)brow + lane + 64 * j) = w; }
}

__global__ void __launch_bounds__(NWAVES * 64, 2) fwd_megakernel(Args args) {
    extern __shared__ __attribute__((aligned(16))) unsigned char lds_raw[];
    cg::grid_group grid = cg::this_grid();
    ALDS unsigned char* lds = (ALDS unsigned char*)lds_raw;
    const int tid = threadIdx.x, lane = tid & 63, wave = __builtin_amdgcn_readfirstlane(tid >> 6);
    const int G = gridDim.x, bx = blockIdx.x, vcu = (G % 8 == 0) ? (bx % 8) * (G / 8) + bx / 8 : bx;
    unsigned char* ws = args.ws;
    const float* x_in = args.in[0]; const int* positions = (const int*)args.in[1];
    float* out = args.out;
    bf16* XB = (bf16*)(ws + WS_XB); bf16* HB = (bf16*)(ws + WS_H); bf16* QKV = (bf16*)(ws + WS_H); bf16* YM = (bf16*)(ws + WS_YM);
    float* ROPE = (float*)(ws + WS_ROPE);
    const int gw = vcu * NWAVES + wave, NGW = G * NWAVES;

    {
        ALDS float* scr = (ALDS float*)(lds + wave * 16384);
        constexpr int I1 = (D / 64) * (2 * FF / 32), I2 = (FF / 64) * (D / 32), I3 = (D / 64) * (NIN / 32), I4 = (D / 64) * (D / 32), IL = 2 * I1 + 2 * I2 + I3 + I4;
        for (int it = gw; it < IL * DEPTH; it += NGW) {
            const int l = it / IL; int r = it % IL;
            unsigned char* wl = ws + WS_W + (size_t)l * WL_STRIDE;
            if (r < I1) { transpose_item(args.in[7] + (size_t)l * D * 2 * FF, D, 2 * FF, 1, (bf16*)(wl + W1_OFF), scr, r, lane); continue; } r -= I1;
            if (r < I2) { transpose_item(args.in[8] + (size_t)l * FF * D, FF, D, 0, (bf16*)(wl + W2_OFF), scr, r, lane); continue; } r -= I2;
            if (r < I3) { transpose_item(args.in[2] + (size_t)l * D * NIN, D, NIN, 2, (bf16*)(wl + WIN_OFF), scr, r, lane); continue; } r -= I3;
            if (r < I4) { transpose_item(args.in[3] + (size_t)l * D * D, D, D, 0, (bf16*)(wl + WO_OFF), scr, r, lane); continue; } r -= I4;
            if (r < I1) { transpose_item(args.in[9] + (size_t)l * D * 2 * FF, D, 2 * FF, 1, (bf16*)(wl + W3_OFF), scr, r, lane); continue; } r -= I1;
            transpose_item(args.in[10] + (size_t)l * FF * D, FF, D, 0, (bf16*)(wl + W4_OFF), scr, r, lane);
        }
        const size_t gt = (size_t)vcu * (NWAVES * 64) + tid, GT = (size_t)G * NWAVES * 64;
        for (size_t i = gt; i < (size_t)M * D / 4; i += GT) { const f32x4 v = *((const f32x4*)x_in + i); v2u w; w.x = cvtpk(v[0], v[1]); w.y = cvtpk(v[2], v[3]); *((v2u*)XB + i) = w; }
        for (size_t i = gt; i < (size_t)M * 32; i += GT) { const int row = (int)(i >> 5), k = (int)(i & 31); float c, s; sincos_f32angle((float)positions[row] * args.inv[k], c, s);
            ROPE[(size_t)row * 64 + k] = c; ROPE[(size_t)row * 64 + 32 + k] = s; }
    }
    grid.sync();

    for (int l = 0; l < DEPTH; ++l) {
        unsigned char* wl = ws + WS_W + (size_t)l * WL_STRIDE;
        const float* lng = args.in[11] + (size_t)l * 3 * D; const float* lnb = args.in[12] + (size_t)l * 3 * D;
#ifndef NO_G1
        { pg8::Gemm g{XB, (const bf16*)(wl + W1_OFF), M, 2 * FF, D}; pg8::StaticOrder S; S.init(M, 2 * FF, G, bx); pg8::EpiSwiGLU E{HB, FF};
          pg8::gemm_phase<pg8::EpiSwiGLU, pg8::StaticOrder, true, true>(lds, g, S, E); }
#endif
        grid.sync();
#ifndef NO_G2
        { pg8::Gemm g{HB, (const bf16*)(wl + W2_OFF), M, D, FF}; pg8::StaticOrder S; S.init(M, D, G, bx); pg8::EpiRes E{(l == 0) ? x_in : (const float*)out, out, ALPHA, 0.5f};
          pg8::gemm_phase<pg8::EpiRes, pg8::StaticOrder, true, true>(lds, g, S, E); }
#endif
        grid.sync();
        for (int m = gw; m < M; m += NGW) ln_row(out + (size_t)m * D, lng, lnb, out + (size_t)m * D, XB + (size_t)m * D, lane);
        grid.sync();
#ifndef NO_G3
        { pg8::Gemm g{XB, (const bf16*)(wl + WIN_OFF), M, NIN, D}; pg8::StaticOrder S; S.init(M, NIN, G, bx); pg8::EpiQKV E{QKV, ROPE, QSCALE};
          pg8::gemm_phase<pg8::EpiQKV, pg8::StaticOrder, true, true>(lds, g, S, E); }
#endif
        grid.sync();
        {
            const float* lv = args.in[4] + (size_t)l * 256;
            const float a1 = wave_sum(lv[lane] * lv[64 + lane]), a2 = wave_sum(lv[128 + lane] * lv[192 + lane]);
            const float lam_init = args.lam_init[l], lam = expf(a1) - expf(a2) + lam_init;
            const float* subg = args.in[5] + (size_t)l * 128; const float* sink = args.in[6] + (size_t)l * 8;
#ifndef NO_DIFF
            for (int u = vcu; u < 2048; u += G) att::diff_unit(lds, wave, lane, QKV, YM, u, lam, 1.0f - lam_init, subg);
#endif
#ifndef NO_SWA
            for (int u = vcu; u < 2048; u += G) att::swa_unit(lds, wave, lane, QKV, YM, u, sink);
#endif
        }
        grid.sync();
#ifndef NO_G2
        { pg8::Gemm g{YM, (const bf16*)(wl + WO_OFF), M, D, D}; pg8::StaticOrder S; S.init(M, D, G, bx); pg8::EpiRes E{out, out, ALPHA, 1.0f};
          pg8::gemm_phase<pg8::EpiRes, pg8::StaticOrder, true, true>(lds, g, S, E); }
#endif
        grid.sync();
        for (int m = gw; m < M; m += NGW) ln_row(out + (size_t)m * D, lng + D, lnb + D, out + (size_t)m * D, XB + (size_t)m * D, lane);
        grid.sync();
#ifndef NO_G1
        { pg8::Gemm g{XB, (const bf16*)(wl + W3_OFF), M, 2 * FF, D}; pg8::StaticOrder S; S.init(M, 2 * FF, G, bx); pg8::EpiSwiGLU E{HB, FF};
          pg8::gemm_phase<pg8::EpiSwiGLU, pg8::StaticOrder, true, true>(lds, g, S, E); }
#endif
        grid.sync();
#ifndef NO_G2
        { pg8::Gemm g{HB, (const bf16*)(wl + W4_OFF), M, D, FF}; pg8::StaticOrder S; S.init(M, D, G, bx); pg8::EpiRes E{out, out, ALPHA, 0.5f};
          pg8::gemm_phase<pg8::EpiRes, pg8::StaticOrder, true, true>(lds, g, S, E); }
#endif
        grid.sync();
        for (int m = gw; m < M; m += NGW) ln_row(out + (size_t)m * D, lng + 2 * D, lnb + 2 * D, out + (size_t)m * D, XB + (size_t)m * D, lane);
        if (l + 1 < DEPTH) grid.sync();
    }
}

extern "C" void kernel_launch(void* const* d_in, const int* in_sizes, int n_in, void* d_out, int out_size, void* d_ws, size_t ws_size, hipStream_t stream) {
    static int grid = 0;
    if (grid == 0) {
        if (n_in != 13 || in_sizes[0] != M * D || out_size != M * D || ws_size < WS_END) { fprintf(stderr, "kernel_launch: unexpected shapes (n_in %d, in0 %d, out %d, ws %zu); nothing launched\n", n_in, n_in > 0 ? in_sizes[0] : -1, out_size, ws_size); grid = -1; return; }
        int dev = 0, cus = 0, per_cu = 0;
        if (hipGetDevice(&dev) != hipSuccess || hipDeviceGetAttribute(&cus, hipDeviceAttributeMultiprocessorCount, dev) != hipSuccess) { grid = -1; return; }
        if (hipFuncSetAttribute((const void*)fwd_megakernel, hipFuncAttributeMaxDynamicSharedMemorySize, LDS_BYTES) != hipSuccess) { fprintf(stderr, "kernel_launch: hipFuncSetAttribute failed\n"); grid = -1; return; }
        if (hipOccupancyMaxActiveBlocksPerMultiprocessor(&per_cu, (const void*)fwd_megakernel, NWAVES * 64, LDS_BYTES) != hipSuccess || per_cu < 1) { fprintf(stderr, "kernel_launch: occupancy query gives %d\n", per_cu); per_cu = 1; }
        (void)hipGetLastError();
        grid = cus * 1;
    }
    if (grid < 0) return;
    Args a{};
    for (int i = 0; i < 13; ++i) a.in[i] = (const float*)d_in[i];
    a.out = (float*)d_out; a.ws = (unsigned char*)d_ws;
    for (int i = 0; i < 32; ++i) a.inv[i] = (float)pow(10000.0, -(double)(2 * i) / 64.0);
    for (int l = 0; l < 4; ++l) a.lam_init[l] = (float)(0.8 - 0.6 * exp(-0.3 * (double)l));
    void* kargs[] = {&a};
    const hipError_t e = hipLaunchCooperativeKernel((const void*)fwd_megakernel, dim3(grid), dim3(NWAVES * 64), kargs, LDS_BYTES, stream);
    if (e != hipSuccess) fprintf(stderr, "kernel_launch: cooperative launch failed: %s (grid %d)\n", hipGetErrorString(e), grid);
}
```

```cpp
#include <hip/hip_runtime.h>
#include <hip/hip_cooperative_groups.h>
#include <cstdio>
#include <cstdint>
#include <cmath>
namespace cg = cooperative_groups;
namespace pg8 {
#define PG8_LAS __attribute__((address_space(3)))
typedef unsigned short bf16_t;
typedef short bf16x8 __attribute__((ext_vector_type(8)));
typedef float f32x4 __attribute__((ext_vector_type(4)));
typedef unsigned u32x4 __attribute__((ext_vector_type(4)));
constexpr int BM = 256, BK = 64, HALF = 128, HTB = HALF * BK * 2  , STAGE_BYTES = 8 * HTB, NXCD = 8, WGM = 8;

__host__ __device__ __forceinline__ int lds_byte(int r, int c) { const int st = (r >> 4) * 2 + (c >> 5), rr = r & 15, cc = c & 31, ob = rr * 64 + cc * 2; return st * 1024 + (ob ^ (((ob >> 9) & 1) << 5)); }
__host__ __device__ __forceinline__ void stage_rc(int b, int& R, int& C) { const int st = b / 1024, sb = b % 1024, swz = sb ^ (((sb >> 9) & 1) << 5); R = (st >> 1) * 16 + swz / 64; C = (st & 1) * 32 + (swz % 64) / 2; }
__host__ __device__ __forceinline__ int perm32(int rho) { const int n = rho >> 4, i = rho & 15; return 8 * (i >> 2) + 4 * n + (i & 3); }

struct Unit { int pm, pn; };
struct Gemm { const bf16_t* A; const bf16_t* Bt; int M, N, K; };

struct StaticOrder {
    int nM, nN, nwg, G, c;
    __host__ __device__ void init(int M, int N, int G_, int c_) { nM = M / BM; nN = N / BM; nwg = nM * nN; G = G_; c = c_; }
    __host__ __device__ bool next(int i, Unit& u) const {
        const long L = (long)i * G + c; if (L >= nwg) return false;
        int wgid = (int)L; { const int q = nwg / NXCD, r = nwg % NXCD, xcd = wgid % NXCD, off = wgid / NXCD; wgid = (xcd < r ? xcd * (q + 1) : r * (q + 1) + (xcd - r) * q) + off; }
        const int nig = WGM * nN, gid = wgid / nig, fm = gid * WGM, gsz = (nM - fm) < WGM ? (nM - fm) : WGM;
        u.pm = fm + ((wgid % nig) % gsz); u.pn = (wgid % nig) / gsz; return true;
    }
    __device__ __forceinline__ void a_ready(const Unit&) const {}
    __device__ __forceinline__ void done(const Unit&) const {}
};

typedef float f32x2_t __attribute__((ext_vector_type(2))); typedef __bf16 bf16x2_t __attribute__((ext_vector_type(2)));
__device__ __forceinline__ unsigned cvtpk(float lo, float hi) { f32x2_t v = {lo, hi}; bf16x2_t b = __builtin_convertvector(v, bf16x2_t); return __builtin_bit_cast(unsigned, b); }
__device__ __forceinline__ float silu_f(float g) { return g * __builtin_amdgcn_rcpf(1.0f + __builtin_amdgcn_exp2f(-1.4426950408889634f * g)); }

typedef float f32x2v __attribute__((ext_vector_type(2)));
struct RowLN {
    const float* st; const float* cs; const float* bw;
    __device__ __forceinline__ void row(int r, float& a, float& c) const {
        if (st) { const f32x2v s = *(const f32x2v*)(st + 2 * (size_t)r); const float mu = s.x * (1.0f / 1024.0f), var = s.y * (1.0f / 1024.0f) - mu * mu; a = rsqrtf(var + 1e-5f); c = -a * mu; }
        else { a = 1.0f; c = 0.0f; }
    }
};
struct EpiSwiGLU {
    static constexpr bool PERM = true, AFTER_DRAIN = false;
    bf16_t* H; int ldh; RowLN ln;
    __device__ __forceinline__ void operator()(const f32x4 (&acc)[2][2][4][2], const Unit& u, int wr, int wc, int fr, int fq) const {
        const int row0 = u.pm * BM + wr * 64 + fr, col0 = u.pn * HALF + wc * 32 + 8 * fq, wrow0 = u.pn * BM + wc * 32 + 8 * fq;
        f32x4 cs[2][2], bw[2][2];
#pragma unroll
        for (int bj = 0; bj < 2; ++bj)
#pragma unroll
            for (int n = 0; n < 2; ++n) { const f32x4 z = (f32x4){0.f, 0.f, 0.f, 0.f}; cs[bj][n] = ln.st ? *(const f32x4*)(ln.cs + wrow0 + bj * HALF + 4 * n) : z; bw[bj][n] = ln.st ? *(const f32x4*)(ln.bw + wrow0 + bj * HALF + 4 * n) : z; }
#pragma unroll
        for (int ai = 0; ai < 2; ++ai)
#pragma unroll
            for (int m = 0; m < 4; ++m) {
                const int row = row0 + ai * HALF + m * 16; float a, c; ln.row(row, a, c);
                const f32x4 g0 = acc[ai][0][m][0] * a + cs[0][0] * c + bw[0][0], g1 = acc[ai][0][m][1] * a + cs[0][1] * c + bw[0][1];
                const f32x4 u0 = acc[ai][1][m][0] * a + cs[1][0] * c + bw[1][0], u1 = acc[ai][1][m][1] * a + cs[1][1] * c + bw[1][1];
                u32x4 w;
                w.x = cvtpk(silu_f(g0[0]) * u0[0], silu_f(g0[1]) * u0[1]); w.y = cvtpk(silu_f(g0[2]) * u0[2], silu_f(g0[3]) * u0[3]);
                w.z = cvtpk(silu_f(g1[0]) * u1[0], silu_f(g1[1]) * u1[1]); w.w = cvtpk(silu_f(g1[2]) * u1[2], silu_f(g1[3]) * u1[3]);
                *(u32x4*)(H + (size_t)row * ldh + col0) = w;
                if (m & 1) asm volatile("" ::: "memory");
            }
    }
};
struct EpiRes {
    static constexpr bool PERM = true, AFTER_DRAIN = false;
    const float* yprev; float* yout; bf16_t* yb; const float* st; const float* g; const float* b; float* st_new; float alpha, s;
    __device__ __forceinline__ void operator()(const f32x4 (&acc)[2][2][4][2], const Unit& u, int wr, int wc, int fr, int fq) const {
        const int row0 = u.pm * BM + wr * 64 + fr, col0 = u.pn * BM + wc * 32 + 8 * fq;
        f32x4 gv[2][2], bv[2][2];
#pragma unroll
        for (int bj = 0; bj < 2; ++bj)
#pragma unroll
            for (int n = 0; n < 2; ++n) { gv[bj][n] = st ? *(const f32x4*)(g + col0 + bj * HALF + 4 * n) : (f32x4){1.f, 1.f, 1.f, 1.f}; bv[bj][n] = st ? *(const f32x4*)(b + col0 + bj * HALF + 4 * n) : (f32x4){0.f, 0.f, 0.f, 0.f}; }
#pragma unroll
        for (int ai = 0; ai < 2; ++ai)
#pragma unroll
            for (int m = 0; m < 4; ++m) {
                const int row = row0 + ai * HALF + m * 16; const size_t off = (size_t)row * 1024 + col0;
                float a = 1.0f, mu = 0.0f;
                if (st) { const f32x2v sv = *(const f32x2v*)(st + 2 * (size_t)row); mu = sv.x * (1.0f / 1024.0f); a = rsqrtf(sv.y * (1.0f / 1024.0f) - mu * mu + 1e-5f); }
                float s1 = 0.f, s2 = 0.f;
#pragma unroll
                for (int bj = 0; bj < 2; ++bj) {
                    f32x4 y[2];
#pragma unroll
                    for (int n = 0; n < 2; ++n) { const f32x4 yp = *(const f32x4*)(yprev + off + bj * HALF + 4 * n);
                        const f32x4 x = (yp - mu) * a * gv[bj][n] + bv[bj][n];
                        y[n] = x * alpha + acc[ai][bj][m][n] * s;
                        *(f32x4*)(yout + off + bj * HALF + 4 * n) = y[n];
                        s1 += (y[n][0] + y[n][1]) + (y[n][2] + y[n][3]); s2 += (y[n][0] * y[n][0] + y[n][1] * y[n][1]) + (y[n][2] * y[n][2] + y[n][3] * y[n][3]); }
                    u32x4 w; w.x = cvtpk(y[0][0], y[0][1]); w.y = cvtpk(y[0][2], y[0][3]); w.z = cvtpk(y[1][0], y[1][1]); w.w = cvtpk(y[1][2], y[1][3]);
                    *(u32x4*)(yb + off + bj * HALF) = w;
                }
                s1 += __shfl_xor(s1, 16); s1 += __shfl_xor(s1, 32); s2 += __shfl_xor(s2, 16); s2 += __shfl_xor(s2, 32);
                if (fq == 0) { atomicAdd(st_new + 2 * (size_t)row, s1); atomicAdd(st_new + 2 * (size_t)row + 1, s2); }
                if (m & 1) asm volatile("" ::: "memory");
            }
    }
};
struct EpiQKV {
    static constexpr bool PERM = true, AFTER_DRAIN = false;
    bf16_t* O; const float* rope; float qscale; RowLN ln;
    __device__ __forceinline__ void operator()(const f32x4 (&acc)[2][2][4][2], const Unit& u, int wr, int wc, int fr, int fq) const {
        const int pn = u.pn, row0 = u.pm * BM + wr * 64 + fr, col0 = pn * BM + wc * 32 + 8 * fq, i0 = 16 * (wc & 1) + 4 * fq;
        const bool anyrope = (pn != 4 && pn != 5);
        const float sc = (pn < 2 || pn == 6 || pn == 7) ? qscale : 1.0f;
        f32x4 cs[2][2], bw[2][2];
#pragma unroll
        for (int bj = 0; bj < 2; ++bj)
#pragma unroll
            for (int n = 0; n < 2; ++n) { cs[bj][n] = *(const f32x4*)(ln.cs + col0 + bj * HALF + 4 * n); bw[bj][n] = *(const f32x4*)(ln.bw + col0 + bj * HALF + 4 * n); }
#pragma unroll
        for (int ai = 0; ai < 2; ++ai)
#pragma unroll
            for (int m = 0; m < 4; ++m) {
                const int row = row0 + ai * HALF + m * 16; float a, c; ln.row(row, a, c);
                f32x4 cs4 = (f32x4){1.f, 1.f, 1.f, 1.f}, sn = (f32x4){0.f, 0.f, 0.f, 0.f};
                if (anyrope) { cs4 = *(const f32x4*)(rope + (size_t)row * 64 + i0); sn = *(const f32x4*)(rope + (size_t)row * 64 + 32 + i0); }
#pragma unroll
                for (int bj = 0; bj < 2; ++bj) {
                    const bool rp = anyrope && !(pn == 8 && bj == 1);
                    f32x4 v0 = acc[ai][bj][m][0] * a + cs[bj][0] * c + bw[bj][0], v1 = acc[ai][bj][m][1] * a + cs[bj][1] * c + bw[bj][1];
                    if (rp) {
                        const f32x4 a0 = v0, a1 = v1;
                        v0[0] = a0[0] * cs4[0] - a0[1] * sn[0]; v0[1] = a0[1] * cs4[0] + a0[0] * sn[0];
                        v0[2] = a0[2] * cs4[1] - a0[3] * sn[1]; v0[3] = a0[3] * cs4[1] + a0[2] * sn[1];
                        v1[0] = a1[0] * cs4[2] - a1[1] * sn[2]; v1[1] = a1[1] * cs4[2] + a1[0] * sn[2];
                        v1[2] = a1[2] * cs4[3] - a1[3] * sn[3]; v1[3] = a1[3] * cs4[3] + a1[2] * sn[3];
                    }
                    v0 = v0 * sc; v1 = v1 * sc;
                    u32x4 w; w.x = cvtpk(v0[0], v0[1]); w.y = cvtpk(v0[2], v0[3]); w.z = cvtpk(v1[0], v1[1]); w.w = cvtpk(v1[2], v1[3]);
                    *(u32x4*)(O + (size_t)row * 2304 + col0 + bj * HALF) = w;
                }
            }
    }
};

template <class Epi, class Sched, bool ALIGN_EPI = false, bool SP2 = false>
__device__ __forceinline__ void gemm_phase(PG8_LAS unsigned char* lds, const Gemm g, const Sched& S, const Epi& E) {
    int tid_ = threadIdx.x; asm volatile("" : "+v"(tid_));
    const int tid = tid_, wid = __builtin_amdgcn_readfirstlane(tid >> 6), lane = tid & 63, wr = wid >> 2, wc = wid & 3, fr = lane & 15, fq = lane >> 4;
    const int K = g.K, nt = K / BK;
    unsigned voffA[2], voffB[2];
#pragma unroll
    for (int i = 0; i < 2; ++i) { int R, C; stage_rc(tid * 16 + i * 8192, R, C); const int Rb = Epi::PERM ? ((R & ~31) + perm32(R & 31)) : R;
        voffA[i] = (unsigned)(R * K + C) * 2u; voffB[i] = (unsigned)(Rb * K + C) * 2u; }
    const size_t kstep = (size_t)(BK * 2);
    const size_t hstep = (size_t)HALF * K * 2;
    const size_t tstep = 2 * hstep;
    const unsigned ldsw = (unsigned)wid * 1024u;
    const int aoff = lds_byte(wr * 64 + fr, fq * 8), boff = lds_byte(wc * 32 + fr, fq * 8);
#define PG8_SA(b, h) (((b) * 2 + (h)) * HTB)
#define PG8_SB(b, h) ((4 + (b) * 2 + (h)) * HTB)
#define PG8_STAGE(bufoff, gbase, voff) do { _Pragma("unroll") for (int _i = 0; _i < 2; ++_i) \
        __builtin_amdgcn_global_load_lds((const unsigned*)((const char*)(gbase) + (voff)[_i]), (PG8_LAS unsigned*)(lds + (bufoff) + ldsw + _i * 8192), 16, 0, 0); } while (0)
#define PG8_LDA(dst, b, h) do { _Pragma("unroll") for (int m = 0; m < 4; ++m) _Pragma("unroll") for (int k = 0; k < 2; ++k) dst[m][k] = *(const PG8_LAS bf16x8*)(lds + PG8_SA(b, h) + aoff + m * 2048 + k * 1024); } while (0)
#define PG8_LDB(dst, b, h) do { _Pragma("unroll") for (int n = 0; n < 2; ++n) _Pragma("unroll") for (int k = 0; k < 2; ++k) dst[n][k] = *(const PG8_LAS bf16x8*)(lds + PG8_SB(b, h) + boff + n * 2048 + k * 1024); } while (0)
#define PG8_MMA(ai, bj, At, Bt) do { __builtin_amdgcn_s_setprio(1); _Pragma("unroll") for (int m = 0; m < 4; ++m) _Pragma("unroll") for (int n = 0; n < 2; ++n) _Pragma("unroll") for (int k = 0; k < 2; ++k) \
        acc[ai][bj][m][n] = __builtin_amdgcn_mfma_f32_16x16x32_bf16(Bt[n][k], At[m][k], acc[ai][bj][m][n], 0, 0, 0); __builtin_amdgcn_s_setprio(0); } while (0)
#define PG8_WAIT_V(n) asm volatile("s_waitcnt vmcnt(" #n ")" ::: "memory")
#define PG8_WAIT_L(n) asm volatile("s_waitcnt lgkmcnt(" #n ")" ::: "memory")
#define PG8_BAR __builtin_amdgcn_s_barrier()
#define PG8_SCHED __builtin_amdgcn_sched_barrier(0)
    Unit cur, nxt; int ui = 0;
    if (!S.next(0, cur)) return;
    f32x4 acc[2][2][4][2];
#pragma unroll
    for (int a = 0; a < 2; ++a)
#pragma unroll
        for (int b = 0; b < 2; ++b)
#pragma unroll
            for (int m = 0; m < 4; ++m)
#pragma unroll
                for (int n = 0; n < 2; ++n) acc[a][b][m][n] = (f32x4){0.f, 0.f, 0.f, 0.f};
    bf16x8 At[4][2], B0[2][2], B1[2][2];
    const char* cA = (const char*)g.A + (size_t)cur.pm * tstep; const char* cB = (const char*)g.Bt + (size_t)cur.pn * tstep;
    S.a_ready(cur);
    if constexpr (SP2) {
        PG8_STAGE(PG8_SB(0, 0), cB, voffB); PG8_STAGE(PG8_SB(0, 1), cB + hstep, voffB); PG8_STAGE(PG8_SA(0, 0), cA, voffA); PG8_STAGE(PG8_SA(0, 1), cA + hstep, voffA);
        if (wr == 1) PG8_BAR;
        PG8_WAIT_V(2); PG8_BAR;
        PG8_STAGE(PG8_SB(1, 0), cB + kstep, voffB); PG8_STAGE(PG8_SA(1, 0), cA + kstep, voffA); PG8_STAGE(PG8_SB(1, 1), cB + hstep + kstep, voffB);
        PG8_WAIT_V(6); PG8_BAR;
    } else {
        PG8_STAGE(PG8_SB(0, 0), cB, voffB); PG8_STAGE(PG8_SA(0, 0), cA, voffA); PG8_STAGE(PG8_SB(0, 1), cB + hstep, voffB); PG8_STAGE(PG8_SA(0, 1), cA + hstep, voffA);
        if (wr == 1) PG8_BAR;
        PG8_WAIT_V(4); PG8_BAR;
        PG8_STAGE(PG8_SB(1, 0), cB + kstep, voffB); PG8_STAGE(PG8_SA(1, 0), cA + kstep, voffA); PG8_STAGE(PG8_SB(1, 1), cB + hstep + kstep, voffB);
        PG8_WAIT_V(6); PG8_BAR;
    }
    for (;;) {
        const bool has_next = S.next(ui + 1, nxt);
        const char* nA = has_next ? (const char*)g.A + (size_t)nxt.pm * tstep : cA; const char* nB = has_next ? (const char*)g.Bt + (size_t)nxt.pn * tstep : cB;
        for (int t = 0; t < nt; t += 2) {
            const bool last = (t == nt - 2);
            const char* a1 = cA + (size_t)(t + 1) * kstep;
            const char* a2 = last ? nA : cA + (size_t)(t + 2) * kstep; const char* b2 = last ? nB : cB + (size_t)(t + 2) * kstep;
            const char* a3 = a2 + kstep; const char* b3 = b2 + kstep;
            if (last && has_next) S.a_ready(nxt);
            if constexpr (SP2) {
            PG8_LDB(B0, 0, 0); PG8_LDB(B1, 0, 1); PG8_SCHED; PG8_LDA(At, 0, 0); PG8_STAGE(PG8_SA(1, 1), a1 + hstep, voffA);
            PG8_WAIT_V(8); PG8_WAIT_L(0); PG8_BAR; PG8_MMA(0, 0, At, B0); PG8_MMA(0, 1, At, B1); PG8_BAR; PG8_SCHED;
            PG8_LDA(At, 0, 1); PG8_STAGE(PG8_SB(0, 0), b2, voffB); PG8_STAGE(PG8_SB(0, 1), b2 + hstep, voffB); PG8_STAGE(PG8_SA(0, 0), a2, voffA);
            PG8_WAIT_V(8); PG8_WAIT_L(0); PG8_BAR; PG8_MMA(1, 0, At, B0); PG8_MMA(1, 1, At, B1); PG8_BAR; PG8_SCHED;
            PG8_LDB(B0, 1, 0); PG8_LDB(B1, 1, 1); PG8_SCHED; PG8_LDA(At, 1, 0); PG8_STAGE(PG8_SA(0, 1), a2 + hstep, voffA);
            PG8_WAIT_V(8); PG8_WAIT_L(0); PG8_BAR; PG8_MMA(0, 0, At, B0); PG8_MMA(0, 1, At, B1); PG8_BAR; PG8_SCHED;
            PG8_LDA(At, 1, 1); PG8_STAGE(PG8_SB(1, 0), b3, voffB); PG8_STAGE(PG8_SB(1, 1), b3 + hstep, voffB); PG8_STAGE(PG8_SA(1, 0), a3, voffA);
            PG8_WAIT_V(8); PG8_WAIT_L(0); PG8_BAR; PG8_MMA(1, 0, At, B0); PG8_MMA(1, 1, At, B1); PG8_BAR; PG8_SCHED;
            } else {
            PG8_LDB(B0, 0, 0); PG8_SCHED; PG8_LDA(At, 0, 0); PG8_STAGE(PG8_SA(1, 1), a1 + hstep, voffA);
            PG8_WAIT_L(8); PG8_BAR; PG8_WAIT_L(0); PG8_MMA(0, 0, At, B0); PG8_BAR; PG8_SCHED;
            PG8_LDB(B1, 0, 1); PG8_STAGE(PG8_SB(0, 0), b2, voffB);
            PG8_BAR; PG8_WAIT_L(0); PG8_MMA(0, 1, At, B1); PG8_BAR;
            PG8_LDA(At, 0, 1); PG8_STAGE(PG8_SA(0, 0), a2, voffA);
            PG8_BAR; PG8_WAIT_L(0); PG8_MMA(1, 0, At, B0); PG8_BAR; PG8_SCHED;
            PG8_STAGE(PG8_SB(0, 1), b2 + hstep, voffB);
            PG8_WAIT_V(6); PG8_BAR; PG8_MMA(1, 1, At, B1); PG8_BAR;
            PG8_LDB(B0, 1, 0); PG8_SCHED; PG8_LDA(At, 1, 0); PG8_STAGE(PG8_SA(0, 1), a2 + hstep, voffA);
            PG8_WAIT_L(8); PG8_BAR; PG8_WAIT_L(0); PG8_MMA(0, 0, At, B0); PG8_BAR; PG8_SCHED;
            PG8_LDB(B1, 1, 1); PG8_STAGE(PG8_SB(1, 0), b3, voffB);
            PG8_BAR; PG8_WAIT_L(0); PG8_MMA(0, 1, At, B1); PG8_BAR;
            PG8_LDA(At, 1, 1); PG8_STAGE(PG8_SA(1, 0), a3, voffA);
            PG8_BAR; PG8_WAIT_L(0); PG8_MMA(1, 0, At, B0); PG8_BAR; PG8_SCHED;
            PG8_STAGE(PG8_SB(1, 1), b3 + hstep, voffB);
            PG8_WAIT_V(6); PG8_BAR; PG8_MMA(1, 1, At, B1); PG8_BAR;
            }
        }
        if constexpr (ALIGN_EPI) { if (wr == 0) PG8_BAR; }
        if constexpr (!Epi::AFTER_DRAIN) { E(acc, cur, wr, wc, fr, fq); S.done(cur); }
        if (!has_next) break;
#pragma unroll
        for (int a = 0; a < 2; ++a)
#pragma unroll
            for (int b = 0; b < 2; ++b)
#pragma unroll
                for (int m = 0; m < 4; ++m)
#pragma unroll
                    for (int n = 0; n < 2; ++n) acc[a][b][m][n] = (f32x4){0.f, 0.f, 0.f, 0.f};
        cur = nxt; cA = nA; cB = nB; ++ui;
        if constexpr (ALIGN_EPI) { if (wr == 1) PG8_BAR; }
    }
    PG8_WAIT_V(0);
    if constexpr (!ALIGN_EPI) { if (wr == 0) PG8_BAR; }
    PG8_BAR;
    if constexpr (Epi::AFTER_DRAIN) { E.fused(acc, cur, wr, wc, fr, fq, lds, wid, lane); S.done(cur); }
#undef PG8_SA
#undef PG8_SB
#undef PG8_STAGE
#undef PG8_LDA
#undef PG8_LDB
#undef PG8_MMA
#undef PG8_WAIT_V
#undef PG8_WAIT_L
#undef PG8_BAR
#undef PG8_SCHED
}
}

namespace att {
using pg8::bf16_t; using pg8::bf16x8; using pg8::f32x4; using pg8::u32x4; using pg8::cvtpk;
#define ALDS __attribute__((address_space(3)))
typedef float f32x16 __attribute__((ext_vector_type(16)));
typedef short s16x4 __attribute__((ext_vector_type(4)));
typedef unsigned u32x2 __attribute__((ext_vector_type(2)));
constexpr int PITCH = 2304;
constexpr float THR = 8.0f;
__device__ __forceinline__ void glds16(const void* gsrc, unsigned lds_dst) { unsigned keep;
    asm volatile("s_mov_b32 %0, m0\n\ts_mov_b32 m0, %2\n\ts_nop 0\n\tglobal_load_lds_dwordx4 %1, off\n\ts_mov_b32 m0, %0" : "=&s"(keep) : "v"(gsrc), "s"(lds_dst) : "memory"); }
__device__ __forceinline__ unsigned rfl(unsigned v) { return (unsigned)__builtin_amdgcn_readfirstlane((int)v); }
__device__ __forceinline__ int pi23(int x) { return (x & ~12) | ((x & 4) << 1) | ((x & 8) >> 1); }
__device__ __forceinline__ s16x4 vtr(const ALDS unsigned char* p) { return __builtin_bit_cast(s16x4, __builtin_amdgcn_ds_read_tr16_b64_v4i16((ALDS s16x4*)p)); }
__device__ __forceinline__ float halfswap_max(float v) { auto rr = __builtin_amdgcn_permlane32_swap(__float_as_uint(v), __float_as_uint(v), false, false); return fmaxf(__uint_as_float(rr[0]), __uint_as_float(rr[1])); }
__device__ __forceinline__ float halfswap_sum(float v) { auto rr = __builtin_amdgcn_permlane32_swap(__float_as_uint(v), __float_as_uint(v), false, false); return __uint_as_float(rr[0]) + __uint_as_float(rr[1]); }

template <int DV, bool BAND>
__device__ __forceinline__ float attn_core(ALDS unsigned char* ring, const int wid, const int lane,
                                           const bf16_t* Qw, const bf16_t* ksrc, const bf16_t* vsrc, const int koff,
                                           const int t0, const int t1, const int tq, const int qpos, const float m_init, float l, f32x16 (&o)[DV / 32]) {
    constexpr int NDB = DV / 32, SLOT = (DV == 128) ? 32768 : 16384, VOFF = (DV == 128) ? 16384 : 8192, ROWB = DV * 2, NP = (DV == 128) ? 4 : 2;
    const int r32 = lane & 31, hi = lane >> 5;
    const unsigned ring_a = (unsigned)(uintptr_t)ring;
    bf16x8 qr[4];
#pragma unroll
    for (int d0 = 0; d0 < 4; ++d0) qr[d0] = *(const bf16x8*)(Qw + (size_t)r32 * PITCH + d0 * 16 + hi * 8);
#define ATT_ISSUE(t_, so_) do { const size_t go_ = (size_t)(t_) * (64 * PITCH); const unsigned d_ = ring_a + (unsigned)(so_) + (unsigned)wid * 1024u; \
        glds16(ksrc + go_, rfl(d_)); \
        if (DV == 128) { glds16(ksrc + go_ + 64, rfl(d_ + 8192u)); glds16(vsrc + go_, rfl(ring_a + (unsigned)(so_) + (unsigned)VOFF + (unsigned)wid * 2048u)); \
                         glds16(vsrc + go_ + 4 * PITCH, rfl(ring_a + (unsigned)(so_) + (unsigned)VOFF + (unsigned)wid * 2048u + 1024u)); } \
        else { glds16(vsrc + go_, rfl(d_ + (unsigned)VOFF)); } } while (0)
    ATT_ISSUE(t0, 0);
    { const int tn = (t0 + 1 < t1) ? t0 + 1 : t1 - 1; ATT_ISSUE(tn, SLOT); }
    const int g = (lane >> 4) & 1, q4 = (lane & 15) >> 2, p = lane & 3, sw = (DV == 128) ? q4 : (q4 >> 1);
    int va[NDB];
#pragma unroll
    for (int db = 0; db < NDB; ++db) va[db] = VOFF + (8 * hi + q4) * ROWB + ((db ^ sw) << 6) + (2 * g + (p >> 1)) * 16 + 8 * (p & 1);
    const int ka = koff + hi * 1024 + r32 * 16;
    float m = m_init;
    f32x16 negm;
#pragma unroll
    for (int r = 0; r < 16; ++r) negm[r] = -m;
#pragma unroll
    for (int db = 0; db < NDB; ++db)
#pragma unroll
        for (int r = 0; r < 16; ++r) o[db][r] = 0.f;
    int s_cur = 0, s_n2 = 2 * SLOT;
    for (int t = t0; t < t1; ++t) {
        asm volatile("s_waitcnt vmcnt(%0)" :: "n"(NP) : "memory");
        asm volatile("s_waitcnt lgkmcnt(0)\n\ts_barrier" ::: "memory");
        { const int tn = (t + 2 < t1) ? t + 2 : t1 - 1; ATT_ISSUE(tn, s_n2); }
        const ALDS unsigned char* sb = ring + s_cur;
        f32x16 p0 = negm, p1 = negm;
        bf16x8 kf[8];
#pragma unroll
        for (int d0 = 0; d0 < 4; ++d0) { kf[2 * d0] = *(const ALDS bf16x8*)(sb + ka + d0 * 2048); kf[2 * d0 + 1] = *(const ALDS bf16x8*)(sb + ka + d0 * 2048 + 512); }
        s16x4 vlo[2][4], vhh[2][4];
#pragma unroll
        for (int ks = 0; ks < 4; ++ks) { vlo[0][ks] = vtr(sb + va[0] + ks * (16 * ROWB)); vhh[0][ks] = vtr(sb + va[0] + ks * (16 * ROWB) + 4 * ROWB); }
        __builtin_amdgcn_sched_barrier(0);
#pragma unroll
        for (int d0 = 0; d0 < 4; ++d0) {
            p0 = __builtin_amdgcn_mfma_f32_32x32x16_bf16(kf[2 * d0], qr[d0], p0, 0, 0, 0);
            p1 = __builtin_amdgcn_mfma_f32_32x32x16_bf16(kf[2 * d0 + 1], qr[d0], p1, 0, 0, 0);
        }
        if (BAND) {
            if (t == tq - 2 || t == tq + 2) {
                const int rel0 = t * 64 + 8 * hi - qpos;
#pragma unroll
                for (int r = 0; r < 16; ++r) { const int rel = rel0 + 16 * (r >> 3) + (r & 7);
                    if (rel < -128 || rel > 128) p0[r] = -INFINITY;
                    if (rel + 32 < -128 || rel + 32 > 128) p1[r] = -INFINITY; }
            }
        }
        float mx = fmaxf(p0[0], p1[0]);
#pragma unroll
        for (int r = 1; r < 16; ++r) mx = fmaxf(fmaxf(mx, p0[r]), p1[r]);
        mx = halfswap_max(mx);
        const bool first = (!BAND) && (t == t0);
        const float dl = first ? mx : ((mx > THR) ? mx : 0.f);
        if (__any(dl != 0.f)) {
            m += dl;
#pragma unroll
            for (int r = 0; r < 16; ++r) { p0[r] -= dl; p1[r] -= dl; negm[r] = -m; }
            const float f = first ? 1.f : __builtin_amdgcn_exp2f(-dl);
            l *= f;
#pragma unroll
            for (int db = 0; db < NDB; ++db)
#pragma unroll
                for (int r = 0; r < 16; ++r) o[db][r] *= f;
        }
        float s0 = 0.f, s1 = 0.f;
#pragma unroll
        for (int r = 0; r < 16; ++r) { p0[r] = __builtin_amdgcn_exp2f(p0[r]); p1[r] = __builtin_amdgcn_exp2f(p1[r]); s0 += p0[r]; s1 += p1[r]; }
        l += s0 + s1;
        bf16x8 pf[4];
        { u32x4 w;
          w.x = cvtpk(p0[0], p0[1]); w.y = cvtpk(p0[2], p0[3]); w.z = cvtpk(p0[4], p0[5]); w.w = cvtpk(p0[6], p0[7]); pf[0] = __builtin_bit_cast(bf16x8, w);
          w.x = cvtpk(p0[8], p0[9]); w.y = cvtpk(p0[10], p0[11]); w.z = cvtpk(p0[12], p0[13]); w.w = cvtpk(p0[14], p0[15]); pf[1] = __builtin_bit_cast(bf16x8, w);
          w.x = cvtpk(p1[0], p1[1]); w.y = cvtpk(p1[2], p1[3]); w.z = cvtpk(p1[4], p1[5]); w.w = cvtpk(p1[6], p1[7]); pf[2] = __builtin_bit_cast(bf16x8, w);
          w.x = cvtpk(p1[8], p1[9]); w.y = cvtpk(p1[10], p1[11]); w.z = cvtpk(p1[12], p1[13]); w.w = cvtpk(p1[14], p1[15]); pf[3] = __builtin_bit_cast(bf16x8, w); }
#pragma unroll
        for (int db = 0; db < NDB; ++db) {
            if (db + 1 < NDB) {
#pragma unroll
                for (int ks = 0; ks < 4; ++ks) { vlo[(db + 1) & 1][ks] = vtr(sb + va[db + 1] + ks * (16 * ROWB)); vhh[(db + 1) & 1][ks] = vtr(sb + va[db + 1] + ks * (16 * ROWB) + 4 * ROWB); }
            }
            __builtin_amdgcn_sched_barrier(0);
#pragma unroll
            for (int ks = 0; ks < 4; ++ks) {
                const s16x4 lo = vlo[db & 1][ks], hh = vhh[db & 1][ks];
                const bf16x8 vf = (bf16x8){lo[0], lo[1], lo[2], lo[3], hh[0], hh[1], hh[2], hh[3]};
                o[db] = __builtin_amdgcn_mfma_f32_32x32x16_bf16(vf, pf[ks], o[db], 0, 0, 0);
            }
        }
        s_cur = (s_cur == 2 * SLOT) ? 0 : s_cur + SLOT; s_n2 = (s_n2 == 2 * SLOT) ? 0 : s_n2 + SLOT;
    }
    asm volatile("s_waitcnt vmcnt(0) lgkmcnt(0)\n\ts_barrier" ::: "memory");
#undef ATT_ISSUE
    return l;
}

__device__ __forceinline__ void diff_unit(ALDS unsigned char* ring, const int wid, int lane, const bf16_t* qkv, bf16_t* ymix, const int u, const float lam, const float post, const float* subg) {
    asm volatile("" : "+v"(lane));
    const int bh = u >> 5, qb = u & 31, b = bh >> 2, h = bh & 3, comp = wid >> 2, wq = wid & 3, r32 = lane & 31, hi = lane >> 5;
    const size_t rowbase = (size_t)b * 4096;
    const int q0 = qb * 128 + wq * 32;
    const bf16_t* Qw = qkv + (rowbase + q0) * PITCH + h * 128 + comp * 64;
    const bf16_t* ksrc = qkv + (rowbase + pi23(lane)) * PITCH + 512 + h * 128 + wid * 8;
    const bf16_t* vsrc = qkv + (rowbase + 8 * wid + (lane >> 4)) * PITCH + 1024 + h * 128 + (((lane & 15) ^ ((lane >> 4) << 2)) * 8);
    f32x16 o[4];
    float l = attn_core<128, false>(ring, wid, lane, Qw, ksrc, vsrc, comp * 8192, 0, 64, 0, 0, 0.f, 0.f, o);
    l = halfswap_sum(l);
    const float inv = 1.0f / l;
    ALDS f32x4* X = (ALDS f32x4*)ring + (size_t)wq * (16 * 64);
    if (comp == 1) {
#pragma unroll
        for (int db = 0; db < 4; ++db)
#pragma unroll
            for (int rq = 0; rq < 4; ++rq) X[(db * 4 + rq) * 64 + lane] = (f32x4){o[db][4 * rq] * inv, o[db][4 * rq + 1] * inv, o[db][4 * rq + 2] * inv, o[db][4 * rq + 3] * inv};
    }
    asm volatile("s_waitcnt lgkmcnt(0)\n\ts_barrier" ::: "memory");
    if (comp == 0) {
        float ss = 0.f;
#pragma unroll
        for (int db = 0; db < 4; ++db)
#pragma unroll
            for (int rq = 0; rq < 4; ++rq) { const f32x4 o2 = X[(db * 4 + rq) * 64 + lane];
#pragma unroll
                for (int e = 0; e < 4; ++e) { const float d = o[db][4 * rq + e] * inv - lam * o2[e]; o[db][4 * rq + e] = d; ss += d * d; } }
        ss = halfswap_sum(ss);
        const float rs = rsqrtf(ss * (1.0f / 128.0f) + 1e-5f) * post;
        bf16_t* orow = ymix + (rowbase + q0 + r32) * 1024 + h * 128 + 4 * hi;
#pragma unroll
        for (int db = 0; db < 4; ++db)
#pragma unroll
            for (int rq = 0; rq < 4; ++rq) { const f32x4 gv = *(const f32x4*)(subg + 32 * db + 8 * rq + 4 * hi);
                u32x2 w; w.x = cvtpk(o[db][4 * rq] * rs * gv[0], o[db][4 * rq + 1] * rs * gv[1]); w.y = cvtpk(o[db][4 * rq + 2] * rs * gv[2], o[db][4 * rq + 3] * rs * gv[3]);
                *(u32x2*)(orow + 32 * db + 8 * rq) = w; }
    }
    asm volatile("s_waitcnt lgkmcnt(0)\n\ts_barrier" ::: "memory");
}

__device__ __forceinline__ void swa_unit(ALDS unsigned char* ring, const int wid, int lane, const bf16_t* qkv, bf16_t* ymix, const int u, const float* sink) {
    asm volatile("" : "+v"(lane));
    const int bkv = u >> 6, qblk = u & 63, b = bkv >> 1, kvh = bkv & 1, head = kvh * 4 + (wid >> 1), r32 = lane & 31, hi = lane >> 5;
    const size_t rowbase = (size_t)b * 4096;
    const int q0 = qblk * 64 + (wid & 1) * 32;
    const bf16_t* Qw = qkv + (rowbase + q0) * PITCH + 1536 + head * 64;
    const bf16_t* ksrc = qkv + (rowbase + pi23(lane)) * PITCH + 2048 + kvh * 64 + wid * 8;
    const bf16_t* vsrc = qkv + (rowbase + 8 * wid + (lane >> 3)) * PITCH + 2176 + kvh * 64 + (((lane & 7) ^ (((lane >> 4) & 1) << 2)) * 8);
    const int t0 = (qblk - 2 > 0) ? qblk - 2 : 0, t1 = ((qblk + 2 < 63) ? qblk + 2 : 63) + 1;
    f32x16 o[2];
    float l = attn_core<64, true>(ring, wid, lane, Qw, ksrc, vsrc, 0, t0, t1, qblk, q0 + r32, sink[head] * 1.4426950408889634f, (hi == 0) ? 1.0f : 0.0f, o);
    l = halfswap_sum(l);
    const float inv = 1.0f / l;
    bf16_t* orow = ymix + (rowbase + q0 + r32) * 1024 + 512 + head * 64 + 4 * hi;
#pragma unroll
    for (int db = 0; db < 2; ++db)
#pragma unroll
        for (int rq = 0; rq < 4; ++rq) { u32x2 w; w.x = cvtpk(o[db][4 * rq] * inv, o[db][4 * rq + 1] * inv); w.y = cvtpk(o[db][4 * rq + 2] * inv, o[db][4 * rq + 3] * inv);
            *(u32x2*)(orow + 32 * db + 8 * rq) = w; }
}
}

#ifndef REP_ATT
#define REP_ATT 1
#endif
#ifndef REP_G1
#define REP_G1 1
#endif
#ifndef REP_SYNC
#define REP_SYNC 1
#endif
#ifndef REP_LN
#define REP_LN 1
#endif
#ifndef REP_PRO
#define REP_PRO 1
#endif
constexpr int NWAVES = 8;
constexpr int M = 65536, D = 1024, FF = 2816, NIN = 2304, SEQ = 4096, DEPTH = 4;
constexpr size_t MiB = 1u << 20;
constexpr size_t W1_OFF = 0, W1_B = (size_t)2 * FF * D * 2, W2_OFF = W1_OFF + W1_B, W2_B = (size_t)D * FF * 2, WIN_OFF = W2_OFF + W2_B, WIN_B = (size_t)NIN * D * 2,
                 WO_OFF = WIN_OFF + WIN_B, WO_B = (size_t)D * D * 2, W3_OFF = WO_OFF + WO_B, W4_OFF = W3_OFF + W1_B, WL_STRIDE = W4_OFF + W2_B;
constexpr size_t WS_W = 0, WS_ROPE = 160 * MiB, WS_XB = 176 * MiB, WS_H = 304 * MiB, WS_YM = 656 * MiB, WS_CSBW = 784 * MiB, WS_ST = 785 * MiB, WS_END = 786 * MiB;
constexpr int CSBW_N = 2 * FF;
static_assert((size_t)DEPTH * 3 * 2 * CSBW_N * 4 <= MiB && (size_t)2 * M * 2 * 4 <= MiB, "aux map");
static_assert(WL_STRIDE * DEPTH <= WS_ROPE && WS_ROPE + (size_t)M * 64 * 4 <= WS_XB && WS_XB + (size_t)M * D * 2 <= WS_H && WS_H + (size_t)M * FF * 2 <= WS_YM && WS_YM + (size_t)M * D * 2 <= WS_END, "d_ws map");
constexpr int LDS_BYTES = 147456;
constexpr float ALPHA = 1.681792830507429f;
constexpr float QSCALE = 0.125f * 1.4426950408889634f;

typedef unsigned short bf16;
typedef float f32x4 __attribute__((ext_vector_type(4)));
typedef unsigned v4u __attribute__((ext_vector_type(4)));
typedef unsigned v2u __attribute__((ext_vector_type(2)));
using pg8::cvtpk;

struct Args { const float* in[13]; float* out; unsigned char* ws; float inv[32]; float lam_init[4]; };

__device__ __forceinline__ float wave_sum(float v) {
#pragma unroll
    for (int o = 1; o < 64; o <<= 1) v += __shfl_xor(v, o);
    return v;
}
__device__ __forceinline__ int src_col(int type, int n) {
    if (type == 1) { const int pn = n >> 8, w = n & 255; return (w < 128) ? (128 * pn + w) : (FF + 128 * pn + (w - 128)); }
    if (type == 2) { const bool rp = (n < 1024) || (n >= 1536 && n < 2176); return rp ? ((n & ~63) + ((n & 63) >> 1) + 32 * (n & 1)) : n; }
    return n;
}
__device__ __forceinline__ void transpose_item(const float* W, int K, int N, int type, const float* gk, bf16* WT, ALDS float* scr, int item, int lane) {
    const int nblk = N / 32, kb = item / nblk, nb = item % nblk, k0 = 64 * kb, n0 = 32 * nb;
    const int sc = src_col(type, n0 + (lane & 31));
#pragma unroll 8
    for (int i = 0; i < 32; ++i) { const int kk = 2 * i + (lane >> 5); scr[kk * 33 + (lane & 31)] = W[(size_t)(k0 + kk) * N + sc] * (gk ? gk[k0 + kk] : 1.0f); }
    asm volatile("s_waitcnt lgkmcnt(0)" ::: "memory");
    const int c = lane & 7;
#pragma unroll
    for (int j = 0; j < 4; ++j) { const int n = (lane >> 3) + 8 * j; const ALDS float* s = scr + (8 * c) * 33 + n;
        v4u o; o.x = cvtpk(s[0 * 33], s[1 * 33]); o.y = cvtpk(s[2 * 33], s[3 * 33]); o.z = cvtpk(s[4 * 33], s[5 * 33]); o.w = cvtpk(s[6 * 33], s[7 * 33]);
        *(v4u*)(WT + (size_t)(n0 + n) * K + k0 + 8 * c) = o; }
    asm volatile("s_waitcnt lgkmcnt(0)" ::: "memory");
}
__device__ __forceinline__ void sincos_f32angle(float ang, float& c, float& s) {
    const double a = (double)ang, k = __builtin_rint(a * 0.63661977236758134308);
    double r = __builtin_fma(-k, 1.57079632679489655800e+00, a); r = __builtin_fma(-k, 6.12323399573676603587e-17, r);
    const double r2 = r * r;
    double sp = -1.0 / 1307674368000.0; sp = sp * r2 + 1.0 / 6227020800.0; sp = sp * r2 - 1.0 / 39916800.0; sp = sp * r2 + 1.0 / 362880.0; sp = sp * r2 - 1.0 / 5040.0; sp = sp * r2 + 1.0 / 120.0; sp = sp * r2 - 1.0 / 6.0;
    const double sn = r + r * r2 * sp;
    double cp = 1.0 / 20922789888000.0; cp = cp * r2 - 1.0 / 87178291200.0; cp = cp * r2 + 1.0 / 479001600.0; cp = cp * r2 - 1.0 / 3628800.0; cp = cp * r2 + 1.0 / 40320.0; cp = cp * r2 - 1.0 / 720.0; cp = cp * r2 + 1.0 / 24.0; cp = cp * r2 - 0.5;
    const double cn = 1.0 + r2 * cp;
    const int q = ((int)k) & 3;
    const double cc = (q == 0) ? cn : (q == 1) ? -sn : (q == 2) ? -cn : sn;
    const double ss = (q == 0) ? sn : (q == 1) ? cn : (q == 2) ? -sn : -cn;
    c = (float)cc; s = (float)ss;
}
__device__ __forceinline__ void ln_row(const float* xrow, const float* g, const float* bta, float* orow, bf16* brow, int lane) {
    asm volatile("" : "+v"(lane));
    const f32x4* xr = (const f32x4*)xrow + lane;
    f32x4 v[4]; float s = 0.f;
#pragma unroll
    for (int j = 0; j < 4; ++j) { v[j] = xr[64 * j]; s += (v[j][0] + v[j][1]) + (v[j][2] + v[j][3]); }
    const float mean = wave_sum(s) * (1.f / D); float s2 = 0.f;
#pragma unroll
    for (int j = 0; j < 4; ++j) { v[j] = v[j] - mean; s2 += (v[j][0] * v[j][0] + v[j][1] * v[j][1]) + (v[j][2] * v[j][2] + v[j][3] * v[j][3]); }
    const float rstd = 1.0f / sqrtf(wave_sum(s2) * (1.f / D) + 1e-5f);
#pragma unroll
    for (int j = 0; j < 4; ++j) { const f32x4 gg = *((const f32x4*)g + lane + 64 * j), bb = *((const f32x4*)bta + lane + 64 * j);
        const f32x4 y = v[j] * rstd * gg + bb;
        *((f32x4*)orow + lane + 64 * j) = y;
        v2u w; w.x = cvtpk(y[0], y[1]); w.y = cvtpk(y[2], y[3]); *((v2u*)brow + lane + 64 * j) = w; }
}

__global__ void __launch_bounds__(NWAVES * 64, 2) fwd_megakernel(Args args) {
    extern __shared__ __attribute__((aligned(16))) unsigned char lds_raw[];
    cg::grid_group grid = cg::this_grid();
#define GSYNC() do { for (int rs_ = 0; rs_ < REP_SYNC; ++rs_) grid.sync(); } while (0)
    ALDS unsigned char* lds = (ALDS unsigned char*)lds_raw;
    const int tid = threadIdx.x, lane = tid & 63, wave = __builtin_amdgcn_readfirstlane(tid >> 6);
    const int G = gridDim.x, bx = blockIdx.x, vcu = (G % 8 == 0) ? (bx % 8) * (G / 8) + bx / 8 : bx;
    unsigned char* ws = args.ws;
    const float* x_in = args.in[0]; const int* positions = (const int*)args.in[1];
    float* out = args.out;
    bf16* XB = (bf16*)(ws + WS_XB); bf16* HB = (bf16*)(ws + WS_H); bf16* QKV = (bf16*)(ws + WS_H); bf16* YM = (bf16*)(ws + WS_YM);
    float* ROPE = (float*)(ws + WS_ROPE); float* CSBW = (float*)(ws + WS_CSBW); float* ST = (float*)(ws + WS_ST);
    const int gw = vcu * NWAVES + wave, NGW = G * NWAVES;

    for (int rep = 0; rep < REP_PRO; ++rep) {
        ALDS float* scr = (ALDS float*)(lds + wave * 16384);
        constexpr int I1 = (D / 64) * (2 * FF / 32), I2 = (FF / 64) * (D / 32), I3 = (D / 64) * (NIN / 32), I4 = (D / 64) * (D / 32), IL = 2 * I1 + 2 * I2 + I3 + I4;
        for (int it = gw; it < IL * DEPTH; it += NGW) {
            const int l = it / IL; int r = it % IL;
            unsigned char* wl = ws + WS_W + (size_t)l * WL_STRIDE;
            if (r < I1) { transpose_item(args.in[7] + (size_t)l * D * 2 * FF, D, 2 * FF, 1, (l > 0) ? args.in[11] + (size_t)((l - 1) * 3 + 2) * D : nullptr, (bf16*)(wl + W1_OFF), scr, r, lane); continue; } r -= I1;
            if (r < I2) { transpose_item(args.in[8] + (size_t)l * FF * D, FF, D, 0, nullptr, (bf16*)(wl + W2_OFF), scr, r, lane); continue; } r -= I2;
            if (r < I3) { transpose_item(args.in[2] + (size_t)l * D * NIN, D, NIN, 2, args.in[11] + (size_t)(l * 3) * D, (bf16*)(wl + WIN_OFF), scr, r, lane); continue; } r -= I3;
            if (r < I4) { transpose_item(args.in[3] + (size_t)l * D * D, D, D, 0, nullptr, (bf16*)(wl + WO_OFF), scr, r, lane); continue; } r -= I4;
            if (r < I1) { transpose_item(args.in[9] + (size_t)l * D * 2 * FF, D, 2 * FF, 1, args.in[11] + (size_t)(l * 3 + 1) * D, (bf16*)(wl + W3_OFF), scr, r, lane); continue; } r -= I1;
            transpose_item(args.in[10] + (size_t)l * FF * D, FF, D, 0, nullptr, (bf16*)(wl + W4_OFF), scr, r, lane);
        }
        const size_t gt = (size_t)vcu * (NWAVES * 64) + tid, GT = (size_t)G * NWAVES * 64;
        for (size_t i = gt; i < (size_t)M * D / 4; i += GT) { const f32x4 v = *((const f32x4*)x_in + i); v2u w; w.x = cvtpk(v[0], v[1]); w.y = cvtpk(v[2], v[3]); *((v2u*)XB + i) = w; }
        for (size_t i = gt; i < (size_t)M * 32; i += GT) { const int row = (int)(i >> 5), k = (int)(i & 31); float c, s; sincos_f32angle((float)positions[row] * args.inv[k], c, s);
            ROPE[(size_t)row * 64 + k] = c; ROPE[(size_t)row * 64 + 32 + k] = s; }
        for (size_t i = gt; i < (size_t)M * 2; i += GT) ST[i] = 0.f;
        {
            ALDS float* red = (ALDS float*)(lds + 131072);
            constexpr int CG0 = 2 * FF / 64, CG1 = NIN / 64, CGL = 2 * CG0 + CG1;
            for (int cgi = vcu; cgi < CGL * DEPTH; cgi += G) {
                const int l = cgi / CGL; int r = cgi % CGL; int j = 0;
                if (r >= CG0) { r -= CG0; j = 1; if (r >= CG1) { r -= CG1; j = 2; } }
                const int lnidx = (j == 0) ? (l - 1) * 3 + 2 : (j == 1) ? l * 3 : l * 3 + 1;
                if (lnidx < 0) continue;
                const int N = (j == 1) ? NIN : 2 * FF, type = (j == 1) ? 2 : 1;
                const float* W = (j == 0) ? args.in[7] + (size_t)l * D * 2 * FF : (j == 1) ? args.in[2] + (size_t)l * D * NIN : args.in[9] + (size_t)l * D * 2 * FF;
                const float* gk = args.in[11] + (size_t)lnidx * D; const float* bk = args.in[12] + (size_t)lnidx * D;
                const int n = r * 64 + lane, sc = src_col(type, n);
                float c1 = 0.f, b1 = 0.f;
#pragma unroll 16
                for (int k = wave * 128; k < wave * 128 + 128; ++k) { const float w = W[(size_t)k * N + sc]; const float gw = gk[k] * w;
                    c1 += __uint_as_float(cvtpk(gw, 0.f) << 16); b1 += bk[k] * w; }
                red[(wave * 64 + lane) * 2] = c1; red[(wave * 64 + lane) * 2 + 1] = b1;
                __syncthreads();
                if (wave == 0) { float cc = 0.f, bb = 0.f;
#pragma unroll
                    for (int w8 = 0; w8 < 8; ++w8) { cc += red[(w8 * 64 + lane) * 2]; bb += red[(w8 * 64 + lane) * 2 + 1]; }
                    float* dst = CSBW + (size_t)((l * 3 + j) * 2) * CSBW_N; dst[n] = cc; dst[CSBW_N + n] = bb; }
                __syncthreads();
            }
        }
    }
    GSYNC();

#define ZERO_ST(buf_) do { int t_ = tid; asm volatile("" : "+v"(t_)); float* z_ = ST + (size_t)(buf_) * M * 2; for (int i_ = vcu * (NWAVES * 64) + t_; i_ < M * 2; i_ += G * NWAVES * 64) z_[i_] = 0.f; } while (0)
    for (int l = 0; l < DEPTH; ++l) {
        unsigned char* wl = ws + WS_W + (size_t)l * WL_STRIDE;
        const float* lng = args.in[11]; const float* lnb = args.in[12];
        { const int k = 3 * l; ZERO_ST(k & 1);
          const float* cb = CSBW + (size_t)((l * 3 + 0) * 2) * CSBW_N;
          pg8::Gemm g{XB, (const bf16*)(wl + W1_OFF), M, 2 * FF, D}; pg8::StaticOrder S; S.init(M, 2 * FF, G, bx);
          pg8::EpiSwiGLU E{HB, FF, pg8::RowLN{(k == 0) ? nullptr : ST + (size_t)((k - 1) & 1) * M * 2, cb, cb + CSBW_N}};
          for (int rep = 0; rep < REP_G1; ++rep) pg8::gemm_phase<pg8::EpiSwiGLU, pg8::StaticOrder, true, true>(lds, g, S, E); }
        GSYNC();
        { const int k = 3 * l;
          pg8::Gemm g{HB, (const bf16*)(wl + W2_OFF), M, D, FF}; pg8::StaticOrder S; S.init(M, D, G, bx);
          pg8::EpiRes E{(k == 0) ? x_in : (const float*)out, out, XB, (k == 0) ? nullptr : ST + (size_t)((k - 1) & 1) * M * 2, lng + (size_t)(k > 0 ? k - 1 : 0) * D, lnb + (size_t)(k > 0 ? k - 1 : 0) * D, ST + (size_t)(k & 1) * M * 2, ALPHA, 0.5f};
          pg8::gemm_phase<pg8::EpiRes, pg8::StaticOrder, true, true>(lds, g, S, E); }
        GSYNC();
        { const int k = 3 * l + 1; ZERO_ST(k & 1);
          const float* cb = CSBW + (size_t)((l * 3 + 1) * 2) * CSBW_N;
          pg8::Gemm g{XB, (const bf16*)(wl + WIN_OFF), M, NIN, D}; pg8::StaticOrder S; S.init(M, NIN, G, bx);
          pg8::EpiQKV E{QKV, ROPE, QSCALE, pg8::RowLN{ST + (size_t)((k - 1) & 1) * M * 2, cb, cb + CSBW_N}};
          pg8::gemm_phase<pg8::EpiQKV, pg8::StaticOrder, true, true>(lds, g, S, E); }
        GSYNC();
        {
            const float* lv = args.in[4] + (size_t)l * 256;
            int la = lane; asm volatile("" : "+v"(la));
            const float a1 = wave_sum(lv[la] * lv[64 + la]), a2 = wave_sum(lv[128 + la] * lv[192 + la]);
            const float lam_init = args.lam_init[l], lam = expf(a1) - expf(a2) + lam_init;
            const float* subg = args.in[5] + (size_t)l * 128; const float* sink = args.in[6] + (size_t)l * 8;
            for (int rep = 0; rep < REP_ATT; ++rep) {
            for (int u = vcu; u < 2048; u += G) att::diff_unit(lds, wave, lane, QKV, YM, u, lam, 1.0f - lam_init, subg);
            for (int u = vcu; u < 2048; u += G) att::swa_unit(lds, wave, lane, QKV, YM, u, sink);
            }
        }
        GSYNC();
        { const int k = 3 * l + 1;
          pg8::Gemm g{YM, (const bf16*)(wl + WO_OFF), M, D, D}; pg8::StaticOrder S; S.init(M, D, G, bx);
          pg8::EpiRes E{out, out, XB, ST + (size_t)((k - 1) & 1) * M * 2, lng + (size_t)(k - 1) * D, lnb + (size_t)(k - 1) * D, ST + (size_t)(k & 1) * M * 2, ALPHA, 1.0f};
          pg8::gemm_phase<pg8::EpiRes, pg8::StaticOrder, true, true>(lds, g, S, E); }
        GSYNC();
        { const int k = 3 * l + 2; ZERO_ST(k & 1);
          const float* cb = CSBW + (size_t)((l * 3 + 2) * 2) * CSBW_N;
          pg8::Gemm g{XB, (const bf16*)(wl + W3_OFF), M, 2 * FF, D}; pg8::StaticOrder S; S.init(M, 2 * FF, G, bx);
          pg8::EpiSwiGLU E{HB, FF, pg8::RowLN{ST + (size_t)((k - 1) & 1) * M * 2, cb, cb + CSBW_N}};
          for (int rep = 0; rep < REP_G1; ++rep) pg8::gemm_phase<pg8::EpiSwiGLU, pg8::StaticOrder, true, true>(lds, g, S, E); }
        GSYNC();
        { const int k = 3 * l + 2;
          pg8::Gemm g{HB, (const bf16*)(wl + W4_OFF), M, D, FF}; pg8::StaticOrder S; S.init(M, D, G, bx);
          pg8::EpiRes E{out, out, XB, ST + (size_t)((k - 1) & 1) * M * 2, lng + (size_t)(k - 1) * D, lnb + (size_t)(k - 1) * D, ST + (size_t)(k & 1) * M * 2, ALPHA, 0.5f};
          pg8::gemm_phase<pg8::EpiRes, pg8::StaticOrder, true, true>(lds, g, S, E); }
        GSYNC();
    }
    for (int m = gw; m < M; m += NGW) ln_row(out + (size_t)m * D, args.in[11] + (size_t)11 * D, args.in[12] + (size_t)11 * D, out + (size_t)m * D, XB + (size_t)m * D, lane);
}

extern "C" void kernel_launch(void* const* d_in, const int* in_sizes, int n_in, void* d_out, int out_size, void* d_ws, size_t ws_size, hipStream_t stream) {
    static int grid = 0;
    if (grid == 0) {
        if (n_in != 13 || in_sizes[0] != M * D || out_size != M * D || ws_size < WS_END) { fprintf(stderr, "kernel_launch: unexpected shapes (n_in %d, in0 %d, out %d, ws %zu); nothing launched\n", n_in, n_in > 0 ? in_sizes[0] : -1, out_size, ws_size); grid = -1; return; }
        int dev = 0, cus = 0, per_cu = 0;
        if (hipGetDevice(&dev) != hipSuccess || hipDeviceGetAttribute(&cus, hipDeviceAttributeMultiprocessorCount, dev) != hipSuccess) { grid = -1; return; }
        if (hipFuncSetAttribute((const void*)fwd_megakernel, hipFuncAttributeMaxDynamicSharedMemorySize, LDS_BYTES) != hipSuccess) { fprintf(stderr, "kernel_launch: hipFuncSetAttribute failed\n"); grid = -1; return; }
        if (hipOccupancyMaxActiveBlocksPerMultiprocessor(&per_cu, (const void*)fwd_megakernel, NWAVES * 64, LDS_BYTES) != hipSuccess || per_cu < 1) { fprintf(stderr, "kernel_launch: occupancy query gives %d\n", per_cu); per_cu = 1; }
        (void)hipGetLastError();
        grid = cus * 1;
    }
    if (grid < 0) return;
    Args a{};
    for (int i = 0; i < 13; ++i) a.in[i] = (const float*)d_in[i];
    a.out = (float*)d_out; a.ws = (unsigned char*)d_ws;
    for (int i = 0; i < 32; ++i) a.inv[i] = (float)pow(10000.0, -(double)(2 * i) / 64.0);
    for (int l = 0; l < 4; ++l) a.lam_init[l] = (float)(0.8 - 0.6 * exp(-0.3 * (double)l));
    void* kargs[] = {&a};
    const hipError_t e = hipLaunchCooperativeKernel((const void*)fwd_megakernel, dim3(grid), dim3(NWAVES * 64), kargs, LDS_BYTES, stream);
    if (e != hipSuccess) fprintf(stderr, "kernel_launch: cooperative launch failed: %s (grid %d)\n", hipGetErrorString(e), grid);
}
```

```cpp
#include <hip/hip_runtime.h>
#include <hip/hip_cooperative_groups.h>
#include <cstdio>
#include <cstdint>
#include <cmath>
namespace cg = cooperative_groups;
namespace pg8 {
#define PG8_LAS __attribute__((address_space(3)))
typedef unsigned short bf16_t;
typedef short bf16x8 __attribute__((ext_vector_type(8)));
typedef float f32x4 __attribute__((ext_vector_type(4)));
typedef unsigned u32x4 __attribute__((ext_vector_type(4)));
constexpr int BM = 256, BK = 64, HALF = 128, HTB = HALF * BK * 2  , STAGE_BYTES = 8 * HTB, NXCD = 8, WGM = 8;

__host__ __device__ __forceinline__ int lds_byte(int r, int c) { const int st = (r >> 4) * 2 + (c >> 5), rr = r & 15, cc = c & 31, ob = rr * 64 + cc * 2; return st * 1024 + (ob ^ (((ob >> 9) & 1) << 5)); }
__host__ __device__ __forceinline__ void stage_rc(int b, int& R, int& C) { const int st = b / 1024, sb = b % 1024, swz = sb ^ (((sb >> 9) & 1) << 5); R = (st >> 1) * 16 + swz / 64; C = (st & 1) * 32 + (swz % 64) / 2; }
__host__ __device__ __forceinline__ int perm32(int rho) { const int n = rho >> 4, i = rho & 15; return 8 * (i >> 2) + 4 * n + (i & 3); }

struct Unit { int pm, pn; };
struct Gemm { const bf16_t* A; const bf16_t* Bt; int M, N, K; };

struct StaticOrder {
    int nM, nN, nwg, G, c;
    __host__ __device__ void init(int M, int N, int G_, int c_) { nM = M / BM; nN = N / BM; nwg = nM * nN; G = G_; c = c_; }
    __host__ __device__ bool next(int i, Unit& u) const {
        const long L = (long)i * G + c; if (L >= nwg) return false;
        int wgid = (int)L; { const int q = nwg / NXCD, r = nwg % NXCD, xcd = wgid % NXCD, off = wgid / NXCD; wgid = (xcd < r ? xcd * (q + 1) : r * (q + 1) + (xcd - r) * q) + off; }
        const int nig = WGM * nN, gid = wgid / nig, fm = gid * WGM, gsz = (nM - fm) < WGM ? (nM - fm) : WGM;
        u.pm = fm + ((wgid % nig) % gsz); u.pn = (wgid % nig) / gsz; return true;
    }
    __device__ __forceinline__ void a_ready(const Unit&) const {}
    __device__ __forceinline__ void done(const Unit&) const {}
};

typedef float f32x2_t __attribute__((ext_vector_type(2))); typedef __bf16 bf16x2_t __attribute__((ext_vector_type(2)));
__device__ __forceinline__ unsigned cvtpk(float lo, float hi) { f32x2_t v = {lo, hi}; bf16x2_t b = __builtin_convertvector(v, bf16x2_t); return __builtin_bit_cast(unsigned, b); }
typedef _Float16 f16x8 __attribute__((ext_vector_type(8))); typedef _Float16 f16x2_t __attribute__((ext_vector_type(2)));
template <bool F16> __device__ __forceinline__ f32x4 mma16(bf16x8 a, bf16x8 b, f32x4 c) {
    if constexpr (F16) return __builtin_amdgcn_mfma_f32_16x16x32_f16(__builtin_bit_cast(f16x8, a), __builtin_bit_cast(f16x8, b), c, 0, 0, 0);
    else return __builtin_amdgcn_mfma_f32_16x16x32_bf16(a, b, c, 0, 0, 0);
}
__device__ __forceinline__ unsigned cvtpk_h(float lo, float hi) { f16x2_t v = {(_Float16)lo, (_Float16)hi}; return __builtin_bit_cast(unsigned, v); }
__device__ __forceinline__ float silu_f(float g) { return g * __builtin_amdgcn_rcpf(1.0f + __builtin_amdgcn_exp2f(-1.4426950408889634f * g)); }

typedef float f32x2v __attribute__((ext_vector_type(2)));
struct RowLN {
    const float* st; const float* cs; const float* bw;
    __device__ __forceinline__ void row(int r, float& a, float& c) const {
        if (st) { const f32x2v s = *(const f32x2v*)(st + 2 * (size_t)r); const float mu = s.x * (1.0f / 1024.0f), var = s.y * (1.0f / 1024.0f) - mu * mu; a = rsqrtf(var + 1e-5f); c = -a * mu; }
        else { a = 1.0f; c = 0.0f; }
    }
};
struct EpiSwiGLU {
    static constexpr bool PERM = true, AFTER_DRAIN = false, F16 = true;
    bf16_t* H; int ldh; RowLN ln;
    __device__ __forceinline__ void operator()(const f32x4 (&acc)[2][2][4][2], const Unit& u, int wr, int wc, int fr, int fq) const {
        const int row0 = u.pm * BM + wr * 64 + fr, col0 = u.pn * HALF + wc * 32 + 8 * fq, wrow0 = u.pn * BM + wc * 32 + 8 * fq;
        f32x4 cs[2][2], bw[2][2];
#pragma unroll
        for (int bj = 0; bj < 2; ++bj)
#pragma unroll
            for (int n = 0; n < 2; ++n) { const f32x4 z = (f32x4){0.f, 0.f, 0.f, 0.f}; cs[bj][n] = ln.st ? *(const f32x4*)(ln.cs + wrow0 + bj * HALF + 4 * n) : z; bw[bj][n] = ln.st ? *(const f32x4*)(ln.bw + wrow0 + bj * HALF + 4 * n) : z; }
#pragma unroll
        for (int ai = 0; ai < 2; ++ai)
#pragma unroll
            for (int m = 0; m < 4; ++m) {
                const int row = row0 + ai * HALF + m * 16; float a, c; ln.row(row, a, c);
                const f32x4 g0 = acc[ai][0][m][0] * a + cs[0][0] * c + bw[0][0], g1 = acc[ai][0][m][1] * a + cs[0][1] * c + bw[0][1];
                const f32x4 u0 = acc[ai][1][m][0] * a + cs[1][0] * c + bw[1][0], u1 = acc[ai][1][m][1] * a + cs[1][1] * c + bw[1][1];
                u32x4 w;
                w.x = cvtpk(silu_f(g0[0]) * u0[0], silu_f(g0[1]) * u0[1]); w.y = cvtpk(silu_f(g0[2]) * u0[2], silu_f(g0[3]) * u0[3]);
                w.z = cvtpk(silu_f(g1[0]) * u1[0], silu_f(g1[1]) * u1[1]); w.w = cvtpk(silu_f(g1[2]) * u1[2], silu_f(g1[3]) * u1[3]);
                *(u32x4*)(H + (size_t)row * ldh + col0) = w;
                if (m & 1) asm volatile("" ::: "memory");
            }
    }
};
struct EpiRes {
    static constexpr bool PERM = true, AFTER_DRAIN = false, F16 = false;
    const float* x0; bf16_t* yh; const float* st; const float* g; const float* b; float* st_new; float alpha, s;
    __device__ __forceinline__ void operator()(const f32x4 (&acc)[2][2][4][2], const Unit& u, int wr, int wc, int fr, int fq) const {
        const int row0 = u.pm * BM + wr * 64 + fr, col0 = u.pn * BM + wc * 32 + 8 * fq;
        f32x4 gv[2][2], bv[2][2];
#pragma unroll
        for (int bj = 0; bj < 2; ++bj)
#pragma unroll
            for (int n = 0; n < 2; ++n) { gv[bj][n] = st ? *(const f32x4*)(g + col0 + bj * HALF + 4 * n) : (f32x4){1.f, 1.f, 1.f, 1.f}; bv[bj][n] = st ? *(const f32x4*)(b + col0 + bj * HALF + 4 * n) : (f32x4){0.f, 0.f, 0.f, 0.f}; }
#pragma unroll
        for (int ai = 0; ai < 2; ++ai)
#pragma unroll
            for (int m = 0; m < 4; ++m) {
                const int row = row0 + ai * HALF + m * 16; const size_t off = (size_t)row * 1024 + col0;
                float a = 1.0f, mu = 0.0f;
                if (st) { const f32x2v sv = *(const f32x2v*)(st + 2 * (size_t)row); mu = sv.x * (1.0f / 1024.0f); a = rsqrtf(sv.y * (1.0f / 1024.0f) - mu * mu + 1e-5f); }
                float s1 = 0.f, s2 = 0.f;
#pragma unroll
                for (int bj = 0; bj < 2; ++bj) {
                    f32x4 yp[2];
                    if (st) { const f16x8 hv = *(const f16x8*)(yh + off + bj * HALF);
                        yp[0] = (f32x4){(float)hv[0], (float)hv[1], (float)hv[2], (float)hv[3]}; yp[1] = (f32x4){(float)hv[4], (float)hv[5], (float)hv[6], (float)hv[7]}; }
                    else { yp[0] = *(const f32x4*)(x0 + off + bj * HALF); yp[1] = *(const f32x4*)(x0 + off + bj * HALF + 4); }
                    f32x4 y[2];
#pragma unroll
                    for (int n = 0; n < 2; ++n) { const f32x4 x = (yp[n] - mu) * a * gv[bj][n] + bv[bj][n];
                        y[n] = x * alpha + acc[ai][bj][m][n] * s;
                        s1 += (y[n][0] + y[n][1]) + (y[n][2] + y[n][3]); s2 += (y[n][0] * y[n][0] + y[n][1] * y[n][1]) + (y[n][2] * y[n][2] + y[n][3] * y[n][3]); }
                    u32x4 w; w.x = cvtpk_h(y[0][0], y[0][1]); w.y = cvtpk_h(y[0][2], y[0][3]); w.z = cvtpk_h(y[1][0], y[1][1]); w.w = cvtpk_h(y[1][2], y[1][3]);
                    *(u32x4*)(yh + off + bj * HALF) = w;
                }
                s1 += __shfl_xor(s1, 16); s1 += __shfl_xor(s1, 32); s2 += __shfl_xor(s2, 16); s2 += __shfl_xor(s2, 32);
                if (fq == 0) { atomicAdd(st_new + 2 * (size_t)row, s1); atomicAdd(st_new + 2 * (size_t)row + 1, s2); }
                if (m & 1) asm volatile("" ::: "memory");
            }
    }
};
struct EpiQKV {
    static constexpr bool PERM = true, AFTER_DRAIN = false, F16 = true;
    bf16_t* O; const float* rope; float qscale; RowLN ln;
    __device__ __forceinline__ void operator()(const f32x4 (&acc)[2][2][4][2], const Unit& u, int wr, int wc, int fr, int fq) const {
        const int pn = u.pn, row0 = u.pm * BM + wr * 64 + fr, col0 = pn * BM + wc * 32 + 8 * fq, i0 = 16 * (wc & 1) + 4 * fq;
        const bool anyrope = (pn != 4 && pn != 5);
        const float sc = (pn < 2 || pn == 6 || pn == 7) ? qscale : 1.0f;
        f32x4 cs[2][2], bw[2][2];
#pragma unroll
        for (int bj = 0; bj < 2; ++bj)
#pragma unroll
            for (int n = 0; n < 2; ++n) { cs[bj][n] = *(const f32x4*)(ln.cs + col0 + bj * HALF + 4 * n); bw[bj][n] = *(const f32x4*)(ln.bw + col0 + bj * HALF + 4 * n); }
#pragma unroll
        for (int ai = 0; ai < 2; ++ai)
#pragma unroll
            for (int m = 0; m < 4; ++m) {
                const int row = row0 + ai * HALF + m * 16; float a, c; ln.row(row, a, c);
                f32x4 cs4 = (f32x4){1.f, 1.f, 1.f, 1.f}, sn = (f32x4){0.f, 0.f, 0.f, 0.f};
                if (anyrope) { cs4 = *(const f32x4*)(rope + (size_t)row * 64 + i0); sn = *(const f32x4*)(rope + (size_t)row * 64 + 32 + i0); }
#pragma unroll
                for (int bj = 0; bj < 2; ++bj) {
                    const bool rp = anyrope && !(pn == 8 && bj == 1);
                    f32x4 v0 = acc[ai][bj][m][0] * a + cs[bj][0] * c + bw[bj][0], v1 = acc[ai][bj][m][1] * a + cs[bj][1] * c + bw[bj][1];
                    if (rp) {
                        const f32x4 a0 = v0, a1 = v1;
                        v0[0] = a0[0] * cs4[0] - a0[1] * sn[0]; v0[1] = a0[1] * cs4[0] + a0[0] * sn[0];
                        v0[2] = a0[2] * cs4[1] - a0[3] * sn[1]; v0[3] = a0[3] * cs4[1] + a0[2] * sn[1];
                        v1[0] = a1[0] * cs4[2] - a1[1] * sn[2]; v1[1] = a1[1] * cs4[2] + a1[0] * sn[2];
                        v1[2] = a1[2] * cs4[3] - a1[3] * sn[3]; v1[3] = a1[3] * cs4[3] + a1[2] * sn[3];
                    }
                    v0 = v0 * sc; v1 = v1 * sc;
                    u32x4 w; w.x = cvtpk(v0[0], v0[1]); w.y = cvtpk(v0[2], v0[3]); w.z = cvtpk(v1[0], v1[1]); w.w = cvtpk(v1[2], v1[3]);
                    *(u32x4*)(O + (size_t)row * 2304 + col0 + bj * HALF) = w;
                }
            }
    }
};

template <class Epi, class Sched, bool ALIGN_EPI = false, bool SP2 = false>
__device__ __forceinline__ void gemm_phase(PG8_LAS unsigned char* lds, const Gemm g, const Sched& S, const Epi& E) {
    int tid_ = threadIdx.x; asm volatile("" : "+v"(tid_));
    const int tid = tid_, wid = __builtin_amdgcn_readfirstlane(tid >> 6), lane = tid & 63, wr = wid >> 2, wc = wid & 3, fr = lane & 15, fq = lane >> 4;
    const int K = g.K, nt = K / BK;
    unsigned voffA[2], voffB[2];
#pragma unroll
    for (int i = 0; i < 2; ++i) { int R, C; stage_rc(tid * 16 + i * 8192, R, C); const int Rb = Epi::PERM ? ((R & ~31) + perm32(R & 31)) : R;
        voffA[i] = (unsigned)(R * K + C) * 2u; voffB[i] = (unsigned)(Rb * K + C) * 2u; }
    const size_t kstep = (size_t)(BK * 2);
    const size_t hstep = (size_t)HALF * K * 2;
    const size_t tstep = 2 * hstep;
    const unsigned ldsw = (unsigned)wid * 1024u;
    const int aoff = lds_byte(wr * 64 + fr, fq * 8), boff = lds_byte(wc * 32 + fr, fq * 8);
#define PG8_SA(b, h) (((b) * 2 + (h)) * HTB)
#define PG8_SB(b, h) ((4 + (b) * 2 + (h)) * HTB)
#define PG8_STAGE(bufoff, gbase, voff) do { _Pragma("unroll") for (int _i = 0; _i < 2; ++_i) \
        __builtin_amdgcn_global_load_lds((const unsigned*)((const char*)(gbase) + (voff)[_i]), (PG8_LAS unsigned*)(lds + (bufoff) + ldsw + _i * 8192), 16, 0, 0); } while (0)
#define PG8_LDA(dst, b, h) do { _Pragma("unroll") for (int m = 0; m < 4; ++m) _Pragma("unroll") for (int k = 0; k < 2; ++k) dst[m][k] = *(const PG8_LAS bf16x8*)(lds + PG8_SA(b, h) + aoff + m * 2048 + k * 1024); } while (0)
#define PG8_LDB(dst, b, h) do { _Pragma("unroll") for (int n = 0; n < 2; ++n) _Pragma("unroll") for (int k = 0; k < 2; ++k) dst[n][k] = *(const PG8_LAS bf16x8*)(lds + PG8_SB(b, h) + boff + n * 2048 + k * 1024); } while (0)
#define PG8_MMA(ai, bj, At, Bt) do { __builtin_amdgcn_s_setprio(1); _Pragma("unroll") for (int m = 0; m < 4; ++m) _Pragma("unroll") for (int n = 0; n < 2; ++n) _Pragma("unroll") for (int k = 0; k < 2; ++k) \
        acc[ai][bj][m][n] = mma16<Epi::F16>(Bt[n][k], At[m][k], acc[ai][bj][m][n]); __builtin_amdgcn_s_setprio(0); } while (0)
#define PG8_WAIT_V(n) asm volatile("s_waitcnt vmcnt(" #n ")" ::: "memory")
#define PG8_WAIT_L(n) asm volatile("s_waitcnt lgkmcnt(" #n ")" ::: "memory")
#define PG8_BAR __builtin_amdgcn_s_barrier()
#define PG8_SCHED __builtin_amdgcn_sched_barrier(0)
    Unit cur, nxt; int ui = 0;
    if (!S.next(0, cur)) return;
    f32x4 acc[2][2][4][2];
#pragma unroll
    for (int a = 0; a < 2; ++a)
#pragma unroll
        for (int b = 0; b < 2; ++b)
#pragma unroll
            for (int m = 0; m < 4; ++m)
#pragma unroll
                for (int n = 0; n < 2; ++n) acc[a][b][m][n] = (f32x4){0.f, 0.f, 0.f, 0.f};
    bf16x8 At[4][2], B0[2][2], B1[2][2];
    const char* cA = (const char*)g.A + (size_t)cur.pm * tstep; const char* cB = (const char*)g.Bt + (size_t)cur.pn * tstep;
    S.a_ready(cur);
    if constexpr (SP2) {
        PG8_STAGE(PG8_SB(0, 0), cB, voffB); PG8_STAGE(PG8_SB(0, 1), cB + hstep, voffB); PG8_STAGE(PG8_SA(0, 0), cA, voffA); PG8_STAGE(PG8_SA(0, 1), cA + hstep, voffA);
        if (wr == 1) PG8_BAR;
        PG8_WAIT_V(2); PG8_BAR;
        PG8_STAGE(PG8_SB(1, 0), cB + kstep, voffB); PG8_STAGE(PG8_SA(1, 0), cA + kstep, voffA); PG8_STAGE(PG8_SB(1, 1), cB + hstep + kstep, voffB);
        PG8_WAIT_V(6); PG8_BAR;
    } else {
        PG8_STAGE(PG8_SB(0, 0), cB, voffB); PG8_STAGE(PG8_SA(0, 0), cA, voffA); PG8_STAGE(PG8_SB(0, 1), cB + hstep, voffB); PG8_STAGE(PG8_SA(0, 1), cA + hstep, voffA);
        if (wr == 1) PG8_BAR;
        PG8_WAIT_V(4); PG8_BAR;
        PG8_STAGE(PG8_SB(1, 0), cB + kstep, voffB); PG8_STAGE(PG8_SA(1, 0), cA + kstep, voffA); PG8_STAGE(PG8_SB(1, 1), cB + hstep + kstep, voffB);
        PG8_WAIT_V(6); PG8_BAR;
    }
    for (;;) {
        const bool has_next = S.next(ui + 1, nxt);
        const char* nA = has_next ? (const char*)g.A + (size_t)nxt.pm * tstep : cA; const char* nB = has_next ? (const char*)g.Bt + (size_t)nxt.pn * tstep : cB;
        for (int t = 0; t < nt; t += 2) {
            const bool last = (t == nt - 2);
            const char* a1 = cA + (size_t)(t + 1) * kstep;
            const char* a2 = last ? nA : cA + (size_t)(t + 2) * kstep; const char* b2 = last ? nB : cB + (size_t)(t + 2) * kstep;
            const char* a3 = a2 + kstep; const char* b3 = b2 + kstep;
            if (last && has_next) S.a_ready(nxt);
            if constexpr (SP2) {
            PG8_LDB(B0, 0, 0); PG8_LDB(B1, 0, 1); PG8_SCHED; PG8_LDA(At, 0, 0); PG8_STAGE(PG8_SA(1, 1), a1 + hstep, voffA);
            PG8_WAIT_V(8); PG8_WAIT_L(0); PG8_BAR; PG8_MMA(0, 0, At, B0); PG8_MMA(0, 1, At, B1); PG8_BAR; PG8_SCHED;
            PG8_LDA(At, 0, 1); PG8_STAGE(PG8_SB(0, 0), b2, voffB); PG8_STAGE(PG8_SB(0, 1), b2 + hstep, voffB); PG8_STAGE(PG8_SA(0, 0), a2, voffA);
            PG8_WAIT_V(8); PG8_WAIT_L(0); PG8_BAR; PG8_MMA(1, 0, At, B0); PG8_MMA(1, 1, At, B1); PG8_BAR; PG8_SCHED;
            PG8_LDB(B0, 1, 0); PG8_LDB(B1, 1, 1); PG8_SCHED; PG8_LDA(At, 1, 0); PG8_STAGE(PG8_SA(0, 1), a2 + hstep, voffA);
            PG8_WAIT_V(8); PG8_WAIT_L(0); PG8_BAR; PG8_MMA(0, 0, At, B0); PG8_MMA(0, 1, At, B1); PG8_BAR; PG8_SCHED;
            PG8_LDA(At, 1, 1); PG8_STAGE(PG8_SB(1, 0), b3, voffB); PG8_STAGE(PG8_SB(1, 1), b3 + hstep, voffB); PG8_STAGE(PG8_SA(1, 0), a3, voffA);
            PG8_WAIT_V(8); PG8_WAIT_L(0); PG8_BAR; PG8_MMA(1, 0, At, B0); PG8_MMA(1, 1, At, B1); PG8_BAR; PG8_SCHED;
            } else {
            PG8_LDB(B0, 0, 0); PG8_SCHED; PG8_LDA(At, 0, 0); PG8_STAGE(PG8_SA(1, 1), a1 + hstep, voffA);
            PG8_WAIT_L(8); PG8_BAR; PG8_WAIT_L(0); PG8_MMA(0, 0, At, B0); PG8_BAR; PG8_SCHED;
            PG8_LDB(B1, 0, 1); PG8_STAGE(PG8_SB(0, 0), b2, voffB);
            PG8_BAR; PG8_WAIT_L(0); PG8_MMA(0, 1, At, B1); PG8_BAR;
            PG8_LDA(At, 0, 1); PG8_STAGE(PG8_SA(0, 0), a2, voffA);
            PG8_BAR; PG8_WAIT_L(0); PG8_MMA(1, 0, At, B0); PG8_BAR; PG8_SCHED;
            PG8_STAGE(PG8_SB(0, 1), b2 + hstep, voffB);
            PG8_WAIT_V(6); PG8_BAR; PG8_MMA(1, 1, At, B1); PG8_BAR;
            PG8_LDB(B0, 1, 0); PG8_SCHED; PG8_LDA(At, 1, 0); PG8_STAGE(PG8_SA(0, 1), a2 + hstep, voffA);
            PG8_WAIT_L(8); PG8_BAR; PG8_WAIT_L(0); PG8_MMA(0, 0, At, B0); PG8_BAR; PG8_SCHED;
            PG8_LDB(B1, 1, 1); PG8_STAGE(PG8_SB(1, 0), b3, voffB);
            PG8_BAR; PG8_WAIT_L(0); PG8_MMA(0, 1, At, B1); PG8_BAR;
            PG8_LDA(At, 1, 1); PG8_STAGE(PG8_SA(1, 0), a3, voffA);
            PG8_BAR; PG8_WAIT_L(0); PG8_MMA(1, 0, At, B0); PG8_BAR; PG8_SCHED;
            PG8_STAGE(PG8_SB(1, 1), b3 + hstep, voffB);
            PG8_WAIT_V(6); PG8_BAR; PG8_MMA(1, 1, At, B1); PG8_BAR;
            }
        }
        if constexpr (ALIGN_EPI) { if (wr == 0) PG8_BAR; }
        if constexpr (!Epi::AFTER_DRAIN) { E(acc, cur, wr, wc, fr, fq); S.done(cur); }
        if (!has_next) break;
#pragma unroll
        for (int a = 0; a < 2; ++a)
#pragma unroll
            for (int b = 0; b < 2; ++b)
#pragma unroll
                for (int m = 0; m < 4; ++m)
#pragma unroll
                    for (int n = 0; n < 2; ++n) acc[a][b][m][n] = (f32x4){0.f, 0.f, 0.f, 0.f};
        cur = nxt; cA = nA; cB = nB; ++ui;
        if constexpr (ALIGN_EPI) { if (wr == 1) PG8_BAR; }
    }
    PG8_WAIT_V(0);
    if constexpr (!ALIGN_EPI) { if (wr == 0) PG8_BAR; }
    PG8_BAR;
    if constexpr (Epi::AFTER_DRAIN) { E.fused(acc, cur, wr, wc, fr, fq, lds, wid, lane); S.done(cur); }
#undef PG8_SA
#undef PG8_SB
#undef PG8_STAGE
#undef PG8_LDA
#undef PG8_LDB
#undef PG8_MMA
#undef PG8_WAIT_V
#undef PG8_WAIT_L
#undef PG8_BAR
#undef PG8_SCHED
}
}

namespace att {
using pg8::bf16_t; using pg8::bf16x8; using pg8::f32x4; using pg8::u32x4; using pg8::cvtpk;
#define ALDS __attribute__((address_space(3)))
typedef float f32x16 __attribute__((ext_vector_type(16)));
typedef short s16x4 __attribute__((ext_vector_type(4)));
typedef unsigned u32x2 __attribute__((ext_vector_type(2)));
constexpr int PITCH = 2304;
constexpr float THR = 8.0f;
__device__ __forceinline__ void glds16(const void* gsrc, unsigned lds_dst) { unsigned keep;
    asm volatile("s_mov_b32 %0, m0\n\ts_mov_b32 m0, %2\n\ts_nop 0\n\tglobal_load_lds_dwordx4 %1, off\n\ts_mov_b32 m0, %0" : "=&s"(keep) : "v"(gsrc), "s"(lds_dst) : "memory"); }
__device__ __forceinline__ unsigned rfl(unsigned v) { return (unsigned)__builtin_amdgcn_readfirstlane((int)v); }
__device__ __forceinline__ int pi23(int x) { return (x & ~12) | ((x & 4) << 1) | ((x & 8) >> 1); }
__device__ __forceinline__ s16x4 vtr(const ALDS unsigned char* p) { return __builtin_bit_cast(s16x4, __builtin_amdgcn_ds_read_tr16_b64_v4i16((ALDS s16x4*)p)); }
__device__ __forceinline__ float halfswap_max(float v) { auto rr = __builtin_amdgcn_permlane32_swap(__float_as_uint(v), __float_as_uint(v), false, false); return fmaxf(__uint_as_float(rr[0]), __uint_as_float(rr[1])); }
__device__ __forceinline__ float halfswap_sum(float v) { auto rr = __builtin_amdgcn_permlane32_swap(__float_as_uint(v), __float_as_uint(v), false, false); return __uint_as_float(rr[0]) + __uint_as_float(rr[1]); }

template <int DV, bool BAND>
__device__ __forceinline__ float attn_core(ALDS unsigned char* ring, const int wid, const int lane,
                                           const bf16_t* Qw, const bf16_t* ksrc, const bf16_t* vsrc, const int koff,
                                           const int t0, const int t1, const int tq, const int qpos, const float m_init, float l, f32x16 (&o)[DV / 32]) {
    constexpr int NDB = DV / 32, SLOT = (DV == 128) ? 32768 : 16384, VOFF = (DV == 128) ? 16384 : 8192, ROWB = DV * 2, NP = (DV == 128) ? 4 : 2;
    const int r32 = lane & 31, hi = lane >> 5;
    const unsigned ring_a = (unsigned)(uintptr_t)ring;
    bf16x8 qr[4];
#pragma unroll
    for (int d0 = 0; d0 < 4; ++d0) qr[d0] = *(const bf16x8*)(Qw + (size_t)r32 * PITCH + d0 * 16 + hi * 8);
#define ATT_ISSUE(t_, so_) do { const size_t go_ = (size_t)(t_) * (64 * PITCH); const unsigned d_ = ring_a + (unsigned)(so_) + (unsigned)wid * 1024u; \
        glds16(ksrc + go_, rfl(d_)); \
        if (DV == 128) { glds16(ksrc + go_ + 64, rfl(d_ + 8192u)); glds16(vsrc + go_, rfl(ring_a + (unsigned)(so_) + (unsigned)VOFF + (unsigned)wid * 2048u)); \
                         glds16(vsrc + go_ + 4 * PITCH, rfl(ring_a + (unsigned)(so_) + (unsigned)VOFF + (unsigned)wid * 2048u + 1024u)); } \
        else { glds16(vsrc + go_, rfl(d_ + (unsigned)VOFF)); } } while (0)
    ATT_ISSUE(t0, 0);
    { const int tn = (t0 + 1 < t1) ? t0 + 1 : t1 - 1; ATT_ISSUE(tn, SLOT); }
    const int g = (lane >> 4) & 1, q4 = (lane & 15) >> 2, p = lane & 3, sw = (DV == 128) ? q4 : (q4 >> 1);
    int va[NDB];
#pragma unroll
    for (int db = 0; db < NDB; ++db) va[db] = VOFF + (8 * hi + q4) * ROWB + ((db ^ sw) << 6) + (2 * g + (p >> 1)) * 16 + 8 * (p & 1);
    const int ka = koff + hi * 1024 + r32 * 16;
    float m = m_init;
    f32x16 negm;
#pragma unroll
    for (int r = 0; r < 16; ++r) negm[r] = -m;
#pragma unroll
    for (int db = 0; db < NDB; ++db)
#pragma unroll
        for (int r = 0; r < 16; ++r) o[db][r] = 0.f;
    int s_cur = 0, s_n2 = 2 * SLOT;
    for (int t = t0; t < t1; ++t) {
        asm volatile("s_waitcnt vmcnt(%0)" :: "n"(NP) : "memory");
        asm volatile("s_waitcnt lgkmcnt(0)\n\ts_barrier" ::: "memory");
        { const int tn = (t + 2 < t1) ? t + 2 : t1 - 1; ATT_ISSUE(tn, s_n2); }
        const ALDS unsigned char* sb = ring + s_cur;
        f32x16 p0 = negm, p1 = negm;
        bf16x8 kf[8];
#pragma unroll
        for (int d0 = 0; d0 < 4; ++d0) { kf[2 * d0] = *(const ALDS bf16x8*)(sb + ka + d0 * 2048); kf[2 * d0 + 1] = *(const ALDS bf16x8*)(sb + ka + d0 * 2048 + 512); }
        s16x4 vlo[2][NDB], vhh[2][NDB];
#pragma unroll
        for (int db = 0; db < NDB; ++db) { vlo[0][db] = vtr(sb + va[db]); vhh[0][db] = vtr(sb + va[db] + 4 * ROWB); }
        __builtin_amdgcn_sched_barrier(0);
#pragma unroll
        for (int d0 = 0; d0 < 4; ++d0) {
            p0 = __builtin_amdgcn_mfma_f32_32x32x16_bf16(kf[2 * d0], qr[d0], p0, 0, 0, 0);
            p1 = __builtin_amdgcn_mfma_f32_32x32x16_bf16(kf[2 * d0 + 1], qr[d0], p1, 0, 0, 0);
        }
        if (BAND) {
            if (t == tq - 2 || t == tq + 2) {
                const int rel0 = t * 64 + 8 * hi - qpos;
#pragma unroll
                for (int r = 0; r < 16; ++r) { const int rel = rel0 + 16 * (r >> 3) + (r & 7);
                    if (rel < -128 || rel > 128) p0[r] = -INFINITY;
                    if (rel + 32 < -128 || rel + 32 > 128) p1[r] = -INFINITY; }
            }
        }
        float mx = fmaxf(p0[0], p1[0]);
#pragma unroll
        for (int r = 1; r < 16; ++r) mx = fmaxf(fmaxf(mx, p0[r]), p1[r]);
        mx = halfswap_max(mx);
        const bool first = (!BAND) && (t == t0);
        const float dl = first ? mx : ((mx > THR) ? mx : 0.f);
        if (__any(dl != 0.f)) {
            m += dl;
#pragma unroll
            for (int r = 0; r < 16; ++r) { p0[r] -= dl; p1[r] -= dl; negm[r] = -m; }
            const float f = first ? 1.f : __builtin_amdgcn_exp2f(-dl);
            l *= f;
#pragma unroll
            for (int db = 0; db < NDB; ++db)
#pragma unroll
                for (int r = 0; r < 16; ++r) o[db][r] *= f;
        }
        float ssum = 0.f;
        bf16x8 pf;
#define ATT_EXP_SLICE(P_, B_, DST_) do { u32x4 w_; \
        P_[B_ + 0] = __builtin_amdgcn_exp2f(P_[B_ + 0]); P_[B_ + 1] = __builtin_amdgcn_exp2f(P_[B_ + 1]); P_[B_ + 2] = __builtin_amdgcn_exp2f(P_[B_ + 2]); P_[B_ + 3] = __builtin_amdgcn_exp2f(P_[B_ + 3]); \
        P_[B_ + 4] = __builtin_amdgcn_exp2f(P_[B_ + 4]); P_[B_ + 5] = __builtin_amdgcn_exp2f(P_[B_ + 5]); P_[B_ + 6] = __builtin_amdgcn_exp2f(P_[B_ + 6]); P_[B_ + 7] = __builtin_amdgcn_exp2f(P_[B_ + 7]); \
        ssum += ((P_[B_ + 0] + P_[B_ + 1]) + (P_[B_ + 2] + P_[B_ + 3])) + ((P_[B_ + 4] + P_[B_ + 5]) + (P_[B_ + 6] + P_[B_ + 7])); \
        w_.x = cvtpk(P_[B_ + 0], P_[B_ + 1]); w_.y = cvtpk(P_[B_ + 2], P_[B_ + 3]); w_.z = cvtpk(P_[B_ + 4], P_[B_ + 5]); w_.w = cvtpk(P_[B_ + 6], P_[B_ + 7]); DST_ = __builtin_bit_cast(bf16x8, w_); } while (0)
        ATT_EXP_SLICE(p0, 0, pf);
        __builtin_amdgcn_sched_barrier(0);
#pragma unroll
        for (int ks = 0; ks < 4; ++ks) {
            bf16x8 pfn = pf;
            if (ks + 1 < 4) {
#pragma unroll
                for (int db = 0; db < NDB; ++db) { vlo[(ks + 1) & 1][db] = vtr(sb + va[db] + (ks + 1) * (16 * ROWB)); vhh[(ks + 1) & 1][db] = vtr(sb + va[db] + (ks + 1) * (16 * ROWB) + 4 * ROWB); }
            }
#pragma unroll
            for (int db = 0; db < NDB; ++db) {
                const s16x4 lo = vlo[ks & 1][db], hh = vhh[ks & 1][db];
                const bf16x8 vf = (bf16x8){lo[0], lo[1], lo[2], lo[3], hh[0], hh[1], hh[2], hh[3]};
                o[db] = __builtin_amdgcn_mfma_f32_32x32x16_bf16(vf, pf, o[db], 0, 0, 0);
            }
            if (ks == 0) ATT_EXP_SLICE(p0, 8, pfn);
            if (ks == 1) ATT_EXP_SLICE(p1, 0, pfn);
            if (ks == 2) ATT_EXP_SLICE(p1, 8, pfn);
            if (ks + 1 < 4) {
                __builtin_amdgcn_sched_group_barrier(0x100, 2 * NDB, 0);
#pragma unroll
                for (int db = 0; db < NDB; ++db) { __builtin_amdgcn_sched_group_barrier(0x008, 1, 0); __builtin_amdgcn_sched_group_barrier(0x002, 20 / NDB, 0); }
            }
            __builtin_amdgcn_sched_barrier(0);
            pf = pfn;
        }
#undef ATT_EXP_SLICE
        l += ssum;
        s_cur = (s_cur == 2 * SLOT) ? 0 : s_cur + SLOT; s_n2 = (s_n2 == 2 * SLOT) ? 0 : s_n2 + SLOT;
    }
    asm volatile("s_waitcnt vmcnt(0) lgkmcnt(0)\n\ts_barrier" ::: "memory");
#undef ATT_ISSUE
    return l;
}

__device__ __forceinline__ void diff_unit(ALDS unsigned char* ring, const int wid, int lane, const bf16_t* qkv, bf16_t* ymix, const int u, const float lam, const float post, const float* subg) {
    asm volatile("" : "+v"(lane));
    const int bh = u >> 5, qb = u & 31, b = bh >> 2, h = bh & 3, comp = wid >> 2, wq = wid & 3, r32 = lane & 31, hi = lane >> 5;
    const size_t rowbase = (size_t)b * 4096;
    const int q0 = qb * 128 + wq * 32;
    const bf16_t* Qw = qkv + (rowbase + q0) * PITCH + h * 128 + comp * 64;
    const bf16_t* ksrc = qkv + (rowbase + pi23(lane)) * PITCH + 512 + h * 128 + wid * 8;
    const bf16_t* vsrc = qkv + (rowbase + 8 * wid + (lane >> 4)) * PITCH + 1024 + h * 128 + (((lane & 15) ^ ((lane >> 4) << 2)) * 8);
    f32x16 o[4];
    float l = attn_core<128, false>(ring, wid, lane, Qw, ksrc, vsrc, comp * 8192, 0, 64, 0, 0, 0.f, 0.f, o);
    l = halfswap_sum(l);
    const float inv = 1.0f / l;
    ALDS f32x4* X = (ALDS f32x4*)ring + (size_t)wq * (16 * 64);
    if (comp == 1) {
#pragma unroll
        for (int db = 0; db < 4; ++db)
#pragma unroll
            for (int rq = 0; rq < 4; ++rq) X[(db * 4 + rq) * 64 + lane] = (f32x4){o[db][4 * rq] * inv, o[db][4 * rq + 1] * inv, o[db][4 * rq + 2] * inv, o[db][4 * rq + 3] * inv};
    }
    asm volatile("s_waitcnt lgkmcnt(0)\n\ts_barrier" ::: "memory");
    if (comp == 0) {
        float ss = 0.f;
#pragma unroll
        for (int db = 0; db < 4; ++db)
#pragma unroll
            for (int rq = 0; rq < 4; ++rq) { const f32x4 o2 = X[(db * 4 + rq) * 64 + lane];
#pragma unroll
                for (int e = 0; e < 4; ++e) { const float d = o[db][4 * rq + e] * inv - lam * o2[e]; o[db][4 * rq + e] = d; ss += d * d; } }
        ss = halfswap_sum(ss);
        const float rs = rsqrtf(ss * (1.0f / 128.0f) + 1e-5f) * post;
        bf16_t* orow = ymix + (rowbase + q0 + r32) * 1024 + h * 128 + 4 * hi;
#pragma unroll
        for (int db = 0; db < 4; ++db)
#pragma unroll
            for (int rq = 0; rq < 4; ++rq) { const f32x4 gv = *(const f32x4*)(subg + 32 * db + 8 * rq + 4 * hi);
                u32x2 w; w.x = cvtpk(o[db][4 * rq] * rs * gv[0], o[db][4 * rq + 1] * rs * gv[1]); w.y = cvtpk(o[db][4 * rq + 2] * rs * gv[2], o[db][4 * rq + 3] * rs * gv[3]);
                *(u32x2*)(orow + 32 * db + 8 * rq) = w; }
    }
    asm volatile("s_waitcnt lgkmcnt(0)\n\ts_barrier" ::: "memory");
}

__device__ __forceinline__ void swa_unit(ALDS unsigned char* ring, const int wid, int lane, const bf16_t* qkv, bf16_t* ymix, const int u, const float* sink) {
    asm volatile("" : "+v"(lane));
    const int bkv = u >> 6, qblk = u & 63, b = bkv >> 1, kvh = bkv & 1, head = kvh * 4 + (wid >> 1), r32 = lane & 31, hi = lane >> 5;
    const size_t rowbase = (size_t)b * 4096;
    const int q0 = qblk * 64 + (wid & 1) * 32;
    const bf16_t* Qw = qkv + (rowbase + q0) * PITCH + 1536 + head * 64;
    const bf16_t* ksrc = qkv + (rowbase + pi23(lane)) * PITCH + 2048 + kvh * 64 + wid * 8;
    const bf16_t* vsrc = qkv + (rowbase + 8 * wid + (lane >> 3)) * PITCH + 2176 + kvh * 64 + (((lane & 7) ^ (((lane >> 4) & 1) << 2)) * 8);
    const int t0 = (qblk - 2 > 0) ? qblk - 2 : 0, t1 = ((qblk + 2 < 63) ? qblk + 2 : 63) + 1;
    f32x16 o[2];
    float l = attn_core<64, true>(ring, wid, lane, Qw, ksrc, vsrc, 0, t0, t1, qblk, q0 + r32, sink[head] * 1.4426950408889634f, (hi == 0) ? 1.0f : 0.0f, o);
    l = halfswap_sum(l);
    const float inv = 1.0f / l;
    bf16_t* orow = ymix + (rowbase + q0 + r32) * 1024 + 512 + head * 64 + 4 * hi;
#pragma unroll
    for (int db = 0; db < 2; ++db)
#pragma unroll
        for (int rq = 0; rq < 4; ++rq) { u32x2 w; w.x = cvtpk(o[db][4 * rq] * inv, o[db][4 * rq + 1] * inv); w.y = cvtpk(o[db][4 * rq + 2] * inv, o[db][4 * rq + 3] * inv);
            *(u32x2*)(orow + 32 * db + 8 * rq) = w; }
}
}

#ifndef REP_ATT
#define REP_ATT 1
#endif
#ifndef REP_G1
#define REP_G1 1
#endif
#ifndef REP_SYNC
#define REP_SYNC 1
#endif
#ifndef REP_LN
#define REP_LN 1
#endif
#ifndef REP_PRO
#define REP_PRO 1
#endif
constexpr int NWAVES = 8;
constexpr int M = 65536, D = 1024, FF = 2816, NIN = 2304, SEQ = 4096, DEPTH = 4;
constexpr size_t MiB = 1u << 20;
constexpr size_t W1_OFF = 0, W1_B = (size_t)2 * FF * D * 2, W2_OFF = W1_OFF + W1_B, W2_B = (size_t)D * FF * 2, WIN_OFF = W2_OFF + W2_B, WIN_B = (size_t)NIN * D * 2,
                 WO_OFF = WIN_OFF + WIN_B, WO_B = (size_t)D * D * 2, W3_OFF = WO_OFF + WO_B, W4_OFF = W3_OFF + W1_B, WL_STRIDE = W4_OFF + W2_B;
constexpr size_t WS_W = 0, WS_ROPE = 160 * MiB, WS_XB = 176 * MiB, WS_H = 304 * MiB, WS_YM = 656 * MiB, WS_CSBW = 784 * MiB, WS_ST = 785 * MiB, WS_END = 786 * MiB;
constexpr int CSBW_N = 2 * FF;
static_assert((size_t)DEPTH * 3 * 2 * CSBW_N * 4 <= MiB && (size_t)2 * M * 2 * 4 <= MiB, "aux map");
static_assert(WL_STRIDE * DEPTH <= WS_ROPE && WS_ROPE + (size_t)M * 64 * 4 <= WS_XB && WS_XB + (size_t)M * D * 2 <= WS_H && WS_H + (size_t)M * FF * 2 <= WS_YM && WS_YM + (size_t)M * D * 2 <= WS_END, "d_ws map");
constexpr int LDS_BYTES = 147456;
constexpr float ALPHA = 1.681792830507429f;
constexpr float QSCALE = 0.125f * 1.4426950408889634f;

typedef unsigned short bf16;
typedef float f32x4 __attribute__((ext_vector_type(4)));
typedef unsigned v4u __attribute__((ext_vector_type(4)));
typedef unsigned v2u __attribute__((ext_vector_type(2)));
using pg8::cvtpk;

struct Args { const float* in[13]; float* out; unsigned char* ws; float inv[32]; float lam_init[4]; };

__device__ __forceinline__ float wave_sum(float v) {
#pragma unroll
    for (int o = 1; o < 64; o <<= 1) v += __shfl_xor(v, o);
    return v;
}
__device__ __forceinline__ int src_col(int type, int n) {
    if (type == 1) { const int pn = n >> 8, w = n & 255; return (w < 128) ? (128 * pn + w) : (FF + 128 * pn + (w - 128)); }
    if (type == 2) { const bool rp = (n < 1024) || (n >= 1536 && n < 2176); return rp ? ((n & ~63) + ((n & 63) >> 1) + 32 * (n & 1)) : n; }
    return n;
}
template <bool F16> __device__ __forceinline__ void transpose_item(const float* W, int K, int N, int type, const float* gk, bf16* WT, ALDS float* scr, int item, int lane) {
    const int nblk = N / 32, kb = item / nblk, nb = item % nblk, k0 = 64 * kb, n0 = 32 * nb;
    const int sc = src_col(type, n0 + (lane & 31));
#pragma unroll 8
    for (int i = 0; i < 32; ++i) { const int kk = 2 * i + (lane >> 5); scr[kk * 33 + (lane & 31)] = W[(size_t)(k0 + kk) * N + sc] * (gk ? gk[k0 + kk] : 1.0f); }
    asm volatile("s_waitcnt lgkmcnt(0)" ::: "memory");
    const int c = lane & 7;
#pragma unroll
    for (int j = 0; j < 4; ++j) { const int n = (lane >> 3) + 8 * j; const ALDS float* s = scr + (8 * c) * 33 + n;
        v4u o; if (F16) { o.x = pg8::cvtpk_h(s[0 * 33], s[1 * 33]); o.y = pg8::cvtpk_h(s[2 * 33], s[3 * 33]); o.z = pg8::cvtpk_h(s[4 * 33], s[5 * 33]); o.w = pg8::cvtpk_h(s[6 * 33], s[7 * 33]); }
        else { o.x = cvtpk(s[0 * 33], s[1 * 33]); o.y = cvtpk(s[2 * 33], s[3 * 33]); o.z = cvtpk(s[4 * 33], s[5 * 33]); o.w = cvtpk(s[6 * 33], s[7 * 33]); }
        *(v4u*)(WT + (size_t)(n0 + n) * K + k0 + 8 * c) = o; }
    asm volatile("s_waitcnt lgkmcnt(0)" ::: "memory");
}
__device__ __forceinline__ void sincos_f32angle(float ang, float& c, float& s) {
    const double a = (double)ang, k = __builtin_rint(a * 0.63661977236758134308);
    double r = __builtin_fma(-k, 1.57079632679489655800e+00, a); r = __builtin_fma(-k, 6.12323399573676603587e-17, r);
    const double r2 = r * r;
    double sp = -1.0 / 1307674368000.0; sp = sp * r2 + 1.0 / 6227020800.0; sp = sp * r2 - 1.0 / 39916800.0; sp = sp * r2 + 1.0 / 362880.0; sp = sp * r2 - 1.0 / 5040.0; sp = sp * r2 + 1.0 / 120.0; sp = sp * r2 - 1.0 / 6.0;
    const double sn = r + r * r2 * sp;
    double cp = 1.0 / 20922789888000.0; cp = cp * r2 - 1.0 / 87178291200.0; cp = cp * r2 + 1.0 / 479001600.0; cp = cp * r2 - 1.0 / 3628800.0; cp = cp * r2 + 1.0 / 40320.0; cp = cp * r2 - 1.0 / 720.0; cp = cp * r2 + 1.0 / 24.0; cp = cp * r2 - 0.5;
    const double cn = 1.0 + r2 * cp;
    const int q = ((int)k) & 3;
    const double cc = (q == 0) ? cn : (q == 1) ? -sn : (q == 2) ? -cn : sn;
    const double ss = (q == 0) ? sn : (q == 1) ? cn : (q == 2) ? -sn : -cn;
    c = (float)cc; s = (float)ss;
}
__device__ __forceinline__ void ln_row(const float* xrow, const float* g, const float* bta, float* orow, bf16* brow, int lane) {
    asm volatile("" : "+v"(lane));
    const f32x4* xr = (const f32x4*)xrow + lane;
    f32x4 v[4]; float s = 0.f;
#pragma unroll
    for (int j = 0; j < 4; ++j) { v[j] = xr[64 * j]; s += (v[j][0] + v[j][1]) + (v[j][2] + v[j][3]); }
    const float mean = wave_sum(s) * (1.f / D); float s2 = 0.f;
#pragma unroll
    for (int j = 0; j < 4; ++j) { v[j] = v[j] - mean; s2 += (v[j][0] * v[j][0] + v[j][1] * v[j][1]) + (v[j][2] * v[j][2] + v[j][3] * v[j][3]); }
    const float rstd = 1.0f / sqrtf(wave_sum(s2) * (1.f / D) + 1e-5f);
#pragma unroll
    for (int j = 0; j < 4; ++j) { const f32x4 gg = *((const f32x4*)g + lane + 64 * j), bb = *((const f32x4*)bta + lane + 64 * j);
        const f32x4 y = v[j] * rstd * gg + bb;
        *((f32x4*)orow + lane + 64 * j) = y;
        v2u w; w.x = cvtpk(y[0], y[1]); w.y = cvtpk(y[2], y[3]); *((v2u*)brow + lane + 64 * j) = w; }
}

__device__ __forceinline__ void ln_row_h(const bf16* hrow, const float* g, const float* bta, float* orow, int lane) {
    asm volatile("" : "+v"(lane));
    typedef _Float16 h4 __attribute__((ext_vector_type(4)));
    f32x4 v[4]; float s = 0.f;
#pragma unroll
    for (int j = 0; j < 4; ++j) { const h4 h = *((const h4*)hrow + lane + 64 * j); v[j] = (f32x4){(float)h[0], (float)h[1], (float)h[2], (float)h[3]}; s += (v[j][0] + v[j][1]) + (v[j][2] + v[j][3]); }
    const float mean = wave_sum(s) * (1.f / D); float s2 = 0.f;
#pragma unroll
    for (int j = 0; j < 4; ++j) { v[j] = v[j] - mean; s2 += (v[j][0] * v[j][0] + v[j][1] * v[j][1]) + (v[j][2] * v[j][2] + v[j][3] * v[j][3]); }
    const float rstd = 1.0f / sqrtf(wave_sum(s2) * (1.f / D) + 1e-5f);
#pragma unroll
    for (int j = 0; j < 4; ++j) { const f32x4 gg = *((const f32x4*)g + lane + 64 * j), bb = *((const f32x4*)bta + lane + 64 * j);
        *((f32x4*)orow + lane + 64 * j) = v[j] * rstd * gg + bb; }
}

__global__ void __launch_bounds__(NWAVES * 64, 2) fwd_megakernel(Args args) {
    extern __shared__ __attribute__((aligned(16))) unsigned char lds_raw[];
    cg::grid_group grid = cg::this_grid();
#define GSYNC() do { for (int rs_ = 0; rs_ < REP_SYNC; ++rs_) grid.sync(); } while (0)
    ALDS unsigned char* lds = (ALDS unsigned char*)lds_raw;
    const int tid = threadIdx.x, lane = tid & 63, wave = __builtin_amdgcn_readfirstlane(tid >> 6);
    const int G = gridDim.x, bx = blockIdx.x, vcu = (G % 8 == 0) ? (bx % 8) * (G / 8) + bx / 8 : bx;
    unsigned char* ws = args.ws;
    const float* x_in = args.in[0]; const int* positions = (const int*)args.in[1];
    float* out = args.out;
    bf16* XB = (bf16*)(ws + WS_XB); bf16* HB = (bf16*)(ws + WS_H); bf16* QKV = (bf16*)(ws + WS_H); bf16* YM = (bf16*)(ws + WS_YM);
    float* ROPE = (float*)(ws + WS_ROPE); float* CSBW = (float*)(ws + WS_CSBW); float* ST = (float*)(ws + WS_ST);
    const int gw = vcu * NWAVES + wave, NGW = G * NWAVES;

    for (int rep = 0; rep < REP_PRO; ++rep) {
        ALDS float* scr = (ALDS float*)(lds + wave * 16384);
        constexpr int I1 = (D / 64) * (2 * FF / 32), I2 = (FF / 64) * (D / 32), I3 = (D / 64) * (NIN / 32), I4 = (D / 64) * (D / 32), IL = 2 * I1 + 2 * I2 + I3 + I4;
        for (int it = gw; it < IL * DEPTH; it += NGW) {
            const int l = it / IL; int r = it % IL;
            unsigned char* wl = ws + WS_W + (size_t)l * WL_STRIDE;
            if (r < I1) { transpose_item<true>(args.in[7] + (size_t)l * D * 2 * FF, D, 2 * FF, 1, (l > 0) ? args.in[11] + (size_t)((l - 1) * 3 + 2) * D : nullptr, (bf16*)(wl + W1_OFF), scr, r, lane); continue; } r -= I1;
            if (r < I2) { transpose_item<false>(args.in[8] + (size_t)l * FF * D, FF, D, 0, nullptr, (bf16*)(wl + W2_OFF), scr, r, lane); continue; } r -= I2;
            if (r < I3) { transpose_item<true>(args.in[2] + (size_t)l * D * NIN, D, NIN, 2, args.in[11] + (size_t)(l * 3) * D, (bf16*)(wl + WIN_OFF), scr, r, lane); continue; } r -= I3;
            if (r < I4) { transpose_item<false>(args.in[3] + (size_t)l * D * D, D, D, 0, nullptr, (bf16*)(wl + WO_OFF), scr, r, lane); continue; } r -= I4;
            if (r < I1) { transpose_item<true>(args.in[9] + (size_t)l * D * 2 * FF, D, 2 * FF, 1, args.in[11] + (size_t)(l * 3 + 1) * D, (bf16*)(wl + W3_OFF), scr, r, lane); continue; } r -= I1;
            transpose_item<false>(args.in[10] + (size_t)l * FF * D, FF, D, 0, nullptr, (bf16*)(wl + W4_OFF), scr, r, lane);
        }
        const size_t gt = (size_t)vcu * (NWAVES * 64) + tid, GT = (size_t)G * NWAVES * 64;
        for (size_t i = gt; i < (size_t)M * D / 4; i += GT) { const f32x4 v = *((const f32x4*)x_in + i); v2u w; w.x = pg8::cvtpk_h(v[0], v[1]); w.y = pg8::cvtpk_h(v[2], v[3]); *((v2u*)XB + i) = w; }
        for (size_t i = gt; i < (size_t)M * 32; i += GT) { const int row = (int)(i >> 5), k = (int)(i & 31); float c, s; sincos_f32angle((float)positions[row] * args.inv[k], c, s);
            ROPE[(size_t)row * 64 + k] = c; ROPE[(size_t)row * 64 + 32 + k] = s; }
        for (size_t i = gt; i < (size_t)M * 2; i += GT) ST[i] = 0.f;
        {
            ALDS float* red = (ALDS float*)(lds + 131072);
            constexpr int CG0 = 2 * FF / 64, CG1 = NIN / 64, CGL = 2 * CG0 + CG1;
            for (int cgi = vcu; cgi < CGL * DEPTH; cgi += G) {
                const int l = cgi / CGL; int r = cgi % CGL; int j = 0;
                if (r >= CG0) { r -= CG0; j = 1; if (r >= CG1) { r -= CG1; j = 2; } }
                const int lnidx = (j == 0) ? (l - 1) * 3 + 2 : (j == 1) ? l * 3 : l * 3 + 1;
                if (lnidx < 0) continue;
                const int N = (j == 1) ? NIN : 2 * FF, type = (j == 1) ? 2 : 1;
                const float* W = (j == 0) ? args.in[7] + (size_t)l * D * 2 * FF : (j == 1) ? args.in[2] + (size_t)l * D * NIN : args.in[9] + (size_t)l * D * 2 * FF;
                const float* gk = args.in[11] + (size_t)lnidx * D; const float* bk = args.in[12] + (size_t)lnidx * D;
                const int n = r * 64 + lane, sc = src_col(type, n);
                float c1 = 0.f, b1 = 0.f;
#pragma unroll 16
                for (int k = wave * 128; k < wave * 128 + 128; ++k) { const float w = W[(size_t)k * N + sc]; const float gw = gk[k] * w;
                    c1 += (float)(_Float16)gw; b1 += bk[k] * w; }
                red[(wave * 64 + lane) * 2] = c1; red[(wave * 64 + lane) * 2 + 1] = b1;
                __syncthreads();
                if (wave == 0) { float cc = 0.f, bb = 0.f;
#pragma unroll
                    for (int w8 = 0; w8 < 8; ++w8) { cc += red[(w8 * 64 + lane) * 2]; bb += red[(w8 * 64 + lane) * 2 + 1]; }
                    float* dst = CSBW + (size_t)((l * 3 + j) * 2) * CSBW_N; dst[n] = cc; dst[CSBW_N + n] = bb; }
                __syncthreads();
            }
        }
    }
    GSYNC();

#define ZERO_ST(buf_) do { int t_ = tid; asm volatile("" : "+v"(t_)); float* z_ = ST + (size_t)(buf_) * M * 2; for (int i_ = vcu * (NWAVES * 64) + t_; i_ < M * 2; i_ += G * NWAVES * 64) { z_[i_] = 0.f; asm volatile("" : "+v"(i_)); } } while (0)
    for (int l = 0; l < DEPTH; ++l) {
        unsigned char* wl = ws + WS_W + (size_t)l * WL_STRIDE;
        const float* lng = args.in[11]; const float* lnb = args.in[12];
        { const int k = 3 * l; ZERO_ST(k & 1);
          const float* cb = CSBW + (size_t)((l * 3 + 0) * 2) * CSBW_N;
          pg8::Gemm g{XB, (const bf16*)(wl + W1_OFF), M, 2 * FF, D}; pg8::StaticOrder S; S.init(M, 2 * FF, G, bx);
          pg8::EpiSwiGLU E{HB, FF, pg8::RowLN{(k == 0) ? nullptr : ST + (size_t)((k - 1) & 1) * M * 2, cb, cb + CSBW_N}};
          for (int rep = 0; rep < REP_G1; ++rep) pg8::gemm_phase<pg8::EpiSwiGLU, pg8::StaticOrder, true, true>(lds, g, S, E); }
        GSYNC();
        { const int k = 3 * l;
          pg8::Gemm g{HB, (const bf16*)(wl + W2_OFF), M, D, FF}; pg8::StaticOrder S; S.init(M, D, G, bx);
          pg8::EpiRes E{x_in, XB, (k == 0) ? nullptr : ST + (size_t)((k - 1) & 1) * M * 2, lng + (size_t)(k > 0 ? k - 1 : 0) * D, lnb + (size_t)(k > 0 ? k - 1 : 0) * D, ST + (size_t)(k & 1) * M * 2, ALPHA, 0.5f};
          pg8::gemm_phase<pg8::EpiRes, pg8::StaticOrder, true, true>(lds, g, S, E); }
        GSYNC();
        { const int k = 3 * l + 1; ZERO_ST(k & 1);
          const float* cb = CSBW + (size_t)((l * 3 + 1) * 2) * CSBW_N;
          pg8::Gemm g{XB, (const bf16*)(wl + WIN_OFF), M, NIN, D}; pg8::StaticOrder S; S.init(M, NIN, G, bx);
          pg8::EpiQKV E{QKV, ROPE, QSCALE, pg8::RowLN{ST + (size_t)((k - 1) & 1) * M * 2, cb, cb + CSBW_N}};
          pg8::gemm_phase<pg8::EpiQKV, pg8::StaticOrder, true, true>(lds, g, S, E); }
        GSYNC();
        {
            const float* lv = args.in[4] + (size_t)l * 256;
            int la = lane; asm volatile("" : "+v"(la));
            const float a1 = wave_sum(lv[la] * lv[64 + la]), a2 = wave_sum(lv[128 + la] * lv[192 + la]);
            const float lam_init = args.lam_init[l], lam = expf(a1) - expf(a2) + lam_init;
            const float* subg = args.in[5] + (size_t)l * 128; const float* sink = args.in[6] + (size_t)l * 8;
            for (int rep = 0; rep < REP_ATT; ++rep) {
            for (int u = vcu; u < 2048; u += G) att::diff_unit(lds, wave, lane, QKV, YM, u, lam, 1.0f - lam_init, subg);
            for (int u = vcu; u < 2048; u += G) att::swa_unit(lds, wave, lane, QKV, YM, u, sink);
            }
        }
        GSYNC();
        { const int k = 3 * l + 1;
          pg8::Gemm g{YM, (const bf16*)(wl + WO_OFF), M, D, D}; pg8::StaticOrder S; S.init(M, D, G, bx);
          pg8::EpiRes E{x_in, XB, ST + (size_t)((k - 1) & 1) * M * 2, lng + (size_t)(k - 1) * D, lnb + (size_t)(k - 1) * D, ST + (size_t)(k & 1) * M * 2, ALPHA, 1.0f};
          pg8::gemm_phase<pg8::EpiRes, pg8::StaticOrder, true, true>(lds, g, S, E); }
        GSYNC();
        { const int k = 3 * l + 2; ZERO_ST(k & 1);
          const float* cb = CSBW + (size_t)((l * 3 + 2) * 2) * CSBW_N;
          pg8::Gemm g{XB, (const bf16*)(wl + W3_OFF), M, 2 * FF, D}; pg8::StaticOrder S; S.init(M, 2 * FF, G, bx);
          pg8::EpiSwiGLU E{HB, FF, pg8::RowLN{ST + (size_t)((k - 1) & 1) * M * 2, cb, cb + CSBW_N}};
          for (int rep = 0; rep < REP_G1; ++rep) pg8::gemm_phase<pg8::EpiSwiGLU, pg8::StaticOrder, true, true>(lds, g, S, E); }
        GSYNC();
        { const int k = 3 * l + 2;
          pg8::Gemm g{HB, (const bf16*)(wl + W4_OFF), M, D, FF}; pg8::StaticOrder S; S.init(M, D, G, bx);
          pg8::EpiRes E{x_in, XB, ST + (size_t)((k - 1) & 1) * M * 2, lng + (size_t)(k - 1) * D, lnb + (size_t)(k - 1) * D, ST + (size_t)(k & 1) * M * 2, ALPHA, 0.5f};
          pg8::gemm_phase<pg8::EpiRes, pg8::StaticOrder, true, true>(lds, g, S, E); }
        GSYNC();
    }
    for (int m = gw; m < M; m += NGW) ln_row_h(XB + (size_t)m * D, args.in[11] + (size_t)11 * D, args.in[12] + (size_t)11 * D, out + (size_t)m * D, lane);
}

extern "C" void kernel_launch(void* const* d_in, const int* in_sizes, int n_in, void* d_out, int out_size, void* d_ws, size_t ws_size, hipStream_t stream) {
    static int grid = 0;
    if (grid == 0) {
        if (n_in != 13 || in_sizes[0] != M * D || out_size != M * D || ws_size < WS_END) { fprintf(stderr, "kernel_launch: unexpected shapes (n_in %d, in0 %d, out %d, ws %zu); nothing launched\n", n_in, n_in > 0 ? in_sizes[0] : -1, out_size, ws_size); grid = -1; return; }
        int dev = 0, cus = 0, per_cu = 0;
        if (hipGetDevice(&dev) != hipSuccess || hipDeviceGetAttribute(&cus, hipDeviceAttributeMultiprocessorCount, dev) != hipSuccess) { grid = -1; return; }
        if (hipFuncSetAttribute((const void*)fwd_megakernel, hipFuncAttributeMaxDynamicSharedMemorySize, LDS_BYTES) != hipSuccess) { fprintf(stderr, "kernel_launch: hipFuncSetAttribute failed\n"); grid = -1; return; }
        if (hipOccupancyMaxActiveBlocksPerMultiprocessor(&per_cu, (const void*)fwd_megakernel, NWAVES * 64, LDS_BYTES) != hipSuccess || per_cu < 1) { fprintf(stderr, "kernel_launch: occupancy query gives %d\n", per_cu); per_cu = 1; }
        (void)hipGetLastError();
        grid = cus * 1;
    }
    if (grid < 0) return;
    Args a{};
    for (int i = 0; i < 13; ++i) a.in[i] = (const float*)d_in[i];
    a.out = (float*)d_out; a.ws = (unsigned char*)d_ws;
    for (int i = 0; i < 32; ++i) a.inv[i] = (float)pow(10000.0, -(double)(2 * i) / 64.0);
    for (int l = 0; l < 4; ++l) a.lam_init[l] = (float)(0.8 - 0.6 * exp(-0.3 * (double)l));
    void* kargs[] = {&a};
    const hipError_t e = hipLaunchCooperativeKernel((const void*)fwd_megakernel, dim3(grid), dim3(NWAVES * 64), kargs, LDS_BYTES, stream);
    if (e != hipSuccess) fprintf(stderr, "kernel_launch: cooperative launch failed: %s (grid %d)\n", hipGetErrorString(e), grid);
}
```

```cpp
#include <hip/hip_runtime.h>
#include <hip/hip_cooperative_groups.h>
#include <cstdio>
#include <cstdint>
#include <cmath>
namespace cg = cooperative_groups;
namespace pg8 {
#define PG8_LAS __attribute__((address_space(3)))
typedef unsigned short bf16_t;
typedef short bf16x8 __attribute__((ext_vector_type(8)));
typedef float f32x4 __attribute__((ext_vector_type(4)));
typedef unsigned u32x4 __attribute__((ext_vector_type(4)));
constexpr int BM = 256, BK = 64, HALF = 128, HTB = HALF * BK * 2  , STAGE_BYTES = 8 * HTB, NXCD = 8, WGM = 8;

__host__ __device__ __forceinline__ int lds_byte(int r, int c) { const int st = (r >> 4) * 2 + (c >> 5), rr = r & 15, cc = c & 31, ob = rr * 64 + cc * 2; return st * 1024 + (ob ^ (((ob >> 9) & 1) << 5)); }
__host__ __device__ __forceinline__ void stage_rc(int b, int& R, int& C) { const int st = b / 1024, sb = b % 1024, swz = sb ^ (((sb >> 9) & 1) << 5); R = (st >> 1) * 16 + swz / 64; C = (st & 1) * 32 + (swz % 64) / 2; }
__host__ __device__ __forceinline__ int perm32(int rho) { const int n = rho >> 4, i = rho & 15; return 8 * (i >> 2) + 4 * n + (i & 3); }

struct Unit { int pm, pn; };
struct Gemm { const bf16_t* A; const bf16_t* Bt; int M, N, K; };

struct StaticOrder {
    int nM, nN, nwg, G, c;
    __host__ __device__ void init(int M, int N, int G_, int c_) { nM = M / BM; nN = N / BM; nwg = nM * nN; G = G_; c = c_; }
    __host__ __device__ bool next(int i, Unit& u) const {
        const long L = (long)i * G + c; if (L >= nwg) return false;
        int wgid = (int)L; { const int q = nwg / NXCD, r = nwg % NXCD, xcd = wgid % NXCD, off = wgid / NXCD; wgid = (xcd < r ? xcd * (q + 1) : r * (q + 1) + (xcd - r) * q) + off; }
        const int nig = WGM * nN, gid = wgid / nig, fm = gid * WGM, gsz = (nM - fm) < WGM ? (nM - fm) : WGM;
        u.pm = fm + ((wgid % nig) % gsz); u.pn = (wgid % nig) / gsz; return true;
    }
    __device__ __forceinline__ void a_ready(const Unit&) const {}
    __device__ __forceinline__ void done(const Unit&) const {}
};

typedef float f32x2_t __attribute__((ext_vector_type(2))); typedef __bf16 bf16x2_t __attribute__((ext_vector_type(2)));
__device__ __forceinline__ unsigned cvtpk(float lo, float hi) { f32x2_t v = {lo, hi}; bf16x2_t b = __builtin_convertvector(v, bf16x2_t); return __builtin_bit_cast(unsigned, b); }
typedef _Float16 f16x8 __attribute__((ext_vector_type(8))); typedef _Float16 f16x2_t __attribute__((ext_vector_type(2)));
template <bool F16> __device__ __forceinline__ f32x4 mma16(bf16x8 a, bf16x8 b, f32x4 c) {
    if constexpr (F16) return __builtin_amdgcn_mfma_f32_16x16x32_f16(__builtin_bit_cast(f16x8, a), __builtin_bit_cast(f16x8, b), c, 0, 0, 0);
    else return __builtin_amdgcn_mfma_f32_16x16x32_bf16(a, b, c, 0, 0, 0);
}
__device__ __forceinline__ unsigned cvtpk_h(float lo, float hi) { f16x2_t v = {(_Float16)lo, (_Float16)hi}; return __builtin_bit_cast(unsigned, v); }
__device__ __forceinline__ float silu_f(float g) { return g * __builtin_amdgcn_rcpf(1.0f + __builtin_amdgcn_exp2f(-1.4426950408889634f * g)); }

typedef float f32x2v __attribute__((ext_vector_type(2)));
struct RowLN {
    const float* st; const float* cs; const float* bw;
    __device__ __forceinline__ void row(int r, float& a, float& c) const {
        if (st) { const f32x2v s = *(const f32x2v*)(st + 2 * (size_t)r); const float mu = s.x * (1.0f / 1024.0f), var = s.y * (1.0f / 1024.0f) - mu * mu; a = rsqrtf(var + 1e-5f); c = -a * mu; }
        else { a = 1.0f; c = 0.0f; }
    }
};
struct EpiSwiGLU {
    static constexpr bool PERM = true, AFTER_DRAIN = false, F16 = true;
    bf16_t* H; int ldh; RowLN ln;
    __device__ __forceinline__ void operator()(const f32x4 (&acc)[2][2][4][2], const Unit& u, int wr, int wc, int fr, int fq) const {
        const int row0 = u.pm * BM + wr * 64 + fr, col0 = u.pn * HALF + wc * 32 + 8 * fq, wrow0 = u.pn * BM + wc * 32 + 8 * fq;
        f32x4 cs[2][2], bw[2][2];
#pragma unroll
        for (int bj = 0; bj < 2; ++bj)
#pragma unroll
            for (int n = 0; n < 2; ++n) { const f32x4 z = (f32x4){0.f, 0.f, 0.f, 0.f}; cs[bj][n] = ln.st ? *(const f32x4*)(ln.cs + wrow0 + bj * HALF + 4 * n) : z; bw[bj][n] = ln.st ? *(const f32x4*)(ln.bw + wrow0 + bj * HALF + 4 * n) : z; }
#pragma unroll
        for (int ai = 0; ai < 2; ++ai)
#pragma unroll
            for (int m = 0; m < 4; ++m) {
                const int row = row0 + ai * HALF + m * 16; float a, c; ln.row(row, a, c);
                const f32x4 g0 = acc[ai][0][m][0] * a + cs[0][0] * c + bw[0][0], g1 = acc[ai][0][m][1] * a + cs[0][1] * c + bw[0][1];
                const f32x4 u0 = acc[ai][1][m][0] * a + cs[1][0] * c + bw[1][0], u1 = acc[ai][1][m][1] * a + cs[1][1] * c + bw[1][1];
                u32x4 w;
                w.x = cvtpk(silu_f(g0[0]) * u0[0], silu_f(g0[1]) * u0[1]); w.y = cvtpk(silu_f(g0[2]) * u0[2], silu_f(g0[3]) * u0[3]);
                w.z = cvtpk(silu_f(g1[0]) * u1[0], silu_f(g1[1]) * u1[1]); w.w = cvtpk(silu_f(g1[2]) * u1[2], silu_f(g1[3]) * u1[3]);
                *(u32x4*)(H + (size_t)row * ldh + col0) = w;
            }
    }
};
struct EpiRes {
    static constexpr bool PERM = true, AFTER_DRAIN = false, F16 = false;
    const float* x0; bf16_t* yh; const float* st; const float* g; const float* b; float* st_new; float alpha, s;
    __device__ __forceinline__ void operator()(const f32x4 (&acc)[2][2][4][2], const Unit& u, int wr, int wc, int fr, int fq) const {
        const int row0 = u.pm * BM + wr * 64 + fr, col0 = u.pn * BM + wc * 32 + 8 * fq;
        f32x4 gv[2][2], bv[2][2];
#pragma unroll
        for (int bj = 0; bj < 2; ++bj)
#pragma unroll
            for (int n = 0; n < 2; ++n) { gv[bj][n] = st ? *(const f32x4*)(g + col0 + bj * HALF + 4 * n) : (f32x4){1.f, 1.f, 1.f, 1.f}; bv[bj][n] = st ? *(const f32x4*)(b + col0 + bj * HALF + 4 * n) : (f32x4){0.f, 0.f, 0.f, 0.f}; }
#pragma unroll
        for (int ai = 0; ai < 2; ++ai)
#pragma unroll
            for (int m = 0; m < 4; ++m) {
                const int row = row0 + ai * HALF + m * 16; const size_t off = (size_t)row * 1024 + col0;
                float a = 1.0f, mu = 0.0f;
                if (st) { const f32x2v sv = *(const f32x2v*)(st + 2 * (size_t)row); mu = sv.x * (1.0f / 1024.0f); a = rsqrtf(sv.y * (1.0f / 1024.0f) - mu * mu + 1e-5f); }
                float s1 = 0.f, s2 = 0.f;
#pragma unroll
                for (int bj = 0; bj < 2; ++bj) {
                    f32x4 yp[2];
                    if (st) { const f16x8 hv = *(const f16x8*)(yh + off + bj * HALF);
                        yp[0] = (f32x4){(float)hv[0], (float)hv[1], (float)hv[2], (float)hv[3]}; yp[1] = (f32x4){(float)hv[4], (float)hv[5], (float)hv[6], (float)hv[7]}; }
                    else { yp[0] = *(const f32x4*)(x0 + off + bj * HALF); yp[1] = *(const f32x4*)(x0 + off + bj * HALF + 4); }
                    f32x4 y[2];
#pragma unroll
                    for (int n = 0; n < 2; ++n) { const f32x4 x = (yp[n] - mu) * a * gv[bj][n] + bv[bj][n];
                        y[n] = x * alpha + acc[ai][bj][m][n] * s;
                        s1 += (y[n][0] + y[n][1]) + (y[n][2] + y[n][3]); s2 += (y[n][0] * y[n][0] + y[n][1] * y[n][1]) + (y[n][2] * y[n][2] + y[n][3] * y[n][3]); }
                    u32x4 w; w.x = cvtpk_h(y[0][0], y[0][1]); w.y = cvtpk_h(y[0][2], y[0][3]); w.z = cvtpk_h(y[1][0], y[1][1]); w.w = cvtpk_h(y[1][2], y[1][3]);
                    *(u32x4*)(yh + off + bj * HALF) = w;
                }
                s1 += __shfl_xor(s1, 16); s1 += __shfl_xor(s1, 32); s2 += __shfl_xor(s2, 16); s2 += __shfl_xor(s2, 32);
                if (fq == 0) { atomicAdd(st_new + 2 * (size_t)row, s1); atomicAdd(st_new + 2 * (size_t)row + 1, s2); }
                if (m == 3) asm volatile("" ::: "memory");
            }
    }
};
struct EpiQKV {
    static constexpr bool PERM = true, AFTER_DRAIN = false, F16 = true;
    bf16_t* O; const float* rope; float qscale; RowLN ln;
    __device__ __forceinline__ void operator()(const f32x4 (&acc)[2][2][4][2], const Unit& u, int wr, int wc, int fr, int fq) const {
        const int pn = u.pn, row0 = u.pm * BM + wr * 64 + fr, col0 = pn * BM + wc * 32 + 8 * fq, i0 = 16 * (wc & 1) + 4 * fq;
        const bool anyrope = (pn != 4 && pn != 5);
        const float sc = (pn < 2 || pn == 6 || pn == 7) ? qscale : 1.0f;
        f32x4 cs[2][2], bw[2][2];
#pragma unroll
        for (int bj = 0; bj < 2; ++bj)
#pragma unroll
            for (int n = 0; n < 2; ++n) { cs[bj][n] = *(const f32x4*)(ln.cs + col0 + bj * HALF + 4 * n); bw[bj][n] = *(const f32x4*)(ln.bw + col0 + bj * HALF + 4 * n); }
#pragma unroll
        for (int ai = 0; ai < 2; ++ai)
#pragma unroll
            for (int m = 0; m < 4; ++m) {
                const int row = row0 + ai * HALF + m * 16; float a, c; ln.row(row, a, c);
                f32x4 cs4 = (f32x4){1.f, 1.f, 1.f, 1.f}, sn = (f32x4){0.f, 0.f, 0.f, 0.f};
                if (anyrope) { cs4 = *(const f32x4*)(rope + (size_t)row * 64 + i0); sn = *(const f32x4*)(rope + (size_t)row * 64 + 32 + i0); }
#pragma unroll
                for (int bj = 0; bj < 2; ++bj) {
                    const bool rp = anyrope && !(pn == 8 && bj == 1);
                    f32x4 v0 = acc[ai][bj][m][0] * a + cs[bj][0] * c + bw[bj][0], v1 = acc[ai][bj][m][1] * a + cs[bj][1] * c + bw[bj][1];
                    if (rp) {
                        const f32x4 a0 = v0, a1 = v1;
                        v0[0] = a0[0] * cs4[0] - a0[1] * sn[0]; v0[1] = a0[1] * cs4[0] + a0[0] * sn[0];
                        v0[2] = a0[2] * cs4[1] - a0[3] * sn[1]; v0[3] = a0[3] * cs4[1] + a0[2] * sn[1];
                        v1[0] = a1[0] * cs4[2] - a1[1] * sn[2]; v1[1] = a1[1] * cs4[2] + a1[0] * sn[2];
                        v1[2] = a1[2] * cs4[3] - a1[3] * sn[3]; v1[3] = a1[3] * cs4[3] + a1[2] * sn[3];
                    }
                    v0 = v0 * sc; v1 = v1 * sc;
                    u32x4 w; w.x = cvtpk(v0[0], v0[1]); w.y = cvtpk(v0[2], v0[3]); w.z = cvtpk(v1[0], v1[1]); w.w = cvtpk(v1[2], v1[3]);
                    *(u32x4*)(O + (size_t)row * 2304 + col0 + bj * HALF) = w;
                }
            }
    }
};

template <class Epi, class Sched, bool ALIGN_EPI = false, bool SP2 = false>
__device__ __forceinline__ void gemm_phase(PG8_LAS unsigned char* lds, const Gemm g, const Sched& S, const Epi& E) {
    int tid_ = threadIdx.x; asm volatile("" : "+v"(tid_));
    const int tid = tid_, wid = __builtin_amdgcn_readfirstlane(tid >> 6), lane = tid & 63, wr = wid >> 2, wc = wid & 3, fr = lane & 15, fq = lane >> 4;
    const int K = g.K, nt = K / BK;
    unsigned voffA[2], voffB[2];
#pragma unroll
    for (int i = 0; i < 2; ++i) { int R, C; stage_rc(tid * 16 + i * 8192, R, C); const int Rb = Epi::PERM ? ((R & ~31) + perm32(R & 31)) : R;
        voffA[i] = (unsigned)(R * K + C) * 2u; voffB[i] = (unsigned)(Rb * K + C) * 2u; }
    const size_t kstep = (size_t)(BK * 2);
    const size_t hstep = (size_t)HALF * K * 2;
    const size_t tstep = 2 * hstep;
    const unsigned ldsw = (unsigned)wid * 1024u;
    const int aoff = lds_byte(wr * 64 + fr, fq * 8), boff = lds_byte(wc * 32 + fr, fq * 8);
#define PG8_SA(b, h) (((b) * 2 + (h)) * HTB)
#define PG8_SB(b, h) ((4 + (b) * 2 + (h)) * HTB)
#define PG8_STAGE(bufoff, gbase, voff) do { _Pragma("unroll") for (int _i = 0; _i < 2; ++_i) \
        __builtin_amdgcn_global_load_lds((const unsigned*)((const char*)(gbase) + (voff)[_i]), (PG8_LAS unsigned*)(lds + (bufoff) + ldsw + _i * 8192), 16, 0, 0); } while (0)
#define PG8_LDA(dst, b, h) do { _Pragma("unroll") for (int m = 0; m < 4; ++m) _Pragma("unroll") for (int k = 0; k < 2; ++k) dst[m][k] = *(const PG8_LAS bf16x8*)(lds + PG8_SA(b, h) + aoff + m * 2048 + k * 1024); } while (0)
#define PG8_LDB(dst, b, h) do { _Pragma("unroll") for (int n = 0; n < 2; ++n) _Pragma("unroll") for (int k = 0; k < 2; ++k) dst[n][k] = *(const PG8_LAS bf16x8*)(lds + PG8_SB(b, h) + boff + n * 2048 + k * 1024); } while (0)
#define PG8_MMA(ai, bj, At, Bt) do { __builtin_amdgcn_s_setprio(1); _Pragma("unroll") for (int m = 0; m < 4; ++m) _Pragma("unroll") for (int n = 0; n < 2; ++n) _Pragma("unroll") for (int k = 0; k < 2; ++k) \
        acc[ai][bj][m][n] = mma16<Epi::F16>(Bt[n][k], At[m][k], acc[ai][bj][m][n]); __builtin_amdgcn_s_setprio(0); } while (0)
#define PG8_WAIT_V(n) asm volatile("s_waitcnt vmcnt(" #n ")" ::: "memory")
#define PG8_WAIT_L(n) asm volatile("s_waitcnt lgkmcnt(" #n ")" ::: "memory")
#define PG8_BAR __builtin_amdgcn_s_barrier()
#define PG8_SCHED __builtin_amdgcn_sched_barrier(0)
    Unit cur, nxt; int ui = 0;
    if (!S.next(0, cur)) return;
    f32x4 acc[2][2][4][2];
#pragma unroll
    for (int a = 0; a < 2; ++a)
#pragma unroll
        for (int b = 0; b < 2; ++b)
#pragma unroll
            for (int m = 0; m < 4; ++m)
#pragma unroll
                for (int n = 0; n < 2; ++n) acc[a][b][m][n] = (f32x4){0.f, 0.f, 0.f, 0.f};
    bf16x8 At[4][2], B0[2][2], B1[2][2];
    const char* cA = (const char*)g.A + (size_t)cur.pm * tstep; const char* cB = (const char*)g.Bt + (size_t)cur.pn * tstep;
    S.a_ready(cur);
    if constexpr (SP2) {
        PG8_STAGE(PG8_SB(0, 0), cB, voffB); PG8_STAGE(PG8_SB(0, 1), cB + hstep, voffB); PG8_STAGE(PG8_SA(0, 0), cA, voffA); PG8_STAGE(PG8_SA(0, 1), cA + hstep, voffA);
        if (wr == 1) PG8_BAR;
        PG8_WAIT_V(2); PG8_BAR;
        PG8_STAGE(PG8_SB(1, 0), cB + kstep, voffB); PG8_STAGE(PG8_SA(1, 0), cA + kstep, voffA); PG8_STAGE(PG8_SB(1, 1), cB + hstep + kstep, voffB);
        PG8_WAIT_V(6); PG8_BAR;
    } else {
        PG8_STAGE(PG8_SB(0, 0), cB, voffB); PG8_STAGE(PG8_SA(0, 0), cA, voffA); PG8_STAGE(PG8_SB(0, 1), cB + hstep, voffB); PG8_STAGE(PG8_SA(0, 1), cA + hstep, voffA);
        if (wr == 1) PG8_BAR;
        PG8_WAIT_V(4); PG8_BAR;
        PG8_STAGE(PG8_SB(1, 0), cB + kstep, voffB); PG8_STAGE(PG8_SA(1, 0), cA + kstep, voffA); PG8_STAGE(PG8_SB(1, 1), cB + hstep + kstep, voffB);
        PG8_WAIT_V(6); PG8_BAR;
    }
    for (;;) {
        const bool has_next = S.next(ui + 1, nxt);
        const char* nA = has_next ? (const char*)g.A + (size_t)nxt.pm * tstep : cA; const char* nB = has_next ? (const char*)g.Bt + (size_t)nxt.pn * tstep : cB;
        for (int t = 0; t < nt; t += 2) {
            const bool last = (t == nt - 2);
            const char* a1 = cA + (size_t)(t + 1) * kstep;
            const char* a2 = last ? nA : cA + (size_t)(t + 2) * kstep; const char* b2 = last ? nB : cB + (size_t)(t + 2) * kstep;
            const char* a3 = a2 + kstep; const char* b3 = b2 + kstep;
            if (last && has_next) S.a_ready(nxt);
            if constexpr (SP2) {
            PG8_LDB(B0, 0, 0); PG8_LDB(B1, 0, 1); PG8_SCHED; PG8_LDA(At, 0, 0); PG8_STAGE(PG8_SA(1, 1), a1 + hstep, voffA);
            PG8_WAIT_V(8); PG8_WAIT_L(0); PG8_BAR; PG8_MMA(0, 0, At, B0); PG8_MMA(0, 1, At, B1); PG8_BAR; PG8_SCHED;
            PG8_LDA(At, 0, 1); PG8_STAGE(PG8_SB(0, 0), b2, voffB); PG8_STAGE(PG8_SB(0, 1), b2 + hstep, voffB); PG8_STAGE(PG8_SA(0, 0), a2, voffA);
            PG8_WAIT_V(8); PG8_WAIT_L(0); PG8_BAR; PG8_MMA(1, 0, At, B0); PG8_MMA(1, 1, At, B1); PG8_BAR; PG8_SCHED;
            PG8_LDB(B0, 1, 0); PG8_LDB(B1, 1, 1); PG8_SCHED; PG8_LDA(At, 1, 0); PG8_STAGE(PG8_SA(0, 1), a2 + hstep, voffA);
            PG8_WAIT_V(8); PG8_WAIT_L(0); PG8_BAR; PG8_MMA(0, 0, At, B0); PG8_MMA(0, 1, At, B1); PG8_BAR; PG8_SCHED;
            PG8_LDA(At, 1, 1); PG8_STAGE(PG8_SB(1, 0), b3, voffB); PG8_STAGE(PG8_SB(1, 1), b3 + hstep, voffB); PG8_STAGE(PG8_SA(1, 0), a3, voffA);
            PG8_WAIT_V(8); PG8_WAIT_L(0); PG8_BAR; PG8_MMA(1, 0, At, B0); PG8_MMA(1, 1, At, B1); PG8_BAR; PG8_SCHED;
            } else {
            PG8_LDB(B0, 0, 0); PG8_SCHED; PG8_LDA(At, 0, 0); PG8_STAGE(PG8_SA(1, 1), a1 + hstep, voffA);
            PG8_WAIT_L(8); PG8_BAR; PG8_WAIT_L(0); PG8_MMA(0, 0, At, B0); PG8_BAR; PG8_SCHED;
            PG8_LDB(B1, 0, 1); PG8_STAGE(PG8_SB(0, 0), b2, voffB);
            PG8_BAR; PG8_WAIT_L(0); PG8_MMA(0, 1, At, B1); PG8_BAR;
            PG8_LDA(At, 0, 1); PG8_STAGE(PG8_SA(0, 0), a2, voffA);
            PG8_BAR; PG8_WAIT_L(0); PG8_MMA(1, 0, At, B0); PG8_BAR; PG8_SCHED;
            PG8_STAGE(PG8_SB(0, 1), b2 + hstep, voffB);
            PG8_WAIT_V(6); PG8_BAR; PG8_MMA(1, 1, At, B1); PG8_BAR;
            PG8_LDB(B0, 1, 0); PG8_SCHED; PG8_LDA(At, 1, 0); PG8_STAGE(PG8_SA(0, 1), a2 + hstep, voffA);
            PG8_WAIT_L(8); PG8_BAR; PG8_WAIT_L(0); PG8_MMA(0, 0, At, B0); PG8_BAR; PG8_SCHED;
            PG8_LDB(B1, 1, 1); PG8_STAGE(PG8_SB(1, 0), b3, voffB);
            PG8_BAR; PG8_WAIT_L(0); PG8_MMA(0, 1, At, B1); PG8_BAR;
            PG8_LDA(At, 1, 1); PG8_STAGE(PG8_SA(1, 0), a3, voffA);
            PG8_BAR; PG8_WAIT_L(0); PG8_MMA(1, 0, At, B0); PG8_BAR; PG8_SCHED;
            PG8_STAGE(PG8_SB(1, 1), b3 + hstep, voffB);
            PG8_WAIT_V(6); PG8_BAR; PG8_MMA(1, 1, At, B1); PG8_BAR;
            }
        }
        if constexpr (ALIGN_EPI) { if (wr == 0) PG8_BAR; }
        if constexpr (!Epi::AFTER_DRAIN) { E(acc, cur, wr, wc, fr, fq); S.done(cur); }
        if (!has_next) break;
#pragma unroll
        for (int a = 0; a < 2; ++a)
#pragma unroll
            for (int b = 0; b < 2; ++b)
#pragma unroll
                for (int m = 0; m < 4; ++m)
#pragma unroll
                    for (int n = 0; n < 2; ++n) acc[a][b][m][n] = (f32x4){0.f, 0.f, 0.f, 0.f};
        cur = nxt; cA = nA; cB = nB; ++ui;
        if constexpr (ALIGN_EPI) { if (wr == 1) PG8_BAR; }
    }
    PG8_WAIT_V(0);
    if constexpr (!ALIGN_EPI) { if (wr == 0) PG8_BAR; }
    PG8_BAR;
    if constexpr (Epi::AFTER_DRAIN) { E.fused(acc, cur, wr, wc, fr, fq, lds, wid, lane); S.done(cur); }
#undef PG8_SA
#undef PG8_SB
#undef PG8_STAGE
#undef PG8_LDA
#undef PG8_LDB
#undef PG8_MMA
#undef PG8_WAIT_V
#undef PG8_WAIT_L
#undef PG8_BAR
#undef PG8_SCHED
}
}

namespace att {
using pg8::bf16_t; using pg8::bf16x8; using pg8::f32x4; using pg8::u32x4; using pg8::cvtpk;
#define ALDS __attribute__((address_space(3)))
typedef float f32x16 __attribute__((ext_vector_type(16)));
typedef short s16x4 __attribute__((ext_vector_type(4)));
typedef unsigned u32x2 __attribute__((ext_vector_type(2)));
constexpr int PITCH = 2304;
constexpr float THR = 8.0f;
__device__ __forceinline__ void glds16(const void* gsrc, unsigned lds_dst) { unsigned keep;
    asm volatile("s_mov_b32 %0, m0\n\ts_mov_b32 m0, %2\n\ts_nop 0\n\tglobal_load_lds_dwordx4 %1, off\n\ts_mov_b32 m0, %0" : "=&s"(keep) : "v"(gsrc), "s"(lds_dst) : "memory"); }
__device__ __forceinline__ unsigned rfl(unsigned v) { return (unsigned)__builtin_amdgcn_readfirstlane((int)v); }
__device__ __forceinline__ int pi23(int x) { return (x & ~12) | ((x & 4) << 1) | ((x & 8) >> 1); }
__device__ __forceinline__ s16x4 vtr(const ALDS unsigned char* p) { return __builtin_bit_cast(s16x4, __builtin_amdgcn_ds_read_tr16_b64_v4i16((ALDS s16x4*)p)); }
__device__ __forceinline__ float halfswap_max(float v) { auto rr = __builtin_amdgcn_permlane32_swap(__float_as_uint(v), __float_as_uint(v), false, false); return fmaxf(__uint_as_float(rr[0]), __uint_as_float(rr[1])); }
__device__ __forceinline__ float halfswap_sum(float v) { auto rr = __builtin_amdgcn_permlane32_swap(__float_as_uint(v), __float_as_uint(v), false, false); return __uint_as_float(rr[0]) + __uint_as_float(rr[1]); }

template <int DV, bool BAND>
__device__ __forceinline__ float attn_core(ALDS unsigned char* ring, const int wid, const int lane,
                                           const bf16_t* Qw, const bf16_t* ksrc, const bf16_t* vsrc, const int koff,
                                           const int t0, const int t1, const int tq, const int qpos, const float m_init, float l, f32x16 (&o)[DV / 32]) {
    constexpr int NDB = DV / 32, SLOT = (DV == 128) ? 32768 : 16384, VOFF = (DV == 128) ? 16384 : 8192, ROWB = DV * 2, NP = (DV == 128) ? 4 : 2;
    const int r32 = lane & 31, hi = lane >> 5;
    const unsigned ring_a = (unsigned)(uintptr_t)ring;
    bf16x8 qr[4];
#pragma unroll
    for (int d0 = 0; d0 < 4; ++d0) qr[d0] = *(const bf16x8*)(Qw + (size_t)r32 * PITCH + d0 * 16 + hi * 8);
#define ATT_ISSUE(t_, so_) do { const size_t go_ = (size_t)(t_) * (64 * PITCH); const unsigned d_ = ring_a + (unsigned)(so_) + (unsigned)wid * 1024u; \
        glds16(ksrc + go_, rfl(d_)); \
        if (DV == 128) { glds16(ksrc + go_ + 64, rfl(d_ + 8192u)); glds16(vsrc + go_, rfl(ring_a + (unsigned)(so_) + (unsigned)VOFF + (unsigned)wid * 2048u)); \
                         glds16(vsrc + go_ + 4 * PITCH, rfl(ring_a + (unsigned)(so_) + (unsigned)VOFF + (unsigned)wid * 2048u + 1024u)); } \
        else { glds16(vsrc + go_, rfl(d_ + (unsigned)VOFF)); } } while (0)
    ATT_ISSUE(t0, 0);
    { const int tn = (t0 + 1 < t1) ? t0 + 1 : t1 - 1; ATT_ISSUE(tn, SLOT); }
    const int g = (lane >> 4) & 1, q4 = (lane & 15) >> 2, p = lane & 3, sw = (DV == 128) ? q4 : (q4 >> 1);
    int va[NDB];
#pragma unroll
    for (int db = 0; db < NDB; ++db) va[db] = VOFF + (8 * hi + q4) * ROWB + ((db ^ sw) << 6) + (2 * g + (p >> 1)) * 16 + 8 * (p & 1);
    const int ka = koff + hi * 1024 + r32 * 16;
    float m = m_init;
    f32x16 negm;
#pragma unroll
    for (int r = 0; r < 16; ++r) negm[r] = -m;
#pragma unroll
    for (int db = 0; db < NDB; ++db)
#pragma unroll
        for (int r = 0; r < 16; ++r) o[db][r] = 0.f;
    int s_cur = 0, s_n2 = 2 * SLOT;
    for (int t = t0; t < t1; ++t) {
        asm volatile("s_waitcnt vmcnt(%0)" :: "n"(NP) : "memory");
        asm volatile("s_waitcnt lgkmcnt(0)\n\ts_barrier" ::: "memory");
        { const int tn = (t + 2 < t1) ? t + 2 : t1 - 1; ATT_ISSUE(tn, s_n2); }
        const ALDS unsigned char* sb = ring + s_cur;
        f32x16 p0 = negm, p1 = negm;
        bf16x8 kf[8];
#pragma unroll
        for (int d0 = 0; d0 < 4; ++d0) { kf[2 * d0] = *(const ALDS bf16x8*)(sb + ka + d0 * 2048); kf[2 * d0 + 1] = *(const ALDS bf16x8*)(sb + ka + d0 * 2048 + 512); }
        s16x4 vlo[2][NDB], vhh[2][NDB];
#pragma unroll
        for (int db = 0; db < NDB; ++db) { vlo[0][db] = vtr(sb + va[db]); vhh[0][db] = vtr(sb + va[db] + 4 * ROWB); }
        __builtin_amdgcn_sched_barrier(0);
#pragma unroll
        for (int d0 = 0; d0 < 4; ++d0) {
            p0 = __builtin_amdgcn_mfma_f32_32x32x16_bf16(kf[2 * d0], qr[d0], p0, 0, 0, 0);
            p1 = __builtin_amdgcn_mfma_f32_32x32x16_bf16(kf[2 * d0 + 1], qr[d0], p1, 0, 0, 0);
        }
        if (BAND) {
            if (t == tq - 2 || t == tq + 2) {
                const int rel0 = t * 64 + 8 * hi - qpos;
#pragma unroll
                for (int r = 0; r < 16; ++r) { const int rel = rel0 + 16 * (r >> 3) + (r & 7);
                    if (rel < -128 || rel > 128) p0[r] = -INFINITY;
                    if (rel + 32 < -128 || rel + 32 > 128) p1[r] = -INFINITY; }
            }
        }
        float mx = fmaxf(p0[0], p1[0]);
#pragma unroll
        for (int r = 1; r < 16; ++r) mx = fmaxf(fmaxf(mx, p0[r]), p1[r]);
        mx = halfswap_max(mx);
        const bool first = (!BAND) && (t == t0);
        const float dl = first ? mx : ((mx > THR) ? mx : 0.f);
        if (__any(dl != 0.f)) {
            m += dl;
#pragma unroll
            for (int r = 0; r < 16; ++r) { p0[r] -= dl; p1[r] -= dl; negm[r] = -m; }
            const float f = first ? 1.f : __builtin_amdgcn_exp2f(-dl);
            l *= f;
#pragma unroll
            for (int db = 0; db < NDB; ++db)
#pragma unroll
                for (int r = 0; r < 16; ++r) o[db][r] *= f;
        }
        float ssum = 0.f;
        bf16x8 pf;
#define ATT_EXP_SLICE(P_, B_, DST_) do { u32x4 w_; \
        P_[B_ + 0] = __builtin_amdgcn_exp2f(P_[B_ + 0]); P_[B_ + 1] = __builtin_amdgcn_exp2f(P_[B_ + 1]); P_[B_ + 2] = __builtin_amdgcn_exp2f(P_[B_ + 2]); P_[B_ + 3] = __builtin_amdgcn_exp2f(P_[B_ + 3]); \
        P_[B_ + 4] = __builtin_amdgcn_exp2f(P_[B_ + 4]); P_[B_ + 5] = __builtin_amdgcn_exp2f(P_[B_ + 5]); P_[B_ + 6] = __builtin_amdgcn_exp2f(P_[B_ + 6]); P_[B_ + 7] = __builtin_amdgcn_exp2f(P_[B_ + 7]); \
        ssum += ((P_[B_ + 0] + P_[B_ + 1]) + (P_[B_ + 2] + P_[B_ + 3])) + ((P_[B_ + 4] + P_[B_ + 5]) + (P_[B_ + 6] + P_[B_ + 7])); \
        w_.x = cvtpk(P_[B_ + 0], P_[B_ + 1]); w_.y = cvtpk(P_[B_ + 2], P_[B_ + 3]); w_.z = cvtpk(P_[B_ + 4], P_[B_ + 5]); w_.w = cvtpk(P_[B_ + 6], P_[B_ + 7]); DST_ = __builtin_bit_cast(bf16x8, w_); } while (0)
        ATT_EXP_SLICE(p0, 0, pf);
        __builtin_amdgcn_sched_barrier(0);
#pragma unroll
        for (int ks = 0; ks < 4; ++ks) {
            bf16x8 pfn = pf;
            if (ks + 1 < 4) {
#pragma unroll
                for (int db = 0; db < NDB; ++db) { vlo[(ks + 1) & 1][db] = vtr(sb + va[db] + (ks + 1) * (16 * ROWB)); vhh[(ks + 1) & 1][db] = vtr(sb + va[db] + (ks + 1) * (16 * ROWB) + 4 * ROWB); }
            }
#pragma unroll
            for (int db = 0; db < NDB; ++db) {
                const s16x4 lo = vlo[ks & 1][db], hh = vhh[ks & 1][db];
                const bf16x8 vf = (bf16x8){lo[0], lo[1], lo[2], lo[3], hh[0], hh[1], hh[2], hh[3]};
                o[db] = __builtin_amdgcn_mfma_f32_32x32x16_bf16(vf, pf, o[db], 0, 0, 0);
            }
            if (ks == 0) ATT_EXP_SLICE(p0, 8, pfn);
            if (ks == 1) ATT_EXP_SLICE(p1, 0, pfn);
            if (ks == 2) ATT_EXP_SLICE(p1, 8, pfn);
            if (ks + 1 < 4) {
                __builtin_amdgcn_sched_group_barrier(0x100, 2 * NDB, 0);
#pragma unroll
                for (int db = 0; db < NDB; ++db) { __builtin_amdgcn_sched_group_barrier(0x008, 1, 0); __builtin_amdgcn_sched_group_barrier(0x002, 20 / NDB, 0); }
            }
            __builtin_amdgcn_sched_barrier(0);
            pf = pfn;
        }
#undef ATT_EXP_SLICE
        l += ssum;
        s_cur = (s_cur == 2 * SLOT) ? 0 : s_cur + SLOT; s_n2 = (s_n2 == 2 * SLOT) ? 0 : s_n2 + SLOT;
    }
    asm volatile("s_waitcnt vmcnt(0) lgkmcnt(0)\n\ts_barrier" ::: "memory");
#undef ATT_ISSUE
    return l;
}

__device__ __forceinline__ void diff_unit(ALDS unsigned char* ring, const int wid, int lane, const bf16_t* qkv, bf16_t* ymix, const int u, const float lam, const float post, const float* subg) {
    asm volatile("" : "+v"(lane));
    const int bh = u >> 5, qb = u & 31, b = bh >> 2, h = bh & 3, comp = wid >> 2, wq = wid & 3, r32 = lane & 31, hi = lane >> 5;
    const size_t rowbase = (size_t)b * 4096;
    const int q0 = qb * 128 + wq * 32;
    const bf16_t* Qw = qkv + (rowbase + q0) * PITCH + h * 128 + comp * 64;
    const bf16_t* ksrc = qkv + (rowbase + pi23(lane)) * PITCH + 512 + h * 128 + wid * 8;
    const bf16_t* vsrc = qkv + (rowbase + 8 * wid + (lane >> 4)) * PITCH + 1024 + h * 128 + (((lane & 15) ^ ((lane >> 4) << 2)) * 8);
    f32x16 o[4];
    float l = attn_core<128, false>(ring, wid, lane, Qw, ksrc, vsrc, comp * 8192, 0, 64, 0, 0, 0.f, 0.f, o);
    l = halfswap_sum(l);
    const float inv = 1.0f / l;
    ALDS f32x4* X = (ALDS f32x4*)ring + (size_t)wq * (16 * 64);
    if (comp == 1) {
#pragma unroll
        for (int db = 0; db < 4; ++db)
#pragma unroll
            for (int rq = 0; rq < 4; ++rq) X[(db * 4 + rq) * 64 + lane] = (f32x4){o[db][4 * rq] * inv, o[db][4 * rq + 1] * inv, o[db][4 * rq + 2] * inv, o[db][4 * rq + 3] * inv};
    }
    asm volatile("s_waitcnt lgkmcnt(0)\n\ts_barrier" ::: "memory");
    if (comp == 0) {
        float ss = 0.f;
#pragma unroll
        for (int db = 0; db < 4; ++db)
#pragma unroll
            for (int rq = 0; rq < 4; ++rq) { const f32x4 o2 = X[(db * 4 + rq) * 64 + lane];
#pragma unroll
                for (int e = 0; e < 4; ++e) { const float d = o[db][4 * rq + e] * inv - lam * o2[e]; o[db][4 * rq + e] = d; ss += d * d; } }
        ss = halfswap_sum(ss);
        const float rs = rsqrtf(ss * (1.0f / 128.0f) + 1e-5f) * post;
        bf16_t* orow = ymix + (rowbase + q0 + r32) * 1024 + h * 128 + 4 * hi;
#pragma unroll
        for (int db = 0; db < 4; ++db)
#pragma unroll
            for (int rq = 0; rq < 4; ++rq) { const f32x4 gv = *(const f32x4*)(subg + 32 * db + 8 * rq + 4 * hi);
                u32x2 w; w.x = cvtpk(o[db][4 * rq] * rs * gv[0], o[db][4 * rq + 1] * rs * gv[1]); w.y = cvtpk(o[db][4 * rq + 2] * rs * gv[2], o[db][4 * rq + 3] * rs * gv[3]);
                *(u32x2*)(orow + 32 * db + 8 * rq) = w; }
    }
    asm volatile("s_waitcnt lgkmcnt(0)\n\ts_barrier" ::: "memory");
}

__device__ __forceinline__ void swa_unit(ALDS unsigned char* ring, const int wid, int lane, const bf16_t* qkv, bf16_t* ymix, const int u, const float* sink) {
    asm volatile("" : "+v"(lane));
    const int bkv = u >> 6, qblk = u & 63, b = bkv >> 1, kvh = bkv & 1, head = kvh * 4 + (wid >> 1), r32 = lane & 31, hi = lane >> 5;
    const size_t rowbase = (size_t)b * 4096;
    const int q0 = qblk * 64 + (wid & 1) * 32;
    const bf16_t* Qw = qkv + (rowbase + q0) * PITCH + 1536 + head * 64;
    const bf16_t* ksrc = qkv + (rowbase + pi23(lane)) * PITCH + 2048 + kvh * 64 + wid * 8;
    const bf16_t* vsrc = qkv + (rowbase + 8 * wid + (lane >> 3)) * PITCH + 2176 + kvh * 64 + (((lane & 7) ^ (((lane >> 4) & 1) << 2)) * 8);
    const int t0 = (qblk - 2 > 0) ? qblk - 2 : 0, t1 = ((qblk + 2 < 63) ? qblk + 2 : 63) + 1;
    f32x16 o[2];
    float l = attn_core<64, true>(ring, wid, lane, Qw, ksrc, vsrc, 0, t0, t1, qblk, q0 + r32, sink[head] * 1.4426950408889634f, (hi == 0) ? 1.0f : 0.0f, o);
    l = halfswap_sum(l);
    const float inv = 1.0f / l;
    bf16_t* orow = ymix + (rowbase + q0 + r32) * 1024 + 512 + head * 64 + 4 * hi;
#pragma unroll
    for (int db = 0; db < 2; ++db)
#pragma unroll
        for (int rq = 0; rq < 4; ++rq) { u32x2 w; w.x = cvtpk(o[db][4 * rq] * inv, o[db][4 * rq + 1] * inv); w.y = cvtpk(o[db][4 * rq + 2] * inv, o[db][4 * rq + 3] * inv);
            *(u32x2*)(orow + 32 * db + 8 * rq) = w; }
}
}

#ifndef REP_ATT
#define REP_ATT 1
#endif
#ifndef REP_G1
#define REP_G1 1
#endif
#ifndef REP_SYNC
#define REP_SYNC 1
#endif
#ifndef REP_LN
#define REP_LN 1
#endif
#ifndef REP_PRO
#define REP_PRO 1
#endif
constexpr int NWAVES = 8;
constexpr int M = 65536, D = 1024, FF = 2816, NIN = 2304, SEQ = 4096, DEPTH = 4;
constexpr size_t MiB = 1u << 20;
constexpr size_t W1_OFF = 0, W1_B = (size_t)2 * FF * D * 2, W2_OFF = W1_OFF + W1_B, W2_B = (size_t)D * FF * 2, WIN_OFF = W2_OFF + W2_B, WIN_B = (size_t)NIN * D * 2,
                 WO_OFF = WIN_OFF + WIN_B, WO_B = (size_t)D * D * 2, W3_OFF = WO_OFF + WO_B, W4_OFF = W3_OFF + W1_B, WL_STRIDE = W4_OFF + W2_B;
constexpr size_t WS_W = 0, WS_ROPE = 160 * MiB, WS_XB = 176 * MiB, WS_H = 304 * MiB, WS_YM = 656 * MiB, WS_CSBW = 784 * MiB, WS_ST = 785 * MiB, WS_CTL = 786 * MiB, WS_END = 787 * MiB;
constexpr size_t CTL_ZERO_BYTES = 16384;
constexpr int CSBW_N = 2 * FF;
static_assert((size_t)DEPTH * 3 * 2 * CSBW_N * 4 <= MiB && (size_t)2 * M * 2 * 4 <= MiB, "aux map");
static_assert(WL_STRIDE * DEPTH <= WS_ROPE && WS_ROPE + (size_t)M * 64 * 4 <= WS_XB && WS_XB + (size_t)M * D * 2 <= WS_H && WS_H + (size_t)M * FF * 2 <= WS_YM && WS_YM + (size_t)M * D * 2 <= WS_END, "d_ws map");
constexpr int LDS_BYTES = 147456;
constexpr float ALPHA = 1.681792830507429f;
constexpr float QSCALE = 0.125f * 1.4426950408889634f;

typedef unsigned short bf16;
typedef float f32x4 __attribute__((ext_vector_type(4)));
typedef unsigned v4u __attribute__((ext_vector_type(4)));
typedef unsigned v2u __attribute__((ext_vector_type(2)));
using pg8::cvtpk;

struct Args { const float* in[13]; float* out; unsigned char* ws; float inv[32]; float lam_init[4]; };

__device__ __forceinline__ float wave_sum(float v) {
#pragma unroll
    for (int o = 1; o < 64; o <<= 1) v += __shfl_xor(v, o);
    return v;
}
__device__ __forceinline__ int src_col(int type, int n) {
    if (type == 1) { const int pn = n >> 8, w = n & 255; return (w < 128) ? (128 * pn + w) : (FF + 128 * pn + (w - 128)); }
    if (type == 2) { const bool rp = (n < 1024) || (n >= 1536 && n < 2176); return rp ? ((n & ~63) + ((n & 63) >> 1) + 32 * (n & 1)) : n; }
    return n;
}
template <bool F16> __device__ __forceinline__ void transpose_item(const float* W, int K, int N, int type, const float* gk, bf16* WT, ALDS float* scr, int item, int lane) {
    const int nblk = N / 32, kb = item / nblk, nb = item % nblk, k0 = 64 * kb, n0 = 32 * nb;
    const int sc = src_col(type, n0 + (lane & 31));
#pragma unroll 8
    for (int i = 0; i < 32; ++i) { const int kk = 2 * i + (lane >> 5); scr[kk * 33 + (lane & 31)] = W[(size_t)(k0 + kk) * N + sc] * (gk ? gk[k0 + kk] : 1.0f); }
    asm volatile("s_waitcnt lgkmcnt(0)" ::: "memory");
    const int c = lane & 7;
#pragma unroll
    for (int j = 0; j < 4; ++j) { const int n = (lane >> 3) + 8 * j; const ALDS float* s = scr + (8 * c) * 33 + n;
        v4u o; if (F16) { o.x = pg8::cvtpk_h(s[0 * 33], s[1 * 33]); o.y = pg8::cvtpk_h(s[2 * 33], s[3 * 33]); o.z = pg8::cvtpk_h(s[4 * 33], s[5 * 33]); o.w = pg8::cvtpk_h(s[6 * 33], s[7 * 33]); }
        else { o.x = cvtpk(s[0 * 33], s[1 * 33]); o.y = cvtpk(s[2 * 33], s[3 * 33]); o.z = cvtpk(s[4 * 33], s[5 * 33]); o.w = cvtpk(s[6 * 33], s[7 * 33]); }
        *(v4u*)(WT + (size_t)(n0 + n) * K + k0 + 8 * c) = o; }
    asm volatile("s_waitcnt lgkmcnt(0)" ::: "memory");
}
__device__ __forceinline__ void sincos_f32angle(float ang, float& c, float& s) {
    const double a = (double)ang, k = __builtin_rint(a * 0.63661977236758134308);
    double r = __builtin_fma(-k, 1.57079632679489655800e+00, a); r = __builtin_fma(-k, 6.12323399573676603587e-17, r);
    const double r2 = r * r;
    double sp = -1.0 / 1307674368000.0; sp = sp * r2 + 1.0 / 6227020800.0; sp = sp * r2 - 1.0 / 39916800.0; sp = sp * r2 + 1.0 / 362880.0; sp = sp * r2 - 1.0 / 5040.0; sp = sp * r2 + 1.0 / 120.0; sp = sp * r2 - 1.0 / 6.0;
    const double sn = r + r * r2 * sp;
    double cp = 1.0 / 20922789888000.0; cp = cp * r2 - 1.0 / 87178291200.0; cp = cp * r2 + 1.0 / 479001600.0; cp = cp * r2 - 1.0 / 3628800.0; cp = cp * r2 + 1.0 / 40320.0; cp = cp * r2 - 1.0 / 720.0; cp = cp * r2 + 1.0 / 24.0; cp = cp * r2 - 0.5;
    const double cn = 1.0 + r2 * cp;
    const int q = ((int)k) & 3;
    const double cc = (q == 0) ? cn : (q == 1) ? -sn : (q == 2) ? -cn : sn;
    const double ss = (q == 0) ? sn : (q == 1) ? cn : (q == 2) ? -sn : -cn;
    c = (float)cc; s = (float)ss;
}
__device__ __forceinline__ void ln_row(const float* xrow, const float* g, const float* bta, float* orow, bf16* brow, int lane) {
    asm volatile("" : "+v"(lane));
    const f32x4* xr = (const f32x4*)xrow + lane;
    f32x4 v[4]; float s = 0.f;
#pragma unroll
    for (int j = 0; j < 4; ++j) { v[j] = xr[64 * j]; s += (v[j][0] + v[j][1]) + (v[j][2] + v[j][3]); }
    const float mean = wave_sum(s) * (1.f / D); float s2 = 0.f;
#pragma unroll
    for (int j = 0; j < 4; ++j) { v[j] = v[j] - mean; s2 += (v[j][0] * v[j][0] + v[j][1] * v[j][1]) + (v[j][2] * v[j][2] + v[j][3] * v[j][3]); }
    const float rstd = 1.0f / sqrtf(wave_sum(s2) * (1.f / D) + 1e-5f);
#pragma unroll
    for (int j = 0; j < 4; ++j) { const f32x4 gg = *((const f32x4*)g + lane + 64 * j), bb = *((const f32x4*)bta + lane + 64 * j);
        const f32x4 y = v[j] * rstd * gg + bb;
        *((f32x4*)orow + lane + 64 * j) = y;
        v2u w; w.x = cvtpk(y[0], y[1]); w.y = cvtpk(y[2], y[3]); *((v2u*)brow + lane + 64 * j) = w; }
}

#define XB_TMO      128
#define XB_XCNT(j)  (256  + 64 * (j))
#define XB_XSUB(j)  (1280 + 64 * (j))
#define XB_XGEN(j)  (2304 + 64 * (j))
#define XB_TOP      3328
#define XB_TOPGEN   3392
#define XCD_BAR_WORDS 3456
#define XB_SPIN_CAP (1u << 18)

__device__ __forceinline__ unsigned xb_ld(unsigned* p)              { return __hip_atomic_load(p, __ATOMIC_RELAXED, __HIP_MEMORY_SCOPE_AGENT); }
__device__ __forceinline__ unsigned xb_add(unsigned* p, unsigned v) { return __hip_atomic_fetch_add(p, v, __ATOMIC_RELAXED, __HIP_MEMORY_SCOPE_AGENT); }
__device__ __forceinline__ unsigned xb_xcc_id() { return (unsigned)__builtin_amdgcn_s_getreg((3 << 11) | 20) & 0xFu; }
#define XB_SPIN(cond, bar) do { unsigned _sp = 0; while (cond) { __builtin_amdgcn_s_sleep(1); \
    if ((++_sp & 255u) == 0u) { if (xb_ld(&(bar)[XB_TMO])) break; if (_sp > XB_SPIN_CAP) { atomicAdd(&(bar)[XB_TMO], 1u); break; } } } } while (0)

struct XcdBarrier {
    unsigned* bar; unsigned x;
    volatile ALDS unsigned* st;
};

__device__ __forceinline__ XcdBarrier xcd_barrier_post(unsigned* bar, volatile ALDS unsigned* st) {
    XcdBarrier b; b.bar = bar; b.x = xb_xcc_id(); b.st = st;
    if (threadIdx.x == 0) (void)xb_add(&bar[XB_XCNT(b.x)], 1u);
    return b;
}
__device__ __forceinline__ void xcd_barrier_complete(unsigned* bar, unsigned x, unsigned& nloc, unsigned& nx) {
    const unsigned G = gridDim.x * gridDim.y * gridDim.z;
    unsigned sum, cnt, mine, sp = 0u;
    for (;;) {
        sum = 0u; cnt = 0u; mine = 0u;
#pragma unroll
        for (unsigned j = 0; j < 16; ++j) { const unsigned c = xb_ld(&bar[XB_XCNT(j)]); sum += c; cnt += (c > 0u) ? 1u : 0u; mine = (j == x) ? c : mine; }
        if (sum == G) break;
        __builtin_amdgcn_s_sleep(1);
        if ((++sp & 255u) == 0u) { if (xb_ld(&bar[XB_TMO])) break; if (sp > XB_SPIN_CAP) { atomicAdd(&bar[XB_TMO], 1u); break; } }
    }
    nloc = mine > 0u ? mine : 1u; nx = cnt > 0u ? cnt : 1u;
}

__device__ __forceinline__ void xcd_barrier(const XcdBarrier& b) {
    asm volatile("s_waitcnt vmcnt(0)" ::: "memory");
    __syncthreads();
    if (threadIdx.x == 0) {
        unsigned* bar = b.bar;
        __builtin_amdgcn_s_waitcnt(0);
        unsigned nloc = b.st[0], nx = b.st[1];
        if (nloc == 0u) { xcd_barrier_complete(bar, b.x, nloc, nx); b.st[0] = nloc; b.st[1] = nx; }
        const unsigned old = xb_add(&bar[XB_XSUB(b.x)], 1u);
        const unsigned gen = old / nloc;
        if (old + 1u == (gen + 1u) * nloc) {
            __builtin_amdgcn_fence(__ATOMIC_RELEASE, "agent");
            asm volatile("s_waitcnt vmcnt(0)" ::: "memory");
            const unsigned og = xb_add(&bar[XB_TOP], 1u);
            const unsigned tg = og / nx;
            if (og + 1u == (tg + 1u) * nx) xb_add(&bar[XB_TOPGEN], 1u);
            else XB_SPIN(xb_ld(&bar[XB_TOPGEN]) == tg, bar);
            __builtin_amdgcn_fence(__ATOMIC_ACQUIRE, "agent");
            xb_add(&bar[XB_XGEN(b.x)], 1u);
            asm volatile("s_waitcnt vmcnt(0)" ::: "memory");
        } else {
            XB_SPIN(xb_ld(&bar[XB_XGEN(b.x)]) == gen, bar);
            __builtin_amdgcn_fence(__ATOMIC_ACQUIRE, "agent");
            asm volatile("s_waitcnt vmcnt(0)" ::: "memory");
        }
    }
    __syncthreads();
}

__device__ __forceinline__ void ln_row_h(const bf16* hrow, const float* g, const float* bta, float* orow, int lane) {
    asm volatile("" : "+v"(lane));
    typedef _Float16 h4 __attribute__((ext_vector_type(4)));
    f32x4 v[4]; float s = 0.f;
#pragma unroll
    for (int j = 0; j < 4; ++j) { const h4 h = *((const h4*)hrow + lane + 64 * j); v[j] = (f32x4){(float)h[0], (float)h[1], (float)h[2], (float)h[3]}; s += (v[j][0] + v[j][1]) + (v[j][2] + v[j][3]); }
    const float mean = wave_sum(s) * (1.f / D); float s2 = 0.f;
#pragma unroll
    for (int j = 0; j < 4; ++j) { v[j] = v[j] - mean; s2 += (v[j][0] * v[j][0] + v[j][1] * v[j][1]) + (v[j][2] * v[j][2] + v[j][3] * v[j][3]); }
    const float rstd = 1.0f / sqrtf(wave_sum(s2) * (1.f / D) + 1e-5f);
#pragma unroll
    for (int j = 0; j < 4; ++j) { const f32x4 gg = *((const f32x4*)g + lane + 64 * j), bb = *((const f32x4*)bta + lane + 64 * j);
        *((f32x4*)orow + lane + 64 * j) = v[j] * rstd * gg + bb; }
}

__global__ void __launch_bounds__(NWAVES * 64, 2) fwd_megakernel(Args args) {
    extern __shared__ __attribute__((aligned(16))) unsigned char lds_raw[];
    cg::grid_group grid = cg::this_grid();
#define GSYNC() xcd_barrier(bar)
    ALDS unsigned char* lds = (ALDS unsigned char*)lds_raw;
    const int tid = threadIdx.x, lane = tid & 63, wave = __builtin_amdgcn_readfirstlane(tid >> 6);
    const int G = gridDim.x, bx = blockIdx.x, vcu = (G % 8 == 0) ? (bx % 8) * (G / 8) + bx / 8 : bx;
    unsigned char* ws = args.ws;
    const float* x_in = args.in[0]; const int* positions = (const int*)args.in[1];
    float* out = args.out;
    bf16* XB = (bf16*)(ws + WS_XB); bf16* HB = (bf16*)(ws + WS_H); bf16* QKV = (bf16*)(ws + WS_H); bf16* YM = (bf16*)(ws + WS_YM);
    float* ROPE = (float*)(ws + WS_ROPE); float* CSBW = (float*)(ws + WS_CSBW); float* ST = (float*)(ws + WS_ST);
    const int gw = vcu * NWAVES + wave, NGW = G * NWAVES;
    volatile ALDS unsigned* bst = (volatile ALDS unsigned*)(lds + 131072 + 8192);
    if (tid < 2) bst[tid] = 0u;
    __syncthreads();
    XcdBarrier bar = xcd_barrier_post((unsigned*)(ws + WS_CTL), bst);

    for (int rep = 0; rep < REP_PRO; ++rep) {
        ALDS float* scr = (ALDS float*)(lds + wave * 16384);
        constexpr int I1 = (D / 64) * (2 * FF / 32), I2 = (FF / 64) * (D / 32), I3 = (D / 64) * (NIN / 32), I4 = (D / 64) * (D / 32), IL = 2 * I1 + 2 * I2 + I3 + I4;
        for (int it = gw; it < IL * DEPTH; it += NGW) {
            const int l = it / IL; int r = it % IL;
            unsigned char* wl = ws + WS_W + (size_t)l * WL_STRIDE;
            if (r < I1) { transpose_item<true>(args.in[7] + (size_t)l * D * 2 * FF, D, 2 * FF, 1, (l > 0) ? args.in[11] + (size_t)((l - 1) * 3 + 2) * D : nullptr, (bf16*)(wl + W1_OFF), scr, r, lane); continue; } r -= I1;
            if (r < I2) { transpose_item<false>(args.in[8] + (size_t)l * FF * D, FF, D, 0, nullptr, (bf16*)(wl + W2_OFF), scr, r, lane); continue; } r -= I2;
            if (r < I3) { transpose_item<true>(args.in[2] + (size_t)l * D * NIN, D, NIN, 2, args.in[11] + (size_t)(l * 3) * D, (bf16*)(wl + WIN_OFF), scr, r, lane); continue; } r -= I3;
            if (r < I4) { transpose_item<false>(args.in[3] + (size_t)l * D * D, D, D, 0, nullptr, (bf16*)(wl + WO_OFF), scr, r, lane); continue; } r -= I4;
            if (r < I1) { transpose_item<true>(args.in[9] + (size_t)l * D * 2 * FF, D, 2 * FF, 1, args.in[11] + (size_t)(l * 3 + 1) * D, (bf16*)(wl + W3_OFF), scr, r, lane); continue; } r -= I1;
            transpose_item<false>(args.in[10] + (size_t)l * FF * D, FF, D, 0, nullptr, (bf16*)(wl + W4_OFF), scr, r, lane);
        }
        const size_t gt = (size_t)vcu * (NWAVES * 64) + tid, GT = (size_t)G * NWAVES * 64;
        for (size_t i = gt; i < (size_t)M * D / 4; i += GT) { const f32x4 v = *((const f32x4*)x_in + i); v2u w; w.x = pg8::cvtpk_h(v[0], v[1]); w.y = pg8::cvtpk_h(v[2], v[3]); *((v2u*)XB + i) = w; }
        for (size_t i = gt; i < (size_t)M * 32; i += GT) { const int row = (int)(i >> 5), k = (int)(i & 31); float c, s; sincos_f32angle((float)positions[row] * args.inv[k], c, s);
            ROPE[(size_t)row * 64 + k] = c; ROPE[(size_t)row * 64 + 32 + k] = s; }
        for (size_t i = gt; i < (size_t)M * 2; i += GT) ST[i] = 0.f;
        {
            ALDS float* red = (ALDS float*)(lds + 131072);
            constexpr int CG0 = 2 * FF / 64, CG1 = NIN / 64, CGL = 2 * CG0 + CG1;
            for (int cgi = vcu; cgi < CGL * DEPTH; cgi += G) {
                const int l = cgi / CGL; int r = cgi % CGL; int j = 0;
                if (r >= CG0) { r -= CG0; j = 1; if (r >= CG1) { r -= CG1; j = 2; } }
                const int lnidx = (j == 0) ? (l - 1) * 3 + 2 : (j == 1) ? l * 3 : l * 3 + 1;
                if (lnidx < 0) continue;
                const int N = (j == 1) ? NIN : 2 * FF, type = (j == 1) ? 2 : 1;
                const float* W = (j == 0) ? args.in[7] + (size_t)l * D * 2 * FF : (j == 1) ? args.in[2] + (size_t)l * D * NIN : args.in[9] + (size_t)l * D * 2 * FF;
                const float* gk = args.in[11] + (size_t)lnidx * D; const float* bk = args.in[12] + (size_t)lnidx * D;
                const int n = r * 64 + lane, sc = src_col(type, n);
                float c1 = 0.f, b1 = 0.f;
#pragma unroll 16
                for (int k = wave * 128; k < wave * 128 + 128; ++k) { const float w = W[(size_t)k * N + sc]; const float gw = gk[k] * w;
                    c1 += (float)(_Float16)gw; b1 += bk[k] * w; }
                red[(wave * 64 + lane) * 2] = c1; red[(wave * 64 + lane) * 2 + 1] = b1;
                __syncthreads();
                if (wave == 0) { float cc = 0.f, bb = 0.f;
#pragma unroll
                    for (int w8 = 0; w8 < 8; ++w8) { cc += red[(w8 * 64 + lane) * 2]; bb += red[(w8 * 64 + lane) * 2 + 1]; }
                    float* dst = CSBW + (size_t)((l * 3 + j) * 2) * CSBW_N; dst[n] = cc; dst[CSBW_N + n] = bb; }
                __syncthreads();
            }
        }
    }
    grid.sync();

#define ZERO_ST(buf_) do { int t_ = tid; asm volatile("" : "+v"(t_)); float* z_ = ST + (size_t)(buf_) * M * 2; for (int i_ = vcu * (NWAVES * 64) + t_; i_ < M * 2; i_ += G * NWAVES * 64) { z_[i_] = 0.f; asm volatile("" : "+v"(i_)); } } while (0)
    for (int l = 0; l < DEPTH; ++l) {
        unsigned char* wl = ws + WS_W + (size_t)l * WL_STRIDE;
        const float* lng = args.in[11]; const float* lnb = args.in[12];
        { const int k = 3 * l; ZERO_ST(k & 1);
          const float* cb = CSBW + (size_t)((l * 3 + 0) * 2) * CSBW_N;
          pg8::Gemm g{XB, (const bf16*)(wl + W1_OFF), M, 2 * FF, D}; pg8::StaticOrder S; S.init(M, 2 * FF, G, bx);
          pg8::EpiSwiGLU E{HB, FF, pg8::RowLN{(k == 0) ? nullptr : ST + (size_t)((k - 1) & 1) * M * 2, cb, cb + CSBW_N}};
          for (int rep = 0; rep < REP_G1; ++rep) pg8::gemm_phase<pg8::EpiSwiGLU, pg8::StaticOrder, true, true>(lds, g, S, E); }
        GSYNC();
        { const int k = 3 * l;
          pg8::Gemm g{HB, (const bf16*)(wl + W2_OFF), M, D, FF}; pg8::StaticOrder S; S.init(M, D, G, bx);
          pg8::EpiRes E{x_in, XB, (k == 0) ? nullptr : ST + (size_t)((k - 1) & 1) * M * 2, lng + (size_t)(k > 0 ? k - 1 : 0) * D, lnb + (size_t)(k > 0 ? k - 1 : 0) * D, ST + (size_t)(k & 1) * M * 2, ALPHA, 0.5f};
          pg8::gemm_phase<pg8::EpiRes, pg8::StaticOrder, true, true>(lds, g, S, E); }
        GSYNC();
        { const int k = 3 * l + 1; ZERO_ST(k & 1);
          const float* cb = CSBW + (size_t)((l * 3 + 1) * 2) * CSBW_N;
          pg8::Gemm g{XB, (const bf16*)(wl + WIN_OFF), M, NIN, D}; pg8::StaticOrder S; S.init(M, NIN, G, bx);
          pg8::EpiQKV E{QKV, ROPE, QSCALE, pg8::RowLN{ST + (size_t)((k - 1) & 1) * M * 2, cb, cb + CSBW_N}};
          pg8::gemm_phase<pg8::EpiQKV, pg8::StaticOrder, true, true>(lds, g, S, E); }
        GSYNC();
        {
            const float* lv = args.in[4] + (size_t)l * 256;
            int la = lane; asm volatile("" : "+v"(la));
            const float a1 = wave_sum(lv[la] * lv[64 + la]), a2 = wave_sum(lv[128 + la] * lv[192 + la]);
            const float lam_init = args.lam_init[l], lam = expf(a1) - expf(a2) + lam_init;
            const float* subg = args.in[5] + (size_t)l * 128; const float* sink = args.in[6] + (size_t)l * 8;
            for (int rep = 0; rep < REP_ATT; ++rep) {
            for (int u = vcu; u < 2048; u += G) att::diff_unit(lds, wave, lane, QKV, YM, u, lam, 1.0f - lam_init, subg);
            for (int u = vcu; u < 2048; u += G) att::swa_unit(lds, wave, lane, QKV, YM, u, sink);
            }
        }
        GSYNC();
        { const int k = 3 * l + 1;
          pg8::Gemm g{YM, (const bf16*)(wl + WO_OFF), M, D, D}; pg8::StaticOrder S; S.init(M, D, G, bx);
          pg8::EpiRes E{x_in, XB, ST + (size_t)((k - 1) & 1) * M * 2, lng + (size_t)(k - 1) * D, lnb + (size_t)(k - 1) * D, ST + (size_t)(k & 1) * M * 2, ALPHA, 1.0f};
          pg8::gemm_phase<pg8::EpiRes, pg8::StaticOrder, true, true>(lds, g, S, E); }
        GSYNC();
        { const int k = 3 * l + 2; ZERO_ST(k & 1);
          const float* cb = CSBW + (size_t)((l * 3 + 2) * 2) * CSBW_N;
          pg8::Gemm g{XB, (const bf16*)(wl + W3_OFF), M, 2 * FF, D}; pg8::StaticOrder S; S.init(M, 2 * FF, G, bx);
          pg8::EpiSwiGLU E{HB, FF, pg8::RowLN{ST + (size_t)((k - 1) & 1) * M * 2, cb, cb + CSBW_N}};
          for (int rep = 0; rep < REP_G1; ++rep) pg8::gemm_phase<pg8::EpiSwiGLU, pg8::StaticOrder, true, true>(lds, g, S, E); }
        GSYNC();
        { const int k = 3 * l + 2;
          pg8::Gemm g{HB, (const bf16*)(wl + W4_OFF), M, D, FF}; pg8::StaticOrder S; S.init(M, D, G, bx);
          pg8::EpiRes E{x_in, XB, ST + (size_t)((k - 1) & 1) * M * 2, lng + (size_t)(k - 1) * D, lnb + (size_t)(k - 1) * D, ST + (size_t)(k & 1) * M * 2, ALPHA, 0.5f};
          pg8::gemm_phase<pg8::EpiRes, pg8::StaticOrder, true, true>(lds, g, S, E); }
        GSYNC();
    }
    for (int m = gw; m < M; m += NGW) ln_row_h(XB + (size_t)m * D, args.in[11] + (size_t)11 * D, args.in[12] + (size_t)11 * D, out + (size_t)m * D, lane);
}

extern "C" void kernel_launch(void* const* d_in, const int* in_sizes, int n_in, void* d_out, int out_size, void* d_ws, size_t ws_size, hipStream_t stream) {
    static int grid = 0;
    if (grid == 0) {
        if (n_in != 13 || in_sizes[0] != M * D || out_size != M * D || ws_size < WS_END) { fprintf(stderr, "kernel_launch: unexpected shapes (n_in %d, in0 %d, out %d, ws %zu); nothing launched\n", n_in, n_in > 0 ? in_sizes[0] : -1, out_size, ws_size); grid = -1; return; }
        int dev = 0, cus = 0, per_cu = 0;
        if (hipGetDevice(&dev) != hipSuccess || hipDeviceGetAttribute(&cus, hipDeviceAttributeMultiprocessorCount, dev) != hipSuccess) { grid = -1; return; }
        if (hipFuncSetAttribute((const void*)fwd_megakernel, hipFuncAttributeMaxDynamicSharedMemorySize, LDS_BYTES) != hipSuccess) { fprintf(stderr, "kernel_launch: hipFuncSetAttribute failed\n"); grid = -1; return; }
        if (hipOccupancyMaxActiveBlocksPerMultiprocessor(&per_cu, (const void*)fwd_megakernel, NWAVES * 64, LDS_BYTES) != hipSuccess || per_cu < 1) { fprintf(stderr, "kernel_launch: occupancy query gives %d\n", per_cu); per_cu = 1; }
        (void)hipGetLastError();
        grid = cus * 1;
    }
    if (grid < 0) return;
    if (hipMemsetAsync((char*)d_ws + WS_CTL, 0, CTL_ZERO_BYTES, stream) != hipSuccess) { fprintf(stderr, "kernel_launch: memset of the barrier words failed\n"); return; }
    Args a{};
    for (int i = 0; i < 13; ++i) a.in[i] = (const float*)d_in[i];
    a.out = (float*)d_out; a.ws = (unsigned char*)d_ws;
    for (int i = 0; i < 32; ++i) a.inv[i] = (float)pow(10000.0, -(double)(2 * i) / 64.0);
    for (int l = 0; l < 4; ++l) a.lam_init[l] = (float)(0.8 - 0.6 * exp(-0.3 * (double)l));
    void* kargs[] = {&a};
    const hipError_t e = hipLaunchCooperativeKernel((const void*)fwd_megakernel, dim3(grid), dim3(NWAVES * 64), kargs, LDS_BYTES, stream);
    if (e != hipSuccess) fprintf(stderr, "kernel_launch: cooperative launch failed: %s (grid %d)\n", hipGetErrorString(e), grid);
}
```

```cpp
#include <hip/hip_runtime.h>
#include <hip/hip_cooperative_groups.h>
#include <cstdio>
#include <cstdint>
#include <cmath>
namespace cg = cooperative_groups;
namespace pg8 {
#define PG8_LAS __attribute__((address_space(3)))
typedef unsigned short bf16_t;
typedef short bf16x8 __attribute__((ext_vector_type(8)));
typedef float f32x4 __attribute__((ext_vector_type(4)));
typedef unsigned u32x4 __attribute__((ext_vector_type(4)));
constexpr int BM = 256, BK = 64, HALF = 128, HTB = HALF * BK * 2  , STAGE_BYTES = 8 * HTB, NXCD = 8, WGM = 8;

__host__ __device__ __forceinline__ int lds_byte(int r, int c) { const int st = (r >> 4) * 2 + (c >> 5), rr = r & 15, cc = c & 31, ob = rr * 64 + cc * 2; return st * 1024 + (ob ^ (((ob >> 9) & 1) << 5)); }
__host__ __device__ __forceinline__ void stage_rc(int b, int& R, int& C) { const int st = b / 1024, sb = b % 1024, swz = sb ^ (((sb >> 9) & 1) << 5); R = (st >> 1) * 16 + swz / 64; C = (st & 1) * 32 + (swz % 64) / 2; }
__host__ __device__ __forceinline__ int perm32(int rho) { const int n = rho >> 4, i = rho & 15; return 8 * (i >> 2) + 4 * n + (i & 3); }

struct Unit { int pm, pn; };
struct Gemm { const bf16_t* A; const bf16_t* Bt; int M, N, K; };

struct StaticOrder {
    int nM, nN, nwg, G, c;
    __host__ __device__ void init(int M, int N, int G_, int c_) { nM = M / BM; nN = N / BM; nwg = nM * nN; G = G_; c = c_; }
    __host__ __device__ bool next(int i, Unit& u) const {
        const long L = (long)i * G + c; if (L >= nwg) return false;
        int wgid = (int)L; { const int q = nwg / NXCD, r = nwg % NXCD, xcd = wgid % NXCD, off = wgid / NXCD; wgid = (xcd < r ? xcd * (q + 1) : r * (q + 1) + (xcd - r) * q) + off; }
        const int nig = WGM * nN, gid = wgid / nig, fm = gid * WGM, gsz = (nM - fm) < WGM ? (nM - fm) : WGM;
        u.pm = fm + ((wgid % nig) % gsz); u.pn = (wgid % nig) / gsz; return true;
    }
    __device__ __forceinline__ void a_ready(const Unit&) const {}
    __device__ __forceinline__ void done(const Unit&) const {}
};

typedef float f32x2_t __attribute__((ext_vector_type(2))); typedef __bf16 bf16x2_t __attribute__((ext_vector_type(2)));
__device__ __forceinline__ unsigned cvtpk(float lo, float hi) { f32x2_t v = {lo, hi}; bf16x2_t b = __builtin_convertvector(v, bf16x2_t); return __builtin_bit_cast(unsigned, b); }
typedef _Float16 f16x8 __attribute__((ext_vector_type(8))); typedef _Float16 f16x2_t __attribute__((ext_vector_type(2)));
template <bool F16> __device__ __forceinline__ f32x4 mma16(bf16x8 a, bf16x8 b, f32x4 c) {
    if constexpr (F16) return __builtin_amdgcn_mfma_f32_16x16x32_f16(__builtin_bit_cast(f16x8, a), __builtin_bit_cast(f16x8, b), c, 0, 0, 0);
    else return __builtin_amdgcn_mfma_f32_16x16x32_bf16(a, b, c, 0, 0, 0);
}
__device__ __forceinline__ unsigned cvtpk_h(float lo, float hi) { f16x2_t v = {(_Float16)lo, (_Float16)hi}; return __builtin_bit_cast(unsigned, v); }
__device__ __forceinline__ float silu_f(float g) { return g * __builtin_amdgcn_rcpf(1.0f + __builtin_amdgcn_exp2f(-1.4426950408889634f * g)); }

typedef float f32x2v __attribute__((ext_vector_type(2)));
struct RowLN {
    const float* st; const float* cs; const float* bw;
    __device__ __forceinline__ void row(int r, float& a, float& c) const {
        if (st) { const f32x2v s = *(const f32x2v*)(st + 2 * (size_t)r); const float mu = s.x * (1.0f / 1024.0f), var = s.y * (1.0f / 1024.0f) - mu * mu; a = rsqrtf(var + 1e-5f); c = -a * mu; }
        else { a = 1.0f; c = 0.0f; }
    }
};
struct EpiSwiGLU {
    static constexpr bool PERM = true, AFTER_DRAIN = false, F16 = true;
    bf16_t* H; int ldh; RowLN ln;
    __device__ __forceinline__ void operator()(const f32x4 (&acc)[2][2][4][2], const Unit& u, int wr, int wc, int fr, int fq) const {
        const int row0 = u.pm * BM + wr * 64 + fr, col0 = u.pn * HALF + wc * 32 + 8 * fq, wrow0 = u.pn * BM + wc * 32 + 8 * fq;
        f32x4 cs[2][2], bw[2][2];
#pragma unroll
        for (int bj = 0; bj < 2; ++bj)
#pragma unroll
            for (int n = 0; n < 2; ++n) { const f32x4 z = (f32x4){0.f, 0.f, 0.f, 0.f}; cs[bj][n] = ln.st ? *(const f32x4*)(ln.cs + wrow0 + bj * HALF + 4 * n) : z; bw[bj][n] = ln.st ? *(const f32x4*)(ln.bw + wrow0 + bj * HALF + 4 * n) : z; }
#pragma unroll
        for (int ai = 0; ai < 2; ++ai)
#pragma unroll
            for (int m = 0; m < 4; ++m) {
                const int row = row0 + ai * HALF + m * 16; float a, c; ln.row(row, a, c);
                const f32x4 g0 = acc[ai][0][m][0] * a + cs[0][0] * c + bw[0][0], g1 = acc[ai][0][m][1] * a + cs[0][1] * c + bw[0][1];
                const f32x4 u0 = acc[ai][1][m][0] * a + cs[1][0] * c + bw[1][0], u1 = acc[ai][1][m][1] * a + cs[1][1] * c + bw[1][1];
                u32x4 w;
                w.x = cvtpk(silu_f(g0[0]) * u0[0], silu_f(g0[1]) * u0[1]); w.y = cvtpk(silu_f(g0[2]) * u0[2], silu_f(g0[3]) * u0[3]);
                w.z = cvtpk(silu_f(g1[0]) * u1[0], silu_f(g1[1]) * u1[1]); w.w = cvtpk(silu_f(g1[2]) * u1[2], silu_f(g1[3]) * u1[3]);
                *(u32x4*)(H + (size_t)row * ldh + col0) = w;
            }
    }
};
struct EpiRes {
    static constexpr bool PERM = true, AFTER_DRAIN = false, F16 = false;
    const float* x0; bf16_t* yh; const float* st; const float* g; const float* b; float* st_new; float alpha, s;
    __device__ __forceinline__ void operator()(const f32x4 (&acc)[2][2][4][2], const Unit& u, int wr, int wc, int fr, int fq) const {
        const int row0 = u.pm * BM + wr * 64 + fr, col0 = u.pn * BM + wc * 32 + 8 * fq;
        f32x4 gv[2][2], bv[2][2];
#pragma unroll
        for (int bj = 0; bj < 2; ++bj)
#pragma unroll
            for (int n = 0; n < 2; ++n) { gv[bj][n] = st ? *(const f32x4*)(g + col0 + bj * HALF + 4 * n) : (f32x4){1.f, 1.f, 1.f, 1.f}; bv[bj][n] = st ? *(const f32x4*)(b + col0 + bj * HALF + 4 * n) : (f32x4){0.f, 0.f, 0.f, 0.f}; }
#pragma unroll
        for (int ai = 0; ai < 2; ++ai)
#pragma unroll
            for (int m = 0; m < 4; ++m) {
                const int row = row0 + ai * HALF + m * 16; const size_t off = (size_t)row * 1024 + col0;
                float a = 1.0f, mu = 0.0f;
                if (st) { const f32x2v sv = *(const f32x2v*)(st + 2 * (size_t)row); mu = sv.x * (1.0f / 1024.0f); a = rsqrtf(sv.y * (1.0f / 1024.0f) - mu * mu + 1e-5f); }
                float s1 = 0.f, s2 = 0.f;
#pragma unroll
                for (int bj = 0; bj < 2; ++bj) {
                    f32x4 yp[2];
                    if (st) { const f16x8 hv = *(const f16x8*)(yh + off + bj * HALF);
                        yp[0] = (f32x4){(float)hv[0], (float)hv[1], (float)hv[2], (float)hv[3]}; yp[1] = (f32x4){(float)hv[4], (float)hv[5], (float)hv[6], (float)hv[7]}; }
                    else { yp[0] = *(const f32x4*)(x0 + off + bj * HALF); yp[1] = *(const f32x4*)(x0 + off + bj * HALF + 4); }
                    f32x4 y[2];
#pragma unroll
                    for (int n = 0; n < 2; ++n) { const f32x4 x = (yp[n] - mu) * a * gv[bj][n] + bv[bj][n];
                        y[n] = x * alpha + acc[ai][bj][m][n] * s;
                        s1 += (y[n][0] + y[n][1]) + (y[n][2] + y[n][3]); s2 += (y[n][0] * y[n][0] + y[n][1] * y[n][1]) + (y[n][2] * y[n][2] + y[n][3] * y[n][3]); }
                    u32x4 w; w.x = cvtpk_h(y[0][0], y[0][1]); w.y = cvtpk_h(y[0][2], y[0][3]); w.z = cvtpk_h(y[1][0], y[1][1]); w.w = cvtpk_h(y[1][2], y[1][3]);
                    *(u32x4*)(yh + off + bj * HALF) = w;
                }
                s1 += __shfl_xor(s1, 16); s1 += __shfl_xor(s1, 32); s2 += __shfl_xor(s2, 16); s2 += __shfl_xor(s2, 32);
                if (fq == 0) { atomicAdd(st_new + 2 * (size_t)row, s1); atomicAdd(st_new + 2 * (size_t)row + 1, s2); }
                if (m == 3) asm volatile("" ::: "memory");
            }
    }
};
struct EpiQKV {
    static constexpr bool PERM = true, AFTER_DRAIN = false, F16 = true;
    bf16_t* O; const float* rope; float qscale; RowLN ln;
    __device__ __forceinline__ void operator()(const f32x4 (&acc)[2][2][4][2], const Unit& u, int wr, int wc, int fr, int fq) const {
        const int pn = u.pn, row0 = u.pm * BM + wr * 64 + fr, col0 = pn * BM + wc * 32 + 8 * fq, i0 = 16 * (wc & 1) + 4 * fq;
        const bool anyrope = (pn != 4 && pn != 5);
        const float sc = (pn < 2 || pn == 6 || pn == 7) ? qscale : 1.0f;
        f32x4 cs[2][2], bw[2][2];
#pragma unroll
        for (int bj = 0; bj < 2; ++bj)
#pragma unroll
            for (int n = 0; n < 2; ++n) { cs[bj][n] = *(const f32x4*)(ln.cs + col0 + bj * HALF + 4 * n); bw[bj][n] = *(const f32x4*)(ln.bw + col0 + bj * HALF + 4 * n); }
#pragma unroll
        for (int ai = 0; ai < 2; ++ai)
#pragma unroll
            for (int m = 0; m < 4; ++m) {
                const int row = row0 + ai * HALF + m * 16; float a, c; ln.row(row, a, c);
                f32x4 cs4 = (f32x4){1.f, 1.f, 1.f, 1.f}, sn = (f32x4){0.f, 0.f, 0.f, 0.f};
                if (anyrope) { cs4 = *(const f32x4*)(rope + (size_t)row * 64 + i0); sn = *(const f32x4*)(rope + (size_t)row * 64 + 32 + i0); }
#pragma unroll
                for (int bj = 0; bj < 2; ++bj) {
                    const bool rp = anyrope && !(pn == 8 && bj == 1);
                    f32x4 v0 = acc[ai][bj][m][0] * a + cs[bj][0] * c + bw[bj][0], v1 = acc[ai][bj][m][1] * a + cs[bj][1] * c + bw[bj][1];
                    if (rp) {
                        const f32x4 a0 = v0, a1 = v1;
                        v0[0] = a0[0] * cs4[0] - a0[1] * sn[0]; v0[1] = a0[1] * cs4[0] + a0[0] * sn[0];
                        v0[2] = a0[2] * cs4[1] - a0[3] * sn[1]; v0[3] = a0[3] * cs4[1] + a0[2] * sn[1];
                        v1[0] = a1[0] * cs4[2] - a1[1] * sn[2]; v1[1] = a1[1] * cs4[2] + a1[0] * sn[2];
                        v1[2] = a1[2] * cs4[3] - a1[3] * sn[3]; v1[3] = a1[3] * cs4[3] + a1[2] * sn[3];
                    }
                    v0 = v0 * sc; v1 = v1 * sc;
                    u32x4 w; w.x = cvtpk(v0[0], v0[1]); w.y = cvtpk(v0[2], v0[3]); w.z = cvtpk(v1[0], v1[1]); w.w = cvtpk(v1[2], v1[3]);
                    *(u32x4*)(O + (size_t)row * 2304 + col0 + bj * HALF) = w;
                }
            }
    }
};

template <class Epi, class Sched, bool ALIGN_EPI = false, bool SP2 = false>
__device__ __forceinline__ void gemm_phase(PG8_LAS unsigned char* lds, const Gemm g, const Sched& S, const Epi& E) {
    int tid_ = threadIdx.x; asm volatile("" : "+v"(tid_));
    const int tid = tid_, wid = __builtin_amdgcn_readfirstlane(tid >> 6), lane = tid & 63, wr = wid >> 2, wc = wid & 3, fr = lane & 15, fq = lane >> 4;
    const int K = g.K, nt = K / BK;
    unsigned voffA[2], voffB[2];
#pragma unroll
    for (int i = 0; i < 2; ++i) { int R, C; stage_rc(tid * 16 + i * 8192, R, C); const int Rb = Epi::PERM ? ((R & ~31) + perm32(R & 31)) : R;
        voffA[i] = (unsigned)(R * K + C) * 2u; voffB[i] = (unsigned)(Rb * K + C) * 2u; }
    const size_t kstep = (size_t)(BK * 2);
    const size_t hstep = (size_t)HALF * K * 2;
    const size_t tstep = 2 * hstep;
    const unsigned ldsw = (unsigned)wid * 1024u;
    const int aoff = lds_byte(wr * 64 + fr, fq * 8), boff = lds_byte(wc * 32 + fr, fq * 8);
#define PG8_SA(b, h) (((b) * 2 + (h)) * HTB)
#define PG8_SB(b, h) ((4 + (b) * 2 + (h)) * HTB)
#define PG8_STAGE(bufoff, gbase, voff) do { _Pragma("unroll") for (int _i = 0; _i < 2; ++_i) \
        __builtin_amdgcn_global_load_lds((const unsigned*)((const char*)(gbase) + (voff)[_i]), (PG8_LAS unsigned*)(lds + (bufoff) + ldsw + _i * 8192), 16, 0, 0); } while (0)
#define PG8_LDA(dst, b, h) do { _Pragma("unroll") for (int m = 0; m < 4; ++m) _Pragma("unroll") for (int k = 0; k < 2; ++k) dst[m][k] = *(const PG8_LAS bf16x8*)(lds + PG8_SA(b, h) + aoff + m * 2048 + k * 1024); } while (0)
#define PG8_LDB(dst, b, h) do { _Pragma("unroll") for (int n = 0; n < 2; ++n) _Pragma("unroll") for (int k = 0; k < 2; ++k) dst[n][k] = *(const PG8_LAS bf16x8*)(lds + PG8_SB(b, h) + boff + n * 2048 + k * 1024); } while (0)
#define PG8_MMA(ai, bj, At, Bt) do { __builtin_amdgcn_s_setprio(1); _Pragma("unroll") for (int m = 0; m < 4; ++m) _Pragma("unroll") for (int n = 0; n < 2; ++n) _Pragma("unroll") for (int k = 0; k < 2; ++k) \
        acc[ai][bj][m][n] = mma16<Epi::F16>(Bt[n][k], At[m][k], acc[ai][bj][m][n]); __builtin_amdgcn_s_setprio(0); } while (0)
#define PG8_WAIT_V(n) asm volatile("s_waitcnt vmcnt(" #n ")" ::: "memory")
#define PG8_WAIT_L(n) asm volatile("s_waitcnt lgkmcnt(" #n ")" ::: "memory")
#define PG8_BAR __builtin_amdgcn_s_barrier()
#define PG8_SCHED __builtin_amdgcn_sched_barrier(0)
    Unit cur, nxt; int ui = 0;
    if (!S.next(0, cur)) return;
    f32x4 acc[2][2][4][2];
#pragma unroll
    for (int a = 0; a < 2; ++a)
#pragma unroll
        for (int b = 0; b < 2; ++b)
#pragma unroll
            for (int m = 0; m < 4; ++m)
#pragma unroll
                for (int n = 0; n < 2; ++n) acc[a][b][m][n] = (f32x4){0.f, 0.f, 0.f, 0.f};
    bf16x8 At[4][2], B0[2][2], B1[2][2];
    const char* cA = (const char*)g.A + (size_t)cur.pm * tstep; const char* cB = (const char*)g.Bt + (size_t)cur.pn * tstep;
    S.a_ready(cur);
    if constexpr (SP2) {
        PG8_STAGE(PG8_SB(0, 0), cB, voffB); PG8_STAGE(PG8_SB(0, 1), cB + hstep, voffB); PG8_STAGE(PG8_SA(0, 0), cA, voffA); PG8_STAGE(PG8_SA(0, 1), cA + hstep, voffA);
        if (wr == 1) PG8_BAR;
        PG8_WAIT_V(2); PG8_BAR;
        PG8_STAGE(PG8_SB(1, 0), cB + kstep, voffB); PG8_STAGE(PG8_SA(1, 0), cA + kstep, voffA); PG8_STAGE(PG8_SB(1, 1), cB + hstep + kstep, voffB);
        PG8_WAIT_V(6); PG8_BAR;
    } else {
        PG8_STAGE(PG8_SB(0, 0), cB, voffB); PG8_STAGE(PG8_SA(0, 0), cA, voffA); PG8_STAGE(PG8_SB(0, 1), cB + hstep, voffB); PG8_STAGE(PG8_SA(0, 1), cA + hstep, voffA);
        if (wr == 1) PG8_BAR;
        PG8_WAIT_V(4); PG8_BAR;
        PG8_STAGE(PG8_SB(1, 0), cB + kstep, voffB); PG8_STAGE(PG8_SA(1, 0), cA + kstep, voffA); PG8_STAGE(PG8_SB(1, 1), cB + hstep + kstep, voffB);
        PG8_WAIT_V(6); PG8_BAR;
    }
    for (;;) {
        const bool has_next = S.next(ui + 1, nxt);
        const char* nA = has_next ? (const char*)g.A + (size_t)nxt.pm * tstep : cA; const char* nB = has_next ? (const char*)g.Bt + (size_t)nxt.pn * tstep : cB;
        for (int t = 0; t < nt; t += 2) {
            const bool last = (t == nt - 2);
            const char* a1 = cA + (size_t)(t + 1) * kstep;
            const char* a2 = last ? nA : cA + (size_t)(t + 2) * kstep; const char* b2 = last ? nB : cB + (size_t)(t + 2) * kstep;
            const char* a3 = a2 + kstep; const char* b3 = b2 + kstep;
            if (last && has_next) S.a_ready(nxt);
            if constexpr (SP2) {
            PG8_LDB(B0, 0, 0); PG8_LDB(B1, 0, 1); PG8_SCHED; PG8_LDA(At, 0, 0); PG8_STAGE(PG8_SA(1, 1), a1 + hstep, voffA);
            PG8_WAIT_V(8); PG8_WAIT_L(0); PG8_BAR; PG8_MMA(0, 0, At, B0); PG8_MMA(0, 1, At, B1); PG8_BAR; PG8_SCHED;
            PG8_LDA(At, 0, 1); PG8_STAGE(PG8_SB(0, 0), b2, voffB); PG8_STAGE(PG8_SB(0, 1), b2 + hstep, voffB); PG8_STAGE(PG8_SA(0, 0), a2, voffA);
            PG8_WAIT_V(8); PG8_WAIT_L(0); PG8_BAR; PG8_MMA(1, 0, At, B0); PG8_MMA(1, 1, At, B1); PG8_BAR; PG8_SCHED;
            PG8_LDB(B0, 1, 0); PG8_LDB(B1, 1, 1); PG8_SCHED; PG8_LDA(At, 1, 0); PG8_STAGE(PG8_SA(0, 1), a2 + hstep, voffA);
            PG8_WAIT_V(8); PG8_WAIT_L(0); PG8_BAR; PG8_MMA(0, 0, At, B0); PG8_MMA(0, 1, At, B1); PG8_BAR; PG8_SCHED;
            PG8_LDA(At, 1, 1); PG8_STAGE(PG8_SB(1, 0), b3, voffB); PG8_STAGE(PG8_SB(1, 1), b3 + hstep, voffB); PG8_STAGE(PG8_SA(1, 0), a3, voffA);
            PG8_WAIT_V(8); PG8_WAIT_L(0); PG8_BAR; PG8_MMA(1, 0, At, B0); PG8_MMA(1, 1, At, B1); PG8_BAR; PG8_SCHED;
            } else {
            PG8_LDB(B0, 0, 0); PG8_SCHED; PG8_LDA(At, 0, 0); PG8_STAGE(PG8_SA(1, 1), a1 + hstep, voffA);
            PG8_WAIT_L(8); PG8_BAR; PG8_WAIT_L(0); PG8_MMA(0, 0, At, B0); PG8_BAR; PG8_SCHED;
            PG8_LDB(B1, 0, 1); PG8_STAGE(PG8_SB(0, 0), b2, voffB);
            PG8_BAR; PG8_WAIT_L(0); PG8_MMA(0, 1, At, B1); PG8_BAR;
            PG8_LDA(At, 0, 1); PG8_STAGE(PG8_SA(0, 0), a2, voffA);
            PG8_BAR; PG8_WAIT_L(0); PG8_MMA(1, 0, At, B0); PG8_BAR; PG8_SCHED;
            PG8_STAGE(PG8_SB(0, 1), b2 + hstep, voffB);
            PG8_WAIT_V(6); PG8_BAR; PG8_MMA(1, 1, At, B1); PG8_BAR;
            PG8_LDB(B0, 1, 0); PG8_SCHED; PG8_LDA(At, 1, 0); PG8_STAGE(PG8_SA(0, 1), a2 + hstep, voffA);
            PG8_WAIT_L(8); PG8_BAR; PG8_WAIT_L(0); PG8_MMA(0, 0, At, B0); PG8_BAR; PG8_SCHED;
            PG8_LDB(B1, 1, 1); PG8_STAGE(PG8_SB(1, 0), b3, voffB);
            PG8_BAR; PG8_WAIT_L(0); PG8_MMA(0, 1, At, B1); PG8_BAR;
            PG8_LDA(At, 1, 1); PG8_STAGE(PG8_SA(1, 0), a3, voffA);
            PG8_BAR; PG8_WAIT_L(0); PG8_MMA(1, 0, At, B0); PG8_BAR; PG8_SCHED;
            PG8_STAGE(PG8_SB(1, 1), b3 + hstep, voffB);
            PG8_WAIT_V(6); PG8_BAR; PG8_MMA(1, 1, At, B1); PG8_BAR;
            }
        }
        if constexpr (ALIGN_EPI) { if (wr == 0) PG8_BAR; }
        if constexpr (!Epi::AFTER_DRAIN) { E(acc, cur, wr, wc, fr, fq); S.done(cur); }
        if (!has_next) break;
#pragma unroll
        for (int a = 0; a < 2; ++a)
#pragma unroll
            for (int b = 0; b < 2; ++b)
#pragma unroll
                for (int m = 0; m < 4; ++m)
#pragma unroll
                    for (int n = 0; n < 2; ++n) acc[a][b][m][n] = (f32x4){0.f, 0.f, 0.f, 0.f};
        cur = nxt; cA = nA; cB = nB; ++ui;
        if constexpr (ALIGN_EPI) { if (wr == 1) PG8_BAR; }
    }
    PG8_WAIT_V(0);
    if constexpr (!ALIGN_EPI) { if (wr == 0) PG8_BAR; }
    PG8_BAR;
    if constexpr (Epi::AFTER_DRAIN) { E.fused(acc, cur, wr, wc, fr, fq, lds, wid, lane); S.done(cur); }
#undef PG8_SA
#undef PG8_SB
#undef PG8_STAGE
#undef PG8_LDA
#undef PG8_LDB
#undef PG8_MMA
#undef PG8_WAIT_V
#undef PG8_WAIT_L
#undef PG8_BAR
#undef PG8_SCHED
}
}

namespace att {
using pg8::bf16_t; using pg8::bf16x8; using pg8::f32x4; using pg8::u32x4; using pg8::cvtpk;
#define ALDS __attribute__((address_space(3)))
typedef float f32x16 __attribute__((ext_vector_type(16)));
typedef short s16x4 __attribute__((ext_vector_type(4)));
typedef unsigned u32x2 __attribute__((ext_vector_type(2)));
constexpr int PITCH = 2304;
constexpr float THR = 8.0f;
__device__ __forceinline__ void glds16(const void* gsrc, unsigned lds_dst) { unsigned keep;
    asm volatile("s_mov_b32 %0, m0\n\ts_mov_b32 m0, %2\n\ts_nop 0\n\tglobal_load_lds_dwordx4 %1, off\n\ts_mov_b32 m0, %0" : "=&s"(keep) : "v"(gsrc), "s"(lds_dst) : "memory"); }
__device__ __forceinline__ unsigned rfl(unsigned v) { return (unsigned)__builtin_amdgcn_readfirstlane((int)v); }
__device__ __forceinline__ int pi23(int x) { return (x & ~12) | ((x & 4) << 1) | ((x & 8) >> 1); }
__device__ __forceinline__ s16x4 vtr(const ALDS unsigned char* p) { return __builtin_bit_cast(s16x4, __builtin_amdgcn_ds_read_tr16_b64_v4i16((ALDS s16x4*)p)); }
__device__ __forceinline__ float halfswap_max(float v) { auto rr = __builtin_amdgcn_permlane32_swap(__float_as_uint(v), __float_as_uint(v), false, false); return fmaxf(__uint_as_float(rr[0]), __uint_as_float(rr[1])); }
__device__ __forceinline__ float halfswap_sum(float v) { auto rr = __builtin_amdgcn_permlane32_swap(__float_as_uint(v), __float_as_uint(v), false, false); return __uint_as_float(rr[0]) + __uint_as_float(rr[1]); }

template <int DV, bool BAND>
__device__ __forceinline__ float attn_core(ALDS unsigned char* ring, const int wid, const int lane,
                                           const bf16_t* Qw, const bf16_t* ksrc, const bf16_t* vsrc, const int koff,
                                           const int t0, const int t1, const int tq, const int qpos, const float m_init, float l, f32x16 (&o)[DV / 32]) {
    constexpr int NDB = DV / 32, SLOT = (DV == 128) ? 32768 : 16384, VOFF = (DV == 128) ? 16384 : 8192, ROWB = DV * 2, NP = (DV == 128) ? 4 : 2;
    const int r32 = lane & 31, hi = lane >> 5;
    const unsigned ring_a = (unsigned)(uintptr_t)ring;
    bf16x8 qr[4];
#pragma unroll
    for (int d0 = 0; d0 < 4; ++d0) qr[d0] = *(const bf16x8*)(Qw + (size_t)r32 * PITCH + d0 * 16 + hi * 8);
#define ATT_ISSUE(t_, so_) do { const size_t go_ = (size_t)(t_) * (64 * PITCH); const unsigned d_ = ring_a + (unsigned)(so_) + (unsigned)wid * 1024u; \
        glds16(ksrc + go_, rfl(d_)); \
        if (DV == 128) { glds16(ksrc + go_ + 64, rfl(d_ + 8192u)); glds16(vsrc + go_, rfl(ring_a + (unsigned)(so_) + (unsigned)VOFF + (unsigned)wid * 2048u)); \
                         glds16(vsrc + go_ + 4 * PITCH, rfl(ring_a + (unsigned)(so_) + (unsigned)VOFF + (unsigned)wid * 2048u + 1024u)); } \
        else { glds16(vsrc + go_, rfl(d_ + (unsigned)VOFF)); } } while (0)
    ATT_ISSUE(t0, 0);
    { const int tn = (t0 + 1 < t1) ? t0 + 1 : t1 - 1; ATT_ISSUE(tn, SLOT); }
    const int g = (lane >> 4) & 1, q4 = (lane & 15) >> 2, p = lane & 3, sw = (DV == 128) ? q4 : (q4 >> 1);
    int va[NDB];
#pragma unroll
    for (int db = 0; db < NDB; ++db) va[db] = VOFF + (8 * hi + q4) * ROWB + ((db ^ sw) << 6) + (2 * g + (p >> 1)) * 16 + 8 * (p & 1);
    const int ka = koff + hi * 1024 + r32 * 16;
    float m = m_init;
    f32x16 negm;
#pragma unroll
    for (int r = 0; r < 16; ++r) negm[r] = -m;
#pragma unroll
    for (int db = 0; db < NDB; ++db)
#pragma unroll
        for (int r = 0; r < 16; ++r) o[db][r] = 0.f;
    if (wid >= 4) __builtin_amdgcn_s_setprio(1);
    int s_cur = 0, s_n2 = 2 * SLOT;
    for (int t = t0; t < t1; ++t) {
        asm volatile("s_waitcnt vmcnt(%0)" :: "n"(NP) : "memory");
        asm volatile("s_waitcnt lgkmcnt(0)\n\ts_barrier" ::: "memory");
        { const int tn = (t + 2 < t1) ? t + 2 : t1 - 1; ATT_ISSUE(tn, s_n2); }
        const ALDS unsigned char* sb = ring + s_cur;
        f32x16 p0 = negm, p1 = negm;
        bf16x8 kf[8];
#pragma unroll
        for (int d0 = 0; d0 < 4; ++d0) { kf[2 * d0] = *(const ALDS bf16x8*)(sb + ka + d0 * 2048); kf[2 * d0 + 1] = *(const ALDS bf16x8*)(sb + ka + d0 * 2048 + 512); }
        s16x4 vlo[2][NDB], vhh[2][NDB];
#pragma unroll
        for (int db = 0; db < NDB; ++db) { vlo[0][db] = vtr(sb + va[db]); vhh[0][db] = vtr(sb + va[db] + 4 * ROWB); }
        __builtin_amdgcn_sched_barrier(0);
#pragma unroll
        for (int d0 = 0; d0 < 4; ++d0) {
            p0 = __builtin_amdgcn_mfma_f32_32x32x16_bf16(kf[2 * d0], qr[d0], p0, 0, 0, 0);
            p1 = __builtin_amdgcn_mfma_f32_32x32x16_bf16(kf[2 * d0 + 1], qr[d0], p1, 0, 0, 0);
        }
        if (BAND) {
            if (t == tq - 2 || t == tq + 2) {
                const int rel0 = t * 64 + 8 * hi - qpos;
#pragma unroll
                for (int r = 0; r < 16; ++r) { const int rel = rel0 + 16 * (r >> 3) + (r & 7);
                    if (rel < -128 || rel > 128) p0[r] = -INFINITY;
                    if (rel + 32 < -128 || rel + 32 > 128) p1[r] = -INFINITY; }
            }
        }
        float mx = fmaxf(p0[0], p1[0]);
#pragma unroll
        for (int r = 1; r < 16; ++r) mx = fmaxf(fmaxf(mx, p0[r]), p1[r]);
        mx = halfswap_max(mx);
        const bool first = (!BAND) && (t == t0);
        const float dl = first ? mx : ((mx > THR) ? mx : 0.f);
        if (__any(dl != 0.f)) {
            m += dl;
#pragma unroll
            for (int r = 0; r < 16; ++r) { p0[r] -= dl; p1[r] -= dl; negm[r] = -m; }
            const float f = first ? 1.f : __builtin_amdgcn_exp2f(-dl);
            l *= f;
#pragma unroll
            for (int db = 0; db < NDB; ++db)
#pragma unroll
                for (int r = 0; r < 16; ++r) o[db][r] *= f;
        }
        float ssum = 0.f;
        bf16x8 pf;
#define ATT_EXP_SLICE(P_, B_, DST_) do { u32x4 w_; \
        P_[B_ + 0] = __builtin_amdgcn_exp2f(P_[B_ + 0]); P_[B_ + 1] = __builtin_amdgcn_exp2f(P_[B_ + 1]); P_[B_ + 2] = __builtin_amdgcn_exp2f(P_[B_ + 2]); P_[B_ + 3] = __builtin_amdgcn_exp2f(P_[B_ + 3]); \
        P_[B_ + 4] = __builtin_amdgcn_exp2f(P_[B_ + 4]); P_[B_ + 5] = __builtin_amdgcn_exp2f(P_[B_ + 5]); P_[B_ + 6] = __builtin_amdgcn_exp2f(P_[B_ + 6]); P_[B_ + 7] = __builtin_amdgcn_exp2f(P_[B_ + 7]); \
        ssum += ((P_[B_ + 0] + P_[B_ + 1]) + (P_[B_ + 2] + P_[B_ + 3])) + ((P_[B_ + 4] + P_[B_ + 5]) + (P_[B_ + 6] + P_[B_ + 7])); \
        w_.x = cvtpk(P_[B_ + 0], P_[B_ + 1]); w_.y = cvtpk(P_[B_ + 2], P_[B_ + 3]); w_.z = cvtpk(P_[B_ + 4], P_[B_ + 5]); w_.w = cvtpk(P_[B_ + 6], P_[B_ + 7]); DST_ = __builtin_bit_cast(bf16x8, w_); } while (0)
        ATT_EXP_SLICE(p0, 0, pf);
        __builtin_amdgcn_sched_barrier(0);
#pragma unroll
        for (int ks = 0; ks < 4; ++ks) {
            bf16x8 pfn = pf;
            if (ks + 1 < 4) {
#pragma unroll
                for (int db = 0; db < NDB; ++db) { vlo[(ks + 1) & 1][db] = vtr(sb + va[db] + (ks + 1) * (16 * ROWB)); vhh[(ks + 1) & 1][db] = vtr(sb + va[db] + (ks + 1) * (16 * ROWB) + 4 * ROWB); }
            }
#pragma unroll
            for (int db = 0; db < NDB; ++db) {
                const s16x4 lo = vlo[ks & 1][db], hh = vhh[ks & 1][db];
                const bf16x8 vf = (bf16x8){lo[0], lo[1], lo[2], lo[3], hh[0], hh[1], hh[2], hh[3]};
                o[db] = __builtin_amdgcn_mfma_f32_32x32x16_bf16(vf, pf, o[db], 0, 0, 0);
            }
            if (ks == 0) ATT_EXP_SLICE(p0, 8, pfn);
            if (ks == 1) ATT_EXP_SLICE(p1, 0, pfn);
            if (ks == 2) ATT_EXP_SLICE(p1, 8, pfn);
            if (ks + 1 < 4) {
                __builtin_amdgcn_sched_group_barrier(0x100, 2 * NDB, 0);
#pragma unroll
                for (int db = 0; db < NDB; ++db) { __builtin_amdgcn_sched_group_barrier(0x008, 1, 0); __builtin_amdgcn_sched_group_barrier(0x002, 20 / NDB, 0); }
            }
            __builtin_amdgcn_sched_barrier(0);
            pf = pfn;
        }
#undef ATT_EXP_SLICE
        l += ssum;
        s_cur = (s_cur == 2 * SLOT) ? 0 : s_cur + SLOT; s_n2 = (s_n2 == 2 * SLOT) ? 0 : s_n2 + SLOT;
    }
    __builtin_amdgcn_s_setprio(0);
    asm volatile("s_waitcnt vmcnt(0) lgkmcnt(0)\n\ts_barrier" ::: "memory");
#undef ATT_ISSUE
    return l;
}

__device__ __forceinline__ void diff_unit(ALDS unsigned char* ring, const int wid, int lane, const bf16_t* qkv, bf16_t* ymix, const int u, const float lam, const float post, const float* subg) {
    asm volatile("" : "+v"(lane));
    const int bh = u >> 5, qb = u & 31, b = bh >> 2, h = bh & 3, comp = wid >> 2, wq = wid & 3, r32 = lane & 31, hi = lane >> 5;
    const size_t rowbase = (size_t)b * 4096;
    const int q0 = qb * 128 + wq * 32;
    const bf16_t* Qw = qkv + (rowbase + q0) * PITCH + h * 128 + comp * 64;
    const bf16_t* ksrc = qkv + (rowbase + pi23(lane)) * PITCH + 512 + h * 128 + wid * 8;
    const bf16_t* vsrc = qkv + (rowbase + 8 * wid + (lane >> 4)) * PITCH + 1024 + h * 128 + (((lane & 15) ^ ((lane >> 4) << 2)) * 8);
    f32x16 o[4];
    float l = attn_core<128, false>(ring, wid, lane, Qw, ksrc, vsrc, comp * 8192, 0, 64, 0, 0, 0.f, 0.f, o);
    l = halfswap_sum(l);
    const float inv = 1.0f / l;
    ALDS f32x4* X = (ALDS f32x4*)ring + (size_t)wq * (16 * 64);
    if (comp == 1) {
#pragma unroll
        for (int db = 0; db < 4; ++db)
#pragma unroll
            for (int rq = 0; rq < 4; ++rq) X[(db * 4 + rq) * 64 + lane] = (f32x4){o[db][4 * rq] * inv, o[db][4 * rq + 1] * inv, o[db][4 * rq + 2] * inv, o[db][4 * rq + 3] * inv};
    }
    asm volatile("s_waitcnt lgkmcnt(0)\n\ts_barrier" ::: "memory");
    if (comp == 0) {
        float ss = 0.f;
#pragma unroll
        for (int db = 0; db < 4; ++db)
#pragma unroll
            for (int rq = 0; rq < 4; ++rq) { const f32x4 o2 = X[(db * 4 + rq) * 64 + lane];
#pragma unroll
                for (int e = 0; e < 4; ++e) { const float d = o[db][4 * rq + e] * inv - lam * o2[e]; o[db][4 * rq + e] = d; ss += d * d; } }
        ss = halfswap_sum(ss);
        const float rs = rsqrtf(ss * (1.0f / 128.0f) + 1e-5f) * post;
        bf16_t* orow = ymix + (rowbase + q0 + r32) * 1024 + h * 128 + 4 * hi;
#pragma unroll
        for (int db = 0; db < 4; ++db)
#pragma unroll
            for (int rq = 0; rq < 4; ++rq) { const f32x4 gv = *(const f32x4*)(subg + 32 * db + 8 * rq + 4 * hi);
                u32x2 w; w.x = cvtpk(o[db][4 * rq] * rs * gv[0], o[db][4 * rq + 1] * rs * gv[1]); w.y = cvtpk(o[db][4 * rq + 2] * rs * gv[2], o[db][4 * rq + 3] * rs * gv[3]);
                *(u32x2*)(orow + 32 * db + 8 * rq) = w; }
    }
    asm volatile("s_waitcnt lgkmcnt(0)\n\ts_barrier" ::: "memory");
}

__device__ __forceinline__ void swa_unit(ALDS unsigned char* ring, const int wid, int lane, const bf16_t* qkv, bf16_t* ymix, const int u, const float* sink) {
    asm volatile("" : "+v"(lane));
    const int bkv = u >> 6, qblk = u & 63, b = bkv >> 1, kvh = bkv & 1, head = kvh * 4 + (wid >> 1), r32 = lane & 31, hi = lane >> 5;
    const size_t rowbase = (size_t)b * 4096;
    const int q0 = qblk * 64 + (wid & 1) * 32;
    const bf16_t* Qw = qkv + (rowbase + q0) * PITCH + 1536 + head * 64;
    const bf16_t* ksrc = qkv + (rowbase + pi23(lane)) * PITCH + 2048 + kvh * 64 + wid * 8;
    const bf16_t* vsrc = qkv + (rowbase + 8 * wid + (lane >> 3)) * PITCH + 2176 + kvh * 64 + (((lane & 7) ^ (((lane >> 4) & 1) << 2)) * 8);
    const int t0 = (qblk - 2 > 0) ? qblk - 2 : 0, t1 = ((qblk + 2 < 63) ? qblk + 2 : 63) + 1;
    f32x16 o[2];
    float l = attn_core<64, true>(ring, wid, lane, Qw, ksrc, vsrc, 0, t0, t1, qblk, q0 + r32, sink[head] * 1.4426950408889634f, (hi == 0) ? 1.0f : 0.0f, o);
    l = halfswap_sum(l);
    const float inv = 1.0f / l;
    bf16_t* orow = ymix + (rowbase + q0 + r32) * 1024 + 512 + head * 64 + 4 * hi;
#pragma unroll
    for (int db = 0; db < 2; ++db)
#pragma unroll
        for (int rq = 0; rq < 4; ++rq) { u32x2 w; w.x = cvtpk(o[db][4 * rq] * inv, o[db][4 * rq + 1] * inv); w.y = cvtpk(o[db][4 * rq + 2] * inv, o[db][4 * rq + 3] * inv);
            *(u32x2*)(orow + 32 * db + 8 * rq) = w; }
}
}

#ifndef REP_ATT
#define REP_ATT 1
#endif
#ifndef REP_G1
#define REP_G1 1
#endif
#ifndef REP_SYNC
#define REP_SYNC 1
#endif
#ifndef REP_LN
#define REP_LN 1
#endif
#ifndef REP_PRO
#define REP_PRO 1
#endif
constexpr int NWAVES = 8;
constexpr int M = 65536, D = 1024, FF = 2816, NIN = 2304, SEQ = 4096, DEPTH = 4;
constexpr size_t MiB = 1u << 20;
constexpr size_t W1_OFF = 0, W1_B = (size_t)2 * FF * D * 2, W2_OFF = W1_OFF + W1_B, W2_B = (size_t)D * FF * 2, WIN_OFF = W2_OFF + W2_B, WIN_B = (size_t)NIN * D * 2,
                 WO_OFF = WIN_OFF + WIN_B, WO_B = (size_t)D * D * 2, W3_OFF = WO_OFF + WO_B, W4_OFF = W3_OFF + W1_B, WL_STRIDE = W4_OFF + W2_B;
constexpr size_t WS_W = 0, WS_ROPE = 160 * MiB, WS_XB = 176 * MiB, WS_H = 304 * MiB, WS_YM = 656 * MiB, WS_CSBW = 784 * MiB, WS_ST = 785 * MiB, WS_CTL = 786 * MiB, WS_END = 787 * MiB;
constexpr size_t CTL_ZERO_BYTES = 16384;
constexpr int CSBW_N = 2 * FF;
static_assert((size_t)DEPTH * 3 * 2 * CSBW_N * 4 <= MiB && (size_t)2 * M * 2 * 4 <= MiB, "aux map");
static_assert(WL_STRIDE * DEPTH <= WS_ROPE && WS_ROPE + (size_t)M * 64 * 4 <= WS_XB && WS_XB + (size_t)M * D * 2 <= WS_H && WS_H + (size_t)M * FF * 2 <= WS_YM && WS_YM + (size_t)M * D * 2 <= WS_END, "d_ws map");
constexpr int LDS_BYTES = 147456;
constexpr float ALPHA = 1.681792830507429f;
constexpr float QSCALE = 0.125f * 1.4426950408889634f;

typedef unsigned short bf16;
typedef float f32x4 __attribute__((ext_vector_type(4)));
typedef unsigned v4u __attribute__((ext_vector_type(4)));
typedef unsigned v2u __attribute__((ext_vector_type(2)));
using pg8::cvtpk;

struct Args { const float* in[13]; float* out; unsigned char* ws; float inv[32]; float lam_init[4]; };

__device__ __forceinline__ float wave_sum(float v) {
#pragma unroll
    for (int o = 1; o < 64; o <<= 1) v += __shfl_xor(v, o);
    return v;
}
__device__ __forceinline__ int src_col(int type, int n) {
    if (type == 1) { const int pn = n >> 8, w = n & 255; return (w < 128) ? (128 * pn + w) : (FF + 128 * pn + (w - 128)); }
    if (type == 2) { const bool rp = (n < 1024) || (n >= 1536 && n < 2176); return rp ? ((n & ~63) + ((n & 63) >> 1) + 32 * (n & 1)) : n; }
    return n;
}
template <bool F16> __device__ __forceinline__ void transpose_item(const float* W, int K, int N, int type, const float* gk, bf16* WT, ALDS float* scr, int item, int lane) {
    const int nblk = N / 32, kb = item / nblk, nb = item % nblk, k0 = 64 * kb, n0 = 32 * nb;
    const int sc = src_col(type, n0 + (lane & 31));
#pragma unroll 8
    for (int i = 0; i < 32; ++i) { const int kk = 2 * i + (lane >> 5); scr[kk * 33 + (lane & 31)] = W[(size_t)(k0 + kk) * N + sc] * (gk ? gk[k0 + kk] : 1.0f); }
    asm volatile("s_waitcnt lgkmcnt(0)" ::: "memory");
    const int c = lane & 7;
#pragma unroll
    for (int j = 0; j < 4; ++j) { const int n = (lane >> 3) + 8 * j; const ALDS float* s = scr + (8 * c) * 33 + n;
        v4u o; if (F16) { o.x = pg8::cvtpk_h(s[0 * 33], s[1 * 33]); o.y = pg8::cvtpk_h(s[2 * 33], s[3 * 33]); o.z = pg8::cvtpk_h(s[4 * 33], s[5 * 33]); o.w = pg8::cvtpk_h(s[6 * 33], s[7 * 33]); }
        else { o.x = cvtpk(s[0 * 33], s[1 * 33]); o.y = cvtpk(s[2 * 33], s[3 * 33]); o.z = cvtpk(s[4 * 33], s[5 * 33]); o.w = cvtpk(s[6 * 33], s[7 * 33]); }
        *(v4u*)(WT + (size_t)(n0 + n) * K + k0 + 8 * c) = o; }
    asm volatile("s_waitcnt lgkmcnt(0)" ::: "memory");
}
__device__ __forceinline__ void sincos_f32angle(float ang, float& c, float& s) {
    const double a = (double)ang, k = __builtin_rint(a * 0.63661977236758134308);
    double r = __builtin_fma(-k, 1.57079632679489655800e+00, a); r = __builtin_fma(-k, 6.12323399573676603587e-17, r);
    const double r2 = r * r;
    double sp = -1.0 / 1307674368000.0; sp = sp * r2 + 1.0 / 6227020800.0; sp = sp * r2 - 1.0 / 39916800.0; sp = sp * r2 + 1.0 / 362880.0; sp = sp * r2 - 1.0 / 5040.0; sp = sp * r2 + 1.0 / 120.0; sp = sp * r2 - 1.0 / 6.0;
    const double sn = r + r * r2 * sp;
    double cp = 1.0 / 20922789888000.0; cp = cp * r2 - 1.0 / 87178291200.0; cp = cp * r2 + 1.0 / 479001600.0; cp = cp * r2 - 1.0 / 3628800.0; cp = cp * r2 + 1.0 / 40320.0; cp = cp * r2 - 1.0 / 720.0; cp = cp * r2 + 1.0 / 24.0; cp = cp * r2 - 0.5;
    const double cn = 1.0 + r2 * cp;
    const int q = ((int)k) & 3;
    const double cc = (q == 0) ? cn : (q == 1) ? -sn : (q == 2) ? -cn : sn;
    const double ss = (q == 0) ? sn : (q == 1) ? cn : (q == 2) ? -sn : -cn;
    c = (float)cc; s = (float)ss;
}
__device__ __forceinline__ void ln_row(const float* xrow, const float* g, const float* bta, float* orow, bf16* brow, int lane) {
    asm volatile("" : "+v"(lane));
    const f32x4* xr = (const f32x4*)xrow + lane;
    f32x4 v[4]; float s = 0.f;
#pragma unroll
    for (int j = 0; j < 4; ++j) { v[j] = xr[64 * j]; s += (v[j][0] + v[j][1]) + (v[j][2] + v[j][3]); }
    const float mean = wave_sum(s) * (1.f / D); float s2 = 0.f;
#pragma unroll
    for (int j = 0; j < 4; ++j) { v[j] = v[j] - mean; s2 += (v[j][0] * v[j][0] + v[j][1] * v[j][1]) + (v[j][2] * v[j][2] + v[j][3] * v[j][3]); }
    const float rstd = 1.0f / sqrtf(wave_sum(s2) * (1.f / D) + 1e-5f);
#pragma unroll
    for (int j = 0; j < 4; ++j) { const f32x4 gg = *((const f32x4*)g + lane + 64 * j), bb = *((const f32x4*)bta + lane + 64 * j);
        const f32x4 y = v[j] * rstd * gg + bb;
        *((f32x4*)orow + lane + 64 * j) = y;
        v2u w; w.x = cvtpk(y[0], y[1]); w.y = cvtpk(y[2], y[3]); *((v2u*)brow + lane + 64 * j) = w; }
}

#define XB_TMO      128
#define XB_XCNT(j)  (256  + 64 * (j))
#define XB_XSUB(j)  (1280 + 64 * (j))
#define XB_XGEN(j)  (2304 + 64 * (j))
#define XB_TOP      3328
#define XB_TOPGEN   3392
#define XCD_BAR_WORDS 3456
#define XB_SPIN_CAP (1u << 18)

__device__ __forceinline__ unsigned xb_ld(unsigned* p)              { return __hip_atomic_load(p, __ATOMIC_RELAXED, __HIP_MEMORY_SCOPE_AGENT); }
__device__ __forceinline__ unsigned xb_add(unsigned* p, unsigned v) { return __hip_atomic_fetch_add(p, v, __ATOMIC_RELAXED, __HIP_MEMORY_SCOPE_AGENT); }
__device__ __forceinline__ unsigned xb_xcc_id() { return (unsigned)__builtin_amdgcn_s_getreg((3 << 11) | 20) & 0xFu; }
#define XB_SPIN(cond, bar) do { unsigned _sp = 0; while (cond) { __builtin_amdgcn_s_sleep(1); \
    if ((++_sp & 255u) == 0u) { if (xb_ld(&(bar)[XB_TMO])) break; if (_sp > XB_SPIN_CAP) { atomicAdd(&(bar)[XB_TMO], 1u); break; } } } } while (0)

struct XcdBarrier {
    unsigned* bar; unsigned x;
    volatile ALDS unsigned* st;
};

__device__ __forceinline__ XcdBarrier xcd_barrier_post(unsigned* bar, volatile ALDS unsigned* st) {
    XcdBarrier b; b.bar = bar; b.x = xb_xcc_id(); b.st = st;
    if (threadIdx.x == 0) (void)xb_add(&bar[XB_XCNT(b.x)], 1u);
    return b;
}
__device__ __forceinline__ void xcd_barrier_complete(unsigned* bar, unsigned x, unsigned& nloc, unsigned& nx) {
    const unsigned G = gridDim.x * gridDim.y * gridDim.z;
    unsigned sum, cnt, mine, sp = 0u;
    for (;;) {
        sum = 0u; cnt = 0u; mine = 0u;
#pragma unroll
        for (unsigned j = 0; j < 16; ++j) { const unsigned c = xb_ld(&bar[XB_XCNT(j)]); sum += c; cnt += (c > 0u) ? 1u : 0u; mine = (j == x) ? c : mine; }
        if (sum == G) break;
        __builtin_amdgcn_s_sleep(1);
        if ((++sp & 255u) == 0u) { if (xb_ld(&bar[XB_TMO])) break; if (sp > XB_SPIN_CAP) { atomicAdd(&bar[XB_TMO], 1u); break; } }
    }
    nloc = mine > 0u ? mine : 1u; nx = cnt > 0u ? cnt : 1u;
}

__device__ __forceinline__ void xcd_barrier(const XcdBarrier& b) {
    asm volatile("s_waitcnt vmcnt(0)" ::: "memory");
    __syncthreads();
    if (threadIdx.x == 0) {
        unsigned* bar = b.bar;
        __builtin_amdgcn_s_waitcnt(0);
        unsigned nloc = b.st[0], nx = b.st[1];
        if (nloc == 0u) { xcd_barrier_complete(bar, b.x, nloc, nx); b.st[0] = nloc; b.st[1] = nx; }
        const unsigned old = xb_add(&bar[XB_XSUB(b.x)], 1u);
        const unsigned gen = old / nloc;
        if (old + 1u == (gen + 1u) * nloc) {
            __builtin_amdgcn_fence(__ATOMIC_RELEASE, "agent");
            asm volatile("s_waitcnt vmcnt(0)" ::: "memory");
            const unsigned og = xb_add(&bar[XB_TOP], 1u);
            const unsigned tg = og / nx;
            if (og + 1u == (tg + 1u) * nx) xb_add(&bar[XB_TOPGEN], 1u);
            else XB_SPIN(xb_ld(&bar[XB_TOPGEN]) == tg, bar);
            __builtin_amdgcn_fence(__ATOMIC_ACQUIRE, "agent");
            xb_add(&bar[XB_XGEN(b.x)], 1u);
            asm volatile("s_waitcnt vmcnt(0)" ::: "memory");
        } else {
            XB_SPIN(xb_ld(&bar[XB_XGEN(b.x)]) == gen, bar);
            __builtin_amdgcn_fence(__ATOMIC_ACQUIRE, "agent");
            asm volatile("s_waitcnt vmcnt(0)" ::: "memory");
        }
    }
    __syncthreads();
}

__device__ __forceinline__ void ln_row_h(const bf16* hrow, const float* g, const float* bta, float* orow, int lane) {
    asm volatile("" : "+v"(lane));
    typedef _Float16 h4 __attribute__((ext_vector_type(4)));
    f32x4 v[4]; float s = 0.f;
#pragma unroll
    for (int j = 0; j < 4; ++j) { const h4 h = *((const h4*)hrow + lane + 64 * j); v[j] = (f32x4){(float)h[0], (float)h[1], (float)h[2], (float)h[3]}; s += (v[j][0] + v[j][1]) + (v[j][2] + v[j][3]); }
    const float mean = wave_sum(s) * (1.f / D); float s2 = 0.f;
#pragma unroll
    for (int j = 0; j < 4; ++j) { v[j] = v[j] - mean; s2 += (v[j][0] * v[j][0] + v[j][1] * v[j][1]) + (v[j][2] * v[j][2] + v[j][3] * v[j][3]); }
    const float rstd = 1.0f / sqrtf(wave_sum(s2) * (1.f / D) + 1e-5f);
#pragma unroll
    for (int j = 0; j < 4; ++j) { const f32x4 gg = *((const f32x4*)g + lane + 64 * j), bb = *((const f32x4*)bta + lane + 64 * j);
        *((f32x4*)orow + lane + 64 * j) = v[j] * rstd * gg + bb; }
}

__global__ void __launch_bounds__(NWAVES * 64, 2) fwd_megakernel(Args args) {
    extern __shared__ __attribute__((aligned(16))) unsigned char lds_raw[];
    cg::grid_group grid = cg::this_grid();
#define GSYNC() xcd_barrier(bar)
    ALDS unsigned char* lds = (ALDS unsigned char*)lds_raw;
    const int tid = threadIdx.x, lane = tid & 63, wave = __builtin_amdgcn_readfirstlane(tid >> 6);
    const int G = gridDim.x, bx = blockIdx.x, vcu = (G % 8 == 0) ? (bx % 8) * (G / 8) + bx / 8 : bx;
    unsigned char* ws = args.ws;
    const float* x_in = args.in[0]; const int* positions = (const int*)args.in[1];
    float* out = args.out;
    bf16* XB = (bf16*)(ws + WS_XB); bf16* HB = (bf16*)(ws + WS_H); bf16* QKV = (bf16*)(ws + WS_H); bf16* YM = (bf16*)(ws + WS_YM);
    float* ROPE = (float*)(ws + WS_ROPE); float* CSBW = (float*)(ws + WS_CSBW); float* ST = (float*)(ws + WS_ST);
    const int gw = vcu * NWAVES + wave, NGW = G * NWAVES;
    volatile ALDS unsigned* bst = (volatile ALDS unsigned*)(lds + 131072 + 8192);
    if (tid < 2) bst[tid] = 0u;
    __syncthreads();
    XcdBarrier bar = xcd_barrier_post((unsigned*)(ws + WS_CTL), bst);

    for (int rep = 0; rep < REP_PRO; ++rep) {
        ALDS float* scr = (ALDS float*)(lds + wave * 16384);
        constexpr int I1 = (D / 64) * (2 * FF / 32), I2 = (FF / 64) * (D / 32), I3 = (D / 64) * (NIN / 32), I4 = (D / 64) * (D / 32), IL = 2 * I1 + 2 * I2 + I3 + I4;
        for (int it = gw; it < IL * DEPTH; it += NGW) {
            const int l = it / IL; int r = it % IL;
            unsigned char* wl = ws + WS_W + (size_t)l * WL_STRIDE;
            if (r < I1) { transpose_item<true>(args.in[7] + (size_t)l * D * 2 * FF, D, 2 * FF, 1, (l > 0) ? args.in[11] + (size_t)((l - 1) * 3 + 2) * D : nullptr, (bf16*)(wl + W1_OFF), scr, r, lane); continue; } r -= I1;
            if (r < I2) { transpose_item<false>(args.in[8] + (size_t)l * FF * D, FF, D, 0, nullptr, (bf16*)(wl + W2_OFF), scr, r, lane); continue; } r -= I2;
            if (r < I3) { transpose_item<true>(args.in[2] + (size_t)l * D * NIN, D, NIN, 2, args.in[11] + (size_t)(l * 3) * D, (bf16*)(wl + WIN_OFF), scr, r, lane); continue; } r -= I3;
            if (r < I4) { transpose_item<false>(args.in[3] + (size_t)l * D * D, D, D, 0, nullptr, (bf16*)(wl + WO_OFF), scr, r, lane); continue; } r -= I4;
            if (r < I1) { transpose_item<true>(args.in[9] + (size_t)l * D * 2 * FF, D, 2 * FF, 1, args.in[11] + (size_t)(l * 3 + 1) * D, (bf16*)(wl + W3_OFF), scr, r, lane); continue; } r -= I1;
            transpose_item<false>(args.in[10] + (size_t)l * FF * D, FF, D, 0, nullptr, (bf16*)(wl + W4_OFF), scr, r, lane);
        }
        const size_t gt = (size_t)vcu * (NWAVES * 64) + tid, GT = (size_t)G * NWAVES * 64;
        for (size_t i = gt; i < (size_t)M * D / 4; i += GT) { const f32x4 v = *((const f32x4*)x_in + i); v2u w; w.x = pg8::cvtpk_h(v[0], v[1]); w.y = pg8::cvtpk_h(v[2], v[3]); *((v2u*)XB + i) = w; }
        for (size_t i = gt; i < (size_t)M * 32; i += GT) { const int row = (int)(i >> 5), k = (int)(i & 31); float c, s; sincos_f32angle((float)positions[row] * args.inv[k], c, s);
            ROPE[(size_t)row * 64 + k] = c; ROPE[(size_t)row * 64 + 32 + k] = s; }
        for (size_t i = gt; i < (size_t)M * 2; i += GT) ST[i] = 0.f;
        {
            ALDS float* red = (ALDS float*)(lds + 131072);
            constexpr int CG0 = 2 * FF / 64, CG1 = NIN / 64, CGL = 2 * CG0 + CG1;
            for (int cgi = vcu; cgi < CGL * DEPTH; cgi += G) {
                const int l = cgi / CGL; int r = cgi % CGL; int j = 0;
                if (r >= CG0) { r -= CG0; j = 1; if (r >= CG1) { r -= CG1; j = 2; } }
                const int lnidx = (j == 0) ? (l - 1) * 3 + 2 : (j == 1) ? l * 3 : l * 3 + 1;
                if (lnidx < 0) continue;
                const int N = (j == 1) ? NIN : 2 * FF, type = (j == 1) ? 2 : 1;
                const float* W = (j == 0) ? args.in[7] + (size_t)l * D * 2 * FF : (j == 1) ? args.in[2] + (size_t)l * D * NIN : args.in[9] + (size_t)l * D * 2 * FF;
                const float* gk = args.in[11] + (size_t)lnidx * D; const float* bk = args.in[12] + (size_t)lnidx * D;
                const int n = r * 64 + lane, sc = src_col(type, n);
                float c1 = 0.f, b1 = 0.f;
#pragma unroll 16
                for (int k = wave * 128; k < wave * 128 + 128; ++k) { const float w = W[(size_t)k * N + sc]; const float gw = gk[k] * w;
                    c1 += (float)(_Float16)gw; b1 += bk[k] * w; }
                red[(wave * 64 + lane) * 2] = c1; red[(wave * 64 + lane) * 2 + 1] = b1;
                __syncthreads();
                if (wave == 0) { float cc = 0.f, bb = 0.f;
#pragma unroll
                    for (int w8 = 0; w8 < 8; ++w8) { cc += red[(w8 * 64 + lane) * 2]; bb += red[(w8 * 64 + lane) * 2 + 1]; }
                    float* dst = CSBW + (size_t)((l * 3 + j) * 2) * CSBW_N; dst[n] = cc; dst[CSBW_N + n] = bb; }
                __syncthreads();
            }
        }
    }
    grid.sync();

#define ZERO_ST(buf_) do { int t_ = tid; asm volatile("" : "+v"(t_)); float* z_ = ST + (size_t)(buf_) * M * 2; for (int i_ = vcu * (NWAVES * 64) + t_; i_ < M * 2; i_ += G * NWAVES * 64) { z_[i_] = 0.f; asm volatile("" : "+v"(i_)); } } while (0)
    for (int l = 0; l < DEPTH; ++l) {
        unsigned char* wl = ws + WS_W + (size_t)l * WL_STRIDE;
        const float* lng = args.in[11]; const float* lnb = args.in[12];
        { const int k = 3 * l; ZERO_ST(k & 1);
          const float* cb = CSBW + (size_t)((l * 3 + 0) * 2) * CSBW_N;
          pg8::Gemm g{XB, (const bf16*)(wl + W1_OFF), M, 2 * FF, D}; pg8::StaticOrder S; S.init(M, 2 * FF, G, bx);
          pg8::EpiSwiGLU E{HB, FF, pg8::RowLN{(k == 0) ? nullptr : ST + (size_t)((k - 1) & 1) * M * 2, cb, cb + CSBW_N}};
          for (int rep = 0; rep < REP_G1; ++rep) pg8::gemm_phase<pg8::EpiSwiGLU, pg8::StaticOrder, true, true>(lds, g, S, E); }
        GSYNC();
        { const int k = 3 * l;
          pg8::Gemm g{HB, (const bf16*)(wl + W2_OFF), M, D, FF}; pg8::StaticOrder S; S.init(M, D, G, bx);
          pg8::EpiRes E{x_in, XB, (k == 0) ? nullptr : ST + (size_t)((k - 1) & 1) * M * 2, lng + (size_t)(k > 0 ? k - 1 : 0) * D, lnb + (size_t)(k > 0 ? k - 1 : 0) * D, ST + (size_t)(k & 1) * M * 2, ALPHA, 0.5f};
          pg8::gemm_phase<pg8::EpiRes, pg8::StaticOrder, true, true>(lds, g, S, E); }
        GSYNC();
        { const int k = 3 * l + 1; ZERO_ST(k & 1);
          const float* cb = CSBW + (size_t)((l * 3 + 1) * 2) * CSBW_N;
          pg8::Gemm g{XB, (const bf16*)(wl + WIN_OFF), M, NIN, D}; pg8::StaticOrder S; S.init(M, NIN, G, bx);
          pg8::EpiQKV E{QKV, ROPE, QSCALE, pg8::RowLN{ST + (size_t)((k - 1) & 1) * M * 2, cb, cb + CSBW_N}};
          pg8::gemm_phase<pg8::EpiQKV, pg8::StaticOrder, true, true>(lds, g, S, E); }
        GSYNC();
        {
            const float* lv = args.in[4] + (size_t)l * 256;
            int la = lane; asm volatile("" : "+v"(la));
            const float a1 = wave_sum(lv[la] * lv[64 + la]), a2 = wave_sum(lv[128 + la] * lv[192 + la]);
            const float lam_init = args.lam_init[l], lam = expf(a1) - expf(a2) + lam_init;
            const float* subg = args.in[5] + (size_t)l * 128; const float* sink = args.in[6] + (size_t)l * 8;
            for (int rep = 0; rep < REP_ATT; ++rep) {
            for (int u = vcu; u < 2048; u += G) att::diff_unit(lds, wave, lane, QKV, YM, u, lam, 1.0f - lam_init, subg);
            for (int u = vcu; u < 2048; u += G) att::swa_unit(lds, wave, lane, QKV, YM, u, sink);
            }
        }
        GSYNC();
        { const int k = 3 * l + 1;
          pg8::Gemm g{YM, (const bf16*)(wl + WO_OFF), M, D, D}; pg8::StaticOrder S; S.init(M, D, G, bx);
          pg8::EpiRes E{x_in, XB, ST + (size_t)((k - 1) & 1) * M * 2, lng + (size_t)(k - 1) * D, lnb + (size_t)(k - 1) * D, ST + (size_t)(k & 1) * M * 2, ALPHA, 1.0f};
          pg8::gemm_phase<pg8::EpiRes, pg8::StaticOrder, true, true>(lds, g, S, E); }
        GSYNC();
        { const int k = 3 * l + 2; ZERO_ST(k & 1);
          const float* cb = CSBW + (size_t)((l * 3 + 2) * 2) * CSBW_N;
          pg8::Gemm g{XB, (const bf16*)(wl + W3_OFF), M, 2 * FF, D}; pg8::StaticOrder S; S.init(M, 2 * FF, G, bx);
          pg8::EpiSwiGLU E{HB, FF, pg8::RowLN{ST + (size_t)((k - 1) & 1) * M * 2, cb, cb + CSBW_N}};
          for (int rep = 0; rep < REP_G1; ++rep) pg8::gemm_phase<pg8::EpiSwiGLU, pg8::StaticOrder, true, true>(lds, g, S, E); }
        GSYNC();
        { const int k = 3 * l + 2;
          pg8::Gemm g{HB, (const bf16*)(wl + W4_OFF), M, D, FF}; pg8::StaticOrder S; S.init(M, D, G, bx);
          pg8::EpiRes E{x_in, XB, ST + (size_t)((k - 1) & 1) * M * 2, lng + (size_t)(k - 1) * D, lnb + (size_t)(k - 1) * D, ST + (size_t)(k & 1) * M * 2, ALPHA, 0.5f};
          pg8::gemm_phase<pg8::EpiRes, pg8::StaticOrder, true, true>(lds, g, S, E); }
        GSYNC();
    }
    for (int m = gw; m < M; m += NGW) ln_row_h(XB + (size_t)m * D, args.in[11] + (size_t)11 * D, args.in[12] + (size_t)11 * D, out + (size_t)m * D, lane);
}

extern "C" void kernel_launch(void* const* d_in, const int* in_sizes, int n_in, void* d_out, int out_size, void* d_ws, size_t ws_size, hipStream_t stream) {
    static int grid = 0;
    if (grid == 0) {
        if (n_in != 13 || in_sizes[0] != M * D || out_size != M * D || ws_size < WS_END) { fprintf(stderr, "kernel_launch: unexpected shapes (n_in %d, in0 %d, out %d, ws %zu); nothing launched\n", n_in, n_in > 0 ? in_sizes[0] : -1, out_size, ws_size); grid = -1; return; }
        int dev = 0, cus = 0, per_cu = 0;
        if (hipGetDevice(&dev) != hipSuccess || hipDeviceGetAttribute(&cus, hipDeviceAttributeMultiprocessorCount, dev) != hipSuccess) { grid = -1; return; }
        if (hipFuncSetAttribute((const void*)fwd_megakernel, hipFuncAttributeMaxDynamicSharedMemorySize, LDS_BYTES) != hipSuccess) { fprintf(stderr, "kernel_launch: hipFuncSetAttribute failed\n"); grid = -1; return; }
        if (hipOccupancyMaxActiveBlocksPerMultiprocessor(&per_cu, (const void*)fwd_megakernel, NWAVES * 64, LDS_BYTES) != hipSuccess || per_cu < 1) { fprintf(stderr, "kernel_launch: occupancy query gives %d\n", per_cu); per_cu = 1; }
        (void)hipGetLastError();
        grid = cus * 1;
    }
    if (grid < 0) return;
    if (hipMemsetAsync((char*)d_ws + WS_CTL, 0, CTL_ZERO_BYTES, stream) != hipSuccess) { fprintf(stderr, "kernel_launch: memset of the barrier words failed\n"); return; }
    Args a{};
    for (int i = 0; i < 13; ++i) a.in[i] = (const float*)d_in[i];
    a.out = (float*)d_out; a.ws = (unsigned char*)d_ws;
    for (int i = 0; i < 32; ++i) a.inv[i] = (float)pow(10000.0, -(double)(2 * i) / 64.0);
    for (int l = 0; l < 4; ++l) a.lam_init[l] = (float)(0.8 - 0.6 * exp(-0.3 * (double)l));
    void* kargs[] = {&a};
    const hipError_t e = hipLaunchCooperativeKernel((const void*)fwd_megakernel, dim3(grid), dim3(NWAVES * 64), kargs, LDS_BYTES, stream);
    if (e != hipSuccess) fprintf(stderr, "kernel_launch: cooperative launch failed: %s (grid %d)\n", hipGetErrorString(e), grid);
}
```

```cpp
#include <hip/hip_runtime.h>
#include <hip/hip_cooperative_groups.h>
#include <cstdio>
#include <cstdint>
#include <cmath>
namespace cg = cooperative_groups;
namespace pg8 {
#define PG8_LAS __attribute__((address_space(3)))
typedef unsigned short bf16_t;
typedef short bf16x8 __attribute__((ext_vector_type(8)));
typedef float f32x4 __attribute__((ext_vector_type(4)));
typedef unsigned u32x4 __attribute__((ext_vector_type(4)));
constexpr int BM = 256, BK = 64, HALF = 128, HTB = HALF * BK * 2  , STAGE_BYTES = 8 * HTB, NXCD = 8, WGM = 8;

__host__ __device__ __forceinline__ int lds_byte(int r, int c) { const int st = (r >> 4) * 2 + (c >> 5), rr = r & 15, cc = c & 31, ob = rr * 64 + cc * 2; return st * 1024 + (ob ^ (((ob >> 9) & 1) << 5)); }
__host__ __device__ __forceinline__ void stage_rc(int b, int& R, int& C) { const int st = b / 1024, sb = b % 1024, swz = sb ^ (((sb >> 9) & 1) << 5); R = (st >> 1) * 16 + swz / 64; C = (st & 1) * 32 + (swz % 64) / 2; }
__host__ __device__ __forceinline__ int perm32(int rho) { const int n = rho >> 4, i = rho & 15; return 8 * (i >> 2) + 4 * n + (i & 3); }

struct Unit { int pm, pn; };
struct Gemm { const bf16_t* A; const bf16_t* Bt; int M, N, K; };

struct StaticOrder {
    int nM, nN, nwg, G, c;
    __host__ __device__ void init(int M, int N, int G_, int c_) { nM = M / BM; nN = N / BM; nwg = nM * nN; G = G_; c = c_; }
    __host__ __device__ bool next(int i, Unit& u) const {
        const long L = (long)i * G + c; if (L >= nwg) return false;
        int wgid = (int)L; { const int q = nwg / NXCD, r = nwg % NXCD, xcd = wgid % NXCD, off = wgid / NXCD; wgid = (xcd < r ? xcd * (q + 1) : r * (q + 1) + (xcd - r) * q) + off; }
        const int nig = WGM * nN, gid = wgid / nig, fm = gid * WGM, gsz = (nM - fm) < WGM ? (nM - fm) : WGM;
        u.pm = fm + ((wgid % nig) % gsz); u.pn = (wgid % nig) / gsz; return true;
    }
    __device__ __forceinline__ void a_ready(const Unit&) const {}
    __device__ __forceinline__ void done(const Unit&) const {}
};

typedef float f32x2_t __attribute__((ext_vector_type(2))); typedef __bf16 bf16x2_t __attribute__((ext_vector_type(2)));
__device__ __forceinline__ unsigned cvtpk(float lo, float hi) { f32x2_t v = {lo, hi}; bf16x2_t b = __builtin_convertvector(v, bf16x2_t); return __builtin_bit_cast(unsigned, b); }
typedef _Float16 f16x8 __attribute__((ext_vector_type(8))); typedef _Float16 f16x2_t __attribute__((ext_vector_type(2)));
template <bool F16> __device__ __forceinline__ f32x4 mma16(bf16x8 a, bf16x8 b, f32x4 c) {
    if constexpr (F16) return __builtin_amdgcn_mfma_f32_16x16x32_f16(__builtin_bit_cast(f16x8, a), __builtin_bit_cast(f16x8, b), c, 0, 0, 0);
    else return __builtin_amdgcn_mfma_f32_16x16x32_bf16(a, b, c, 0, 0, 0);
}
__device__ __forceinline__ unsigned cvtpk_h(float lo, float hi) { f16x2_t v = {(_Float16)lo, (_Float16)hi}; return __builtin_bit_cast(unsigned, v); }
__device__ __forceinline__ float silu_f(float g) { return g * __builtin_amdgcn_rcpf(1.0f + __builtin_amdgcn_exp2f(-1.4426950408889634f * g)); }

typedef float f32x2v __attribute__((ext_vector_type(2)));
struct RowLN {
    const float* st; const float* cs; const float* bw;
    __device__ __forceinline__ void row(int r, float& a, float& c) const {
        if (st) { const f32x2v s = *(const f32x2v*)(st + 2 * (size_t)r); const float mu = s.x * (1.0f / 1024.0f), var = s.y * (1.0f / 1024.0f) - mu * mu; a = rsqrtf(var + 1e-5f); c = -a * mu; }
        else { a = 1.0f; c = 0.0f; }
    }
};
struct EpiSwiGLU {
    static constexpr bool PERM = true, AFTER_DRAIN = false, F16 = true;
    bf16_t* H; int ldh; RowLN ln;
    __device__ __forceinline__ void operator()(const f32x4 (&acc)[2][2][4][2], const Unit& u, int wr, int wc, int fr, int fq) const {
        const int row0 = u.pm * BM + wr * 64 + fr, col0 = u.pn * HALF + wc * 32 + 8 * fq, wrow0 = u.pn * BM + wc * 32 + 8 * fq;
        f32x4 cs[2][2], bw[2][2]; float ra[8], rc[8];
#pragma unroll
        for (int bj = 0; bj < 2; ++bj)
#pragma unroll
            for (int n = 0; n < 2; ++n) { const f32x4 z = (f32x4){0.f, 0.f, 0.f, 0.f}; cs[bj][n] = ln.st ? *(const f32x4*)(ln.cs + wrow0 + bj * HALF + 4 * n) : z; bw[bj][n] = ln.st ? *(const f32x4*)(ln.bw + wrow0 + bj * HALF + 4 * n) : z; }
#pragma unroll
        for (int i = 0; i < 8; ++i) ln.row(row0 + (i >> 2) * HALF + (i & 3) * 16, ra[i], rc[i]);
        asm volatile("" ::: "memory");
#pragma unroll
        for (int ai = 0; ai < 2; ++ai)
#pragma unroll
            for (int m = 0; m < 4; ++m) {
                const int row = row0 + ai * HALF + m * 16; const float a = ra[ai * 4 + m], c = rc[ai * 4 + m];
                const f32x4 g0 = acc[ai][0][m][0] * a + cs[0][0] * c + bw[0][0], g1 = acc[ai][0][m][1] * a + cs[0][1] * c + bw[0][1];
                const f32x4 u0 = acc[ai][1][m][0] * a + cs[1][0] * c + bw[1][0], u1 = acc[ai][1][m][1] * a + cs[1][1] * c + bw[1][1];
                u32x4 w;
                w.x = cvtpk(silu_f(g0[0]) * u0[0], silu_f(g0[1]) * u0[1]); w.y = cvtpk(silu_f(g0[2]) * u0[2], silu_f(g0[3]) * u0[3]);
                w.z = cvtpk(silu_f(g1[0]) * u1[0], silu_f(g1[1]) * u1[1]); w.w = cvtpk(silu_f(g1[2]) * u1[2], silu_f(g1[3]) * u1[3]);
                *(u32x4*)(H + (size_t)row * ldh + col0) = w;
            }
    }
};
struct EpiRes {
    static constexpr bool PERM = true, AFTER_DRAIN = false, F16 = false;
    const float* x0; bf16_t* yh; const float* st; const float* g; const float* b; float* st_new; float alpha, s;
    __device__ __forceinline__ void operator()(const f32x4 (&acc)[2][2][4][2], const Unit& u, int wr, int wc, int fr, int fq) const {
        const int row0 = u.pm * BM + wr * 64 + fr, col0 = u.pn * BM + wc * 64 + 8 * fq;
        f32x4 gv[2][2], bv[2][2];
#pragma unroll
        for (int bj = 0; bj < 2; ++bj)
#pragma unroll
            for (int n = 0; n < 2; ++n) { gv[bj][n] = st ? *(const f32x4*)(g + col0 + bj * 32 + 4 * n) : (f32x4){1.f, 1.f, 1.f, 1.f}; bv[bj][n] = st ? *(const f32x4*)(b + col0 + bj * 32 + 4 * n) : (f32x4){0.f, 0.f, 0.f, 0.f}; }
#pragma unroll
        for (int ai = 0; ai < 2; ++ai) {
            f16x8 hv[4][2]; float ra[4], rmu[4];
#pragma unroll
            for (int m = 0; m < 4; ++m) {
                const int row = row0 + ai * HALF + m * 16; const size_t off = (size_t)row * 1024 + col0;
                ra[m] = 1.0f; rmu[m] = 0.0f;
                if (st) {
                    const f32x2v sv = *(const f32x2v*)(st + 2 * (size_t)row); rmu[m] = sv.x * (1.0f / 1024.0f); ra[m] = rsqrtf(sv.y * (1.0f / 1024.0f) - rmu[m] * rmu[m] + 1e-5f);
                    hv[m][0] = *(const f16x8*)(yh + off); hv[m][1] = *(const f16x8*)(yh + off + 32);
                }
            }
            asm volatile("" ::: "memory");
#pragma unroll
            for (int m = 0; m < 4; ++m) {
                const int row = row0 + ai * HALF + m * 16; const size_t off = (size_t)row * 1024 + col0;
                float s1 = 0.f, s2 = 0.f;
#pragma unroll
                for (int bj = 0; bj < 2; ++bj) {
                    f32x4 yp[2];
                    if (st) { const f16x8 h = hv[m][bj]; yp[0] = (f32x4){(float)h[0], (float)h[1], (float)h[2], (float)h[3]}; yp[1] = (f32x4){(float)h[4], (float)h[5], (float)h[6], (float)h[7]}; }
                    else { yp[0] = *(const f32x4*)(x0 + off + bj * 32); yp[1] = *(const f32x4*)(x0 + off + bj * 32 + 4); }
                    f32x4 y[2];
#pragma unroll
                    for (int n = 0; n < 2; ++n) { const f32x4 x = (yp[n] - rmu[m]) * ra[m] * gv[bj][n] + bv[bj][n];
                        y[n] = x * alpha + acc[ai][bj][m][n] * s;
                        s1 += (y[n][0] + y[n][1]) + (y[n][2] + y[n][3]); s2 += (y[n][0] * y[n][0] + y[n][1] * y[n][1]) + (y[n][2] * y[n][2] + y[n][3] * y[n][3]); }
                    u32x4 w; w.x = cvtpk_h(y[0][0], y[0][1]); w.y = cvtpk_h(y[0][2], y[0][3]); w.z = cvtpk_h(y[1][0], y[1][1]); w.w = cvtpk_h(y[1][2], y[1][3]);
                    *(u32x4*)(yh + off + bj * 32) = w;
                }
                s1 += __shfl_xor(s1, 16); s1 += __shfl_xor(s1, 32); s2 += __shfl_xor(s2, 16); s2 += __shfl_xor(s2, 32);
                if (fq == 0) { atomicAdd(st_new + 2 * (size_t)row, s1); atomicAdd(st_new + 2 * (size_t)row + 1, s2); }
            }
            asm volatile("" ::: "memory");
        }
    }
};
struct EpiNull {
    static constexpr bool PERM = true, AFTER_DRAIN = false, F16 = false;
    float* sink;
    __device__ __forceinline__ void operator()(const f32x4 (&acc)[2][2][4][2], const Unit& u, int wr, int wc, int fr, int fq) const {
        f32x4 t = (f32x4){0.f, 0.f, 0.f, 0.f};
#pragma unroll
        for (int ai = 0; ai < 2; ++ai)
#pragma unroll
            for (int bj = 0; bj < 2; ++bj)
#pragma unroll
                for (int m = 0; m < 4; ++m) { t += acc[ai][bj][m][0]; t += acc[ai][bj][m][1]; }
        if (t[0] + t[1] + t[2] + t[3] == 12345.678f) *sink = t[0];
    }
};
struct EpiQKV {
    static constexpr bool PERM = true, AFTER_DRAIN = false, F16 = true;
    bf16_t* O; const float* rope; float qscale; RowLN ln;
    __device__ __forceinline__ void operator()(const f32x4 (&acc)[2][2][4][2], const Unit& u, int wr, int wc, int fr, int fq) const {
        const int pn = u.pn, row0 = u.pm * BM + wr * 64 + fr, col0 = pn * BM + wc * 32 + 8 * fq, i0 = 16 * (wc & 1) + 4 * fq;
        const bool anyrope = (pn != 4 && pn != 5);
        const float sc = (pn < 2 || pn == 6 || pn == 7) ? qscale : 1.0f;
        f32x4 cs[2][2], bw[2][2];
#pragma unroll
        for (int bj = 0; bj < 2; ++bj)
#pragma unroll
            for (int n = 0; n < 2; ++n) { cs[bj][n] = *(const f32x4*)(ln.cs + col0 + bj * HALF + 4 * n); bw[bj][n] = *(const f32x4*)(ln.bw + col0 + bj * HALF + 4 * n); }
#pragma unroll
        for (int ai = 0; ai < 2; ++ai)
#pragma unroll
            for (int m = 0; m < 4; ++m) {
                const int row = row0 + ai * HALF + m * 16; float a, c; ln.row(row, a, c);
                f32x4 cs4 = (f32x4){1.f, 1.f, 1.f, 1.f}, sn = (f32x4){0.f, 0.f, 0.f, 0.f};
                if (anyrope) { cs4 = *(const f32x4*)(rope + (size_t)row * 64 + i0); sn = *(const f32x4*)(rope + (size_t)row * 64 + 32 + i0); }
#pragma unroll
                for (int bj = 0; bj < 2; ++bj) {
                    const bool rp = anyrope && !(pn == 8 && bj == 1);
                    f32x4 v0 = acc[ai][bj][m][0] * a + cs[bj][0] * c + bw[bj][0], v1 = acc[ai][bj][m][1] * a + cs[bj][1] * c + bw[bj][1];
                    if (rp) {
                        const f32x4 a0 = v0, a1 = v1;
                        v0[0] = a0[0] * cs4[0] - a0[1] * sn[0]; v0[1] = a0[1] * cs4[0] + a0[0] * sn[0];
                        v0[2] = a0[2] * cs4[1] - a0[3] * sn[1]; v0[3] = a0[3] * cs4[1] + a0[2] * sn[1];
                        v1[0] = a1[0] * cs4[2] - a1[1] * sn[2]; v1[1] = a1[1] * cs4[2] + a1[0] * sn[2];
                        v1[2] = a1[2] * cs4[3] - a1[3] * sn[3]; v1[3] = a1[3] * cs4[3] + a1[2] * sn[3];
                    }
                    v0 = v0 * sc; v1 = v1 * sc;
                    u32x4 w; w.x = cvtpk(v0[0], v0[1]); w.y = cvtpk(v0[2], v0[3]); w.z = cvtpk(v1[0], v1[1]); w.w = cvtpk(v1[2], v1[3]);
                    *(u32x4*)(O + (size_t)row * 2304 + col0 + bj * HALF) = w;
                }
            }
    }
};

template <class Epi, class Sched, bool ALIGN_EPI = false, bool SP2 = false>
__device__ __forceinline__ void gemm_phase(PG8_LAS unsigned char* lds, const Gemm g, const Sched& S, const Epi& E, const int wave_in) {
    int tid_; asm volatile("v_mbcnt_lo_u32_b32 %0, -1, 0\n\tv_mbcnt_hi_u32_b32 %0, -1, %0" : "=v"(tid_)); tid_ += 64 * wave_in;
    const int tid = tid_, wid = __builtin_amdgcn_readfirstlane(tid >> 6), lane = tid & 63, wr = wid >> 2, wc = wid & 3, fr = lane & 15, fq = lane >> 4;
    const int K = g.K, nt = K / BK;
    unsigned voffA[2], voffB[2];
#pragma unroll
    for (int i = 0; i < 2; ++i) { int R, C; stage_rc(tid * 16 + i * 8192, R, C); const int Rb = Epi::PERM ? ((R & ~31) + perm32(R & 31)) : R;
        voffA[i] = (unsigned)(R * K + C) * 2u; voffB[i] = (unsigned)(Rb * K + C) * 2u; }
    const size_t kstep = (size_t)(BK * 2);
    const size_t hstep = (size_t)HALF * K * 2;
    const size_t tstep = 2 * hstep;
    const unsigned ldsw = (unsigned)wid * 1024u;
    const int aoff = lds_byte(wr * 64 + fr, fq * 8), boff = lds_byte(wc * 32 + fr, fq * 8);
#define PG8_SA(b, h) (((b) * 2 + (h)) * HTB)
#define PG8_SB(b, h) ((4 + (b) * 2 + (h)) * HTB)
#define PG8_STAGE(bufoff, gbase, voff) do { _Pragma("unroll") for (int _i = 0; _i < 2; ++_i) \
        __builtin_amdgcn_global_load_lds((const unsigned*)((const char*)(gbase) + (voff)[_i]), (PG8_LAS unsigned*)(lds + (bufoff) + ldsw + _i * 8192), 16, 0, 0); } while (0)
#define PG8_LDA(dst, b, h) do { _Pragma("unroll") for (int m = 0; m < 4; ++m) _Pragma("unroll") for (int k = 0; k < 2; ++k) dst[m][k] = *(const PG8_LAS bf16x8*)(lds + PG8_SA(b, h) + aoff + m * 2048 + k * 1024); } while (0)
#define PG8_LDB(dst, b, h) do { _Pragma("unroll") for (int n = 0; n < 2; ++n) _Pragma("unroll") for (int k = 0; k < 2; ++k) dst[n][k] = *(const PG8_LAS bf16x8*)(lds + PG8_SB(b, h) + boff + n * 2048 + k * 1024); } while (0)
#define PG8_MMA(ai, bj, At, Bt) do { __builtin_amdgcn_s_setprio(1); _Pragma("unroll") for (int m = 0; m < 4; ++m) _Pragma("unroll") for (int n = 0; n < 2; ++n) _Pragma("unroll") for (int k = 0; k < 2; ++k) \
        acc[ai][bj][m][n] = mma16<Epi::F16>(Bt[n][k], At[m][k], acc[ai][bj][m][n]); __builtin_amdgcn_s_setprio(0); } while (0)
#define PG8_WAIT_V(n) asm volatile("s_waitcnt vmcnt(" #n ")" ::: "memory")
#define PG8_WAIT_L(n) asm volatile("s_waitcnt lgkmcnt(" #n ")" ::: "memory")
#define PG8_BAR __builtin_amdgcn_s_barrier()
#define PG8_SCHED __builtin_amdgcn_sched_barrier(0)
    Unit cur, nxt; int ui = 0;
    if (!S.next(0, cur)) return;
    f32x4 acc[2][2][4][2];
#pragma unroll
    for (int a = 0; a < 2; ++a)
#pragma unroll
        for (int b = 0; b < 2; ++b)
#pragma unroll
            for (int m = 0; m < 4; ++m)
#pragma unroll
                for (int n = 0; n < 2; ++n) acc[a][b][m][n] = (f32x4){0.f, 0.f, 0.f, 0.f};
    bf16x8 At[4][2], B0[2][2], B1[2][2];
    const char* cA = (const char*)g.A + (size_t)cur.pm * tstep; const char* cB = (const char*)g.Bt + (size_t)cur.pn * tstep;
    S.a_ready(cur);
    if constexpr (SP2) {
        PG8_STAGE(PG8_SB(0, 0), cB, voffB); PG8_STAGE(PG8_SB(0, 1), cB + hstep, voffB); PG8_STAGE(PG8_SA(0, 0), cA, voffA); PG8_STAGE(PG8_SA(0, 1), cA + hstep, voffA);
        if (wr == 1) PG8_BAR;
        PG8_WAIT_V(2); PG8_BAR;
        PG8_STAGE(PG8_SB(1, 0), cB + kstep, voffB); PG8_STAGE(PG8_SA(1, 0), cA + kstep, voffA); PG8_STAGE(PG8_SB(1, 1), cB + hstep + kstep, voffB);
        PG8_WAIT_V(6); PG8_BAR;
    } else {
        PG8_STAGE(PG8_SB(0, 0), cB, voffB); PG8_STAGE(PG8_SA(0, 0), cA, voffA); PG8_STAGE(PG8_SB(0, 1), cB + hstep, voffB); PG8_STAGE(PG8_SA(0, 1), cA + hstep, voffA);
        if (wr == 1) PG8_BAR;
        PG8_WAIT_V(4); PG8_BAR;
        PG8_STAGE(PG8_SB(1, 0), cB + kstep, voffB); PG8_STAGE(PG8_SA(1, 0), cA + kstep, voffA); PG8_STAGE(PG8_SB(1, 1), cB + hstep + kstep, voffB);
        PG8_WAIT_V(6); PG8_BAR;
    }
    for (;;) {
        const bool has_next = S.next(ui + 1, nxt);
        const char* nA = has_next ? (const char*)g.A + (size_t)nxt.pm * tstep : cA; const char* nB = has_next ? (const char*)g.Bt + (size_t)nxt.pn * tstep : cB;
        for (int t = 0; t < nt; t += 2) {
            const bool last = (t == nt - 2);
            const char* a1 = cA + (size_t)(t + 1) * kstep;
            const char* a2 = last ? nA : cA + (size_t)(t + 2) * kstep; const char* b2 = last ? nB : cB + (size_t)(t + 2) * kstep;
            const char* a3 = a2 + kstep; const char* b3 = b2 + kstep;
            if (last && has_next) S.a_ready(nxt);
            if constexpr (SP2) {
            PG8_LDB(B0, 0, 0); PG8_LDB(B1, 0, 1); PG8_SCHED; PG8_LDA(At, 0, 0); PG8_STAGE(PG8_SA(1, 1), a1 + hstep, voffA);
            PG8_WAIT_V(8); PG8_WAIT_L(0); PG8_BAR; PG8_MMA(0, 0, At, B0); PG8_MMA(0, 1, At, B1); PG8_BAR; PG8_SCHED;
            PG8_LDA(At, 0, 1); PG8_STAGE(PG8_SB(0, 0), b2, voffB); PG8_STAGE(PG8_SB(0, 1), b2 + hstep, voffB); PG8_STAGE(PG8_SA(0, 0), a2, voffA);
            PG8_WAIT_V(8); PG8_WAIT_L(0); PG8_BAR; PG8_MMA(1, 0, At, B0); PG8_MMA(1, 1, At, B1); PG8_BAR; PG8_SCHED;
            PG8_LDB(B0, 1, 0); PG8_LDB(B1, 1, 1); PG8_SCHED; PG8_LDA(At, 1, 0); PG8_STAGE(PG8_SA(0, 1), a2 + hstep, voffA);
            PG8_WAIT_V(8); PG8_WAIT_L(0); PG8_BAR; PG8_MMA(0, 0, At, B0); PG8_MMA(0, 1, At, B1); PG8_BAR; PG8_SCHED;
            PG8_LDA(At, 1, 1); PG8_STAGE(PG8_SB(1, 0), b3, voffB); PG8_STAGE(PG8_SB(1, 1), b3 + hstep, voffB); PG8_STAGE(PG8_SA(1, 0), a3, voffA);
            PG8_WAIT_V(8); PG8_WAIT_L(0); PG8_BAR; PG8_MMA(1, 0, At, B0); PG8_MMA(1, 1, At, B1); PG8_BAR; PG8_SCHED;
            } else {
            PG8_LDB(B0, 0, 0); PG8_SCHED; PG8_LDA(At, 0, 0); PG8_STAGE(PG8_SA(1, 1), a1 + hstep, voffA);
            PG8_WAIT_L(8); PG8_BAR; PG8_WAIT_L(0); PG8_MMA(0, 0, At, B0); PG8_BAR; PG8_SCHED;
            PG8_LDB(B1, 0, 1); PG8_STAGE(PG8_SB(0, 0), b2, voffB);
            PG8_BAR; PG8_WAIT_L(0); PG8_MMA(0, 1, At, B1); PG8_BAR;
            PG8_LDA(At, 0, 1); PG8_STAGE(PG8_SA(0, 0), a2, voffA);
            PG8_BAR; PG8_WAIT_L(0); PG8_MMA(1, 0, At, B0); PG8_BAR; PG8_SCHED;
            PG8_STAGE(PG8_SB(0, 1), b2 + hstep, voffB);
            PG8_WAIT_V(6); PG8_BAR; PG8_MMA(1, 1, At, B1); PG8_BAR;
            PG8_LDB(B0, 1, 0); PG8_SCHED; PG8_LDA(At, 1, 0); PG8_STAGE(PG8_SA(0, 1), a2 + hstep, voffA);
            PG8_WAIT_L(8); PG8_BAR; PG8_WAIT_L(0); PG8_MMA(0, 0, At, B0); PG8_BAR; PG8_SCHED;
            PG8_LDB(B1, 1, 1); PG8_STAGE(PG8_SB(1, 0), b3, voffB);
            PG8_BAR; PG8_WAIT_L(0); PG8_MMA(0, 1, At, B1); PG8_BAR;
            PG8_LDA(At, 1, 1); PG8_STAGE(PG8_SA(1, 0), a3, voffA);
            PG8_BAR; PG8_WAIT_L(0); PG8_MMA(1, 0, At, B0); PG8_BAR; PG8_SCHED;
            PG8_STAGE(PG8_SB(1, 1), b3 + hstep, voffB);
            PG8_WAIT_V(6); PG8_BAR; PG8_MMA(1, 1, At, B1); PG8_BAR;
            }
        }
        if constexpr (ALIGN_EPI) { if (wr == 0) PG8_BAR; }
        if constexpr (!Epi::AFTER_DRAIN) { E(acc, cur, wr, wc, fr, fq); S.done(cur); }
        if (!has_next) break;
#pragma unroll
        for (int a = 0; a < 2; ++a)
#pragma unroll
            for (int b = 0; b < 2; ++b)
#pragma unroll
                for (int m = 0; m < 4; ++m)
#pragma unroll
                    for (int n = 0; n < 2; ++n) acc[a][b][m][n] = (f32x4){0.f, 0.f, 0.f, 0.f};
        cur = nxt; cA = nA; cB = nB; ++ui;
        if constexpr (ALIGN_EPI) { if (wr == 1) PG8_BAR; }
    }
    PG8_WAIT_V(0);
    if constexpr (!ALIGN_EPI) { if (wr == 0) PG8_BAR; }
    PG8_BAR;
    if constexpr (Epi::AFTER_DRAIN) { E.fused(acc, cur, wr, wc, fr, fq, lds, wid, lane); S.done(cur); }
#undef PG8_SA
#undef PG8_SB
#undef PG8_STAGE
#undef PG8_LDA
#undef PG8_LDB
#undef PG8_MMA
#undef PG8_WAIT_V
#undef PG8_WAIT_L
#undef PG8_BAR
#undef PG8_SCHED
}
}

namespace att {
using pg8::bf16_t; using pg8::bf16x8; using pg8::f32x4; using pg8::u32x4; using pg8::cvtpk;
#define ALDS __attribute__((address_space(3)))
typedef float f32x16 __attribute__((ext_vector_type(16)));
typedef short s16x4 __attribute__((ext_vector_type(4)));
typedef unsigned u32x2 __attribute__((ext_vector_type(2)));
constexpr int PITCH = 2304;
constexpr float THR = 8.0f;
__device__ __forceinline__ void glds16(const void* gsrc, unsigned lds_dst) { unsigned keep;
    asm volatile("s_mov_b32 %0, m0\n\ts_mov_b32 m0, %2\n\ts_nop 0\n\tglobal_load_lds_dwordx4 %1, off\n\ts_mov_b32 m0, %0" : "=&s"(keep) : "v"(gsrc), "s"(lds_dst) : "memory"); }
__device__ __forceinline__ unsigned rfl(unsigned v) { return (unsigned)__builtin_amdgcn_readfirstlane((int)v); }
__device__ __forceinline__ int pi23(int x) { return (x & ~12) | ((x & 4) << 1) | ((x & 8) >> 1); }
__device__ __forceinline__ s16x4 vtr(const ALDS unsigned char* p) { return __builtin_bit_cast(s16x4, __builtin_amdgcn_ds_read_tr16_b64_v4i16((ALDS s16x4*)p)); }
__device__ __forceinline__ float halfswap_max(float v) { auto rr = __builtin_amdgcn_permlane32_swap(__float_as_uint(v), __float_as_uint(v), false, false); return fmaxf(__uint_as_float(rr[0]), __uint_as_float(rr[1])); }
__device__ __forceinline__ float halfswap_sum(float v) { auto rr = __builtin_amdgcn_permlane32_swap(__float_as_uint(v), __float_as_uint(v), false, false); return __uint_as_float(rr[0]) + __uint_as_float(rr[1]); }

template <int DV, bool BAND>
__device__ __forceinline__ float attn_core(ALDS unsigned char* ring, const int wid, const int lane,
                                           const bf16_t* Qw, const bf16_t* ksrc, const bf16_t* vsrc, const int koff,
                                           const int t0, const int t1, const int tq, const int qpos, const float m_init, float l, f32x16 (&o)[DV / 32]) {
    constexpr int NDB = DV / 32, SLOT = (DV == 128) ? 32768 : 16384, VOFF = (DV == 128) ? 16384 : 8192, ROWB = DV * 2, NP = (DV == 128) ? 4 : 2;
    const int r32 = lane & 31, hi = lane >> 5;
    const unsigned ring_a = (unsigned)(uintptr_t)ring;
    bf16x8 qr[4];
#pragma unroll
    for (int d0 = 0; d0 < 4; ++d0) qr[d0] = *(const bf16x8*)(Qw + (size_t)r32 * PITCH + d0 * 16 + hi * 8);
#define ATT_ISSUE(t_, so_) do { const size_t go_ = (size_t)(t_) * (64 * PITCH); const unsigned d_ = ring_a + (unsigned)(so_) + (unsigned)wid * 1024u; \
        glds16(ksrc + go_, rfl(d_)); \
        if (DV == 128) { glds16(ksrc + go_ + 64, rfl(d_ + 8192u)); glds16(vsrc + go_, rfl(ring_a + (unsigned)(so_) + (unsigned)VOFF + (unsigned)wid * 2048u)); \
                         glds16(vsrc + go_ + 4 * PITCH, rfl(ring_a + (unsigned)(so_) + (unsigned)VOFF + (unsigned)wid * 2048u + 1024u)); } \
        else { glds16(vsrc + go_, rfl(d_ + (unsigned)VOFF)); } } while (0)
#define ATT_PIECE(i_, t_, so_) do { const size_t go_ = (size_t)(t_) * (64 * PITCH); const unsigned d_ = ring_a + (unsigned)(so_) + (unsigned)wid * 1024u; \
        if (DV == 128) { if ((i_) == 0) glds16(ksrc + go_, rfl(d_)); else if ((i_) == 1) glds16(ksrc + go_ + 64, rfl(d_ + 8192u)); \
                         else if ((i_) == 2) glds16(vsrc + go_, rfl(ring_a + (unsigned)(so_) + (unsigned)VOFF + (unsigned)wid * 2048u)); \
                         else glds16(vsrc + go_ + 4 * PITCH, rfl(ring_a + (unsigned)(so_) + (unsigned)VOFF + (unsigned)wid * 2048u + 1024u)); } \
        else { if ((i_) == 0) glds16(ksrc + go_, rfl(d_)); else if ((i_) == 2) glds16(vsrc + go_, rfl(d_ + (unsigned)VOFF)); } } while (0)
    ATT_ISSUE(t0, 0);
    { const int tn = (t0 + 1 < t1) ? t0 + 1 : t1 - 1; ATT_ISSUE(tn, SLOT); }
    const int g = (lane >> 4) & 1, q4 = (lane & 15) >> 2, p = lane & 3, sw = (DV == 128) ? q4 : (q4 >> 1);
    int va[NDB];
#pragma unroll
    for (int db = 0; db < NDB; ++db) va[db] = VOFF + (8 * hi + q4) * ROWB + ((db ^ sw) << 6) + (2 * g + (p >> 1)) * 16 + 8 * (p & 1);
    const int ka = koff + hi * 1024 + r32 * 16;
    float m = m_init;
    f32x16 negm;
#pragma unroll
    for (int r = 0; r < 16; ++r) negm[r] = -m;
#pragma unroll
    for (int db = 0; db < NDB; ++db)
#pragma unroll
        for (int r = 0; r < 16; ++r) o[db][r] = 0.f;
    if (wid >= 4) __builtin_amdgcn_s_setprio(1);
    int s_cur = 0, s_n2 = 2 * SLOT;
    for (int t = t0; t < t1; ++t) {
        asm volatile("s_waitcnt vmcnt(%0)" :: "n"(NP) : "memory");
        asm volatile("s_waitcnt lgkmcnt(0)\n\ts_barrier" ::: "memory");
        const int tn = (t + 2 < t1) ? t + 2 : t1 - 1;
        const ALDS unsigned char* sb = ring + s_cur;
        f32x16 p0 = negm, p1 = negm;
        bf16x8 kf[8];
#pragma unroll
        for (int d0 = 0; d0 < 4; ++d0) { kf[2 * d0] = *(const ALDS bf16x8*)(sb + ka + d0 * 2048); kf[2 * d0 + 1] = *(const ALDS bf16x8*)(sb + ka + d0 * 2048 + 512); }
        s16x4 vlo[2][NDB], vhh[2][NDB];
#pragma unroll
        for (int db = 0; db < NDB; ++db) { vlo[0][db] = vtr(sb + va[db]); vhh[0][db] = vtr(sb + va[db] + 4 * ROWB); }
        __builtin_amdgcn_sched_barrier(0);
#pragma unroll
        for (int d0 = 0; d0 < 4; ++d0) {
            p0 = __builtin_amdgcn_mfma_f32_32x32x16_bf16(kf[2 * d0], qr[d0], p0, 0, 0, 0);
            p1 = __builtin_amdgcn_mfma_f32_32x32x16_bf16(kf[2 * d0 + 1], qr[d0], p1, 0, 0, 0);
            __builtin_amdgcn_sched_barrier(0);
            ATT_PIECE(d0, tn, s_n2);
            __builtin_amdgcn_sched_barrier(0);
        }
        if (BAND) {
            if (t == tq - 2 || t == tq + 2) {
                const int rel0 = t * 64 + 8 * hi - qpos;
#pragma unroll
                for (int r = 0; r < 16; ++r) { const int rel = rel0 + 16 * (r >> 3) + (r & 7);
                    if (rel < -128 || rel > 128) p0[r] = -INFINITY;
                    if (rel + 32 < -128 || rel + 32 > 128) p1[r] = -INFINITY; }
            }
        }
        float mx = fmaxf(p0[0], p1[0]);
#pragma unroll
        for (int r = 1; r < 16; ++r) mx = fmaxf(fmaxf(mx, p0[r]), p1[r]);
        mx = halfswap_max(mx);
        const bool first = (!BAND) && (t == t0);
        const float dl = first ? mx : ((mx > THR) ? mx : 0.f);
        if (__any(dl != 0.f)) {
            m += dl;
#pragma unroll
            for (int r = 0; r < 16; ++r) { p0[r] -= dl; p1[r] -= dl; negm[r] = -m; }
            const float f = first ? 1.f : __builtin_amdgcn_exp2f(-dl);
            l *= f;
#pragma unroll
            for (int db = 0; db < NDB; ++db)
#pragma unroll
                for (int r = 0; r < 16; ++r) o[db][r] *= f;
        }
        float ssum = 0.f;
        bf16x8 pf;
#define ATT_EXP_SLICE(P_, B_, DST_) do { u32x4 w_; \
        P_[B_ + 0] = __builtin_amdgcn_exp2f(P_[B_ + 0]); P_[B_ + 1] = __builtin_amdgcn_exp2f(P_[B_ + 1]); P_[B_ + 2] = __builtin_amdgcn_exp2f(P_[B_ + 2]); P_[B_ + 3] = __builtin_amdgcn_exp2f(P_[B_ + 3]); \
        P_[B_ + 4] = __builtin_amdgcn_exp2f(P_[B_ + 4]); P_[B_ + 5] = __builtin_amdgcn_exp2f(P_[B_ + 5]); P_[B_ + 6] = __builtin_amdgcn_exp2f(P_[B_ + 6]); P_[B_ + 7] = __builtin_amdgcn_exp2f(P_[B_ + 7]); \
        ssum += ((P_[B_ + 0] + P_[B_ + 1]) + (P_[B_ + 2] + P_[B_ + 3])) + ((P_[B_ + 4] + P_[B_ + 5]) + (P_[B_ + 6] + P_[B_ + 7])); \
        w_.x = cvtpk(P_[B_ + 0], P_[B_ + 1]); w_.y = cvtpk(P_[B_ + 2], P_[B_ + 3]); w_.z = cvtpk(P_[B_ + 4], P_[B_ + 5]); w_.w = cvtpk(P_[B_ + 6], P_[B_ + 7]); DST_ = __builtin_bit_cast(bf16x8, w_); } while (0)
        ATT_EXP_SLICE(p0, 0, pf);
        __builtin_amdgcn_sched_barrier(0);
#pragma unroll
        for (int ks = 0; ks < 4; ++ks) {
            bf16x8 pfn = pf;
            if (ks + 1 < 4) {
#pragma unroll
                for (int db = 0; db < NDB; ++db) { vlo[(ks + 1) & 1][db] = vtr(sb + va[db] + (ks + 1) * (16 * ROWB)); vhh[(ks + 1) & 1][db] = vtr(sb + va[db] + (ks + 1) * (16 * ROWB) + 4 * ROWB); }
            }
#pragma unroll
            for (int db = 0; db < NDB; ++db) {
                const s16x4 lo = vlo[ks & 1][db], hh = vhh[ks & 1][db];
                const bf16x8 vf = (bf16x8){lo[0], lo[1], lo[2], lo[3], hh[0], hh[1], hh[2], hh[3]};
                o[db] = __builtin_amdgcn_mfma_f32_32x32x16_bf16(vf, pf, o[db], 0, 0, 0);
            }
            if (ks == 0) ATT_EXP_SLICE(p0, 8, pfn);
            if (ks == 1) ATT_EXP_SLICE(p1, 0, pfn);
            if (ks == 2) ATT_EXP_SLICE(p1, 8, pfn);
            if (ks + 1 < 4) {
                __builtin_amdgcn_sched_group_barrier(0x100, 2 * NDB, 0);
#pragma unroll
                for (int db = 0; db < NDB; ++db) { __builtin_amdgcn_sched_group_barrier(0x008, 1, 0); __builtin_amdgcn_sched_group_barrier(0x002, 20 / NDB, 0); }
            }
            __builtin_amdgcn_sched_barrier(0);
            pf = pfn;
        }
#undef ATT_EXP_SLICE
        l += ssum;
        s_cur = (s_cur == 2 * SLOT) ? 0 : s_cur + SLOT; s_n2 = (s_n2 == 2 * SLOT) ? 0 : s_n2 + SLOT;
    }
    __builtin_amdgcn_s_setprio(0);
    asm volatile("s_waitcnt vmcnt(0) lgkmcnt(0)\n\ts_barrier" ::: "memory");
#undef ATT_ISSUE
#undef ATT_PIECE
    return l;
}

__device__ __forceinline__ void diff_unit(ALDS unsigned char* ring, const int wid, int lane, const bf16_t* qkv, bf16_t* ymix, const int u, const float lam, const float post, const float* subg) {
    asm volatile("" : "+v"(lane));
    const int bh = u >> 5, qb = u & 31, b = bh >> 2, h = bh & 3, comp = wid >> 2, wq = wid & 3, r32 = lane & 31, hi = lane >> 5;
    const size_t rowbase = (size_t)b * 4096;
    const int q0 = qb * 128 + wq * 32;
    const bf16_t* Qw = qkv + (rowbase + q0) * PITCH + h * 128 + comp * 64;
    const bf16_t* ksrc = qkv + (rowbase + pi23(lane)) * PITCH + 512 + h * 128 + wid * 8;
    const bf16_t* vsrc = qkv + (rowbase + 8 * wid + (lane >> 4)) * PITCH + 1024 + h * 128 + (((lane & 15) ^ ((lane >> 4) << 2)) * 8);
    f32x16 o[4];
    float l = attn_core<128, false>(ring, wid, lane, Qw, ksrc, vsrc, comp * 8192, 0, 64, 0, 0, 0.f, 0.f, o);
    l = halfswap_sum(l);
    const float inv = 1.0f / l;
    ALDS f32x4* X = (ALDS f32x4*)ring + (size_t)wq * (16 * 64);
    if (comp == 1) {
#pragma unroll
        for (int db = 0; db < 4; ++db)
#pragma unroll
            for (int rq = 0; rq < 4; ++rq) X[(db * 4 + rq) * 64 + lane] = (f32x4){o[db][4 * rq] * inv, o[db][4 * rq + 1] * inv, o[db][4 * rq + 2] * inv, o[db][4 * rq + 3] * inv};
    }
    asm volatile("s_waitcnt lgkmcnt(0)\n\ts_barrier" ::: "memory");
    if (comp == 0) {
        float ss = 0.f;
#pragma unroll
        for (int db = 0; db < 4; ++db)
#pragma unroll
            for (int rq = 0; rq < 4; ++rq) { const f32x4 o2 = X[(db * 4 + rq) * 64 + lane];
#pragma unroll
                for (int e = 0; e < 4; ++e) { const float d = o[db][4 * rq + e] * inv - lam * o2[e]; o[db][4 * rq + e] = d; ss += d * d; } }
        ss = halfswap_sum(ss);
        const float rs = rsqrtf(ss * (1.0f / 128.0f) + 1e-5f) * post;
        bf16_t* orow = ymix + (rowbase + q0 + r32) * 1024 + h * 128 + 4 * hi;
#pragma unroll
        for (int db = 0; db < 4; ++db)
#pragma unroll
            for (int rq = 0; rq < 4; ++rq) { const f32x4 gv = *(const f32x4*)(subg + 32 * db + 8 * rq + 4 * hi);
                u32x2 w; w.x = cvtpk(o[db][4 * rq] * rs * gv[0], o[db][4 * rq + 1] * rs * gv[1]); w.y = cvtpk(o[db][4 * rq + 2] * rs * gv[2], o[db][4 * rq + 3] * rs * gv[3]);
                *(u32x2*)(orow + 32 * db + 8 * rq) = w; }
    }
    asm volatile("s_waitcnt lgkmcnt(0)\n\ts_barrier" ::: "memory");
}

__device__ __forceinline__ void swa_unit(ALDS unsigned char* ring, const int wid, int lane, const bf16_t* qkv, bf16_t* ymix, const int u, const float* sink) {
    asm volatile("" : "+v"(lane));
    const int bkv = u >> 6, qblk = u & 63, b = bkv >> 1, kvh = bkv & 1, head = kvh * 4 + (wid >> 1), r32 = lane & 31, hi = lane >> 5;
    const size_t rowbase = (size_t)b * 4096;
    const int q0 = qblk * 64 + (wid & 1) * 32;
    const bf16_t* Qw = qkv + (rowbase + q0) * PITCH + 1536 + head * 64;
    const bf16_t* ksrc = qkv + (rowbase + pi23(lane)) * PITCH + 2048 + kvh * 64 + wid * 8;
    const bf16_t* vsrc = qkv + (rowbase + 8 * wid + (lane >> 3)) * PITCH + 2176 + kvh * 64 + (((lane & 7) ^ (((lane >> 4) & 1) << 2)) * 8);
    const int t0 = (qblk - 2 > 0) ? qblk - 2 : 0, t1 = ((qblk + 2 < 63) ? qblk + 2 : 63) + 1;
    f32x16 o[2];
    float l = attn_core<64, true>(ring, wid, lane, Qw, ksrc, vsrc, 0, t0, t1, qblk, q0 + r32, sink[head] * 1.4426950408889634f, (hi == 0) ? 1.0f : 0.0f, o);
    l = halfswap_sum(l);
    const float inv = 1.0f / l;
    bf16_t* orow = ymix + (rowbase + q0 + r32) * 1024 + 512 + head * 64 + 4 * hi;
#pragma unroll
    for (int db = 0; db < 2; ++db)
#pragma unroll
        for (int rq = 0; rq < 4; ++rq) { u32x2 w; w.x = cvtpk(o[db][4 * rq] * inv, o[db][4 * rq + 1] * inv); w.y = cvtpk(o[db][4 * rq + 2] * inv, o[db][4 * rq + 3] * inv);
            *(u32x2*)(orow + 32 * db + 8 * rq) = w; }
}
}

#ifndef REP_DIFF
#define REP_DIFF 1
#endif
#ifndef REP_SWA
#define REP_SWA 1
#endif
#ifndef REP_G3
#define REP_G3 1
#endif
#ifndef REP_FOUT
#define REP_FOUT 0
#endif
#ifndef REP_RES
#define REP_RES 0
#endif
#ifndef REP_OPROJ
#define REP_OPROJ 0
#endif
#ifndef REP_G1
#define REP_G1 1
#endif
#ifndef REP_SYNC
#define REP_SYNC 1
#endif
#ifndef REP_LN
#define REP_LN 1
#endif
#ifndef REP_PRO
#define REP_PRO 1
#endif
constexpr int NWAVES = 8;
constexpr int M = 65536, D = 1024, FF = 2816, NIN = 2304, SEQ = 4096, DEPTH = 4;
constexpr size_t MiB = 1u << 20;
constexpr size_t W1_OFF = 0, W1_B = (size_t)2 * FF * D * 2, W2_OFF = W1_OFF + W1_B, W2_B = (size_t)D * FF * 2, WIN_OFF = W2_OFF + W2_B, WIN_B = (size_t)NIN * D * 2,
                 WO_OFF = WIN_OFF + WIN_B, WO_B = (size_t)D * D * 2, W3_OFF = WO_OFF + WO_B, W4_OFF = W3_OFF + W1_B, WL_STRIDE = W4_OFF + W2_B;
constexpr size_t WS_W = 0, WS_ROPE = 160 * MiB, WS_XB = 176 * MiB, WS_H = 304 * MiB, WS_YM = 656 * MiB, WS_CSBW = 784 * MiB, WS_ST = 785 * MiB, WS_CTL = 786 * MiB, WS_END = 787 * MiB;
constexpr size_t CTL_ZERO_BYTES = 16384;
constexpr int CSBW_N = 2 * FF;
static_assert((size_t)DEPTH * 3 * 2 * CSBW_N * 4 <= MiB && (size_t)2 * M * 2 * 4 <= MiB, "aux map");
static_assert(WL_STRIDE * DEPTH <= WS_ROPE && WS_ROPE + (size_t)M * 64 * 4 <= WS_XB && WS_XB + (size_t)M * D * 2 <= WS_H && WS_H + (size_t)M * FF * 2 <= WS_YM && WS_YM + (size_t)M * D * 2 <= WS_END, "d_ws map");
constexpr int LDS_BYTES = 147456;
constexpr float ALPHA = 1.681792830507429f;
constexpr float QSCALE = 0.125f * 1.4426950408889634f;

typedef unsigned short bf16;
typedef float f32x4 __attribute__((ext_vector_type(4)));
typedef unsigned v4u __attribute__((ext_vector_type(4)));
typedef unsigned v2u __attribute__((ext_vector_type(2)));
using pg8::cvtpk;

struct Args { const float* in[13]; float* out; unsigned char* ws; float inv[32]; float lam_init[4]; };

__device__ __forceinline__ int cur_lane() { int l; asm volatile("v_mbcnt_lo_u32_b32 %0, -1, 0\n\tv_mbcnt_hi_u32_b32 %0, -1, %0" : "=v"(l)); return l; }
__device__ __forceinline__ float wave_sum(float v) {
#pragma unroll
    for (int o = 1; o < 64; o <<= 1) v += __shfl_xor(v, o);
    return v;
}
__device__ __forceinline__ int src_col(int type, int n) {
    if (type == 1) { const int pn = n >> 8, w = n & 255; return (w < 128) ? (128 * pn + w) : (FF + 128 * pn + (w - 128)); }
    if (type == 3) { const int w = n & 255, bj = w >> 7, wc = (w >> 5) & 3, c = w & 31; return (n & ~255) + 64 * wc + 32 * bj + c; }
    if (type == 2) { const bool rp = (n < 1024) || (n >= 1536 && n < 2176); return rp ? ((n & ~63) + ((n & 63) >> 1) + 32 * (n & 1)) : n; }
    return n;
}
template <bool F16> __device__ __forceinline__ void transpose_item(const float* W, int K, int N, int type, const float* gk, bf16* WT, ALDS float* scr, int item, int lane) {
    const int nblk = N / 32, kb = item / nblk, nb = item % nblk, k0 = 64 * kb, n0 = 32 * nb;
    const int sc = src_col(type, n0 + (lane & 31));
#pragma unroll 8
    for (int i = 0; i < 32; ++i) { const int kk = 2 * i + (lane >> 5); scr[kk * 33 + (lane & 31)] = W[(size_t)(k0 + kk) * N + sc] * (gk ? gk[k0 + kk] : 1.0f); }
    asm volatile("s_waitcnt lgkmcnt(0)" ::: "memory");
    const int c = lane & 7;
#pragma unroll
    for (int j = 0; j < 4; ++j) { const int n = (lane >> 3) + 8 * j; const ALDS float* s = scr + (8 * c) * 33 + n;
        v4u o; if (F16) { o.x = pg8::cvtpk_h(s[0 * 33], s[1 * 33]); o.y = pg8::cvtpk_h(s[2 * 33], s[3 * 33]); o.z = pg8::cvtpk_h(s[4 * 33], s[5 * 33]); o.w = pg8::cvtpk_h(s[6 * 33], s[7 * 33]); }
        else { o.x = cvtpk(s[0 * 33], s[1 * 33]); o.y = cvtpk(s[2 * 33], s[3 * 33]); o.z = cvtpk(s[4 * 33], s[5 * 33]); o.w = cvtpk(s[6 * 33], s[7 * 33]); }
        *(v4u*)(WT + (size_t)(n0 + n) * K + k0 + 8 * c) = o; }
    asm volatile("s_waitcnt lgkmcnt(0)" ::: "memory");
}
__device__ __forceinline__ void sincos_f32angle(float ang, float& c, float& s) {
    const double a = (double)ang, k = __builtin_rint(a * 0.63661977236758134308);
    double r = __builtin_fma(-k, 1.57079632679489655800e+00, a); r = __builtin_fma(-k, 6.12323399573676603587e-17, r);
    const double r2 = r * r;
    double sp = -1.0 / 1307674368000.0; sp = sp * r2 + 1.0 / 6227020800.0; sp = sp * r2 - 1.0 / 39916800.0; sp = sp * r2 + 1.0 / 362880.0; sp = sp * r2 - 1.0 / 5040.0; sp = sp * r2 + 1.0 / 120.0; sp = sp * r2 - 1.0 / 6.0;
    const double sn = r + r * r2 * sp;
    double cp = 1.0 / 20922789888000.0; cp = cp * r2 - 1.0 / 87178291200.0; cp = cp * r2 + 1.0 / 479001600.0; cp = cp * r2 - 1.0 / 3628800.0; cp = cp * r2 + 1.0 / 40320.0; cp = cp * r2 - 1.0 / 720.0; cp = cp * r2 + 1.0 / 24.0; cp = cp * r2 - 0.5;
    const double cn = 1.0 + r2 * cp;
    const int q = ((int)k) & 3;
    const double cc = (q == 0) ? cn : (q == 1) ? -sn : (q == 2) ? -cn : sn;
    const double ss = (q == 0) ? sn : (q == 1) ? cn : (q == 2) ? -sn : -cn;
    c = (float)cc; s = (float)ss;
}
__device__ __forceinline__ void ln_row(const float* xrow, const float* g, const float* bta, float* orow, bf16* brow, int lane) {
    asm volatile("" : "+v"(lane));
    const f32x4* xr = (const f32x4*)xrow + lane;
    f32x4 v[4]; float s = 0.f;
#pragma unroll
    for (int j = 0; j < 4; ++j) { v[j] = xr[64 * j]; s += (v[j][0] + v[j][1]) + (v[j][2] + v[j][3]); }
    const float mean = wave_sum(s) * (1.f / D); float s2 = 0.f;
#pragma unroll
    for (int j = 0; j < 4; ++j) { v[j] = v[j] - mean; s2 += (v[j][0] * v[j][0] + v[j][1] * v[j][1]) + (v[j][2] * v[j][2] + v[j][3] * v[j][3]); }
    const float rstd = 1.0f / sqrtf(wave_sum(s2) * (1.f / D) + 1e-5f);
#pragma unroll
    for (int j = 0; j < 4; ++j) { const f32x4 gg = *((const f32x4*)g + lane + 64 * j), bb = *((const f32x4*)bta + lane + 64 * j);
        const f32x4 y = v[j] * rstd * gg + bb;
        *((f32x4*)orow + lane + 64 * j) = y;
        v2u w; w.x = cvtpk(y[0], y[1]); w.y = cvtpk(y[2], y[3]); *((v2u*)brow + lane + 64 * j) = w; }
}

#define XB_TMO      128
#define XB_XCNT(j)  (256  + 64 * (j))
#define XB_XSUB(j)  (1280 + 64 * (j))
#define XB_XGEN(j)  (2304 + 64 * (j))
#define XB_TOP      3328
#define XB_TOPGEN   3392
#define XCD_BAR_WORDS 3456
#define XB_SPIN_CAP (1u << 18)

__device__ __forceinline__ unsigned xb_ld(unsigned* p)              { return __hip_atomic_load(p, __ATOMIC_RELAXED, __HIP_MEMORY_SCOPE_AGENT); }
__device__ __forceinline__ unsigned xb_add(unsigned* p, unsigned v) { return __hip_atomic_fetch_add(p, v, __ATOMIC_RELAXED, __HIP_MEMORY_SCOPE_AGENT); }
__device__ __forceinline__ unsigned xb_xcc_id() { return (unsigned)__builtin_amdgcn_s_getreg((3 << 11) | 20) & 0xFu; }
#define XB_SPIN(cond, bar) do { unsigned _sp = 0; while (cond) { __builtin_amdgcn_s_sleep(1); \
    if ((++_sp & 255u) == 0u) { if (xb_ld(&(bar)[XB_TMO])) break; if (_sp > XB_SPIN_CAP) { atomicAdd(&(bar)[XB_TMO], 1u); break; } } } } while (0)

struct XcdBarrier {
    unsigned* bar; unsigned x;
    volatile ALDS unsigned* st;
};

__device__ __forceinline__ XcdBarrier xcd_barrier_post(unsigned* bar, volatile ALDS unsigned* st) {
    XcdBarrier b; b.bar = bar; b.x = xb_xcc_id(); b.st = st;
    if (threadIdx.x == 0) (void)xb_add(&bar[XB_XCNT(b.x)], 1u);
    return b;
}
__device__ __forceinline__ void xcd_barrier_complete(unsigned* bar, unsigned x, unsigned& nloc, unsigned& nx) {
    const unsigned G = gridDim.x * gridDim.y * gridDim.z;
    unsigned sum, cnt, mine, sp = 0u;
    for (;;) {
        sum = 0u; cnt = 0u; mine = 0u;
#pragma unroll
        for (unsigned j = 0; j < 16; ++j) { const unsigned c = xb_ld(&bar[XB_XCNT(j)]); sum += c; cnt += (c > 0u) ? 1u : 0u; mine = (j == x) ? c : mine; }
        if (sum == G) break;
        __builtin_amdgcn_s_sleep(1);
        if ((++sp & 255u) == 0u) { if (xb_ld(&bar[XB_TMO])) break; if (sp > XB_SPIN_CAP) { atomicAdd(&bar[XB_TMO], 1u); break; } }
    }
    nloc = mine > 0u ? mine : 1u; nx = cnt > 0u ? cnt : 1u;
}

__device__ __forceinline__ void xcd_barrier(const XcdBarrier& b) {
    asm volatile("s_waitcnt vmcnt(0)" ::: "memory");
    __syncthreads();
    if (threadIdx.x == 0) {
        unsigned* bar = b.bar;
        __builtin_amdgcn_s_waitcnt(0);
        unsigned nloc = b.st[0], nx = b.st[1];
        if (nloc == 0u) { xcd_barrier_complete(bar, b.x, nloc, nx); b.st[0] = nloc; b.st[1] = nx; }
        const unsigned old = xb_add(&bar[XB_XSUB(b.x)], 1u);
        const unsigned gen = old / nloc;
        if (old + 1u == (gen + 1u) * nloc) {
            __builtin_amdgcn_fence(__ATOMIC_RELEASE, "agent");
            asm volatile("s_waitcnt vmcnt(0)" ::: "memory");
            const unsigned og = xb_add(&bar[XB_TOP], 1u);
            const unsigned tg = og / nx;
            if (og + 1u == (tg + 1u) * nx) xb_add(&bar[XB_TOPGEN], 1u);
            else XB_SPIN(xb_ld(&bar[XB_TOPGEN]) == tg, bar);
            __builtin_amdgcn_fence(__ATOMIC_ACQUIRE, "agent");
            xb_add(&bar[XB_XGEN(b.x)], 1u);
            asm volatile("s_waitcnt vmcnt(0)" ::: "memory");
        } else {
            XB_SPIN(xb_ld(&bar[XB_XGEN(b.x)]) == gen, bar);
            __builtin_amdgcn_fence(__ATOMIC_ACQUIRE, "agent");
            asm volatile("s_waitcnt vmcnt(0)" ::: "memory");
        }
    }
    __syncthreads();
}

__device__ __forceinline__ void ln_row_h(const bf16* hrow, const float* g, const float* bta, float* orow, int lane) {
    asm volatile("" : "+v"(lane));
    typedef _Float16 h4 __attribute__((ext_vector_type(4)));
    f32x4 v[4]; float s = 0.f;
#pragma unroll
    for (int j = 0; j < 4; ++j) { const h4 h = *((const h4*)hrow + lane + 64 * j); v[j] = (f32x4){(float)h[0], (float)h[1], (float)h[2], (float)h[3]}; s += (v[j][0] + v[j][1]) + (v[j][2] + v[j][3]); }
    const float mean = wave_sum(s) * (1.f / D); float s2 = 0.f;
#pragma unroll
    for (int j = 0; j < 4; ++j) { v[j] = v[j] - mean; s2 += (v[j][0] * v[j][0] + v[j][1] * v[j][1]) + (v[j][2] * v[j][2] + v[j][3] * v[j][3]); }
    const float rstd = 1.0f / sqrtf(wave_sum(s2) * (1.f / D) + 1e-5f);
#pragma unroll
    for (int j = 0; j < 4; ++j) { const f32x4 gg = *((const f32x4*)g + lane + 64 * j), bb = *((const f32x4*)bta + lane + 64 * j);
        *((f32x4*)orow + lane + 64 * j) = v[j] * rstd * gg + bb; }
}

__global__ void __launch_bounds__(NWAVES * 64, 2) fwd_megakernel(Args args) {
    extern __shared__ __attribute__((aligned(16))) unsigned char lds_raw[];
    cg::grid_group grid = cg::this_grid();
#define GSYNC() xcd_barrier(bar)
    ALDS unsigned char* lds = (ALDS unsigned char*)lds_raw;
    const int tid = threadIdx.x, lane = tid & 63, wave = __builtin_amdgcn_readfirstlane(tid >> 6);
    const int G = gridDim.x, bx = blockIdx.x, vcu = (G % 8 == 0) ? (bx % 8) * (G / 8) + bx / 8 : bx;
    unsigned char* ws = args.ws;
    const float* x_in = args.in[0]; const int* positions = (const int*)args.in[1];
    float* out = args.out;
    bf16* XB = (bf16*)(ws + WS_XB); bf16* HB = (bf16*)(ws + WS_H); bf16* QKV = (bf16*)(ws + WS_H); bf16* YM = (bf16*)(ws + WS_YM);
    float* ROPE = (float*)(ws + WS_ROPE); float* CSBW = (float*)(ws + WS_CSBW); float* ST = (float*)(ws + WS_ST); float* LAMV = (float*)(ws + WS_CSBW + 786432);
    const int gw = vcu * NWAVES + wave, NGW = G * NWAVES;
    volatile ALDS unsigned* bst = (volatile ALDS unsigned*)(lds + 131072 + 8192);
    if (tid < 2) bst[tid] = 0u;
    __syncthreads();
    XcdBarrier bar = xcd_barrier_post((unsigned*)(ws + WS_CTL), bst);

    for (int rep = 0; rep < REP_PRO; ++rep) {
        ALDS float* scr = (ALDS float*)(lds + wave * 16384);
        constexpr int I1 = (D / 64) * (2 * FF / 32), I2 = (FF / 64) * (D / 32), I3 = (D / 64) * (NIN / 32), I4 = (D / 64) * (D / 32), IL = 2 * I1 + 2 * I2 + I3 + I4;
        for (int it = gw; it < IL * DEPTH; it += NGW) {
            const int l = it / IL; int r = it % IL;
            unsigned char* wl = ws + WS_W + (size_t)l * WL_STRIDE;
            if (r < I1) { transpose_item<true>(args.in[7] + (size_t)l * D * 2 * FF, D, 2 * FF, 1, (l > 0) ? args.in[11] + (size_t)((l - 1) * 3 + 2) * D : nullptr, (bf16*)(wl + W1_OFF), scr, r, lane); continue; } r -= I1;
            if (r < I2) { transpose_item<false>(args.in[8] + (size_t)l * FF * D, FF, D, 3, nullptr, (bf16*)(wl + W2_OFF), scr, r, lane); continue; } r -= I2;
            if (r < I3) { transpose_item<true>(args.in[2] + (size_t)l * D * NIN, D, NIN, 2, args.in[11] + (size_t)(l * 3) * D, (bf16*)(wl + WIN_OFF), scr, r, lane); continue; } r -= I3;
            if (r < I4) { transpose_item<false>(args.in[3] + (size_t)l * D * D, D, D, 3, nullptr, (bf16*)(wl + WO_OFF), scr, r, lane); continue; } r -= I4;
            if (r < I1) { transpose_item<true>(args.in[9] + (size_t)l * D * 2 * FF, D, 2 * FF, 1, args.in[11] + (size_t)(l * 3 + 1) * D, (bf16*)(wl + W3_OFF), scr, r, lane); continue; } r -= I1;
            transpose_item<false>(args.in[10] + (size_t)l * FF * D, FF, D, 3, nullptr, (bf16*)(wl + W4_OFF), scr, r, lane);
        }
        const size_t gt = (size_t)vcu * (NWAVES * 64) + tid, GT = (size_t)G * NWAVES * 64;
        for (size_t i = gt; i < (size_t)M * D / 4; i += GT) { const f32x4 v = *((const f32x4*)x_in + i); v2u w; w.x = pg8::cvtpk_h(v[0], v[1]); w.y = pg8::cvtpk_h(v[2], v[3]); *((v2u*)XB + i) = w; }
        for (size_t i = gt; i < (size_t)M * 32; i += GT) { const int row = (int)(i >> 5), k = (int)(i & 31); float c, s; sincos_f32angle((float)positions[row] * args.inv[k], c, s);
            ROPE[(size_t)row * 64 + k] = c; ROPE[(size_t)row * 64 + 32 + k] = s; }
        if (vcu == 0 && wave < DEPTH) {
            const float* lv = args.in[4] + (size_t)wave * 256;
            const float a1 = wave_sum(lv[lane] * lv[64 + lane]), a2 = wave_sum(lv[128 + lane] * lv[192 + lane]);
            if (lane == 0) LAMV[wave] = expf(a1) - expf(a2) + args.lam_init[wave];
        }
        for (size_t i = gt; i < (size_t)M * 2; i += GT) ST[i] = 0.f;
        {
            ALDS float* red = (ALDS float*)(lds + 131072);
            constexpr int CG0 = 2 * FF / 64, CG1 = NIN / 64, CGL = 2 * CG0 + CG1;
            for (int cgi = vcu; cgi < CGL * DEPTH; cgi += G) {
                const int l = cgi / CGL; int r = cgi % CGL; int j = 0;
                if (r >= CG0) { r -= CG0; j = 1; if (r >= CG1) { r -= CG1; j = 2; } }
                const int lnidx = (j == 0) ? (l - 1) * 3 + 2 : (j == 1) ? l * 3 : l * 3 + 1;
                if (lnidx < 0) continue;
                const int N = (j == 1) ? NIN : 2 * FF, type = (j == 1) ? 2 : 1;
                const float* W = (j == 0) ? args.in[7] + (size_t)l * D * 2 * FF : (j == 1) ? args.in[2] + (size_t)l * D * NIN : args.in[9] + (size_t)l * D * 2 * FF;
                const float* gk = args.in[11] + (size_t)lnidx * D; const float* bk = args.in[12] + (size_t)lnidx * D;
                const int n = r * 64 + lane, sc = src_col(type, n);
                float c1 = 0.f, b1 = 0.f;
#pragma unroll 16
                for (int k = wave * 128; k < wave * 128 + 128; ++k) { const float w = W[(size_t)k * N + sc]; const float gw = gk[k] * w;
                    c1 += (float)(_Float16)gw; b1 += bk[k] * w; }
                red[(wave * 64 + lane) * 2] = c1; red[(wave * 64 + lane) * 2 + 1] = b1;
                __syncthreads();
                if (wave == 0) { float cc = 0.f, bb = 0.f;
#pragma unroll
                    for (int w8 = 0; w8 < 8; ++w8) { cc += red[(w8 * 64 + lane) * 2]; bb += red[(w8 * 64 + lane) * 2 + 1]; }
                    float* dst = CSBW + (size_t)((l * 3 + j) * 2) * CSBW_N; dst[n] = cc; dst[CSBW_N + n] = bb; }
                __syncthreads();
            }
        }
    }
    grid.sync();

#define ZERO_ST(buf_) do { int t_ = wave * 64 + cur_lane(); asm volatile("" : "+v"(t_)); float* z_ = ST + (size_t)(buf_) * M * 2; for (int i_ = vcu * (NWAVES * 64) + t_; i_ < M * 2; i_ += G * NWAVES * 64) { z_[i_] = 0.f; asm volatile("" : "+v"(i_)); } } while (0)
    for (int l = 0; l < DEPTH; ++l) {
        unsigned char* wl = ws + WS_W + (size_t)l * WL_STRIDE;
        const float* lng = args.in[11]; const float* lnb = args.in[12];
        { const int k = 3 * l; ZERO_ST(k & 1);
          const float* cb = CSBW + (size_t)((l * 3 + 0) * 2) * CSBW_N;
          pg8::Gemm g{XB, (const bf16*)(wl + W1_OFF), M, 2 * FF, D}; pg8::StaticOrder S; S.init(M, 2 * FF, G, bx);
          pg8::EpiSwiGLU E{HB, FF, pg8::RowLN{(k == 0) ? nullptr : ST + (size_t)((k - 1) & 1) * M * 2, cb, cb + CSBW_N}};
          for (int rep = 0; rep < REP_G1; ++rep) pg8::gemm_phase<pg8::EpiSwiGLU, pg8::StaticOrder, true, true>(lds, g, S, E, wave); }
        GSYNC();
        { const int k = 3 * l;
          pg8::Gemm g{HB, (const bf16*)(wl + W2_OFF), M, D, FF}; pg8::StaticOrder S; S.init(M, D, G, bx);
          for (int rep = 0; rep < REP_FOUT; ++rep) { pg8::EpiNull EN{ROPE}; pg8::gemm_phase<pg8::EpiNull, pg8::StaticOrder, true, true>(lds, g, S, EN, wave); }
          for (int rep = 0; rep < REP_RES; ++rep) { pg8::EpiRes ED{x_in, (bf16*)out, ST, lng, lnb, out + (size_t)48 * 1024 * 1024, ALPHA, 0.5f}; pg8::gemm_phase<pg8::EpiRes, pg8::StaticOrder, true, true>(lds, g, S, ED, wave); }
          pg8::EpiRes E{x_in, XB, (k == 0) ? nullptr : ST + (size_t)((k - 1) & 1) * M * 2, lng + (size_t)(k > 0 ? k - 1 : 0) * D, lnb + (size_t)(k > 0 ? k - 1 : 0) * D, ST + (size_t)(k & 1) * M * 2, ALPHA, 0.5f};
          pg8::gemm_phase<pg8::EpiRes, pg8::StaticOrder, true, true>(lds, g, S, E, wave); }
        GSYNC();
        { const int k = 3 * l + 1; ZERO_ST(k & 1);
          const float* cb = CSBW + (size_t)((l * 3 + 1) * 2) * CSBW_N;
          pg8::Gemm g{XB, (const bf16*)(wl + WIN_OFF), M, NIN, D}; pg8::StaticOrder S; S.init(M, NIN, G, bx);
          pg8::EpiQKV E{QKV, ROPE, QSCALE, pg8::RowLN{ST + (size_t)((k - 1) & 1) * M * 2, cb, cb + CSBW_N}};
          for (int rep = 0; rep < REP_G3; ++rep) pg8::gemm_phase<pg8::EpiQKV, pg8::StaticOrder, true, true>(lds, g, S, E, wave); }
        GSYNC();
        {
            const float lam_init = args.lam_init[l], lam = LAMV[l];
            const float* subg = args.in[5] + (size_t)l * 128; const float* sink = args.in[6] + (size_t)l * 8;
            for (int rep = 0; rep < REP_DIFF; ++rep)
            for (int u = vcu; u < 2048; u += G) att::diff_unit(lds, wave, cur_lane(), QKV, YM, u, lam, 1.0f - lam_init, subg);
            for (int rep = 0; rep < REP_SWA; ++rep)
            for (int u = vcu; u < 2048; u += G) att::swa_unit(lds, wave, cur_lane(), QKV, YM, u, sink);
        }
        GSYNC();
        { const int k = 3 * l + 1;
          pg8::Gemm g{YM, (const bf16*)(wl + WO_OFF), M, D, D}; pg8::StaticOrder S; S.init(M, D, G, bx);
          for (int rep = 0; rep < REP_OPROJ; ++rep) { pg8::EpiNull EN{ROPE}; pg8::gemm_phase<pg8::EpiNull, pg8::StaticOrder, true, true>(lds, g, S, EN, wave); }
          pg8::EpiRes E{x_in, XB, ST + (size_t)((k - 1) & 1) * M * 2, lng + (size_t)(k - 1) * D, lnb + (size_t)(k - 1) * D, ST + (size_t)(k & 1) * M * 2, ALPHA, 1.0f};
          pg8::gemm_phase<pg8::EpiRes, pg8::StaticOrder, true, true>(lds, g, S, E, wave); }
        GSYNC();
        { const int k = 3 * l + 2; ZERO_ST(k & 1);
          const float* cb = CSBW + (size_t)((l * 3 + 2) * 2) * CSBW_N;
          pg8::Gemm g{XB, (const bf16*)(wl + W3_OFF), M, 2 * FF, D}; pg8::StaticOrder S; S.init(M, 2 * FF, G, bx);
          pg8::EpiSwiGLU E{HB, FF, pg8::RowLN{ST + (size_t)((k - 1) & 1) * M * 2, cb, cb + CSBW_N}};
          for (int rep = 0; rep < REP_G1; ++rep) pg8::gemm_phase<pg8::EpiSwiGLU, pg8::StaticOrder, true, true>(lds, g, S, E, wave); }
        GSYNC();
        { const int k = 3 * l + 2;
          pg8::Gemm g{HB, (const bf16*)(wl + W4_OFF), M, D, FF}; pg8::StaticOrder S; S.init(M, D, G, bx);
          for (int rep = 0; rep < REP_FOUT; ++rep) { pg8::EpiNull EN{ROPE}; pg8::gemm_phase<pg8::EpiNull, pg8::StaticOrder, true, true>(lds, g, S, EN, wave); }
          for (int rep = 0; rep < REP_RES; ++rep) { pg8::EpiRes ED{x_in, (bf16*)out, ST, lng, lnb, out + (size_t)48 * 1024 * 1024, ALPHA, 0.5f}; pg8::gemm_phase<pg8::EpiRes, pg8::StaticOrder, true, true>(lds, g, S, ED, wave); }
          pg8::EpiRes E{x_in, XB, ST + (size_t)((k - 1) & 1) * M * 2, lng + (size_t)(k - 1) * D, lnb + (size_t)(k - 1) * D, ST + (size_t)(k & 1) * M * 2, ALPHA, 0.5f};
          pg8::gemm_phase<pg8::EpiRes, pg8::StaticOrder, true, true>(lds, g, S, E, wave); }
        GSYNC();
    }
    for (int m = gw; m < M; m += NGW) ln_row_h(XB + (size_t)m * D, args.in[11] + (size_t)11 * D, args.in[12] + (size_t)11 * D, out + (size_t)m * D, cur_lane());
}

extern "C" void kernel_launch(void* const* d_in, const int* in_sizes, int n_in, void* d_out, int out_size, void* d_ws, size_t ws_size, hipStream_t stream) {
    static int grid = 0;
    if (grid == 0) {
        if (n_in != 13 || in_sizes[0] != M * D || out_size != M * D || ws_size < WS_END) { fprintf(stderr, "kernel_launch: unexpected shapes (n_in %d, in0 %d, out %d, ws %zu); nothing launched\n", n_in, n_in > 0 ? in_sizes[0] : -1, out_size, ws_size); grid = -1; return; }
        int dev = 0, cus = 0, per_cu = 0;
        if (hipGetDevice(&dev) != hipSuccess || hipDeviceGetAttribute(&cus, hipDeviceAttributeMultiprocessorCount, dev) != hipSuccess) { grid = -1; return; }
        if (hipFuncSetAttribute((const void*)fwd_megakernel, hipFuncAttributeMaxDynamicSharedMemorySize, LDS_BYTES) != hipSuccess) { fprintf(stderr, "kernel_launch: hipFuncSetAttribute failed\n"); grid = -1; return; }
        if (hipOccupancyMaxActiveBlocksPerMultiprocessor(&per_cu, (const void*)fwd_megakernel, NWAVES * 64, LDS_BYTES) != hipSuccess || per_cu < 1) { fprintf(stderr, "kernel_launch: occupancy query gives %d\n", per_cu); per_cu = 1; }
        (void)hipGetLastError();
        grid = cus * 1;
    }
    if (grid < 0) return;
    if (hipMemsetAsync((char*)d_ws + WS_CTL, 0, CTL_ZERO_BYTES, stream) != hipSuccess) { fprintf(stderr, "kernel_launch: memset of the barrier words failed\n"); return; }
    Args a{};
    for (int i = 0; i < 13; ++i) a.in[i] = (const float*)d_in[i];
    a.out = (float*)d_out; a.ws = (unsigned char*)d_ws;
    for (int i = 0; i < 32; ++i) a.inv[i] = (float)pow(10000.0, -(double)(2 * i) / 64.0);
    for (int l = 0; l < 4; ++l) a.lam_init[l] = (float)(0.8 - 0.6 * exp(-0.3 * (double)l));
    void* kargs[] = {&a};
    const hipError_t e = hipLaunchCooperativeKernel((const void*)fwd_megakernel, dim3(grid), dim3(NWAVES * 64), kargs, LDS_BYTES, stream);
    if (e != hipSuccess) fprintf(stderr, "kernel_launch: cooperative launch failed: %s (grid %d)\n", hipGetErrorString(e), grid);
}
```

```cpp
#include <hip/hip_runtime.h>
#include <hip/hip_cooperative_groups.h>
#include <cstdio>
#include <cstdint>
#include <cmath>
namespace cg = cooperative_groups;
namespace pg8 {
#define PG8_LAS __attribute__((address_space(3)))
typedef unsigned short bf16_t;
typedef short bf16x8 __attribute__((ext_vector_type(8)));
typedef float f32x4 __attribute__((ext_vector_type(4)));
typedef unsigned u32x4 __attribute__((ext_vector_type(4)));
constexpr int BM = 256, BK = 64, HALF = 128, HTB = HALF * BK * 2  , STAGE_BYTES = 8 * HTB, NXCD = 8, WGM = 8;

__host__ __device__ __forceinline__ int lds_byte(int r, int c) { const int st = (r >> 4) * 2 + (c >> 5), rr = r & 15, cc = c & 31, ob = rr * 64 + cc * 2; return st * 1024 + (ob ^ (((ob >> 9) & 1) << 5)); }
__host__ __device__ __forceinline__ void stage_rc(int b, int& R, int& C) { const int st = b / 1024, sb = b % 1024, swz = sb ^ (((sb >> 9) & 1) << 5); R = (st >> 1) * 16 + swz / 64; C = (st & 1) * 32 + (swz % 64) / 2; }
__host__ __device__ __forceinline__ int perm32(int rho) { const int n = rho >> 4, i = rho & 15; return 8 * (i >> 2) + 4 * n + (i & 3); }

struct Unit { int pm, pn; };
struct Gemm { const bf16_t* A; const bf16_t* Bt; int M, N, K; };

struct StaticOrder {
    int nM, nN, nwg, G, c;
    __host__ __device__ void init(int M, int N, int G_, int c_) { nM = M / BM; nN = N / BM; nwg = nM * nN; G = G_; c = c_; }
    __host__ __device__ bool next(int i, Unit& u) const {
        const long L = (long)i * G + c; if (L >= nwg) return false;
        int wgid = (int)L; { const int q = nwg / NXCD, r = nwg % NXCD, xcd = wgid % NXCD, off = wgid / NXCD; wgid = (xcd < r ? xcd * (q + 1) : r * (q + 1) + (xcd - r) * q) + off; }
        const int nig = WGM * nN, gid = wgid / nig, fm = gid * WGM, gsz = (nM - fm) < WGM ? (nM - fm) : WGM;
        u.pm = fm + ((wgid % nig) % gsz); u.pn = (wgid % nig) / gsz; return true;
    }
    __device__ __forceinline__ void a_ready(const Unit&) const {}
    __device__ __forceinline__ void done(const Unit&) const {}
};

typedef float f32x2_t __attribute__((ext_vector_type(2))); typedef __bf16 bf16x2_t __attribute__((ext_vector_type(2)));
__device__ __forceinline__ unsigned cvtpk(float lo, float hi) { f32x2_t v = {lo, hi}; bf16x2_t b = __builtin_convertvector(v, bf16x2_t); return __builtin_bit_cast(unsigned, b); }
typedef _Float16 f16x8 __attribute__((ext_vector_type(8))); typedef _Float16 f16x2_t __attribute__((ext_vector_type(2)));
template <bool F16> __device__ __forceinline__ f32x4 mma16(bf16x8 a, bf16x8 b, f32x4 c) {
    if constexpr (F16) return __builtin_amdgcn_mfma_f32_16x16x32_f16(__builtin_bit_cast(f16x8, a), __builtin_bit_cast(f16x8, b), c, 0, 0, 0);
    else return __builtin_amdgcn_mfma_f32_16x16x32_bf16(a, b, c, 0, 0, 0);
}
__device__ __forceinline__ unsigned cvtpk_h(float lo, float hi) { f16x2_t v = {(_Float16)lo, (_Float16)hi}; return __builtin_bit_cast(unsigned, v); }
__device__ __forceinline__ float silu_f(float g) { return g * __builtin_amdgcn_rcpf(1.0f + __builtin_amdgcn_exp2f(-1.4426950408889634f * g)); }

typedef float f32x2v __attribute__((ext_vector_type(2)));
struct RowLN {
    const float* st; const float* cs; const float* bw;
    __device__ __forceinline__ void row(int r, float& a, float& c) const {
        if (st) { const f32x2v s = *(const f32x2v*)(st + 2 * (size_t)r); const float mu = s.x * (1.0f / 1024.0f), var = s.y * (1.0f / 1024.0f) - mu * mu; a = rsqrtf(var + 1e-5f); c = -a * mu; }
        else { a = 1.0f; c = 0.0f; }
    }
};
struct EpiSwiGLU {
    static constexpr bool PERM = true, AFTER_DRAIN = false, F16 = true;
    bf16_t* H; int ldh; RowLN ln;
    __device__ __forceinline__ void operator()(const f32x4 (&acc)[2][2][4][2], const Unit& u, int wr, int wc, int fr, int fq) const {
        const int row0 = u.pm * BM + wr * 64 + fr, col0 = u.pn * HALF + wc * 32 + 8 * fq, wrow0 = u.pn * BM + wc * 32 + 8 * fq;
        f32x4 cs[2][2], bw[2][2]; float ra[8], rc[8];
#pragma unroll
        for (int bj = 0; bj < 2; ++bj)
#pragma unroll
            for (int n = 0; n < 2; ++n) { const f32x4 z = (f32x4){0.f, 0.f, 0.f, 0.f}; cs[bj][n] = ln.st ? *(const f32x4*)(ln.cs + wrow0 + bj * HALF + 4 * n) : z; bw[bj][n] = ln.st ? *(const f32x4*)(ln.bw + wrow0 + bj * HALF + 4 * n) : z; }
#pragma unroll
        for (int i = 0; i < 8; ++i) ln.row(row0 + (i >> 2) * HALF + (i & 3) * 16, ra[i], rc[i]);
        asm volatile("" ::: "memory");
#pragma unroll
        for (int ai = 0; ai < 2; ++ai)
#pragma unroll
            for (int m = 0; m < 4; ++m) {
                const int row = row0 + ai * HALF + m * 16; const float a = ra[ai * 4 + m], c = rc[ai * 4 + m];
                const f32x4 g0 = acc[ai][0][m][0] * a + cs[0][0] * c + bw[0][0], g1 = acc[ai][0][m][1] * a + cs[0][1] * c + bw[0][1];
                const f32x4 u0 = acc[ai][1][m][0] * a + cs[1][0] * c + bw[1][0], u1 = acc[ai][1][m][1] * a + cs[1][1] * c + bw[1][1];
                u32x4 w;
                w.x = cvtpk(silu_f(g0[0]) * u0[0], silu_f(g0[1]) * u0[1]); w.y = cvtpk(silu_f(g0[2]) * u0[2], silu_f(g0[3]) * u0[3]);
                w.z = cvtpk(silu_f(g1[0]) * u1[0], silu_f(g1[1]) * u1[1]); w.w = cvtpk(silu_f(g1[2]) * u1[2], silu_f(g1[3]) * u1[3]);
                *(u32x4*)(H + (size_t)row * ldh + col0) = w;
            }
    }
};
struct EpiRes {
    static constexpr bool PERM = true, AFTER_DRAIN = false, F16 = false;
    const float* x0; bf16_t* yh; const float* st; const float* g; const float* b; float* st_new; float alpha, s;
    __device__ __forceinline__ void operator()(const f32x4 (&acc)[2][2][4][2], const Unit& u, int wr, int wc, int fr, int fq) const {
        const int row0 = u.pm * BM + wr * 64 + fr, col0 = u.pn * BM + wc * 64 + 8 * fq;
        f32x4 gv[2][2], bv[2][2];
#pragma unroll
        for (int bj = 0; bj < 2; ++bj)
#pragma unroll
            for (int n = 0; n < 2; ++n) { gv[bj][n] = st ? *(const f32x4*)(g + col0 + bj * 32 + 4 * n) : (f32x4){1.f, 1.f, 1.f, 1.f}; bv[bj][n] = st ? *(const f32x4*)(b + col0 + bj * 32 + 4 * n) : (f32x4){0.f, 0.f, 0.f, 0.f}; }
#pragma unroll
        for (int ai = 0; ai < 2; ++ai) {
            f16x8 hv[4][2]; float ra[4], rmu[4];
#pragma unroll
            for (int m = 0; m < 4; ++m) {
                const int row = row0 + ai * HALF + m * 16; const size_t off = (size_t)row * 1024 + col0;
                ra[m] = 1.0f; rmu[m] = 0.0f;
                if (st) {
                    const f32x2v sv = *(const f32x2v*)(st + 2 * (size_t)row); rmu[m] = sv.x * (1.0f / 1024.0f); ra[m] = rsqrtf(sv.y * (1.0f / 1024.0f) - rmu[m] * rmu[m] + 1e-5f);
                    hv[m][0] = *(const f16x8*)(yh + off); hv[m][1] = *(const f16x8*)(yh + off + 32);
                }
            }
            asm volatile("" ::: "memory");
#pragma unroll
            for (int m = 0; m < 4; ++m) {
                const int row = row0 + ai * HALF + m * 16; const size_t off = (size_t)row * 1024 + col0;
                float s1 = 0.f, s2 = 0.f;
#pragma unroll
                for (int bj = 0; bj < 2; ++bj) {
                    f32x4 yp[2];
                    if (st) { const f16x8 h = hv[m][bj]; yp[0] = (f32x4){(float)h[0], (float)h[1], (float)h[2], (float)h[3]}; yp[1] = (f32x4){(float)h[4], (float)h[5], (float)h[6], (float)h[7]}; }
                    else { yp[0] = *(const f32x4*)(x0 + off + bj * 32); yp[1] = *(const f32x4*)(x0 + off + bj * 32 + 4); }
                    f32x4 y[2];
#pragma unroll
                    for (int n = 0; n < 2; ++n) { const f32x4 x = (yp[n] - rmu[m]) * ra[m] * gv[bj][n] + bv[bj][n];
                        y[n] = x * alpha + acc[ai][bj][m][n] * s;
                        s1 += (y[n][0] + y[n][1]) + (y[n][2] + y[n][3]); s2 += (y[n][0] * y[n][0] + y[n][1] * y[n][1]) + (y[n][2] * y[n][2] + y[n][3] * y[n][3]); }
                    u32x4 w; w.x = cvtpk_h(y[0][0], y[0][1]); w.y = cvtpk_h(y[0][2], y[0][3]); w.z = cvtpk_h(y[1][0], y[1][1]); w.w = cvtpk_h(y[1][2], y[1][3]);
                    *(u32x4*)(yh + off + bj * 32) = w;
                }
                s1 += __shfl_xor(s1, 16); s1 += __shfl_xor(s1, 32); s2 += __shfl_xor(s2, 16); s2 += __shfl_xor(s2, 32);
                if (fq == 0) { atomicAdd(st_new + 2 * (size_t)row, s1); atomicAdd(st_new + 2 * (size_t)row + 1, s2); }
            }
            asm volatile("" ::: "memory");
        }
    }
};
struct EpiNull {
    static constexpr bool PERM = true, AFTER_DRAIN = false, F16 = false;
    float* sink;
    __device__ __forceinline__ void operator()(const f32x4 (&acc)[2][2][4][2], const Unit& u, int wr, int wc, int fr, int fq) const {
        f32x4 t = (f32x4){0.f, 0.f, 0.f, 0.f};
#pragma unroll
        for (int ai = 0; ai < 2; ++ai)
#pragma unroll
            for (int bj = 0; bj < 2; ++bj)
#pragma unroll
                for (int m = 0; m < 4; ++m) { t += acc[ai][bj][m][0]; t += acc[ai][bj][m][1]; }
        if (t[0] + t[1] + t[2] + t[3] == 12345.678f) *sink = t[0];
    }
};
struct EpiQKV {
    static constexpr bool PERM = true, AFTER_DRAIN = false, F16 = true;
    bf16_t* O; const unsigned* rope; float qscale; RowLN ln;
    __device__ __forceinline__ void operator()(const f32x4 (&acc)[2][2][4][2], const Unit& u, int wr, int wc, int fr, int fq) const {
        const int pn = u.pn, row0 = u.pm * BM + wr * 64 + fr, col0 = pn * BM + wc * 32 + 8 * fq, i0 = 16 * (wc & 1) + 4 * fq;
        const bool anyrope = (pn != 4 && pn != 5);
        const float sc = (pn < 2 || pn == 6 || pn == 7) ? qscale : 1.0f;
        f32x4 cs[2][2], bw[2][2];
#pragma unroll
        for (int bj = 0; bj < 2; ++bj)
#pragma unroll
            for (int n = 0; n < 2; ++n) { cs[bj][n] = *(const f32x4*)(ln.cs + col0 + bj * HALF + 4 * n); bw[bj][n] = *(const f32x4*)(ln.bw + col0 + bj * HALF + 4 * n); }
#pragma unroll
        for (int ai = 0; ai < 2; ++ai) {
            f16x8 rp4[4]; float ra[4], rc[4];
#pragma unroll
            for (int m = 0; m < 4; ++m) ln.row(row0 + ai * HALF + m * 16, ra[m], rc[m]);
#pragma unroll
            for (int m = 0; m < 4; ++m) { const int row = row0 + ai * HALF + m * 16;
                if (anyrope) rp4[m] = *(const f16x8*)(rope + (size_t)row * 32 + i0); else rp4[m] = (f16x8){1, 0, 1, 0, 1, 0, 1, 0}; }
            asm volatile("" ::: "memory");
#pragma unroll
            for (int m = 0; m < 4; ++m) {
                const int row = row0 + ai * HALF + m * 16; const float a = ra[m], c = rc[m];
                const f16x8 h = rp4[m];
                const float c0 = (float)h[0], s0 = (float)h[1], c1 = (float)h[2], s1 = (float)h[3], c2 = (float)h[4], s2 = (float)h[5], c3 = (float)h[6], s3 = (float)h[7];
#pragma unroll
                for (int bj = 0; bj < 2; ++bj) {
                    const bool rp = anyrope && !(pn == 8 && bj == 1);
                    f32x4 v0 = acc[ai][bj][m][0] * a + cs[bj][0] * c + bw[bj][0], v1 = acc[ai][bj][m][1] * a + cs[bj][1] * c + bw[bj][1];
                    if (rp) {
                        const f32x4 a0 = v0, a1 = v1;
                        v0[0] = a0[0] * c0 - a0[1] * s0; v0[1] = a0[1] * c0 + a0[0] * s0;
                        v0[2] = a0[2] * c1 - a0[3] * s1; v0[3] = a0[3] * c1 + a0[2] * s1;
                        v1[0] = a1[0] * c2 - a1[1] * s2; v1[1] = a1[1] * c2 + a1[0] * s2;
                        v1[2] = a1[2] * c3 - a1[3] * s3; v1[3] = a1[3] * c3 + a1[2] * s3;
                    }
                    v0 = v0 * sc; v1 = v1 * sc;
                    u32x4 w; w.x = cvtpk(v0[0], v0[1]); w.y = cvtpk(v0[2], v0[3]); w.z = cvtpk(v1[0], v1[1]); w.w = cvtpk(v1[2], v1[3]);
                    *(u32x4*)(O + (size_t)row * 2304 + col0 + bj * HALF) = w;
                }
            }
            asm volatile("" ::: "memory");
        }
    }
};

template <class Epi, class Sched, bool ALIGN_EPI = false, bool SP2 = false>
__device__ __forceinline__ void gemm_phase(PG8_LAS unsigned char* lds, const Gemm g, const Sched& S, const Epi& E, const int wave_in) {
    int tid_; asm volatile("v_mbcnt_lo_u32_b32 %0, -1, 0\n\tv_mbcnt_hi_u32_b32 %0, -1, %0" : "=v"(tid_)); tid_ += 64 * wave_in;
    const int tid = tid_, wid = __builtin_amdgcn_readfirstlane(tid >> 6), lane = tid & 63, wr = wid >> 2, wc = wid & 3, fr = lane & 15, fq = lane >> 4;
    const int K = g.K, nt = K / BK;
    unsigned voffA[2], voffB[2];
#pragma unroll
    for (int i = 0; i < 2; ++i) { int R, C; stage_rc(tid * 16 + i * 8192, R, C); const int Rb = Epi::PERM ? ((R & ~31) + perm32(R & 31)) : R;
        voffA[i] = (unsigned)(R * K + C) * 2u; voffB[i] = (unsigned)(Rb * K + C) * 2u; }
    const size_t kstep = (size_t)(BK * 2);
    const size_t hstep = (size_t)HALF * K * 2;
    const size_t tstep = 2 * hstep;
    const unsigned ldsw = (unsigned)wid * 1024u;
    const int aoff = lds_byte(wr * 64 + fr, fq * 8), boff = lds_byte(wc * 32 + fr, fq * 8);
#define PG8_SA(b, h) (((b) * 2 + (h)) * HTB)
#define PG8_SB(b, h) ((4 + (b) * 2 + (h)) * HTB)
#define PG8_STAGE(bufoff, gbase, voff) do { _Pragma("unroll") for (int _i = 0; _i < 2; ++_i) \
        __builtin_amdgcn_global_load_lds((const unsigned*)((const char*)(gbase) + (voff)[_i]), (PG8_LAS unsigned*)(lds + (bufoff) + ldsw + _i * 8192), 16, 0, 0); } while (0)
#define PG8_LDA(dst, b, h) do { _Pragma("unroll") for (int m = 0; m < 4; ++m) _Pragma("unroll") for (int k = 0; k < 2; ++k) dst[m][k] = *(const PG8_LAS bf16x8*)(lds + PG8_SA(b, h) + aoff + m * 2048 + k * 1024); } while (0)
#define PG8_LDB(dst, b, h) do { _Pragma("unroll") for (int n = 0; n < 2; ++n) _Pragma("unroll") for (int k = 0; k < 2; ++k) dst[n][k] = *(const PG8_LAS bf16x8*)(lds + PG8_SB(b, h) + boff + n * 2048 + k * 1024); } while (0)
#define PG8_MMA(ai, bj, At, Bt) do { __builtin_amdgcn_s_setprio(1); _Pragma("unroll") for (int m = 0; m < 4; ++m) _Pragma("unroll") for (int n = 0; n < 2; ++n) _Pragma("unroll") for (int k = 0; k < 2; ++k) \
        acc[ai][bj][m][n] = mma16<Epi::F16>(Bt[n][k], At[m][k], acc[ai][bj][m][n]); __builtin_amdgcn_s_setprio(0); } while (0)
#define PG8_WAIT_V(n) asm volatile("s_waitcnt vmcnt(" #n ")" ::: "memory")
#define PG8_WAIT_L(n) asm volatile("s_waitcnt lgkmcnt(" #n ")" ::: "memory")
#define PG8_BAR __builtin_amdgcn_s_barrier()
#define PG8_SCHED __builtin_amdgcn_sched_barrier(0)
    Unit cur, nxt; int ui = 0;
    if (!S.next(0, cur)) return;
    f32x4 acc[2][2][4][2];
#pragma unroll
    for (int a = 0; a < 2; ++a)
#pragma unroll
        for (int b = 0; b < 2; ++b)
#pragma unroll
            for (int m = 0; m < 4; ++m)
#pragma unroll
                for (int n = 0; n < 2; ++n) acc[a][b][m][n] = (f32x4){0.f, 0.f, 0.f, 0.f};
    bf16x8 At[4][2], B0[2][2], B1[2][2];
    const char* cA = (const char*)g.A + (size_t)cur.pm * tstep; const char* cB = (const char*)g.Bt + (size_t)cur.pn * tstep;
    S.a_ready(cur);
    if constexpr (SP2) {
        PG8_STAGE(PG8_SB(0, 0), cB, voffB); PG8_STAGE(PG8_SB(0, 1), cB + hstep, voffB); PG8_STAGE(PG8_SA(0, 0), cA, voffA); PG8_STAGE(PG8_SA(0, 1), cA + hstep, voffA);
        if (wr == 1) PG8_BAR;
        PG8_WAIT_V(2); PG8_BAR;
        PG8_STAGE(PG8_SB(1, 0), cB + kstep, voffB); PG8_STAGE(PG8_SA(1, 0), cA + kstep, voffA); PG8_STAGE(PG8_SB(1, 1), cB + hstep + kstep, voffB);
        PG8_WAIT_V(6); PG8_BAR;
    } else {
        PG8_STAGE(PG8_SB(0, 0), cB, voffB); PG8_STAGE(PG8_SA(0, 0), cA, voffA); PG8_STAGE(PG8_SB(0, 1), cB + hstep, voffB); PG8_STAGE(PG8_SA(0, 1), cA + hstep, voffA);
        if (wr == 1) PG8_BAR;
        PG8_WAIT_V(4); PG8_BAR;
        PG8_STAGE(PG8_SB(1, 0), cB + kstep, voffB); PG8_STAGE(PG8_SA(1, 0), cA + kstep, voffA); PG8_STAGE(PG8_SB(1, 1), cB + hstep + kstep, voffB);
        PG8_WAIT_V(6); PG8_BAR;
    }
    for (;;) {
        const bool has_next = S.next(ui + 1, nxt);
        const char* nA = has_next ? (const char*)g.A + (size_t)nxt.pm * tstep : cA; const char* nB = has_next ? (const char*)g.Bt + (size_t)nxt.pn * tstep : cB;
        for (int t = 0; t < nt; t += 2) {
            const bool last = (t == nt - 2);
            const char* a1 = cA + (size_t)(t + 1) * kstep;
            const char* a2 = last ? nA : cA + (size_t)(t + 2) * kstep; const char* b2 = last ? nB : cB + (size_t)(t + 2) * kstep;
            const char* a3 = a2 + kstep; const char* b3 = b2 + kstep;
            if (last && has_next) S.a_ready(nxt);
            if constexpr (SP2) {
            PG8_LDB(B0, 0, 0); PG8_LDB(B1, 0, 1); PG8_SCHED; PG8_LDA(At, 0, 0); PG8_STAGE(PG8_SA(1, 1), a1 + hstep, voffA);
            PG8_WAIT_V(8); PG8_WAIT_L(0); PG8_BAR; PG8_MMA(0, 0, At, B0); PG8_MMA(0, 1, At, B1); PG8_BAR; PG8_SCHED;
            PG8_LDA(At, 0, 1); PG8_STAGE(PG8_SB(0, 0), b2, voffB); PG8_STAGE(PG8_SB(0, 1), b2 + hstep, voffB); PG8_STAGE(PG8_SA(0, 0), a2, voffA);
            PG8_WAIT_V(8); PG8_WAIT_L(0); PG8_BAR; PG8_MMA(1, 0, At, B0); PG8_MMA(1, 1, At, B1); PG8_BAR; PG8_SCHED;
            PG8_LDB(B0, 1, 0); PG8_LDB(B1, 1, 1); PG8_SCHED; PG8_LDA(At, 1, 0); PG8_STAGE(PG8_SA(0, 1), a2 + hstep, voffA);
            PG8_WAIT_V(8); PG8_WAIT_L(0); PG8_BAR; PG8_MMA(0, 0, At, B0); PG8_MMA(0, 1, At, B1); PG8_BAR; PG8_SCHED;
            PG8_LDA(At, 1, 1); PG8_STAGE(PG8_SB(1, 0), b3, voffB); PG8_STAGE(PG8_SB(1, 1), b3 + hstep, voffB); PG8_STAGE(PG8_SA(1, 0), a3, voffA);
            PG8_WAIT_V(8); PG8_WAIT_L(0); PG8_BAR; PG8_MMA(1, 0, At, B0); PG8_MMA(1, 1, At, B1); PG8_BAR; PG8_SCHED;
            } else {
            PG8_LDB(B0, 0, 0); PG8_SCHED; PG8_LDA(At, 0, 0); PG8_STAGE(PG8_SA(1, 1), a1 + hstep, voffA);
            PG8_WAIT_L(8); PG8_BAR; PG8_WAIT_L(0); PG8_MMA(0, 0, At, B0); PG8_BAR; PG8_SCHED;
            PG8_LDB(B1, 0, 1); PG8_STAGE(PG8_SB(0, 0), b2, voffB);
            PG8_BAR; PG8_WAIT_L(0); PG8_MMA(0, 1, At, B1); PG8_BAR;
            PG8_LDA(At, 0, 1); PG8_STAGE(PG8_SA(0, 0), a2, voffA);
            PG8_BAR; PG8_WAIT_L(0); PG8_MMA(1, 0, At, B0); PG8_BAR; PG8_SCHED;
            PG8_STAGE(PG8_SB(0, 1), b2 + hstep, voffB);
            PG8_WAIT_V(6); PG8_BAR; PG8_MMA(1, 1, At, B1); PG8_BAR;
            PG8_LDB(B0, 1, 0); PG8_SCHED; PG8_LDA(At, 1, 0); PG8_STAGE(PG8_SA(0, 1), a2 + hstep, voffA);
            PG8_WAIT_L(8); PG8_BAR; PG8_WAIT_L(0); PG8_MMA(0, 0, At, B0); PG8_BAR; PG8_SCHED;
            PG8_LDB(B1, 1, 1); PG8_STAGE(PG8_SB(1, 0), b3, voffB);
            PG8_BAR; PG8_WAIT_L(0); PG8_MMA(0, 1, At, B1); PG8_BAR;
            PG8_LDA(At, 1, 1); PG8_STAGE(PG8_SA(1, 0), a3, voffA);
            PG8_BAR; PG8_WAIT_L(0); PG8_MMA(1, 0, At, B0); PG8_BAR; PG8_SCHED;
            PG8_STAGE(PG8_SB(1, 1), b3 + hstep, voffB);
            PG8_WAIT_V(6); PG8_BAR; PG8_MMA(1, 1, At, B1); PG8_BAR;
            }
        }
        if constexpr (ALIGN_EPI) { if (wr == 0) PG8_BAR; }
        if constexpr (!Epi::AFTER_DRAIN) { E(acc, cur, wr, wc, fr, fq); S.done(cur); }
        if (!has_next) break;
#pragma unroll
        for (int a = 0; a < 2; ++a)
#pragma unroll
            for (int b = 0; b < 2; ++b)
#pragma unroll
                for (int m = 0; m < 4; ++m)
#pragma unroll
                    for (int n = 0; n < 2; ++n) acc[a][b][m][n] = (f32x4){0.f, 0.f, 0.f, 0.f};
        cur = nxt; cA = nA; cB = nB; ++ui;
        if constexpr (ALIGN_EPI) { if (wr == 1) PG8_BAR; }
    }
    PG8_WAIT_V(0);
    if constexpr (!ALIGN_EPI) { if (wr == 0) PG8_BAR; }
    PG8_BAR;
    if constexpr (Epi::AFTER_DRAIN) { E.fused(acc, cur, wr, wc, fr, fq, lds, wid, lane); S.done(cur); }
#undef PG8_SA
#undef PG8_SB
#undef PG8_STAGE
#undef PG8_LDA
#undef PG8_LDB
#undef PG8_MMA
#undef PG8_WAIT_V
#undef PG8_WAIT_L
#undef PG8_BAR
#undef PG8_SCHED
}
}

namespace att {
using pg8::bf16_t; using pg8::bf16x8; using pg8::f32x4; using pg8::u32x4; using pg8::cvtpk;
#define ALDS __attribute__((address_space(3)))
typedef float f32x16 __attribute__((ext_vector_type(16)));
typedef short s16x4 __attribute__((ext_vector_type(4)));
typedef unsigned u32x2 __attribute__((ext_vector_type(2)));
constexpr int PITCH = 2304;
constexpr float THR = 8.0f;
__device__ __forceinline__ void glds16(const void* gsrc, unsigned lds_dst) { unsigned keep;
    asm volatile("s_mov_b32 %0, m0\n\ts_mov_b32 m0, %2\n\ts_nop 0\n\tglobal_load_lds_dwordx4 %1, off\n\ts_mov_b32 m0, %0" : "=&s"(keep) : "v"(gsrc), "s"(lds_dst) : "memory"); }
__device__ __forceinline__ unsigned rfl(unsigned v) { return (unsigned)__builtin_amdgcn_readfirstlane((int)v); }
__device__ __forceinline__ int pi23(int x) { return (x & ~12) | ((x & 4) << 1) | ((x & 8) >> 1); }
__device__ __forceinline__ s16x4 vtr(const ALDS unsigned char* p) { return __builtin_bit_cast(s16x4, __builtin_amdgcn_ds_read_tr16_b64_v4i16((ALDS s16x4*)p)); }
__device__ __forceinline__ float halfswap_max(float v) { auto rr = __builtin_amdgcn_permlane32_swap(__float_as_uint(v), __float_as_uint(v), false, false); return fmaxf(__uint_as_float(rr[0]), __uint_as_float(rr[1])); }
__device__ __forceinline__ float halfswap_sum(float v) { auto rr = __builtin_amdgcn_permlane32_swap(__float_as_uint(v), __float_as_uint(v), false, false); return __uint_as_float(rr[0]) + __uint_as_float(rr[1]); }

template <int DV, bool BAND>
__device__ __forceinline__ float attn_core(ALDS unsigned char* ring, const int wid, const int lane,
                                           const bf16_t* Qw, const bf16_t* ksrc, const bf16_t* vsrc, const int koff,
                                           const int t0, const int t1, const int tq, const int qpos, const float m_init, float l, f32x16 (&o)[DV / 32]) {
    constexpr int NDB = DV / 32, SLOT = (DV == 128) ? 32768 : 16384, VOFF = (DV == 128) ? 16384 : 8192, ROWB = DV * 2, NP = (DV == 128) ? 4 : 2;
    const int r32 = lane & 31, hi = lane >> 5;
    const unsigned ring_a = (unsigned)(uintptr_t)ring;
    bf16x8 qr[4];
#pragma unroll
    for (int d0 = 0; d0 < 4; ++d0) qr[d0] = *(const bf16x8*)(Qw + (size_t)r32 * PITCH + d0 * 16 + hi * 8);
#define ATT_ISSUE(t_, so_) do { const size_t go_ = (size_t)(t_) * (64 * PITCH); const unsigned d_ = ring_a + (unsigned)(so_) + (unsigned)wid * 1024u; \
        glds16(ksrc + go_, rfl(d_)); \
        if (DV == 128) { glds16(ksrc + go_ + 64, rfl(d_ + 8192u)); glds16(vsrc + go_, rfl(ring_a + (unsigned)(so_) + (unsigned)VOFF + (unsigned)wid * 2048u)); \
                         glds16(vsrc + go_ + 4 * PITCH, rfl(ring_a + (unsigned)(so_) + (unsigned)VOFF + (unsigned)wid * 2048u + 1024u)); } \
        else { glds16(vsrc + go_, rfl(d_ + (unsigned)VOFF)); } } while (0)
#define ATT_PIECE(i_, t_, so_) do { const size_t go_ = (size_t)(t_) * (64 * PITCH); const unsigned d_ = ring_a + (unsigned)(so_) + (unsigned)wid * 1024u; \
        if (DV == 128) { if ((i_) == 0) glds16(ksrc + go_, rfl(d_)); else if ((i_) == 1) glds16(ksrc + go_ + 64, rfl(d_ + 8192u)); \
                         else if ((i_) == 2) glds16(vsrc + go_, rfl(ring_a + (unsigned)(so_) + (unsigned)VOFF + (unsigned)wid * 2048u)); \
                         else glds16(vsrc + go_ + 4 * PITCH, rfl(ring_a + (unsigned)(so_) + (unsigned)VOFF + (unsigned)wid * 2048u + 1024u)); } \
        else { if ((i_) == 0) glds16(ksrc + go_, rfl(d_)); else if ((i_) == 2) glds16(vsrc + go_, rfl(d_ + (unsigned)VOFF)); } } while (0)
    ATT_ISSUE(t0, 0);
    { const int tn = (t0 + 1 < t1) ? t0 + 1 : t1 - 1; ATT_ISSUE(tn, SLOT); }
    const int g = (lane >> 4) & 1, q4 = (lane & 15) >> 2, p = lane & 3, sw = (DV == 128) ? q4 : (q4 >> 1);
    int va[NDB];
#pragma unroll
    for (int db = 0; db < NDB; ++db) va[db] = VOFF + (8 * hi + q4) * ROWB + ((db ^ sw) << 6) + (2 * g + (p >> 1)) * 16 + 8 * (p & 1);
    const int ka = koff + hi * 1024 + r32 * 16;
    float m = m_init;
    f32x16 negm;
#pragma unroll
    for (int r = 0; r < 16; ++r) negm[r] = -m;
#pragma unroll
    for (int db = 0; db < NDB; ++db)
#pragma unroll
        for (int r = 0; r < 16; ++r) o[db][r] = 0.f;
    if (wid >= 4) __builtin_amdgcn_s_setprio(1);
    int s_cur = 0, s_n2 = 2 * SLOT;
    for (int t = t0; t < t1; ++t) {
        asm volatile("s_waitcnt vmcnt(%0)" :: "n"(NP) : "memory");
        asm volatile("s_waitcnt lgkmcnt(0)\n\ts_barrier" ::: "memory");
        const int tn = (t + 2 < t1) ? t + 2 : t1 - 1;
        const ALDS unsigned char* sb = ring + s_cur;
        f32x16 p0 = negm, p1 = negm;
        bf16x8 kf[8];
#pragma unroll
        for (int d0 = 0; d0 < 4; ++d0) { kf[2 * d0] = *(const ALDS bf16x8*)(sb + ka + d0 * 2048); kf[2 * d0 + 1] = *(const ALDS bf16x8*)(sb + ka + d0 * 2048 + 512); }
        s16x4 vlo[2][NDB], vhh[2][NDB];
#pragma unroll
        for (int db = 0; db < NDB; ++db) { vlo[0][db] = vtr(sb + va[db]); vhh[0][db] = vtr(sb + va[db] + 4 * ROWB); }
        __builtin_amdgcn_sched_barrier(0);
#pragma unroll
        for (int d0 = 0; d0 < 4; ++d0) {
            p0 = __builtin_amdgcn_mfma_f32_32x32x16_bf16(kf[2 * d0], qr[d0], p0, 0, 0, 0);
            p1 = __builtin_amdgcn_mfma_f32_32x32x16_bf16(kf[2 * d0 + 1], qr[d0], p1, 0, 0, 0);
            __builtin_amdgcn_sched_barrier(0);
            ATT_PIECE(d0, tn, s_n2);
            __builtin_amdgcn_sched_barrier(0);
        }
        if (BAND) {
            if (t == tq - 2 || t == tq + 2) {
                const int rel0 = t * 64 + 8 * hi - qpos;
#pragma unroll
                for (int r = 0; r < 16; ++r) { const int rel = rel0 + 16 * (r >> 3) + (r & 7);
                    if (rel < -128 || rel > 128) p0[r] = -INFINITY;
                    if (rel + 32 < -128 || rel + 32 > 128) p1[r] = -INFINITY; }
            }
        }
        float mx = fmaxf(p0[0], p1[0]);
#pragma unroll
        for (int r = 1; r < 16; ++r) mx = fmaxf(fmaxf(mx, p0[r]), p1[r]);
        mx = halfswap_max(mx);
        const bool first = (!BAND) && (t == t0);
        const float dl = first ? mx : ((mx > THR) ? mx : 0.f);
        if (__any(dl != 0.f)) {
            m += dl;
#pragma unroll
            for (int r = 0; r < 16; ++r) { p0[r] -= dl; p1[r] -= dl; negm[r] = -m; }
            const float f = first ? 1.f : __builtin_amdgcn_exp2f(-dl);
            l *= f;
#pragma unroll
            for (int db = 0; db < NDB; ++db)
#pragma unroll
                for (int r = 0; r < 16; ++r) o[db][r] *= f;
        }
        float ssum = 0.f;
        bf16x8 pf;
#define ATT_EXP_SLICE(P_, B_, DST_) do { u32x4 w_; \
        P_[B_ + 0] = __builtin_amdgcn_exp2f(P_[B_ + 0]); P_[B_ + 1] = __builtin_amdgcn_exp2f(P_[B_ + 1]); P_[B_ + 2] = __builtin_amdgcn_exp2f(P_[B_ + 2]); P_[B_ + 3] = __builtin_amdgcn_exp2f(P_[B_ + 3]); \
        P_[B_ + 4] = __builtin_amdgcn_exp2f(P_[B_ + 4]); P_[B_ + 5] = __builtin_amdgcn_exp2f(P_[B_ + 5]); P_[B_ + 6] = __builtin_amdgcn_exp2f(P_[B_ + 6]); P_[B_ + 7] = __builtin_amdgcn_exp2f(P_[B_ + 7]); \
        ssum += ((P_[B_ + 0] + P_[B_ + 1]) + (P_[B_ + 2] + P_[B_ + 3])) + ((P_[B_ + 4] + P_[B_ + 5]) + (P_[B_ + 6] + P_[B_ + 7])); \
        w_.x = cvtpk(P_[B_ + 0], P_[B_ + 1]); w_.y = cvtpk(P_[B_ + 2], P_[B_ + 3]); w_.z = cvtpk(P_[B_ + 4], P_[B_ + 5]); w_.w = cvtpk(P_[B_ + 6], P_[B_ + 7]); DST_ = __builtin_bit_cast(bf16x8, w_); } while (0)
        ATT_EXP_SLICE(p0, 0, pf);
        __builtin_amdgcn_sched_barrier(0);
#pragma unroll
        for (int ks = 0; ks < 4; ++ks) {
            bf16x8 pfn = pf;
            if (ks + 1 < 4) {
#pragma unroll
                for (int db = 0; db < NDB; ++db) { vlo[(ks + 1) & 1][db] = vtr(sb + va[db] + (ks + 1) * (16 * ROWB)); vhh[(ks + 1) & 1][db] = vtr(sb + va[db] + (ks + 1) * (16 * ROWB) + 4 * ROWB); }
            }
#pragma unroll
            for (int db = 0; db < NDB; ++db) {
                const s16x4 lo = vlo[ks & 1][db], hh = vhh[ks & 1][db];
                const bf16x8 vf = (bf16x8){lo[0], lo[1], lo[2], lo[3], hh[0], hh[1], hh[2], hh[3]};
                o[db] = __builtin_amdgcn_mfma_f32_32x32x16_bf16(vf, pf, o[db], 0, 0, 0);
            }
            if (ks == 0) ATT_EXP_SLICE(p0, 8, pfn);
            if (ks == 1) ATT_EXP_SLICE(p1, 0, pfn);
            if (ks == 2) ATT_EXP_SLICE(p1, 8, pfn);
            if (ks + 1 < 4) {
                __builtin_amdgcn_sched_group_barrier(0x100, 2 * NDB, 0);
#pragma unroll
                for (int db = 0; db < NDB; ++db) { __builtin_amdgcn_sched_group_barrier(0x008, 1, 0); __builtin_amdgcn_sched_group_barrier(0x002, 20 / NDB, 0); }
            }
            __builtin_amdgcn_sched_barrier(0);
            pf = pfn;
        }
#undef ATT_EXP_SLICE
        l += ssum;
        s_cur = (s_cur == 2 * SLOT) ? 0 : s_cur + SLOT; s_n2 = (s_n2 == 2 * SLOT) ? 0 : s_n2 + SLOT;
    }
    __builtin_amdgcn_s_setprio(0);
    asm volatile("s_waitcnt vmcnt(0) lgkmcnt(0)\n\ts_barrier" ::: "memory");
#undef ATT_ISSUE
#undef ATT_PIECE
    return l;
}

__device__ __forceinline__ void diff_unit(ALDS unsigned char* ring, const int wid, int lane, const bf16_t* qkv, bf16_t* ymix, const int u, const float lam, const float post, const float* subg) {
    asm volatile("" : "+v"(lane));
    const int bh = u >> 5, qb = u & 31, b = bh >> 2, h = bh & 3, comp = wid >> 2, wq = wid & 3, r32 = lane & 31, hi = lane >> 5;
    const size_t rowbase = (size_t)b * 4096;
    const int q0 = qb * 128 + wq * 32;
    const bf16_t* Qw = qkv + (rowbase + q0) * PITCH + h * 128 + comp * 64;
    const bf16_t* ksrc = qkv + (rowbase + pi23(lane)) * PITCH + 512 + h * 128 + wid * 8;
    const bf16_t* vsrc = qkv + (rowbase + 8 * wid + (lane >> 4)) * PITCH + 1024 + h * 128 + (((lane & 15) ^ ((lane >> 4) << 2)) * 8);
    f32x16 o[4];
    float l = attn_core<128, false>(ring, wid, lane, Qw, ksrc, vsrc, comp * 8192, 0, 64, 0, 0, 0.f, 0.f, o);
    l = halfswap_sum(l);
    const float inv = 1.0f / l;
    ALDS f32x4* X = (ALDS f32x4*)ring + (size_t)wq * (16 * 64);
    if (comp == 1) {
#pragma unroll
        for (int db = 0; db < 4; ++db)
#pragma unroll
            for (int rq = 0; rq < 4; ++rq) X[(db * 4 + rq) * 64 + lane] = (f32x4){o[db][4 * rq] * inv, o[db][4 * rq + 1] * inv, o[db][4 * rq + 2] * inv, o[db][4 * rq + 3] * inv};
    }
    asm volatile("s_waitcnt lgkmcnt(0)\n\ts_barrier" ::: "memory");
    if (comp == 0) {
        float ss = 0.f;
#pragma unroll
        for (int db = 0; db < 4; ++db)
#pragma unroll
            for (int rq = 0; rq < 4; ++rq) { const f32x4 o2 = X[(db * 4 + rq) * 64 + lane];
#pragma unroll
                for (int e = 0; e < 4; ++e) { const float d = o[db][4 * rq + e] * inv - lam * o2[e]; o[db][4 * rq + e] = d; ss += d * d; } }
        ss = halfswap_sum(ss);
        const float rs = rsqrtf(ss * (1.0f / 128.0f) + 1e-5f) * post;
        bf16_t* orow = ymix + (rowbase + q0 + r32) * 1024 + h * 128 + 4 * hi;
#pragma unroll
        for (int db = 0; db < 4; ++db)
#pragma unroll
            for (int rq = 0; rq < 4; ++rq) { const f32x4 gv = *(const f32x4*)(subg + 32 * db + 8 * rq + 4 * hi);
                u32x2 w; w.x = cvtpk(o[db][4 * rq] * rs * gv[0], o[db][4 * rq + 1] * rs * gv[1]); w.y = cvtpk(o[db][4 * rq + 2] * rs * gv[2], o[db][4 * rq + 3] * rs * gv[3]);
                *(u32x2*)(orow + 32 * db + 8 * rq) = w; }
    }
    asm volatile("s_waitcnt lgkmcnt(0)\n\ts_barrier" ::: "memory");
}

__device__ __forceinline__ void swa_unit(ALDS unsigned char* ring, const int wid, int lane, const bf16_t* qkv, bf16_t* ymix, const int u, const float* sink) {
    asm volatile("" : "+v"(lane));
    const int bkv = u >> 6, qblk = u & 63, b = bkv >> 1, kvh = bkv & 1, head = kvh * 4 + (wid >> 1), r32 = lane & 31, hi = lane >> 5;
    const size_t rowbase = (size_t)b * 4096;
    const int q0 = qblk * 64 + (wid & 1) * 32;
    const bf16_t* Qw = qkv + (rowbase + q0) * PITCH + 1536 + head * 64;
    const bf16_t* ksrc = qkv + (rowbase + pi23(lane)) * PITCH + 2048 + kvh * 64 + wid * 8;
    const bf16_t* vsrc = qkv + (rowbase + 8 * wid + (lane >> 3)) * PITCH + 2176 + kvh * 64 + (((lane & 7) ^ (((lane >> 4) & 1) << 2)) * 8);
    const int t0 = (qblk - 2 > 0) ? qblk - 2 : 0, t1 = ((qblk + 2 < 63) ? qblk + 2 : 63) + 1;
    f32x16 o[2];
    float l = attn_core<64, true>(ring, wid, lane, Qw, ksrc, vsrc, 0, t0, t1, qblk, q0 + r32, sink[head] * 1.4426950408889634f, (hi == 0) ? 1.0f : 0.0f, o);
    l = halfswap_sum(l);
    const float inv = 1.0f / l;
    bf16_t* orow = ymix + (rowbase + q0 + r32) * 1024 + 512 + head * 64 + 4 * hi;
#pragma unroll
    for (int db = 0; db < 2; ++db)
#pragma unroll
        for (int rq = 0; rq < 4; ++rq) { u32x2 w; w.x = cvtpk(o[db][4 * rq] * inv, o[db][4 * rq + 1] * inv); w.y = cvtpk(o[db][4 * rq + 2] * inv, o[db][4 * rq + 3] * inv);
            *(u32x2*)(orow + 32 * db + 8 * rq) = w; }
}
}

#ifndef REP_DIFF
#define REP_DIFF 1
#endif
#ifndef VARP
#define VARP 0
#endif
#ifndef REP_SWA
#define REP_SWA 1
#endif
#ifndef REP_G3
#define REP_G3 1
#endif
#ifndef REP_FOUT
#define REP_FOUT 0
#endif
#ifndef REP_RES
#define REP_RES 0
#endif
#ifndef REP_OPROJ
#define REP_OPROJ 0
#endif
#ifndef REP_G1
#define REP_G1 1
#endif
#ifndef REP_SYNC
#define REP_SYNC 1
#endif
#ifndef REP_LN
#define REP_LN 1
#endif
#ifndef REP_PRO
#define REP_PRO 1
#endif
constexpr int NWAVES = 8;
constexpr int M = 65536, D = 1024, FF = 2816, NIN = 2304, SEQ = 4096, DEPTH = 4;
constexpr size_t MiB = 1u << 20;
constexpr size_t W1_OFF = 0, W1_B = (size_t)2 * FF * D * 2, W2_OFF = W1_OFF + W1_B, W2_B = (size_t)D * FF * 2, WIN_OFF = W2_OFF + W2_B, WIN_B = (size_t)NIN * D * 2,
                 WO_OFF = WIN_OFF + WIN_B, WO_B = (size_t)D * D * 2, W3_OFF = WO_OFF + WO_B, W4_OFF = W3_OFF + W1_B, WL_STRIDE = W4_OFF + W2_B;
constexpr size_t WS_W = 0, WS_ROPE = 160 * MiB, WS_XB = 176 * MiB, WS_H = 304 * MiB, WS_YM = 656 * MiB, WS_CSBW = 784 * MiB, WS_ST = 785 * MiB, WS_CTL = 786 * MiB, WS_END = 787 * MiB;
constexpr size_t CTL_ZERO_BYTES = 16384;
constexpr int CSBW_N = 2 * FF;
static_assert((size_t)DEPTH * 3 * 2 * CSBW_N * 4 <= MiB && (size_t)2 * M * 2 * 4 <= MiB, "aux map");
static_assert(WL_STRIDE * DEPTH <= WS_ROPE && WS_ROPE + (size_t)M * 64 * 4 <= WS_XB && WS_XB + (size_t)M * D * 2 <= WS_H && WS_H + (size_t)M * FF * 2 <= WS_YM && WS_YM + (size_t)M * D * 2 <= WS_END, "d_ws map");
constexpr int LDS_BYTES = 147456;
constexpr float ALPHA = 1.681792830507429f;
constexpr float QSCALE = 0.125f * 1.4426950408889634f;

typedef unsigned short bf16;
typedef float f32x4 __attribute__((ext_vector_type(4)));
typedef unsigned v4u __attribute__((ext_vector_type(4)));
typedef unsigned v2u __attribute__((ext_vector_type(2)));
using pg8::cvtpk;

struct Args { const float* in[13]; float* out; unsigned char* ws; float inv[32]; float lam_init[4]; };

__device__ __forceinline__ int cur_lane() { int l; asm volatile("v_mbcnt_lo_u32_b32 %0, -1, 0\n\tv_mbcnt_hi_u32_b32 %0, -1, %0" : "=v"(l)); return l; }
__device__ __forceinline__ float wave_sum(float v) {
#pragma unroll
    for (int o = 1; o < 64; o <<= 1) v += __shfl_xor(v, o);
    return v;
}
__device__ __forceinline__ int src_col(int type, int n) {
    if (type == 1) { const int pn = n >> 8, w = n & 255; return (w < 128) ? (128 * pn + w) : (FF + 128 * pn + (w - 128)); }
    if (type == 3) { const int w = n & 255, bj = w >> 7, wc = (w >> 5) & 3, c = w & 31; return (n & ~255) + 64 * wc + 32 * bj + c; }
    if (type == 2) { const bool rp = (n < 1024) || (n >= 1536 && n < 2176); return rp ? ((n & ~63) + ((n & 63) >> 1) + 32 * (n & 1)) : n; }
    return n;
}
template <bool F16> __device__ __forceinline__ void transpose_item(const float* W, int K, int N, int type, const float* gk, bf16* WT, ALDS float* scr, int item, int lane) {
    const int nblk = N / 32, kb = item / nblk, nb = item % nblk, k0 = 64 * kb, n0 = 32 * nb;
    const int sc = src_col(type, n0 + (lane & 31));
#pragma unroll
    for (int i = 0; i < 32; ++i) { const int kk = 2 * i + (lane >> 5); scr[kk * 33 + (lane & 31)] = W[(size_t)(k0 + kk) * N + sc] * (gk ? gk[k0 + kk] : 1.0f); }
    asm volatile("s_waitcnt lgkmcnt(0)" ::: "memory");
    const int c = lane & 7;
#pragma unroll
    for (int j = 0; j < 4; ++j) { const int n = (lane >> 3) + 8 * j; const ALDS float* s = scr + (8 * c) * 33 + n;
        v4u o; if (F16) { o.x = pg8::cvtpk_h(s[0 * 33], s[1 * 33]); o.y = pg8::cvtpk_h(s[2 * 33], s[3 * 33]); o.z = pg8::cvtpk_h(s[4 * 33], s[5 * 33]); o.w = pg8::cvtpk_h(s[6 * 33], s[7 * 33]); }
        else { o.x = cvtpk(s[0 * 33], s[1 * 33]); o.y = cvtpk(s[2 * 33], s[3 * 33]); o.z = cvtpk(s[4 * 33], s[5 * 33]); o.w = cvtpk(s[6 * 33], s[7 * 33]); }
        *(v4u*)(WT + (size_t)(n0 + n) * K + k0 + 8 * c) = o; }
    asm volatile("s_waitcnt lgkmcnt(0)" ::: "memory");
}
__device__ __forceinline__ void sincos_f32angle(float ang, float& c, float& s) {
    const double a = (double)ang, k = __builtin_rint(a * 0.63661977236758134308);
    double r = __builtin_fma(-k, 1.57079632679489655800e+00, a); r = __builtin_fma(-k, 6.12323399573676603587e-17, r);
    const double r2 = r * r;
    double sp = -1.0 / 1307674368000.0; sp = sp * r2 + 1.0 / 6227020800.0; sp = sp * r2 - 1.0 / 39916800.0; sp = sp * r2 + 1.0 / 362880.0; sp = sp * r2 - 1.0 / 5040.0; sp = sp * r2 + 1.0 / 120.0; sp = sp * r2 - 1.0 / 6.0;
    const double sn = r + r * r2 * sp;
    double cp = 1.0 / 20922789888000.0; cp = cp * r2 - 1.0 / 87178291200.0; cp = cp * r2 + 1.0 / 479001600.0; cp = cp * r2 - 1.0 / 3628800.0; cp = cp * r2 + 1.0 / 40320.0; cp = cp * r2 - 1.0 / 720.0; cp = cp * r2 + 1.0 / 24.0; cp = cp * r2 - 0.5;
    const double cn = 1.0 + r2 * cp;
    const int q = ((int)k) & 3;
    const double cc = (q == 0) ? cn : (q == 1) ? -sn : (q == 2) ? -cn : sn;
    const double ss = (q == 0) ? sn : (q == 1) ? cn : (q == 2) ? -sn : -cn;
    c = (float)cc; s = (float)ss;
}
__device__ __forceinline__ void ln_row(const float* xrow, const float* g, const float* bta, float* orow, bf16* brow, int lane) {
    asm volatile("" : "+v"(lane));
    const f32x4* xr = (const f32x4*)xrow + lane;
    f32x4 v[4]; float s = 0.f;
#pragma unroll
    for (int j = 0; j < 4; ++j) { v[j] = xr[64 * j]; s += (v[j][0] + v[j][1]) + (v[j][2] + v[j][3]); }
    const float mean = wave_sum(s) * (1.f / D); float s2 = 0.f;
#pragma unroll
    for (int j = 0; j < 4; ++j) { v[j] = v[j] - mean; s2 += (v[j][0] * v[j][0] + v[j][1] * v[j][1]) + (v[j][2] * v[j][2] + v[j][3] * v[j][3]); }
    const float rstd = 1.0f / sqrtf(wave_sum(s2) * (1.f / D) + 1e-5f);
#pragma unroll
    for (int j = 0; j < 4; ++j) { const f32x4 gg = *((const f32x4*)g + lane + 64 * j), bb = *((const f32x4*)bta + lane + 64 * j);
        const f32x4 y = v[j] * rstd * gg + bb;
        *((f32x4*)orow + lane + 64 * j) = y;
        v2u w; w.x = cvtpk(y[0], y[1]); w.y = cvtpk(y[2], y[3]); *((v2u*)brow + lane + 64 * j) = w; }
}

#define XB_TMO      128
#define XB_XCNT(j)  (256  + 64 * (j))
#define XB_XSUB(j)  (1280 + 64 * (j))
#define XB_XGEN(j)  (2304 + 64 * (j))
#define XB_TOP      3328
#define XB_TOPGEN   3392
#define XCD_BAR_WORDS 3456
#define XB_SPIN_CAP (1u << 18)

__device__ __forceinline__ unsigned xb_ld(unsigned* p)              { return __hip_atomic_load(p, __ATOMIC_RELAXED, __HIP_MEMORY_SCOPE_AGENT); }
__device__ __forceinline__ unsigned xb_add(unsigned* p, unsigned v) { return __hip_atomic_fetch_add(p, v, __ATOMIC_RELAXED, __HIP_MEMORY_SCOPE_AGENT); }
__device__ __forceinline__ unsigned xb_xcc_id() { return (unsigned)__builtin_amdgcn_s_getreg((3 << 11) | 20) & 0xFu; }
#define XB_SPIN(cond, bar) do { unsigned _sp = 0; while (cond) { __builtin_amdgcn_s_sleep(1); \
    if ((++_sp & 255u) == 0u) { if (xb_ld(&(bar)[XB_TMO])) break; if (_sp > XB_SPIN_CAP) { atomicAdd(&(bar)[XB_TMO], 1u); break; } } } } while (0)

struct XcdBarrier {
    unsigned* bar; unsigned x;
    volatile ALDS unsigned* st;
};

__device__ __forceinline__ XcdBarrier xcd_barrier_post(unsigned* bar, volatile ALDS unsigned* st) {
    XcdBarrier b; b.bar = bar; b.x = xb_xcc_id(); b.st = st;
    if (threadIdx.x == 0) (void)xb_add(&bar[XB_XCNT(b.x)], 1u);
    return b;
}
__device__ __forceinline__ void xcd_barrier_complete(unsigned* bar, unsigned x, unsigned& nloc, unsigned& nx) {
    const unsigned G = gridDim.x * gridDim.y * gridDim.z;
    unsigned sum, cnt, mine, sp = 0u;
    for (;;) {
        sum = 0u; cnt = 0u; mine = 0u;
#pragma unroll
        for (unsigned j = 0; j < 16; ++j) { const unsigned c = xb_ld(&bar[XB_XCNT(j)]); sum += c; cnt += (c > 0u) ? 1u : 0u; mine = (j == x) ? c : mine; }
        if (sum == G) break;
        __builtin_amdgcn_s_sleep(1);
        if ((++sp & 255u) == 0u) { if (xb_ld(&bar[XB_TMO])) break; if (sp > XB_SPIN_CAP) { atomicAdd(&bar[XB_TMO], 1u); break; } }
    }
    nloc = mine > 0u ? mine : 1u; nx = cnt > 0u ? cnt : 1u;
}

__device__ __forceinline__ void xcd_barrier(const XcdBarrier& b) {
    asm volatile("s_waitcnt vmcnt(0)" ::: "memory");
    __syncthreads();
    if (threadIdx.x == 0) {
        unsigned* bar = b.bar;
        __builtin_amdgcn_s_waitcnt(0);
        unsigned nloc = b.st[0], nx = b.st[1];
        if (nloc == 0u) { xcd_barrier_complete(bar, b.x, nloc, nx); b.st[0] = nloc; b.st[1] = nx; }
        const unsigned old = xb_add(&bar[XB_XSUB(b.x)], 1u);
        const unsigned gen = old / nloc;
        if (old + 1u == (gen + 1u) * nloc) {
            __builtin_amdgcn_fence(__ATOMIC_RELEASE, "agent");
            asm volatile("s_waitcnt vmcnt(0)" ::: "memory");
            const unsigned og = xb_add(&bar[XB_TOP], 1u);
            const unsigned tg = og / nx;
            if (og + 1u == (tg + 1u) * nx) xb_add(&bar[XB_TOPGEN], 1u);
            else XB_SPIN(xb_ld(&bar[XB_TOPGEN]) == tg, bar);
            __builtin_amdgcn_fence(__ATOMIC_ACQUIRE, "agent");
            xb_add(&bar[XB_XGEN(b.x)], 1u);
            asm volatile("s_waitcnt vmcnt(0)" ::: "memory");
        } else {
            XB_SPIN(xb_ld(&bar[XB_XGEN(b.x)]) == gen, bar);
            __builtin_amdgcn_fence(__ATOMIC_ACQUIRE, "agent");
            asm volatile("s_waitcnt vmcnt(0)" ::: "memory");
        }
    }
    __syncthreads();
}

__device__ __forceinline__ void ln_row_h(const bf16* hrow, const float* g, const float* bta, float* orow, int lane) {
    asm volatile("" : "+v"(lane));
    typedef _Float16 h4 __attribute__((ext_vector_type(4)));
    f32x4 v[4]; float s = 0.f;
#pragma unroll
    for (int j = 0; j < 4; ++j) { const h4 h = *((const h4*)hrow + lane + 64 * j); v[j] = (f32x4){(float)h[0], (float)h[1], (float)h[2], (float)h[3]}; s += (v[j][0] + v[j][1]) + (v[j][2] + v[j][3]); }
    const float mean = wave_sum(s) * (1.f / D); float s2 = 0.f;
#pragma unroll
    for (int j = 0; j < 4; ++j) { v[j] = v[j] - mean; s2 += (v[j][0] * v[j][0] + v[j][1] * v[j][1]) + (v[j][2] * v[j][2] + v[j][3] * v[j][3]); }
    const float rstd = 1.0f / sqrtf(wave_sum(s2) * (1.f / D) + 1e-5f);
#pragma unroll
    for (int j = 0; j < 4; ++j) { const f32x4 gg = *((const f32x4*)g + lane + 64 * j), bb = *((const f32x4*)bta + lane + 64 * j);
        *((f32x4*)orow + lane + 64 * j) = v[j] * rstd * gg + bb; }
}

__global__ void __launch_bounds__(NWAVES * 64, 2) fwd_megakernel(Args args) {
    extern __shared__ __attribute__((aligned(16))) unsigned char lds_raw[];
    cg::grid_group grid = cg::this_grid();
#define GSYNC() xcd_barrier(bar)
    ALDS unsigned char* lds = (ALDS unsigned char*)lds_raw;
    const int tid = threadIdx.x, lane = tid & 63, wave = __builtin_amdgcn_readfirstlane(tid >> 6);
    const int G = gridDim.x, bx = blockIdx.x, vcu = (G % 8 == 0) ? (bx % 8) * (G / 8) + bx / 8 : bx;
    unsigned char* ws = args.ws;
    const float* x_in = args.in[0]; const int* positions = (const int*)args.in[1];
    float* out = args.out;
    bf16* XB = (bf16*)(ws + WS_XB); bf16* HB = (bf16*)(ws + WS_H); bf16* QKV = (bf16*)(ws + WS_H); bf16* YM = (bf16*)(ws + WS_YM);
    unsigned* ROPEH = (unsigned*)(ws + WS_ROPE);
    float* ROPE = (float*)(ws + WS_ROPE); float* CSBW = (float*)(ws + WS_CSBW); float* ST = (float*)(ws + WS_ST); float* LAMV = (float*)(ws + WS_CSBW + 786432);
    const int gw = vcu * NWAVES + wave, NGW = G * NWAVES;
    volatile ALDS unsigned* bst = (volatile ALDS unsigned*)(lds + 131072 + 8192);
    if (tid < 2) bst[tid] = 0u;
    __syncthreads();
    XcdBarrier bar = xcd_barrier_post((unsigned*)(ws + WS_CTL), bst);

    for (int rep = 0; rep < REP_PRO; ++rep) {
        ALDS float* scr = (ALDS float*)(lds + wave * 16384);
        constexpr int I1 = (D / 64) * (2 * FF / 32), I2 = (FF / 64) * (D / 32), I3 = (D / 64) * (NIN / 32), I4 = (D / 64) * (D / 32), IL = 2 * I1 + 2 * I2 + I3 + I4;
        for (int it = gw; it < IL * DEPTH; it += NGW) {
            const int l = it / IL; int r = it % IL;
            unsigned char* wl = ws + WS_W + (size_t)l * WL_STRIDE;
            if (r < I1) { transpose_item<true>(args.in[7] + (size_t)l * D * 2 * FF, D, 2 * FF, 1, (l > 0) ? args.in[11] + (size_t)((l - 1) * 3 + 2) * D : nullptr, (bf16*)(wl + W1_OFF), scr, r, lane); continue; } r -= I1;
            if (r < I2) { transpose_item<false>(args.in[8] + (size_t)l * FF * D, FF, D, 3, nullptr, (bf16*)(wl + W2_OFF), scr, r, lane); continue; } r -= I2;
            if (r < I3) { transpose_item<true>(args.in[2] + (size_t)l * D * NIN, D, NIN, 2, args.in[11] + (size_t)(l * 3) * D, (bf16*)(wl + WIN_OFF), scr, r, lane); continue; } r -= I3;
            if (r < I4) { transpose_item<false>(args.in[3] + (size_t)l * D * D, D, D, 3, nullptr, (bf16*)(wl + WO_OFF), scr, r, lane); continue; } r -= I4;
            if (r < I1) { transpose_item<true>(args.in[9] + (size_t)l * D * 2 * FF, D, 2 * FF, 1, args.in[11] + (size_t)(l * 3 + 1) * D, (bf16*)(wl + W3_OFF), scr, r, lane); continue; } r -= I1;
            transpose_item<false>(args.in[10] + (size_t)l * FF * D, FF, D, 3, nullptr, (bf16*)(wl + W4_OFF), scr, r, lane);
        }
        const size_t gt = (size_t)vcu * (NWAVES * 64) + tid, GT = (size_t)G * NWAVES * 64;
        for (size_t i = gt; i < (size_t)M * D / 4; i += 8 * GT) {
            f32x4 v[8];
#pragma unroll
            for (int j = 0; j < 8; ++j) { const size_t ij = i + (size_t)j * GT; v[j] = (ij < (size_t)M * D / 4) ? *((const f32x4*)x_in + ij) : (f32x4){0.f, 0.f, 0.f, 0.f}; }
#pragma unroll
            for (int j = 0; j < 8; ++j) { const size_t ij = i + (size_t)j * GT; if (ij < (size_t)M * D / 4) { v2u w; w.x = pg8::cvtpk_h(v[j][0], v[j][1]); w.y = pg8::cvtpk_h(v[j][2], v[j][3]); *((v2u*)XB + ij) = w; } }
        }
        for (size_t i = gt; i < (size_t)M * 32; i += GT) { const int row = (int)(i >> 5), k = (int)(i & 31); float c, s; sincos_f32angle((float)positions[row] * args.inv[k], c, s);
            ROPEH[(size_t)row * 32 + k] = pg8::cvtpk_h(c, s); }
        if (vcu == 0 && wave < DEPTH) {
            const float* lv = args.in[4] + (size_t)wave * 256;
            const float a1 = wave_sum(lv[lane] * lv[64 + lane]), a2 = wave_sum(lv[128 + lane] * lv[192 + lane]);
            if (lane == 0) LAMV[wave] = expf(a1) - expf(a2) + args.lam_init[wave];
        }
        for (size_t i = gt; i < (size_t)M * 2; i += GT) ST[i] = 0.f;
        {
            ALDS float* red = (ALDS float*)(lds + 131072);
            constexpr int CG0 = 2 * FF / 64, CG1 = NIN / 64, CGL = 2 * CG0 + CG1;
            for (int cgi = vcu; cgi < CGL * DEPTH; cgi += G) {
                const int l = cgi / CGL; int r = cgi % CGL; int j = 0;
                if (r >= CG0) { r -= CG0; j = 1; if (r >= CG1) { r -= CG1; j = 2; } }
                const int lnidx = (j == 0) ? (l - 1) * 3 + 2 : (j == 1) ? l * 3 : l * 3 + 1;
                if (lnidx < 0) continue;
                const int N = (j == 1) ? NIN : 2 * FF, type = (j == 1) ? 2 : 1;
                const float* W = (j == 0) ? args.in[7] + (size_t)l * D * 2 * FF : (j == 1) ? args.in[2] + (size_t)l * D * NIN : args.in[9] + (size_t)l * D * 2 * FF;
                const float* gk = args.in[11] + (size_t)lnidx * D; const float* bk = args.in[12] + (size_t)lnidx * D;
                const int n = r * 64 + lane, sc = src_col(type, n);
                float c1 = 0.f, b1 = 0.f;
#pragma unroll 16
                for (int k = wave * 128; k < wave * 128 + 128; ++k) { const float w = W[(size_t)k * N + sc]; const float gw = gk[k] * w;
                    c1 += (float)(_Float16)gw; b1 += bk[k] * w; }
                red[(wave * 64 + lane) * 2] = c1; red[(wave * 64 + lane) * 2 + 1] = b1;
                __syncthreads();
                if (wave == 0) { float cc = 0.f, bb = 0.f;
#pragma unroll
                    for (int w8 = 0; w8 < 8; ++w8) { cc += red[(w8 * 64 + lane) * 2]; bb += red[(w8 * 64 + lane) * 2 + 1]; }
                    float* dst = CSBW + (size_t)((l * 3 + j) * 2) * CSBW_N; dst[n] = cc; dst[CSBW_N + n] = bb; }
                __syncthreads();
            }
        }
    }
    grid.sync();

#define ZERO_ST(buf_) do { int t_ = wave * 64 + cur_lane(); asm volatile("" : "+v"(t_)); float* z_ = ST + (size_t)(buf_) * M * 2; for (int i_ = vcu * (NWAVES * 64) + t_; i_ < M * 2; i_ += G * NWAVES * 64) { z_[i_] = 0.f; asm volatile("" : "+v"(i_)); } } while (0)
    for (int l = 0; l < DEPTH; ++l) {
        unsigned char* wl = ws + WS_W + (size_t)l * WL_STRIDE;
        const float* lng = args.in[11]; const float* lnb = args.in[12];
        { const int k = 3 * l; ZERO_ST(k & 1);
          const float* cb = CSBW + (size_t)((l * 3 + 0) * 2) * CSBW_N;
          pg8::Gemm g{XB, (const bf16*)(wl + W1_OFF), M, 2 * FF, D}; pg8::StaticOrder S; S.init(M, 2 * FF, G, bx);
          pg8::EpiSwiGLU E{HB, FF, pg8::RowLN{(k == 0) ? nullptr : ST + (size_t)((k - 1) & 1) * M * 2, cb, cb + CSBW_N}};
          for (int rep = 0; rep < REP_G1; ++rep) pg8::gemm_phase<pg8::EpiSwiGLU, pg8::StaticOrder, true, true>(lds, g, S, E, wave); }
        GSYNC();
        { const int k = 3 * l;
          pg8::Gemm g{HB, (const bf16*)(wl + W2_OFF), M, D, FF}; pg8::StaticOrder S; S.init(M, D, G, bx);
          for (int rep = 0; rep < REP_FOUT; ++rep) { pg8::EpiNull EN{ROPE}; pg8::gemm_phase<pg8::EpiNull, pg8::StaticOrder, true, true>(lds, g, S, EN, wave); }
          for (int rep = 0; rep < REP_RES; ++rep) { pg8::EpiRes ED{x_in, (bf16*)out, ST, lng, lnb, out + (size_t)48 * 1024 * 1024, ALPHA, 0.5f}; pg8::gemm_phase<pg8::EpiRes, pg8::StaticOrder, true, true>(lds, g, S, ED, wave); }
          pg8::EpiRes E{x_in, XB, (k == 0) ? nullptr : ST + (size_t)((k - 1) & 1) * M * 2, lng + (size_t)(k > 0 ? k - 1 : 0) * D, lnb + (size_t)(k > 0 ? k - 1 : 0) * D, ST + (size_t)(k & 1) * M * 2, ALPHA, 0.5f};
          pg8::gemm_phase<pg8::EpiRes, pg8::StaticOrder, true, true>(lds, g, S, E, wave); }
        GSYNC();
        { const int k = 3 * l + 1; ZERO_ST(k & 1);
          const float* cb = CSBW + (size_t)((l * 3 + 1) * 2) * CSBW_N;
          pg8::Gemm g{XB, (const bf16*)(wl + WIN_OFF), M, NIN, D}; pg8::StaticOrder S; S.init(M, NIN, G, bx);
          pg8::EpiQKV E{QKV, ROPEH, QSCALE, pg8::RowLN{ST + (size_t)((k - 1) & 1) * M * 2, cb, cb + CSBW_N}};
          for (int rep = 0; rep < REP_G3; ++rep) pg8::gemm_phase<pg8::EpiQKV, pg8::StaticOrder, true, true>(lds, g, S, E, wave); }
        GSYNC();
        {
            const float lam_init = args.lam_init[l], lam = LAMV[l];
            const float* subg = args.in[5] + (size_t)l * 128; const float* sink = args.in[6] + (size_t)l * 8;
            for (int rep = 0; rep < REP_DIFF; ++rep)
            for (int u = vcu; u < 2048; u += G) att::diff_unit(lds, wave, cur_lane(), QKV, YM, u, lam, 1.0f - lam_init, subg);
            for (int rep = 0; rep < REP_SWA; ++rep)
            for (int u = vcu; u < 2048; u += G) att::swa_unit(lds, wave, cur_lane(), QKV, YM, u, sink);
        }
        GSYNC();
        { const int k = 3 * l + 1;
          pg8::Gemm g{YM, (const bf16*)(wl + WO_OFF), M, D, D}; pg8::StaticOrder S; S.init(M, D, G, bx);
          for (int rep = 0; rep < REP_OPROJ; ++rep) { pg8::EpiNull EN{ROPE}; pg8::gemm_phase<pg8::EpiNull, pg8::StaticOrder, true, true>(lds, g, S, EN, wave); }
          pg8::EpiRes E{x_in, XB, ST + (size_t)((k - 1) & 1) * M * 2, lng + (size_t)(k - 1) * D, lnb + (size_t)(k - 1) * D, ST + (size_t)(k & 1) * M * 2, ALPHA, 1.0f};
          pg8::gemm_phase<pg8::EpiRes, pg8::StaticOrder, true, true>(lds, g, S, E, wave); }
        GSYNC();
        { const int k = 3 * l + 2; ZERO_ST(k & 1);
          const float* cb = CSBW + (size_t)((l * 3 + 2) * 2) * CSBW_N;
          pg8::Gemm g{XB, (const bf16*)(wl + W3_OFF), M, 2 * FF, D}; pg8::StaticOrder S; S.init(M, 2 * FF, G, bx);
          pg8::EpiSwiGLU E{HB, FF, pg8::RowLN{ST + (size_t)((k - 1) & 1) * M * 2, cb, cb + CSBW_N}};
          for (int rep = 0; rep < REP_G1; ++rep) pg8::gemm_phase<pg8::EpiSwiGLU, pg8::StaticOrder, true, true>(lds, g, S, E, wave); }
        GSYNC();
        { const int k = 3 * l + 2;
          pg8::Gemm g{HB, (const bf16*)(wl + W4_OFF), M, D, FF}; pg8::StaticOrder S; S.init(M, D, G, bx);
          for (int rep = 0; rep < REP_FOUT; ++rep) { pg8::EpiNull EN{ROPE}; pg8::gemm_phase<pg8::EpiNull, pg8::StaticOrder, true, true>(lds, g, S, EN, wave); }
          for (int rep = 0; rep < REP_RES; ++rep) { pg8::EpiRes ED{x_in, (bf16*)out, ST, lng, lnb, out + (size_t)48 * 1024 * 1024, ALPHA, 0.5f}; pg8::gemm_phase<pg8::EpiRes, pg8::StaticOrder, true, true>(lds, g, S, ED, wave); }
          pg8::EpiRes E{x_in, XB, ST + (size_t)((k - 1) & 1) * M * 2, lng + (size_t)(k - 1) * D, lnb + (size_t)(k - 1) * D, ST + (size_t)(k & 1) * M * 2, ALPHA, 0.5f};
          pg8::gemm_phase<pg8::EpiRes, pg8::StaticOrder, true, true>(lds, g, S, E, wave); }
        GSYNC();
    }
    for (int m = gw; m < M; m += NGW) ln_row_h(XB + (size_t)m * D, args.in[11] + (size_t)11 * D, args.in[12] + (size_t)11 * D, out + (size_t)m * D, cur_lane());
}

extern "C" void kernel_launch(void* const* d_in, const int* in_sizes, int n_in, void* d_out, int out_size, void* d_ws, size_t ws_size, hipStream_t stream) {
    static int grid = 0;
    if (grid == 0) {
        if (n_in != 13 || in_sizes[0] != M * D || out_size != M * D || ws_size < WS_END) { fprintf(stderr, "kernel_launch: unexpected shapes (n_in %d, in0 %d, out %d, ws %zu); nothing launched\n", n_in, n_in > 0 ? in_sizes[0] : -1, out_size, ws_size); grid = -1; return; }
        int dev = 0, cus = 0, per_cu = 0;
        if (hipGetDevice(&dev) != hipSuccess || hipDeviceGetAttribute(&cus, hipDeviceAttributeMultiprocessorCount, dev) != hipSuccess) { grid = -1; return; }
        if (hipFuncSetAttribute((const void*)fwd_megakernel, hipFuncAttributeMaxDynamicSharedMemorySize, LDS_BYTES) != hipSuccess) { fprintf(stderr, "kernel_launch: hipFuncSetAttribute failed\n"); grid = -1; return; }
        if (hipOccupancyMaxActiveBlocksPerMultiprocessor(&per_cu, (const void*)fwd_megakernel, NWAVES * 64, LDS_BYTES) != hipSuccess || per_cu < 1) { fprintf(stderr, "kernel_launch: occupancy query gives %d\n", per_cu); per_cu = 1; }
        (void)hipGetLastError();
        grid = cus * 1;
    }
    if (grid < 0) return;
    if (hipMemsetAsync((char*)d_ws + WS_CTL, 0, CTL_ZERO_BYTES, stream) != hipSuccess) { fprintf(stderr, "kernel_launch: memset of the barrier words failed\n"); return; }
    Args a{};
    for (int i = 0; i < 13; ++i) a.in[i] = (const float*)d_in[i];
    a.out = (float*)d_out; a.ws = (unsigned char*)d_ws;
    for (int i = 0; i < 32; ++i) a.inv[i] = (float)pow(10000.0, -(double)(2 * i) / 64.0);
    for (int l = 0; l < 4; ++l) a.lam_init[l] = (float)(0.8 - 0.6 * exp(-0.3 * (double)l));
    void* kargs[] = {&a};
    const hipError_t e = hipLaunchCooperativeKernel((const void*)fwd_megakernel, dim3(grid), dim3(NWAVES * 64), kargs, LDS_BYTES, stream);
    if (e != hipSuccess) fprintf(stderr, "kernel_launch: cooperative launch failed: %s (grid %d)\n", hipGetErrorString(e), grid);
}
```

```cpp
#include <hip/hip_runtime.h>
#include <hip/hip_cooperative_groups.h>
#include <cstdio>
#include <cstdint>
#include <cmath>
namespace cg = cooperative_groups;
namespace pg8 {
#define PG8_LAS __attribute__((address_space(3)))
typedef unsigned short bf16_t;
typedef short bf16x8 __attribute__((ext_vector_type(8)));
typedef float f32x4 __attribute__((ext_vector_type(4)));
typedef unsigned u32x4 __attribute__((ext_vector_type(4)));
constexpr int BM = 256, BK = 64, HALF = 128, HTB = HALF * BK * 2  , STAGE_BYTES = 8 * HTB, NXCD = 8, WGM = 8;

__host__ __device__ __forceinline__ int lds_byte(int r, int c) { const int st = (r >> 4) * 2 + (c >> 5), rr = r & 15, cc = c & 31, ob = rr * 64 + cc * 2; return st * 1024 + (ob ^ (((ob >> 9) & 1) << 5)); }
__host__ __device__ __forceinline__ void stage_rc(int b, int& R, int& C) { const int st = b / 1024, sb = b % 1024, swz = sb ^ (((sb >> 9) & 1) << 5); R = (st >> 1) * 16 + swz / 64; C = (st & 1) * 32 + (swz % 64) / 2; }
__host__ __device__ __forceinline__ int perm32(int rho) { const int n = rho >> 4, i = rho & 15; return 8 * (i >> 2) + 4 * n + (i & 3); }

struct Unit { int pm, pn; };
struct Gemm { const bf16_t* A; const bf16_t* Bt; int M, N, K; };

struct StaticOrder {
    int nM, nN, nwg, G, c;
    __host__ __device__ void init(int M, int N, int G_, int c_) { nM = M / BM; nN = N / BM; nwg = nM * nN; G = G_; c = c_; }
    __host__ __device__ bool next(int i, Unit& u) const {
        const long L = (long)i * G + c; if (L >= nwg) return false;
        int wgid = (int)L; { const int q = nwg / NXCD, r = nwg % NXCD, xcd = wgid % NXCD, off = wgid / NXCD; wgid = (xcd < r ? xcd * (q + 1) : r * (q + 1) + (xcd - r) * q) + off; }
        const int nig = WGM * nN, gid = wgid / nig, fm = gid * WGM, gsz = (nM - fm) < WGM ? (nM - fm) : WGM;
        u.pm = fm + ((wgid % nig) % gsz); u.pn = (wgid % nig) / gsz; return true;
    }
    __device__ __forceinline__ void a_ready(const Unit&) const {}
    __device__ __forceinline__ void done(const Unit&) const {}
};

typedef float f32x2_t __attribute__((ext_vector_type(2))); typedef __bf16 bf16x2_t __attribute__((ext_vector_type(2)));
__device__ __forceinline__ unsigned cvtpk(float lo, float hi) { f32x2_t v = {lo, hi}; bf16x2_t b = __builtin_convertvector(v, bf16x2_t); return __builtin_bit_cast(unsigned, b); }
typedef _Float16 f16x8 __attribute__((ext_vector_type(8))); typedef _Float16 f16x2_t __attribute__((ext_vector_type(2)));
template <bool F16> __device__ __forceinline__ f32x4 mma16(bf16x8 a, bf16x8 b, f32x4 c) {
    if constexpr (F16) return __builtin_amdgcn_mfma_f32_16x16x32_f16(__builtin_bit_cast(f16x8, a), __builtin_bit_cast(f16x8, b), c, 0, 0, 0);
    else return __builtin_amdgcn_mfma_f32_16x16x32_bf16(a, b, c, 0, 0, 0);
}
__device__ __forceinline__ unsigned cvtpk_h(float lo, float hi) { f16x2_t v = {(_Float16)lo, (_Float16)hi}; return __builtin_bit_cast(unsigned, v); }
__device__ __forceinline__ float silu_f(float g) { return g * __builtin_amdgcn_rcpf(1.0f + __builtin_amdgcn_exp2f(-1.4426950408889634f * g)); }

typedef float f32x2v __attribute__((ext_vector_type(2)));
struct RowLN {
    const float* st; const float* cs; const float* bw;
    __device__ __forceinline__ void row(int r, float& a, float& c) const {
        if (st) { const f32x2v s = *(const f32x2v*)(st + 2 * (size_t)r); const float mu = s.x * (1.0f / 1024.0f), var = s.y * (1.0f / 1024.0f) - mu * mu; a = rsqrtf(var + 1e-5f); c = -a * mu; }
        else { a = 1.0f; c = 0.0f; }
    }
};
struct EpiSwiGLU {
    static constexpr bool PERM = true, AFTER_DRAIN = false, F16 = true;
    bf16_t* H; int ldh; RowLN ln;
    __device__ __forceinline__ void operator()(const f32x4 (&acc)[2][2][4][2], const Unit& u, int wr, int wc, int fr, int fq) const {
        const int row0 = u.pm * BM + wr * 64 + fr, col0 = u.pn * HALF + wc * 32 + 8 * fq, wrow0 = u.pn * BM + wc * 32 + 8 * fq;
        f32x4 cs[2][2], bw[2][2]; float ra[8], rc[8];
#pragma unroll
        for (int bj = 0; bj < 2; ++bj)
#pragma unroll
            for (int n = 0; n < 2; ++n) { const f32x4 z = (f32x4){0.f, 0.f, 0.f, 0.f}; cs[bj][n] = ln.st ? *(const f32x4*)(ln.cs + wrow0 + bj * HALF + 4 * n) : z; bw[bj][n] = ln.st ? *(const f32x4*)(ln.bw + wrow0 + bj * HALF + 4 * n) : z; }
#pragma unroll
        for (int i = 0; i < 8; ++i) ln.row(row0 + (i >> 2) * HALF + (i & 3) * 16, ra[i], rc[i]);
        asm volatile("" ::: "memory");
#pragma unroll
        for (int ai = 0; ai < 2; ++ai)
#pragma unroll
            for (int m = 0; m < 4; ++m) {
                const int row = row0 + ai * HALF + m * 16; const float a = ra[ai * 4 + m], c = rc[ai * 4 + m];
                const f32x4 g0 = acc[ai][0][m][0] * a + cs[0][0] * c + bw[0][0], g1 = acc[ai][0][m][1] * a + cs[0][1] * c + bw[0][1];
                const f32x4 u0 = acc[ai][1][m][0] * a + cs[1][0] * c + bw[1][0], u1 = acc[ai][1][m][1] * a + cs[1][1] * c + bw[1][1];
                u32x4 w;
                w.x = cvtpk(silu_f(g0[0]) * u0[0], silu_f(g0[1]) * u0[1]); w.y = cvtpk(silu_f(g0[2]) * u0[2], silu_f(g0[3]) * u0[3]);
                w.z = cvtpk(silu_f(g1[0]) * u1[0], silu_f(g1[1]) * u1[1]); w.w = cvtpk(silu_f(g1[2]) * u1[2], silu_f(g1[3]) * u1[3]);
                __builtin_nontemporal_store(w, (u32x4*)(H + (size_t)row * ldh + col0));
            }
    }
};
struct EpiRes {
    static constexpr bool PERM = true, AFTER_DRAIN = false, F16 = false;
    const float* x0; bf16_t* yh; const float* st; const float* g; const float* b; float* st_new; float alpha, s;
    __device__ __forceinline__ void operator()(const f32x4 (&acc)[2][2][4][2], const Unit& u, int wr, int wc, int fr, int fq) const {
        const int row0 = u.pm * BM + wr * 64 + fr, col0 = u.pn * BM + wc * 64 + 8 * fq;
        f32x4 gv[2][2], bv[2][2];
#pragma unroll
        for (int bj = 0; bj < 2; ++bj)
#pragma unroll
            for (int n = 0; n < 2; ++n) { gv[bj][n] = st ? *(const f32x4*)(g + col0 + bj * 32 + 4 * n) : (f32x4){1.f, 1.f, 1.f, 1.f}; bv[bj][n] = st ? *(const f32x4*)(b + col0 + bj * 32 + 4 * n) : (f32x4){0.f, 0.f, 0.f, 0.f}; }
#pragma unroll
        for (int ai = 0; ai < 2; ++ai) {
            f16x8 hv[4][2]; float ra[4], rmu[4];
#pragma unroll
            for (int m = 0; m < 4; ++m) {
                const int row = row0 + ai * HALF + m * 16; const size_t off = (size_t)row * 1024 + col0;
                ra[m] = 1.0f; rmu[m] = 0.0f;
                if (st) {
                    const f32x2v sv = *(const f32x2v*)(st + 2 * (size_t)row); rmu[m] = sv.x * (1.0f / 1024.0f); ra[m] = rsqrtf(sv.y * (1.0f / 1024.0f) - rmu[m] * rmu[m] + 1e-5f);
                    hv[m][0] = *(const f16x8*)(yh + off); hv[m][1] = *(const f16x8*)(yh + off + 32);
                }
            }
            asm volatile("" ::: "memory");
#pragma unroll
            for (int m = 0; m < 4; ++m) {
                const int row = row0 + ai * HALF + m * 16; const size_t off = (size_t)row * 1024 + col0;
                float s1 = 0.f, s2 = 0.f;
#pragma unroll
                for (int bj = 0; bj < 2; ++bj) {
                    f32x4 yp[2];
                    if (st) { const f16x8 h = hv[m][bj]; yp[0] = (f32x4){(float)h[0], (float)h[1], (float)h[2], (float)h[3]}; yp[1] = (f32x4){(float)h[4], (float)h[5], (float)h[6], (float)h[7]}; }
                    else { yp[0] = *(const f32x4*)(x0 + off + bj * 32); yp[1] = *(const f32x4*)(x0 + off + bj * 32 + 4); }
                    f32x4 y[2];
#pragma unroll
                    for (int n = 0; n < 2; ++n) { const f32x4 x = (yp[n] - rmu[m]) * ra[m] * gv[bj][n] + bv[bj][n];
                        y[n] = x * alpha + acc[ai][bj][m][n] * s;
                        s1 += (y[n][0] + y[n][1]) + (y[n][2] + y[n][3]); s2 += (y[n][0] * y[n][0] + y[n][1] * y[n][1]) + (y[n][2] * y[n][2] + y[n][3] * y[n][3]); }
                    u32x4 w; w.x = cvtpk_h(y[0][0], y[0][1]); w.y = cvtpk_h(y[0][2], y[0][3]); w.z = cvtpk_h(y[1][0], y[1][1]); w.w = cvtpk_h(y[1][2], y[1][3]);
                    *(u32x4*)(yh + off + bj * 32) = w;
                }
                s1 += __shfl_xor(s1, 16); s1 += __shfl_xor(s1, 32); s2 += __shfl_xor(s2, 16); s2 += __shfl_xor(s2, 32);
                if (fq == 0) { atomicAdd(st_new + 2 * (size_t)row, s1); atomicAdd(st_new + 2 * (size_t)row + 1, s2); }
            }
            asm volatile("" ::: "memory");
        }
    }
};
struct EpiNull {
    static constexpr bool PERM = true, AFTER_DRAIN = false, F16 = false;
    float* sink;
    __device__ __forceinline__ void operator()(const f32x4 (&acc)[2][2][4][2], const Unit& u, int wr, int wc, int fr, int fq) const {
        f32x4 t = (f32x4){0.f, 0.f, 0.f, 0.f};
#pragma unroll
        for (int ai = 0; ai < 2; ++ai)
#pragma unroll
            for (int bj = 0; bj < 2; ++bj)
#pragma unroll
                for (int m = 0; m < 4; ++m) { t += acc[ai][bj][m][0]; t += acc[ai][bj][m][1]; }
        if (t[0] + t[1] + t[2] + t[3] == 12345.678f) *sink = t[0];
    }
};
struct EpiQKV {
    static constexpr bool PERM = true, AFTER_DRAIN = false, F16 = true;
    bf16_t* O; const unsigned* rope; float qscale; RowLN ln;
    __device__ __forceinline__ void operator()(const f32x4 (&acc)[2][2][4][2], const Unit& u, int wr, int wc, int fr, int fq) const {
        const int pn = u.pn, row0 = u.pm * BM + wr * 64 + fr, col0 = pn * BM + wc * 32 + 8 * fq, i0 = 16 * (wc & 1) + 4 * fq;
        const bool anyrope = (pn != 4 && pn != 5);
        const float sc = (pn < 2 || pn == 6 || pn == 7) ? qscale : 1.0f;
        f32x4 cs[2][2], bw[2][2];
#pragma unroll
        for (int bj = 0; bj < 2; ++bj)
#pragma unroll
            for (int n = 0; n < 2; ++n) { cs[bj][n] = *(const f32x4*)(ln.cs + col0 + bj * HALF + 4 * n); bw[bj][n] = *(const f32x4*)(ln.bw + col0 + bj * HALF + 4 * n); }
#pragma unroll
        for (int ai = 0; ai < 2; ++ai) {
            f16x8 rp4[4]; float ra[4], rc[4];
#pragma unroll
            for (int m = 0; m < 4; ++m) ln.row(row0 + ai * HALF + m * 16, ra[m], rc[m]);
#pragma unroll
            for (int m = 0; m < 4; ++m) { const int row = row0 + ai * HALF + m * 16;
                if (anyrope) rp4[m] = *(const f16x8*)(rope + (size_t)row * 32 + i0); else rp4[m] = (f16x8){1, 0, 1, 0, 1, 0, 1, 0}; }
            asm volatile("" ::: "memory");
#pragma unroll
            for (int m = 0; m < 4; ++m) {
                const int row = row0 + ai * HALF + m * 16; const float a = ra[m], c = rc[m];
                const f16x8 h = rp4[m];
                const float c0 = (float)h[0], s0 = (float)h[1], c1 = (float)h[2], s1 = (float)h[3], c2 = (float)h[4], s2 = (float)h[5], c3 = (float)h[6], s3 = (float)h[7];
#pragma unroll
                for (int bj = 0; bj < 2; ++bj) {
                    const bool rp = anyrope && !(pn == 8 && bj == 1);
                    f32x4 v0 = acc[ai][bj][m][0] * a + cs[bj][0] * c + bw[bj][0], v1 = acc[ai][bj][m][1] * a + cs[bj][1] * c + bw[bj][1];
                    if (rp) {
                        const f32x4 a0 = v0, a1 = v1;
                        v0[0] = a0[0] * c0 - a0[1] * s0; v0[1] = a0[1] * c0 + a0[0] * s0;
                        v0[2] = a0[2] * c1 - a0[3] * s1; v0[3] = a0[3] * c1 + a0[2] * s1;
                        v1[0] = a1[0] * c2 - a1[1] * s2; v1[1] = a1[1] * c2 + a1[0] * s2;
                        v1[2] = a1[2] * c3 - a1[3] * s3; v1[3] = a1[3] * c3 + a1[2] * s3;
                    }
                    v0 = v0 * sc; v1 = v1 * sc;
                    u32x4 w; w.x = cvtpk(v0[0], v0[1]); w.y = cvtpk(v0[2], v0[3]); w.z = cvtpk(v1[0], v1[1]); w.w = cvtpk(v1[2], v1[3]);
                    *(u32x4*)(O + (size_t)row * 2304 + col0 + bj * HALF) = w;
                }
            }
            asm volatile("" ::: "memory");
        }
    }
};

template <class Epi, class Sched, bool ALIGN_EPI = false, bool SP2 = false>
__device__ __forceinline__ void gemm_phase(PG8_LAS unsigned char* lds, const Gemm g, const Sched& S, const Epi& E, const int wave_in) {
    int tid_; asm volatile("v_mbcnt_lo_u32_b32 %0, -1, 0\n\tv_mbcnt_hi_u32_b32 %0, -1, %0" : "=v"(tid_)); tid_ += 64 * wave_in;
    const int tid = tid_, wid = __builtin_amdgcn_readfirstlane(tid >> 6), lane = tid & 63, wr = wid >> 2, wc = wid & 3, fr = lane & 15, fq = lane >> 4;
    const int K = g.K, nt = K / BK;
    unsigned voffA[2], voffB[2];
#pragma unroll
    for (int i = 0; i < 2; ++i) { int R, C; stage_rc(tid * 16 + i * 8192, R, C); const int Rb = Epi::PERM ? ((R & ~31) + perm32(R & 31)) : R;
        voffA[i] = (unsigned)(R * K + C) * 2u; voffB[i] = (unsigned)(Rb * K + C) * 2u; }
    const size_t kstep = (size_t)(BK * 2);
    const size_t hstep = (size_t)HALF * K * 2;
    const size_t tstep = 2 * hstep;
    const unsigned ldsw = (unsigned)wid * 1024u;
    const int aoff = lds_byte(wr * 64 + fr, fq * 8), boff = lds_byte(wc * 32 + fr, fq * 8);
#define PG8_SA(b, h) (((b) * 2 + (h)) * HTB)
#define PG8_SB(b, h) ((4 + (b) * 2 + (h)) * HTB)
#define PG8_STAGE(bufoff, gbase, voff) do { _Pragma("unroll") for (int _i = 0; _i < 2; ++_i) \
        __builtin_amdgcn_global_load_lds((const unsigned*)((const char*)(gbase) + (voff)[_i]), (PG8_LAS unsigned*)(lds + (bufoff) + ldsw + _i * 8192), 16, 0, 0); } while (0)
#define PG8_LDA(dst, b, h) do { _Pragma("unroll") for (int m = 0; m < 4; ++m) _Pragma("unroll") for (int k = 0; k < 2; ++k) dst[m][k] = *(const PG8_LAS bf16x8*)(lds + PG8_SA(b, h) + aoff + m * 2048 + k * 1024); } while (0)
#define PG8_LDB(dst, b, h) do { _Pragma("unroll") for (int n = 0; n < 2; ++n) _Pragma("unroll") for (int k = 0; k < 2; ++k) dst[n][k] = *(const PG8_LAS bf16x8*)(lds + PG8_SB(b, h) + boff + n * 2048 + k * 1024); } while (0)
#define PG8_MMA(ai, bj, At, Bt) do { __builtin_amdgcn_s_setprio(1); _Pragma("unroll") for (int m = 0; m < 4; ++m) _Pragma("unroll") for (int n = 0; n < 2; ++n) _Pragma("unroll") for (int k = 0; k < 2; ++k) \
        acc[ai][bj][m][n] = mma16<Epi::F16>(Bt[n][k], At[m][k], acc[ai][bj][m][n]); __builtin_amdgcn_s_setprio(0); } while (0)
#define PG8_WAIT_V(n) asm volatile("s_waitcnt vmcnt(" #n ")" ::: "memory")
#define PG8_WAIT_L(n) asm volatile("s_waitcnt lgkmcnt(" #n ")" ::: "memory")
#define PG8_BAR __builtin_amdgcn_s_barrier()
#define PG8_SCHED __builtin_amdgcn_sched_barrier(0)
    Unit cur, nxt; int ui = 0;
    if (!S.next(0, cur)) return;
    f32x4 acc[2][2][4][2];
#pragma unroll
    for (int a = 0; a < 2; ++a)
#pragma unroll
        for (int b = 0; b < 2; ++b)
#pragma unroll
            for (int m = 0; m < 4; ++m)
#pragma unroll
                for (int n = 0; n < 2; ++n) acc[a][b][m][n] = (f32x4){0.f, 0.f, 0.f, 0.f};
    bf16x8 At[4][2], B0[2][2], B1[2][2];
    const char* cA = (const char*)g.A + (size_t)cur.pm * tstep; const char* cB = (const char*)g.Bt + (size_t)cur.pn * tstep;
    S.a_ready(cur);
    if constexpr (SP2) {
        PG8_STAGE(PG8_SB(0, 0), cB, voffB); PG8_STAGE(PG8_SB(0, 1), cB + hstep, voffB); PG8_STAGE(PG8_SA(0, 0), cA, voffA); PG8_STAGE(PG8_SA(0, 1), cA + hstep, voffA);
        if (wr == 1) PG8_BAR;
        PG8_WAIT_V(2); PG8_BAR;
        PG8_STAGE(PG8_SB(1, 0), cB + kstep, voffB); PG8_STAGE(PG8_SA(1, 0), cA + kstep, voffA); PG8_STAGE(PG8_SB(1, 1), cB + hstep + kstep, voffB);
        PG8_WAIT_V(6); PG8_BAR;
    } else {
        PG8_STAGE(PG8_SB(0, 0), cB, voffB); PG8_STAGE(PG8_SA(0, 0), cA, voffA); PG8_STAGE(PG8_SB(0, 1), cB + hstep, voffB); PG8_STAGE(PG8_SA(0, 1), cA + hstep, voffA);
        if (wr == 1) PG8_BAR;
        PG8_WAIT_V(4); PG8_BAR;
        PG8_STAGE(PG8_SB(1, 0), cB + kstep, voffB); PG8_STAGE(PG8_SA(1, 0), cA + kstep, voffA); PG8_STAGE(PG8_SB(1, 1), cB + hstep + kstep, voffB);
        PG8_WAIT_V(6); PG8_BAR;
    }
    for (;;) {
        const bool has_next = S.next(ui + 1, nxt);
        const char* nA = has_next ? (const char*)g.A + (size_t)nxt.pm * tstep : cA; const char* nB = has_next ? (const char*)g.Bt + (size_t)nxt.pn * tstep : cB;
        for (int t = 0; t < nt; t += 2) {
            const bool last = (t == nt - 2);
            const char* a1 = cA + (size_t)(t + 1) * kstep;
            const char* a2 = last ? nA : cA + (size_t)(t + 2) * kstep; const char* b2 = last ? nB : cB + (size_t)(t + 2) * kstep;
            const char* a3 = a2 + kstep; const char* b3 = b2 + kstep;
            if (last && has_next) S.a_ready(nxt);
            if constexpr (SP2) {
            PG8_LDB(B0, 0, 0); PG8_LDB(B1, 0, 1); PG8_SCHED; PG8_LDA(At, 0, 0); PG8_STAGE(PG8_SA(1, 1), a1 + hstep, voffA);
            PG8_WAIT_V(8); PG8_WAIT_L(0); PG8_BAR; PG8_MMA(0, 0, At, B0); PG8_MMA(0, 1, At, B1); PG8_BAR; PG8_SCHED;
            PG8_LDA(At, 0, 1); PG8_STAGE(PG8_SB(0, 0), b2, voffB); PG8_STAGE(PG8_SB(0, 1), b2 + hstep, voffB); PG8_STAGE(PG8_SA(0, 0), a2, voffA);
            PG8_WAIT_V(8); PG8_WAIT_L(0); PG8_BAR; PG8_MMA(1, 0, At, B0); PG8_MMA(1, 1, At, B1); PG8_BAR; PG8_SCHED;
            PG8_LDB(B0, 1, 0); PG8_LDB(B1, 1, 1); PG8_SCHED; PG8_LDA(At, 1, 0); PG8_STAGE(PG8_SA(0, 1), a2 + hstep, voffA);
            PG8_WAIT_V(8); PG8_WAIT_L(0); PG8_BAR; PG8_MMA(0, 0, At, B0); PG8_MMA(0, 1, At, B1); PG8_BAR; PG8_SCHED;
            PG8_LDA(At, 1, 1); PG8_STAGE(PG8_SB(1, 0), b3, voffB); PG8_STAGE(PG8_SB(1, 1), b3 + hstep, voffB); PG8_STAGE(PG8_SA(1, 0), a3, voffA);
            PG8_WAIT_V(8); PG8_WAIT_L(0); PG8_BAR; PG8_MMA(1, 0, At, B0); PG8_MMA(1, 1, At, B1); PG8_BAR; PG8_SCHED;
            } else {
            PG8_LDB(B0, 0, 0); PG8_SCHED; PG8_LDA(At, 0, 0); PG8_STAGE(PG8_SA(1, 1), a1 + hstep, voffA);
            PG8_WAIT_L(8); PG8_BAR; PG8_WAIT_L(0); PG8_MMA(0, 0, At, B0); PG8_BAR; PG8_SCHED;
            PG8_LDB(B1, 0, 1); PG8_STAGE(PG8_SB(0, 0), b2, voffB);
            PG8_BAR; PG8_WAIT_L(0); PG8_MMA(0, 1, At, B1); PG8_BAR;
            PG8_LDA(At, 0, 1); PG8_STAGE(PG8_SA(0, 0), a2, voffA);
            PG8_BAR; PG8_WAIT_L(0); PG8_MMA(1, 0, At, B0); PG8_BAR; PG8_SCHED;
            PG8_STAGE(PG8_SB(0, 1), b2 + hstep, voffB);
            PG8_WAIT_V(6); PG8_BAR; PG8_MMA(1, 1, At, B1); PG8_BAR;
            PG8_LDB(B0, 1, 0); PG8_SCHED; PG8_LDA(At, 1, 0); PG8_STAGE(PG8_SA(0, 1), a2 + hstep, voffA);
            PG8_WAIT_L(8); PG8_BAR; PG8_WAIT_L(0); PG8_MMA(0, 0, At, B0); PG8_BAR; PG8_SCHED;
            PG8_LDB(B1, 1, 1); PG8_STAGE(PG8_SB(1, 0), b3, voffB);
            PG8_BAR; PG8_WAIT_L(0); PG8_MMA(0, 1, At, B1); PG8_BAR;
            PG8_LDA(At, 1, 1); PG8_STAGE(PG8_SA(1, 0), a3, voffA);
            PG8_BAR; PG8_WAIT_L(0); PG8_MMA(1, 0, At, B0); PG8_BAR; PG8_SCHED;
            PG8_STAGE(PG8_SB(1, 1), b3 + hstep, voffB);
            PG8_WAIT_V(6); PG8_BAR; PG8_MMA(1, 1, At, B1); PG8_BAR;
            }
        }
        if constexpr (ALIGN_EPI) { if (wr == 0) PG8_BAR; }
        if constexpr (!Epi::AFTER_DRAIN) { E(acc, cur, wr, wc, fr, fq); S.done(cur); }
        if (!has_next) break;
#pragma unroll
        for (int a = 0; a < 2; ++a)
#pragma unroll
            for (int b = 0; b < 2; ++b)
#pragma unroll
                for (int m = 0; m < 4; ++m)
#pragma unroll
                    for (int n = 0; n < 2; ++n) acc[a][b][m][n] = (f32x4){0.f, 0.f, 0.f, 0.f};
        cur = nxt; cA = nA; cB = nB; ++ui;
        if constexpr (ALIGN_EPI) { if (wr == 1) PG8_BAR; }
    }
    PG8_WAIT_V(0);
    if constexpr (!ALIGN_EPI) { if (wr == 0) PG8_BAR; }
    PG8_BAR;
    if constexpr (Epi::AFTER_DRAIN) { E.fused(acc, cur, wr, wc, fr, fq, lds, wid, lane); S.done(cur); }
#undef PG8_SA
#undef PG8_SB
#undef PG8_STAGE
#undef PG8_LDA
#undef PG8_LDB
#undef PG8_MMA
#undef PG8_WAIT_V
#undef PG8_WAIT_L
#undef PG8_BAR
#undef PG8_SCHED
}
}

namespace att {
using pg8::bf16_t; using pg8::bf16x8; using pg8::f32x4; using pg8::u32x4; using pg8::cvtpk;
#define ALDS __attribute__((address_space(3)))
typedef float f32x16 __attribute__((ext_vector_type(16)));
typedef short s16x4 __attribute__((ext_vector_type(4)));
typedef unsigned u32x2 __attribute__((ext_vector_type(2)));
constexpr int PITCH = 2304;
constexpr float THR = 8.0f;
__device__ __forceinline__ void glds16(const void* gsrc, unsigned lds_dst) { unsigned keep;
    asm volatile("s_mov_b32 %0, m0\n\ts_mov_b32 m0, %2\n\ts_nop 0\n\tglobal_load_lds_dwordx4 %1, off\n\ts_mov_b32 m0, %0" : "=&s"(keep) : "v"(gsrc), "s"(lds_dst) : "memory"); }
__device__ __forceinline__ void glds16s(unsigned voff, const void* sbase_, unsigned lds_dst) { unsigned keep;
    const unsigned long long sbase = ((unsigned long long)(unsigned)__builtin_amdgcn_readfirstlane((int)((unsigned long long)(uintptr_t)sbase_ >> 32)) << 32) | (unsigned)__builtin_amdgcn_readfirstlane((int)(unsigned)(uintptr_t)sbase_);
    asm volatile("s_mov_b32 %0, m0\n\ts_mov_b32 m0, %3\n\ts_nop 0\n\tglobal_load_lds_dwordx4 %1, %2\n\ts_mov_b32 m0, %0" : "=&s"(keep) : "v"(voff), "s"(sbase), "s"(lds_dst) : "memory"); }
__device__ __forceinline__ unsigned rfl(unsigned v) { return (unsigned)__builtin_amdgcn_readfirstlane((int)v); }
__device__ __forceinline__ int pi23(int x) { return (x & ~12) | ((x & 4) << 1) | ((x & 8) >> 1); }
__device__ __forceinline__ s16x4 vtr(const ALDS unsigned char* p) { return __builtin_bit_cast(s16x4, __builtin_amdgcn_ds_read_tr16_b64_v4i16((ALDS s16x4*)p)); }
__device__ __forceinline__ float halfswap_max(float v) { auto rr = __builtin_amdgcn_permlane32_swap(__float_as_uint(v), __float_as_uint(v), false, false); return fmaxf(__uint_as_float(rr[0]), __uint_as_float(rr[1])); }
__device__ __forceinline__ float halfswap_sum(float v) { auto rr = __builtin_amdgcn_permlane32_swap(__float_as_uint(v), __float_as_uint(v), false, false); return __uint_as_float(rr[0]) + __uint_as_float(rr[1]); }

template <int DV, bool BAND>
__device__ __forceinline__ float attn_core(ALDS unsigned char* ring, const int wid, const int lane,
                                           const bf16_t* Qw, const bf16_t* gbase, const unsigned koffb, const unsigned voffb, const int koff,
                                           const int t0, const int t1, const int tq, const int qpos, const float m_init, float l, f32x16 (&o)[DV / 32]) {
    constexpr int NDB = DV / 32, SLOT = (DV == 128) ? 32768 : 16384, VOFF = (DV == 128) ? 16384 : 8192, ROWB = DV * 2, NP = (DV == 128) ? 4 : 2;
    const int r32 = lane & 31, hi = lane >> 5;
    const unsigned ring_a = (unsigned)(uintptr_t)ring;
    bf16x8 qr[4];
#pragma unroll
    for (int d0 = 0; d0 < 4; ++d0) qr[d0] = *(const bf16x8*)(Qw + (size_t)r32 * PITCH + d0 * 16 + hi * 8);
#define ATT_PIECE(i_, t_, so_) do { const char* sb_ = (const char*)gbase + (size_t)(t_) * (64 * PITCH * 2); const unsigned d_ = ring_a + (unsigned)(so_) + (unsigned)wid * 1024u; \
        if (DV == 128) { if ((i_) == 0) glds16s(koffb, sb_, d_); else if ((i_) == 1) glds16s(koffb, sb_ + 128, d_ + 8192u); \
                         else if ((i_) == 2) glds16s(voffb, sb_, ring_a + (unsigned)(so_) + (unsigned)VOFF + (unsigned)wid * 2048u); \
                         else glds16s(voffb, sb_ + 4 * PITCH * 2, ring_a + (unsigned)(so_) + (unsigned)VOFF + (unsigned)wid * 2048u + 1024u); } \
        else { if ((i_) == 0) glds16s(koffb, sb_, d_); else if ((i_) == 2) glds16s(voffb, sb_, d_ + (unsigned)VOFF); } } while (0)
#define ATT_ISSUE(t_, so_) do { ATT_PIECE(0, t_, so_); ATT_PIECE(1, t_, so_); ATT_PIECE(2, t_, so_); ATT_PIECE(3, t_, so_); } while (0)
    ATT_ISSUE(t0, 0);
    { const int tn = (t0 + 1 < t1) ? t0 + 1 : t1 - 1; ATT_ISSUE(tn, SLOT); }
    const int g = (lane >> 4) & 1, q4 = (lane & 15) >> 2, p = lane & 3, sw = (DV == 128) ? q4 : (q4 >> 1);
    int va[NDB];
#pragma unroll
    for (int db = 0; db < NDB; ++db) va[db] = VOFF + (8 * hi + q4) * ROWB + ((db ^ sw) << 6) + (2 * g + (p >> 1)) * 16 + 8 * (p & 1);
    const int ka = koff + hi * 1024 + r32 * 16;
    float m = m_init;
    f32x16 negm;
#pragma unroll
    for (int r = 0; r < 16; ++r) negm[r] = -m;
#pragma unroll
    for (int db = 0; db < NDB; ++db)
#pragma unroll
        for (int r = 0; r < 16; ++r) o[db][r] = 0.f;
    if (wid >= 4) __builtin_amdgcn_s_setprio(1);
    int s_cur = 0, s_n2 = 2 * SLOT;
    for (int t = t0; t < t1; ++t) {
        asm volatile("s_waitcnt vmcnt(%0)" :: "n"(NP) : "memory");
        asm volatile("s_waitcnt lgkmcnt(0)\n\ts_barrier" ::: "memory");
        const int tn = (t + 2 < t1) ? t + 2 : t1 - 1;
        const ALDS unsigned char* sb = ring + s_cur;
        f32x16 p0 = negm, p1 = negm;
        bf16x8 kf[8];
#pragma unroll
        for (int d0 = 0; d0 < 4; ++d0) { kf[2 * d0] = *(const ALDS bf16x8*)(sb + ka + d0 * 2048); kf[2 * d0 + 1] = *(const ALDS bf16x8*)(sb + ka + d0 * 2048 + 512); }
        s16x4 vlo[2][NDB], vhh[2][NDB];
#pragma unroll
        for (int db = 0; db < NDB; ++db) { vlo[0][db] = vtr(sb + va[db]); vhh[0][db] = vtr(sb + va[db] + 4 * ROWB); }
        __builtin_amdgcn_sched_barrier(0);
#pragma unroll
        for (int d0 = 0; d0 < 4; ++d0) {
            p0 = __builtin_amdgcn_mfma_f32_32x32x16_bf16(kf[2 * d0], qr[d0], p0, 0, 0, 0);
            p1 = __builtin_amdgcn_mfma_f32_32x32x16_bf16(kf[2 * d0 + 1], qr[d0], p1, 0, 0, 0);
            __builtin_amdgcn_sched_barrier(0);
            ATT_PIECE(d0, tn, s_n2);
            __builtin_amdgcn_sched_barrier(0);
        }
        if (BAND) {
            if (t == tq - 2 || t == tq + 2) {
                const int rel0 = t * 64 + 8 * hi - qpos;
#pragma unroll
                for (int r = 0; r < 16; ++r) { const int rel = rel0 + 16 * (r >> 3) + (r & 7);
                    if (rel < -128 || rel > 128) p0[r] = -INFINITY;
                    if (rel + 32 < -128 || rel + 32 > 128) p1[r] = -INFINITY; }
            }
        }
        float mx = fmaxf(p0[0], p1[0]);
#pragma unroll
        for (int r = 1; r < 16; ++r) mx = fmaxf(fmaxf(mx, p0[r]), p1[r]);
        mx = halfswap_max(mx);
        const bool first = (!BAND) && (t == t0);
        const float dl = first ? mx : ((mx > THR) ? mx : 0.f);
        if (__any(dl != 0.f)) {
            m += dl;
#pragma unroll
            for (int r = 0; r < 16; ++r) { p0[r] -= dl; p1[r] -= dl; negm[r] = -m; }
            const float f = first ? 1.f : __builtin_amdgcn_exp2f(-dl);
            l *= f;
#pragma unroll
            for (int db = 0; db < NDB; ++db)
#pragma unroll
                for (int r = 0; r < 16; ++r) o[db][r] *= f;
        }
        float ssum = 0.f;
        bf16x8 pf;
#define ATT_EXP_SLICE(P_, B_, DST_) do { u32x4 w_; \
        P_[B_ + 0] = __builtin_amdgcn_exp2f(P_[B_ + 0]); P_[B_ + 1] = __builtin_amdgcn_exp2f(P_[B_ + 1]); P_[B_ + 2] = __builtin_amdgcn_exp2f(P_[B_ + 2]); P_[B_ + 3] = __builtin_amdgcn_exp2f(P_[B_ + 3]); \
        P_[B_ + 4] = __builtin_amdgcn_exp2f(P_[B_ + 4]); P_[B_ + 5] = __builtin_amdgcn_exp2f(P_[B_ + 5]); P_[B_ + 6] = __builtin_amdgcn_exp2f(P_[B_ + 6]); P_[B_ + 7] = __builtin_amdgcn_exp2f(P_[B_ + 7]); \
        ssum += ((P_[B_ + 0] + P_[B_ + 1]) + (P_[B_ + 2] + P_[B_ + 3])) + ((P_[B_ + 4] + P_[B_ + 5]) + (P_[B_ + 6] + P_[B_ + 7])); \
        w_.x = cvtpk(P_[B_ + 0], P_[B_ + 1]); w_.y = cvtpk(P_[B_ + 2], P_[B_ + 3]); w_.z = cvtpk(P_[B_ + 4], P_[B_ + 5]); w_.w = cvtpk(P_[B_ + 6], P_[B_ + 7]); DST_ = __builtin_bit_cast(bf16x8, w_); } while (0)
        ATT_EXP_SLICE(p0, 0, pf);
        __builtin_amdgcn_sched_barrier(0);
#pragma unroll
        for (int ks = 0; ks < 4; ++ks) {
            bf16x8 pfn = pf;
            if (ks + 1 < 4) {
#pragma unroll
                for (int db = 0; db < NDB; ++db) { vlo[(ks + 1) & 1][db] = vtr(sb + va[db] + (ks + 1) * (16 * ROWB)); vhh[(ks + 1) & 1][db] = vtr(sb + va[db] + (ks + 1) * (16 * ROWB) + 4 * ROWB); }
            }
#pragma unroll
            for (int db = 0; db < NDB; ++db) {
                const s16x4 lo = vlo[ks & 1][db], hh = vhh[ks & 1][db];
                const bf16x8 vf = (bf16x8){lo[0], lo[1], lo[2], lo[3], hh[0], hh[1], hh[2], hh[3]};
                o[db] = __builtin_amdgcn_mfma_f32_32x32x16_bf16(vf, pf, o[db], 0, 0, 0);
            }
            if (ks == 0) ATT_EXP_SLICE(p0, 8, pfn);
            if (ks == 1) ATT_EXP_SLICE(p1, 0, pfn);
            if (ks == 2) ATT_EXP_SLICE(p1, 8, pfn);
            if (ks + 1 < 4) {
                __builtin_amdgcn_sched_group_barrier(0x100, 2 * NDB, 0);
#pragma unroll
                for (int db = 0; db < NDB; ++db) { __builtin_amdgcn_sched_group_barrier(0x008, 1, 0); __builtin_amdgcn_sched_group_barrier(0x002, 20 / NDB, 0); }
            }
            __builtin_amdgcn_sched_barrier(0);
            pf = pfn;
        }
#undef ATT_EXP_SLICE
        l += ssum;
        s_cur = (s_cur == 2 * SLOT) ? 0 : s_cur + SLOT; s_n2 = (s_n2 == 2 * SLOT) ? 0 : s_n2 + SLOT;
    }
    __builtin_amdgcn_s_setprio(0);
    asm volatile("s_waitcnt vmcnt(0) lgkmcnt(0)\n\ts_barrier" ::: "memory");
#undef ATT_ISSUE
#undef ATT_PIECE
    return l;
}

__device__ __forceinline__ void diff_unit(ALDS unsigned char* ring, const int wid, int lane, const bf16_t* qkv, bf16_t* ymix, const int u, const float lam, const float post, const float* subg) {
    asm volatile("" : "+v"(lane));
    const int bh = u >> 5, qb = u & 31, b = bh >> 2, h = bh & 3, comp = wid >> 2, wq = wid & 3, r32 = lane & 31, hi = lane >> 5;
    const size_t rowbase = (size_t)b * 4096;
    const int q0 = qb * 128 + wq * 32;
    const bf16_t* Qw = qkv + (rowbase + q0) * PITCH + h * 128 + comp * 64;
    const bf16_t* gbase = qkv + rowbase * PITCH;
    const unsigned koffb = (unsigned)((pi23(lane) * PITCH + 512 + h * 128 + wid * 8) * 2);
    const unsigned voffb = (unsigned)(((8 * wid + (lane >> 4)) * PITCH + 1024 + h * 128 + (((lane & 15) ^ ((lane >> 4) << 2)) * 8)) * 2);
    f32x16 o[4];
    float l = attn_core<128, false>(ring, wid, lane, Qw, gbase, koffb, voffb, comp * 8192, 0, 64, 0, 0, 0.f, 0.f, o);
    l = halfswap_sum(l);
    const float inv = 1.0f / l;
    ALDS f32x4* X = (ALDS f32x4*)ring + (size_t)wq * (16 * 64);
    if (comp == 1) {
#pragma unroll
        for (int db = 0; db < 4; ++db)
#pragma unroll
            for (int rq = 0; rq < 4; ++rq) X[(db * 4 + rq) * 64 + lane] = (f32x4){o[db][4 * rq] * inv, o[db][4 * rq + 1] * inv, o[db][4 * rq + 2] * inv, o[db][4 * rq + 3] * inv};
    }
    asm volatile("s_waitcnt lgkmcnt(0)\n\ts_barrier" ::: "memory");
    if (comp == 0) {
        float ss = 0.f;
#pragma unroll
        for (int db = 0; db < 4; ++db)
#pragma unroll
            for (int rq = 0; rq < 4; ++rq) { const f32x4 o2 = X[(db * 4 + rq) * 64 + lane];
#pragma unroll
                for (int e = 0; e < 4; ++e) { const float d = o[db][4 * rq + e] * inv - lam * o2[e]; o[db][4 * rq + e] = d; ss += d * d; } }
        ss = halfswap_sum(ss);
        const float rs = rsqrtf(ss * (1.0f / 128.0f) + 1e-5f) * post;
        bf16_t* orow = ymix + (rowbase + q0 + r32) * 1024 + h * 128 + 4 * hi;
#pragma unroll
        for (int db = 0; db < 4; ++db)
#pragma unroll
            for (int rq = 0; rq < 4; ++rq) { const f32x4 gv = *(const f32x4*)(subg + 32 * db + 8 * rq + 4 * hi);
                u32x2 w; w.x = cvtpk(o[db][4 * rq] * rs * gv[0], o[db][4 * rq + 1] * rs * gv[1]); w.y = cvtpk(o[db][4 * rq + 2] * rs * gv[2], o[db][4 * rq + 3] * rs * gv[3]);
                *(u32x2*)(orow + 32 * db + 8 * rq) = w; }
    }
    asm volatile("s_waitcnt lgkmcnt(0)\n\ts_barrier" ::: "memory");
}

__device__ __forceinline__ void swa_unit(ALDS unsigned char* ring, const int wid, int lane, const bf16_t* qkv, bf16_t* ymix, const int u, const float* sink) {
    asm volatile("" : "+v"(lane));
    const int bkv = u >> 6, qblk = u & 63, b = bkv >> 1, kvh = bkv & 1, head = kvh * 4 + (wid >> 1), r32 = lane & 31, hi = lane >> 5;
    const size_t rowbase = (size_t)b * 4096;
    const int q0 = qblk * 64 + (wid & 1) * 32;
    const bf16_t* Qw = qkv + (rowbase + q0) * PITCH + 1536 + head * 64;
    const bf16_t* gbase = qkv + rowbase * PITCH;
    const unsigned koffb = (unsigned)((pi23(lane) * PITCH + 2048 + kvh * 64 + wid * 8) * 2);
    const unsigned voffb = (unsigned)(((8 * wid + (lane >> 3)) * PITCH + 2176 + kvh * 64 + (((lane & 7) ^ (((lane >> 4) & 1) << 2)) * 8)) * 2);
    const int t0 = (qblk - 2 > 0) ? qblk - 2 : 0, t1 = ((qblk + 2 < 63) ? qblk + 2 : 63) + 1;
    f32x16 o[2];
    float l = attn_core<64, true>(ring, wid, lane, Qw, gbase, koffb, voffb, 0, t0, t1, qblk, q0 + r32, sink[head] * 1.4426950408889634f, (hi == 0) ? 1.0f : 0.0f, o);
    l = halfswap_sum(l);
    const float inv = 1.0f / l;
    bf16_t* orow = ymix + (rowbase + q0 + r32) * 1024 + 512 + head * 64 + 4 * hi;
#pragma unroll
    for (int db = 0; db < 2; ++db)
#pragma unroll
        for (int rq = 0; rq < 4; ++rq) { u32x2 w; w.x = cvtpk(o[db][4 * rq] * inv, o[db][4 * rq + 1] * inv); w.y = cvtpk(o[db][4 * rq + 2] * inv, o[db][4 * rq + 3] * inv);
            *(u32x2*)(orow + 32 * db + 8 * rq) = w; }
}
}

#ifndef REP_DIFF
#define REP_DIFF 1
#endif
#ifndef VARP
#define VARP 0
#endif
#ifndef REP_SWA
#define REP_SWA 1
#endif
#ifndef REP_G3
#define REP_G3 1
#endif
#ifndef REP_FOUT
#define REP_FOUT 0
#endif
#ifndef REP_RES
#define REP_RES 0
#endif
#ifndef REP_OPROJ
#define REP_OPROJ 0
#endif
#ifndef REP_G1
#define REP_G1 1
#endif
#ifndef REP_SYNC
#define REP_SYNC 1
#endif
#ifndef REP_LN
#define REP_LN 1
#endif
#ifndef REP_PRO
#define REP_PRO 1
#endif
constexpr int NWAVES = 8;
constexpr int M = 65536, D = 1024, FF = 2816, NIN = 2304, SEQ = 4096, DEPTH = 4;
constexpr size_t MiB = 1u << 20;
constexpr size_t W1_OFF = 0, W1_B = (size_t)2 * FF * D * 2, W2_OFF = W1_OFF + W1_B, W2_B = (size_t)D * FF * 2, WIN_OFF = W2_OFF + W2_B, WIN_B = (size_t)NIN * D * 2,
                 WO_OFF = WIN_OFF + WIN_B, WO_B = (size_t)D * D * 2, W3_OFF = WO_OFF + WO_B, W4_OFF = W3_OFF + W1_B, WL_STRIDE = W4_OFF + W2_B;
constexpr size_t WS_W = 0, WS_ROPE = 160 * MiB, WS_XB = 176 * MiB, WS_H = 304 * MiB, WS_YM = 656 * MiB, WS_CSBW = 784 * MiB, WS_ST = 785 * MiB, WS_CTL = 786 * MiB, WS_END = 787 * MiB;
constexpr size_t CTL_ZERO_BYTES = 16384;
constexpr int CSBW_N = 2 * FF;
static_assert((size_t)DEPTH * 3 * 2 * CSBW_N * 4 <= MiB && (size_t)2 * M * 2 * 4 <= MiB, "aux map");
static_assert(WL_STRIDE * DEPTH <= WS_ROPE && WS_ROPE + (size_t)M * 64 * 4 <= WS_XB && WS_XB + (size_t)M * D * 2 <= WS_H && WS_H + (size_t)M * FF * 2 <= WS_YM && WS_YM + (size_t)M * D * 2 <= WS_END, "d_ws map");
constexpr int LDS_BYTES = 147456;
constexpr float ALPHA = 1.681792830507429f;
constexpr float QSCALE = 0.125f * 1.4426950408889634f;

typedef unsigned short bf16;
typedef float f32x4 __attribute__((ext_vector_type(4)));
typedef unsigned v4u __attribute__((ext_vector_type(4)));
typedef unsigned v2u __attribute__((ext_vector_type(2)));
using pg8::cvtpk;

struct Args { const float* in[13]; float* out; unsigned char* ws; float inv[32]; float lam_init[4]; };

__device__ __forceinline__ int cur_lane() { int l; asm volatile("v_mbcnt_lo_u32_b32 %0, -1, 0\n\tv_mbcnt_hi_u32_b32 %0, -1, %0" : "=v"(l)); return l; }
__device__ __forceinline__ float wave_sum(float v) {
#pragma unroll
    for (int o = 1; o < 64; o <<= 1) v += __shfl_xor(v, o);
    return v;
}
__device__ __forceinline__ int src_col(int type, int n) {
    if (type == 1) { const int pn = n >> 8, w = n & 255; return (w < 128) ? (128 * pn + w) : (FF + 128 * pn + (w - 128)); }
    if (type == 3) { const int w = n & 255, bj = w >> 7, wc = (w >> 5) & 3, c = w & 31; return (n & ~255) + 64 * wc + 32 * bj + c; }
    if (type == 2) { const bool rp = (n < 1024) || (n >= 1536 && n < 2176); return rp ? ((n & ~63) + ((n & 63) >> 1) + 32 * (n & 1)) : n; }
    return n;
}
template <bool F16> __device__ __forceinline__ void transpose_item(const float* W, int K, int N, int type, const float* gk, bf16* WT, ALDS float* scr, int item, int lane) {
    const int nblk = N / 32, kb = item / nblk, nb = item % nblk, k0 = 64 * kb, n0 = 32 * nb;
    const int sc = src_col(type, n0 + (lane & 31));
#pragma unroll
    for (int i = 0; i < 32; ++i) { const int kk = 2 * i + (lane >> 5); scr[kk * 33 + (lane & 31)] = W[(size_t)(k0 + kk) * N + sc] * (gk ? gk[k0 + kk] : 1.0f); }
    asm volatile("s_waitcnt lgkmcnt(0)" ::: "memory");
    const int c = lane & 7;
#pragma unroll
    for (int j = 0; j < 4; ++j) { const int n = (lane >> 3) + 8 * j; const ALDS float* s = scr + (8 * c) * 33 + n;
        v4u o; if (F16) { o.x = pg8::cvtpk_h(s[0 * 33], s[1 * 33]); o.y = pg8::cvtpk_h(s[2 * 33], s[3 * 33]); o.z = pg8::cvtpk_h(s[4 * 33], s[5 * 33]); o.w = pg8::cvtpk_h(s[6 * 33], s[7 * 33]); }
        else { o.x = cvtpk(s[0 * 33], s[1 * 33]); o.y = cvtpk(s[2 * 33], s[3 * 33]); o.z = cvtpk(s[4 * 33], s[5 * 33]); o.w = cvtpk(s[6 * 33], s[7 * 33]); }
        *(v4u*)(WT + (size_t)(n0 + n) * K + k0 + 8 * c) = o; }
    asm volatile("s_waitcnt lgkmcnt(0)" ::: "memory");
}
__device__ __forceinline__ void sincos_f32angle(float ang, float& c, float& s) {
    const double a = (double)ang, k = __builtin_rint(a * 0.63661977236758134308);
    double r = __builtin_fma(-k, 1.57079632679489655800e+00, a); r = __builtin_fma(-k, 6.12323399573676603587e-17, r);
    const double r2 = r * r;
    double sp = -1.0 / 1307674368000.0; sp = sp * r2 + 1.0 / 6227020800.0; sp = sp * r2 - 1.0 / 39916800.0; sp = sp * r2 + 1.0 / 362880.0; sp = sp * r2 - 1.0 / 5040.0; sp = sp * r2 + 1.0 / 120.0; sp = sp * r2 - 1.0 / 6.0;
    const double sn = r + r * r2 * sp;
    double cp = 1.0 / 20922789888000.0; cp = cp * r2 - 1.0 / 87178291200.0; cp = cp * r2 + 1.0 / 479001600.0; cp = cp * r2 - 1.0 / 3628800.0; cp = cp * r2 + 1.0 / 40320.0; cp = cp * r2 - 1.0 / 720.0; cp = cp * r2 + 1.0 / 24.0; cp = cp * r2 - 0.5;
    const double cn = 1.0 + r2 * cp;
    const int q = ((int)k) & 3;
    const double cc = (q == 0) ? cn : (q == 1) ? -sn : (q == 2) ? -cn : sn;
    const double ss = (q == 0) ? sn : (q == 1) ? cn : (q == 2) ? -sn : -cn;
    c = (float)cc; s = (float)ss;
}
__device__ __forceinline__ void ln_row(const float* xrow, const float* g, const float* bta, float* orow, bf16* brow, int lane) {
    asm volatile("" : "+v"(lane));
    const f32x4* xr = (const f32x4*)xrow + lane;
    f32x4 v[4]; float s = 0.f;
#pragma unroll
    for (int j = 0; j < 4; ++j) { v[j] = xr[64 * j]; s += (v[j][0] + v[j][1]) + (v[j][2] + v[j][3]); }
    const float mean = wave_sum(s) * (1.f / D); float s2 = 0.f;
#pragma unroll
    for (int j = 0; j < 4; ++j) { v[j] = v[j] - mean; s2 += (v[j][0] * v[j][0] + v[j][1] * v[j][1]) + (v[j][2] * v[j][2] + v[j][3] * v[j][3]); }
    const float rstd = 1.0f / sqrtf(wave_sum(s2) * (1.f / D) + 1e-5f);
#pragma unroll
    for (int j = 0; j < 4; ++j) { const f32x4 gg = *((const f32x4*)g + lane + 64 * j), bb = *((const f32x4*)bta + lane + 64 * j);
        const f32x4 y = v[j] * rstd * gg + bb;
        *((f32x4*)orow + lane + 64 * j) = y;
        v2u w; w.x = cvtpk(y[0], y[1]); w.y = cvtpk(y[2], y[3]); *((v2u*)brow + lane + 64 * j) = w; }
}

#define XB_TMO      128
#define XB_XCNT(j)  (256  + 64 * (j))
#define XB_XSUB(j)  (1280 + 64 * (j))
#define XB_XGEN(j)  (2304 + 64 * (j))
#define XB_TOP      3328
#define XB_TOPGEN   3392
#define XCD_BAR_WORDS 3456
#define XB_SPIN_CAP (1u << 18)

__device__ __forceinline__ unsigned xb_ld(unsigned* p)              { return __hip_atomic_load(p, __ATOMIC_RELAXED, __HIP_MEMORY_SCOPE_AGENT); }
__device__ __forceinline__ unsigned xb_add(unsigned* p, unsigned v) { return __hip_atomic_fetch_add(p, v, __ATOMIC_RELAXED, __HIP_MEMORY_SCOPE_AGENT); }
__device__ __forceinline__ unsigned xb_xcc_id() { return (unsigned)__builtin_amdgcn_s_getreg((3 << 11) | 20) & 0xFu; }
#define XB_SPIN(cond, bar) do { unsigned _sp = 0; while (cond) { __builtin_amdgcn_s_sleep(1); \
    if ((++_sp & 255u) == 0u) { if (xb_ld(&(bar)[XB_TMO])) break; if (_sp > XB_SPIN_CAP) { atomicAdd(&(bar)[XB_TMO], 1u); break; } } } } while (0)

struct XcdBarrier {
    unsigned* bar; unsigned x;
    volatile ALDS unsigned* st;
};

__device__ __forceinline__ XcdBarrier xcd_barrier_post(unsigned* bar, volatile ALDS unsigned* st) {
    XcdBarrier b; b.bar = bar; b.x = xb_xcc_id(); b.st = st;
    if (threadIdx.x == 0) (void)xb_add(&bar[XB_XCNT(b.x)], 1u);
    return b;
}
__device__ __forceinline__ void xcd_barrier_complete(unsigned* bar, unsigned x, unsigned& nloc, unsigned& nx) {
    const unsigned G = gridDim.x * gridDim.y * gridDim.z;
    unsigned sum, cnt, mine, sp = 0u;
    for (;;) {
        sum = 0u; cnt = 0u; mine = 0u;
#pragma unroll
        for (unsigned j = 0; j < 16; ++j) { const unsigned c = xb_ld(&bar[XB_XCNT(j)]); sum += c; cnt += (c > 0u) ? 1u : 0u; mine = (j == x) ? c : mine; }
        if (sum == G) break;
        __builtin_amdgcn_s_sleep(1);
        if ((++sp & 255u) == 0u) { if (xb_ld(&bar[XB_TMO])) break; if (sp > XB_SPIN_CAP) { atomicAdd(&bar[XB_TMO], 1u); break; } }
    }
    nloc = mine > 0u ? mine : 1u; nx = cnt > 0u ? cnt : 1u;
}

__device__ __forceinline__ void xcd_barrier(const XcdBarrier& b) {
    asm volatile("s_waitcnt vmcnt(0)" ::: "memory");
    __syncthreads();
    if (threadIdx.x == 0) {
        unsigned* bar = b.bar;
        __builtin_amdgcn_s_waitcnt(0);
        unsigned nloc = b.st[0], nx = b.st[1];
        if (nloc == 0u) { xcd_barrier_complete(bar, b.x, nloc, nx); b.st[0] = nloc; b.st[1] = nx; }
        const unsigned old = xb_add(&bar[XB_XSUB(b.x)], 1u);
        const unsigned gen = old / nloc;
        if (old + 1u == (gen + 1u) * nloc) {
            __builtin_amdgcn_fence(__ATOMIC_RELEASE, "agent");
            asm volatile("s_waitcnt vmcnt(0)" ::: "memory");
            const unsigned og = xb_add(&bar[XB_TOP], 1u);
            const unsigned tg = og / nx;
            if (og + 1u == (tg + 1u) * nx) xb_add(&bar[XB_TOPGEN], 1u);
            else XB_SPIN(xb_ld(&bar[XB_TOPGEN]) == tg, bar);
            __builtin_amdgcn_fence(__ATOMIC_ACQUIRE, "agent");
            xb_add(&bar[XB_XGEN(b.x)], 1u);
            asm volatile("s_waitcnt vmcnt(0)" ::: "memory");
        } else {
            XB_SPIN(xb_ld(&bar[XB_XGEN(b.x)]) == gen, bar);
            __builtin_amdgcn_fence(__ATOMIC_ACQUIRE, "agent");
            asm volatile("s_waitcnt vmcnt(0)" ::: "memory");
        }
    }
    __syncthreads();
}

__device__ __forceinline__ void ln_row_h(const bf16* hrow, const float* g, const float* bta, float* orow, int lane) {
    asm volatile("" : "+v"(lane));
    typedef _Float16 h4 __attribute__((ext_vector_type(4)));
    f32x4 v[4]; float s = 0.f;
#pragma unroll
    for (int j = 0; j < 4; ++j) { const h4 h = *((const h4*)hrow + lane + 64 * j); v[j] = (f32x4){(float)h[0], (float)h[1], (float)h[2], (float)h[3]}; s += (v[j][0] + v[j][1]) + (v[j][2] + v[j][3]); }
    const float mean = wave_sum(s) * (1.f / D); float s2 = 0.f;
#pragma unroll
    for (int j = 0; j < 4; ++j) { v[j] = v[j] - mean; s2 += (v[j][0] * v[j][0] + v[j][1] * v[j][1]) + (v[j][2] * v[j][2] + v[j][3] * v[j][3]); }
    const float rstd = 1.0f / sqrtf(wave_sum(s2) * (1.f / D) + 1e-5f);
#pragma unroll
    for (int j = 0; j < 4; ++j) { const f32x4 gg = *((const f32x4*)g + lane + 64 * j), bb = *((const f32x4*)bta + lane + 64 * j);
        *((f32x4*)orow + lane + 64 * j) = v[j] * rstd * gg + bb; }
}

__global__ void __launch_bounds__(NWAVES * 64, 2) fwd_megakernel(Args args) {
    extern __shared__ __attribute__((aligned(16))) unsigned char lds_raw[];
    cg::grid_group grid = cg::this_grid();
#define GSYNC() xcd_barrier(bar)
    ALDS unsigned char* lds = (ALDS unsigned char*)lds_raw;
    const int tid = threadIdx.x, lane = tid & 63, wave = __builtin_amdgcn_readfirstlane(tid >> 6);
    const int G = gridDim.x, bx = blockIdx.x, vcu = (G % 8 == 0) ? (bx % 8) * (G / 8) + bx / 8 : bx;
    unsigned char* ws = args.ws;
    const float* x_in = args.in[0]; const int* positions = (const int*)args.in[1];
    float* out = args.out;
    bf16* XB = (bf16*)(ws + WS_XB); bf16* HB = (bf16*)(ws + WS_H); bf16* QKV = (bf16*)(ws + WS_H); bf16* YM = (bf16*)(ws + WS_YM);
    unsigned* ROPEH = (unsigned*)(ws + WS_ROPE);
    float* ROPE = (float*)(ws + WS_ROPE); float* CSBW = (float*)(ws + WS_CSBW); float* ST = (float*)(ws + WS_ST); float* LAMV = (float*)(ws + WS_CSBW + 786432);
    const int gw = vcu * NWAVES + wave, NGW = G * NWAVES;
    volatile ALDS unsigned* bst = (volatile ALDS unsigned*)(lds + 131072 + 8192);
    if (tid < 2) bst[tid] = 0u;
    __syncthreads();
    XcdBarrier bar = xcd_barrier_post((unsigned*)(ws + WS_CTL), bst);

    for (int rep = 0; rep < REP_PRO; ++rep) {
        ALDS float* scr = (ALDS float*)(lds + wave * 16384);
        constexpr int I1 = (D / 64) * (2 * FF / 32), I2 = (FF / 64) * (D / 32), I3 = (D / 64) * (NIN / 32), I4 = (D / 64) * (D / 32), IL = 2 * I1 + 2 * I2 + I3 + I4;
        for (int it = gw; it < IL * DEPTH; it += NGW) {
            const int l = it / IL; int r = it % IL;
            unsigned char* wl = ws + WS_W + (size_t)l * WL_STRIDE;
            if (r < I1) { transpose_item<true>(args.in[7] + (size_t)l * D * 2 * FF, D, 2 * FF, 1, (l > 0) ? args.in[11] + (size_t)((l - 1) * 3 + 2) * D : nullptr, (bf16*)(wl + W1_OFF), scr, r, lane); continue; } r -= I1;
            if (r < I2) { transpose_item<false>(args.in[8] + (size_t)l * FF * D, FF, D, 3, nullptr, (bf16*)(wl + W2_OFF), scr, r, lane); continue; } r -= I2;
            if (r < I3) { transpose_item<true>(args.in[2] + (size_t)l * D * NIN, D, NIN, 2, args.in[11] + (size_t)(l * 3) * D, (bf16*)(wl + WIN_OFF), scr, r, lane); continue; } r -= I3;
            if (r < I4) { transpose_item<false>(args.in[3] + (size_t)l * D * D, D, D, 3, nullptr, (bf16*)(wl + WO_OFF), scr, r, lane); continue; } r -= I4;
            if (r < I1) { transpose_item<true>(args.in[9] + (size_t)l * D * 2 * FF, D, 2 * FF, 1, args.in[11] + (size_t)(l * 3 + 1) * D, (bf16*)(wl + W3_OFF), scr, r, lane); continue; } r -= I1;
            transpose_item<false>(args.in[10] + (size_t)l * FF * D, FF, D, 3, nullptr, (bf16*)(wl + W4_OFF), scr, r, lane);
        }
        const size_t gt = (size_t)vcu * (NWAVES * 64) + tid, GT = (size_t)G * NWAVES * 64;
        for (size_t i = gt; i < (size_t)M * D / 4; i += 8 * GT) {
            f32x4 v[8];
#pragma unroll
            for (int j = 0; j < 8; ++j) { const size_t ij = i + (size_t)j * GT; v[j] = (ij < (size_t)M * D / 4) ? *((const f32x4*)x_in + ij) : (f32x4){0.f, 0.f, 0.f, 0.f}; }
#pragma unroll
            for (int j = 0; j < 8; ++j) { const size_t ij = i + (size_t)j * GT; if (ij < (size_t)M * D / 4) { v2u w; w.x = pg8::cvtpk_h(v[j][0], v[j][1]); w.y = pg8::cvtpk_h(v[j][2], v[j][3]); *((v2u*)XB + ij) = w; } }
        }
        for (size_t i = gt; i < (size_t)M * 32; i += GT) { const int row = (int)(i >> 5), k = (int)(i & 31); float c, s; sincos_f32angle((float)positions[row] * args.inv[k], c, s);
            ROPEH[(size_t)row * 32 + k] = pg8::cvtpk_h(c, s); }
        if (vcu == 0 && wave < DEPTH) {
            const float* lv = args.in[4] + (size_t)wave * 256;
            const float a1 = wave_sum(lv[lane] * lv[64 + lane]), a2 = wave_sum(lv[128 + lane] * lv[192 + lane]);
            if (lane == 0) LAMV[wave] = expf(a1) - expf(a2) + args.lam_init[wave];
        }
        for (size_t i = gt; i < (size_t)M * 2; i += GT) ST[i] = 0.f;
        {
            ALDS float* red = (ALDS float*)(lds + 131072);
            constexpr int CG0 = 2 * FF / 64, CG1 = NIN / 64, CGL = 2 * CG0 + CG1;
            for (int cgi = vcu; cgi < CGL * DEPTH; cgi += G) {
                const int l = cgi / CGL; int r = cgi % CGL; int j = 0;
                if (r >= CG0) { r -= CG0; j = 1; if (r >= CG1) { r -= CG1; j = 2; } }
                const int lnidx = (j == 0) ? (l - 1) * 3 + 2 : (j == 1) ? l * 3 : l * 3 + 1;
                if (lnidx < 0) continue;
                const int N = (j == 1) ? NIN : 2 * FF, type = (j == 1) ? 2 : 1;
                const float* W = (j == 0) ? args.in[7] + (size_t)l * D * 2 * FF : (j == 1) ? args.in[2] + (size_t)l * D * NIN : args.in[9] + (size_t)l * D * 2 * FF;
                const float* gk = args.in[11] + (size_t)lnidx * D; const float* bk = args.in[12] + (size_t)lnidx * D;
                const int n = r * 64 + lane, sc = src_col(type, n);
                float c1 = 0.f, b1 = 0.f;
#pragma unroll 16
                for (int k = wave * 128; k < wave * 128 + 128; ++k) { const float w = W[(size_t)k * N + sc]; const float gw = gk[k] * w;
                    c1 += (float)(_Float16)gw; b1 += bk[k] * w; }
                red[(wave * 64 + lane) * 2] = c1; red[(wave * 64 + lane) * 2 + 1] = b1;
                __syncthreads();
                if (wave == 0) { float cc = 0.f, bb = 0.f;
#pragma unroll
                    for (int w8 = 0; w8 < 8; ++w8) { cc += red[(w8 * 64 + lane) * 2]; bb += red[(w8 * 64 + lane) * 2 + 1]; }
                    float* dst = CSBW + (size_t)((l * 3 + j) * 2) * CSBW_N; dst[n] = cc; dst[CSBW_N + n] = bb; }
                __syncthreads();
            }
        }
    }
    grid.sync();

#define ZERO_ST(buf_) do { int t_ = wave * 64 + cur_lane(); asm volatile("" : "+v"(t_)); float* z_ = ST + (size_t)(buf_) * M * 2; for (int i_ = vcu * (NWAVES * 64) + t_; i_ < M * 2; i_ += G * NWAVES * 64) { z_[i_] = 0.f; asm volatile("" : "+v"(i_)); } } while (0)
    for (int l = 0; l < DEPTH; ++l) {
        unsigned char* wl = ws + WS_W + (size_t)l * WL_STRIDE;
        const float* lng = args.in[11]; const float* lnb = args.in[12];
        { const int k = 3 * l; ZERO_ST(k & 1);
          const float* cb = CSBW + (size_t)((l * 3 + 0) * 2) * CSBW_N;
          pg8::Gemm g{XB, (const bf16*)(wl + W1_OFF), M, 2 * FF, D}; pg8::StaticOrder S; S.init(M, 2 * FF, G, bx);
          pg8::EpiSwiGLU E{HB, FF, pg8::RowLN{(k == 0) ? nullptr : ST + (size_t)((k - 1) & 1) * M * 2, cb, cb + CSBW_N}};
          for (int rep = 0; rep < REP_G1; ++rep) pg8::gemm_phase<pg8::EpiSwiGLU, pg8::StaticOrder, true, true>(lds, g, S, E, wave); }
        GSYNC();
        { const int k = 3 * l;
          pg8::Gemm g{HB, (const bf16*)(wl + W2_OFF), M, D, FF}; pg8::StaticOrder S; S.init(M, D, G, bx);
          for (int rep = 0; rep < REP_FOUT; ++rep) { pg8::EpiNull EN{ROPE}; pg8::gemm_phase<pg8::EpiNull, pg8::StaticOrder, true, true>(lds, g, S, EN, wave); }
          for (int rep = 0; rep < REP_RES; ++rep) { pg8::EpiRes ED{x_in, (bf16*)out, ST, lng, lnb, out + (size_t)48 * 1024 * 1024, ALPHA, 0.5f}; pg8::gemm_phase<pg8::EpiRes, pg8::StaticOrder, true, true>(lds, g, S, ED, wave); }
          pg8::EpiRes E{x_in, XB, (k == 0) ? nullptr : ST + (size_t)((k - 1) & 1) * M * 2, lng + (size_t)(k > 0 ? k - 1 : 0) * D, lnb + (size_t)(k > 0 ? k - 1 : 0) * D, ST + (size_t)(k & 1) * M * 2, ALPHA, 0.5f};
          pg8::gemm_phase<pg8::EpiRes, pg8::StaticOrder, true, true>(lds, g, S, E, wave); }
        GSYNC();
        { const int k = 3 * l + 1; ZERO_ST(k & 1);
          const float* cb = CSBW + (size_t)((l * 3 + 1) * 2) * CSBW_N;
          pg8::Gemm g{XB, (const bf16*)(wl + WIN_OFF), M, NIN, D}; pg8::StaticOrder S; S.init(M, NIN, G, bx);
          pg8::EpiQKV E{QKV, ROPEH, QSCALE, pg8::RowLN{ST + (size_t)((k - 1) & 1) * M * 2, cb, cb + CSBW_N}};
          for (int rep = 0; rep < REP_G3; ++rep) pg8::gemm_phase<pg8::EpiQKV, pg8::StaticOrder, true, true>(lds, g, S, E, wave); }
        GSYNC();
        {
            const float lam_init = args.lam_init[l], lam = LAMV[l];
            const float* subg = args.in[5] + (size_t)l * 128; const float* sink = args.in[6] + (size_t)l * 8;
            for (int rep = 0; rep < REP_DIFF; ++rep)
            for (int u = vcu; u < 2048; u += G) att::diff_unit(lds, wave, cur_lane(), QKV, YM, u, lam, 1.0f - lam_init, subg);
            for (int rep = 0; rep < REP_SWA; ++rep)
            for (int u = vcu; u < 2048; u += G) att::swa_unit(lds, wave, cur_lane(), QKV, YM, u, sink);
        }
        GSYNC();
        { const int k = 3 * l + 1;
          pg8::Gemm g{YM, (const bf16*)(wl + WO_OFF), M, D, D}; pg8::StaticOrder S; S.init(M, D, G, bx);
          for (int rep = 0; rep < REP_OPROJ; ++rep) { pg8::EpiNull EN{ROPE}; pg8::gemm_phase<pg8::EpiNull, pg8::StaticOrder, true, true>(lds, g, S, EN, wave); }
          pg8::EpiRes E{x_in, XB, ST + (size_t)((k - 1) & 1) * M * 2, lng + (size_t)(k - 1) * D, lnb + (size_t)(k - 1) * D, ST + (size_t)(k & 1) * M * 2, ALPHA, 1.0f};
          pg8::gemm_phase<pg8::EpiRes, pg8::StaticOrder, true, true>(lds, g, S, E, wave); }
        GSYNC();
        { const int k = 3 * l + 2; ZERO_ST(k & 1);
          const float* cb = CSBW + (size_t)((l * 3 + 2) * 2) * CSBW_N;
          pg8::Gemm g{XB, (const bf16*)(wl + W3_OFF), M, 2 * FF, D}; pg8::StaticOrder S; S.init(M, 2 * FF, G, bx);
          pg8::EpiSwiGLU E{HB, FF, pg8::RowLN{ST + (size_t)((k - 1) & 1) * M * 2, cb, cb + CSBW_N}};
          for (int rep = 0; rep < REP_G1; ++rep) pg8::gemm_phase<pg8::EpiSwiGLU, pg8::StaticOrder, true, true>(lds, g, S, E, wave); }
        GSYNC();
        { const int k = 3 * l + 2;
          pg8::Gemm g{HB, (const bf16*)(wl + W4_OFF), M, D, FF}; pg8::StaticOrder S; S.init(M, D, G, bx);
          for (int rep = 0; rep < REP_FOUT; ++rep) { pg8::EpiNull EN{ROPE}; pg8::gemm_phase<pg8::EpiNull, pg8::StaticOrder, true, true>(lds, g, S, EN, wave); }
          for (int rep = 0; rep < REP_RES; ++rep) { pg8::EpiRes ED{x_in, (bf16*)out, ST, lng, lnb, out + (size_t)48 * 1024 * 1024, ALPHA, 0.5f}; pg8::gemm_phase<pg8::EpiRes, pg8::StaticOrder, true, true>(lds, g, S, ED, wave); }
          pg8::EpiRes E{x_in, XB, ST + (size_t)((k - 1) & 1) * M * 2, lng + (size_t)(k - 1) * D, lnb + (size_t)(k - 1) * D, ST + (size_t)(k & 1) * M * 2, ALPHA, 0.5f};
          pg8::gemm_phase<pg8::EpiRes, pg8::StaticOrder, true, true>(lds, g, S, E, wave); }
        GSYNC();
    }
    for (int m = gw; m < M; m += NGW) ln_row_h(XB + (size_t)m * D, args.in[11] + (size_t)11 * D, args.in[12] + (size_t)11 * D, out + (size_t)m * D, cur_lane());
}

extern "C" void kernel_launch(void* const* d_in, const int* in_sizes, int n_in, void* d_out, int out_size, void* d_ws, size_t ws_size, hipStream_t stream) {
    static int grid = 0;
    if (grid == 0) {
        if (n_in != 13 || in_sizes[0] != M * D || out_size != M * D || ws_size < WS_END) { fprintf(stderr, "kernel_launch: unexpected shapes (n_in %d, in0 %d, out %d, ws %zu); nothing launched\n", n_in, n_in > 0 ? in_sizes[0] : -1, out_size, ws_size); grid = -1; return; }
        int dev = 0, cus = 0, per_cu = 0;
        if (hipGetDevice(&dev) != hipSuccess || hipDeviceGetAttribute(&cus, hipDeviceAttributeMultiprocessorCount, dev) != hipSuccess) { grid = -1; return; }
        if (hipFuncSetAttribute((const void*)fwd_megakernel, hipFuncAttributeMaxDynamicSharedMemorySize, LDS_BYTES) != hipSuccess) { fprintf(stderr, "kernel_launch: hipFuncSetAttribute failed\n"); grid = -1; return; }
        if (hipOccupancyMaxActiveBlocksPerMultiprocessor(&per_cu, (const void*)fwd_megakernel, NWAVES * 64, LDS_BYTES) != hipSuccess || per_cu < 1) { fprintf(stderr, "kernel_launch: occupancy query gives %d\n", per_cu); per_cu = 1; }
        (void)hipGetLastError();
        grid = cus * 1;
    }
    if (grid < 0) return;
    if (hipMemsetAsync((char*)d_ws + WS_CTL, 0, CTL_ZERO_BYTES, stream) != hipSuccess) { fprintf(stderr, "kernel_launch: memset of the barrier words failed\n"); return; }
    Args a{};
    for (int i = 0; i < 13; ++i) a.in[i] = (const float*)d_in[i];
    a.out = (float*)d_out; a.ws = (unsigned char*)d_ws;
    for (int i = 0; i < 32; ++i) a.inv[i] = (float)pow(10000.0, -(double)(2 * i) / 64.0);
    for (int l = 0; l < 4; ++l) a.lam_init[l] = (float)(0.8 - 0.6 * exp(-0.3 * (double)l));
    void* kargs[] = {&a};
    const hipError_t e = hipLaunchCooperativeKernel((const void*)fwd_megakernel, dim3(grid), dim3(NWAVES * 64), kargs, LDS_BYTES, stream);
    if (e != hipSuccess) fprintf(stderr, "kernel_launch: cooperative launch failed: %s (grid %d)\n", hipGetErrorString(e), grid);
}
```

```cpp
#include <hip/hip_runtime.h>
#include <hip/hip_cooperative_groups.h>
#include <cstdio>
#include <cstdint>
#include <cmath>
namespace cg = cooperative_groups;
namespace pg8 {
#define PG8_LAS __attribute__((address_space(3)))
typedef unsigned short bf16_t;
typedef short bf16x8 __attribute__((ext_vector_type(8)));
typedef float f32x4 __attribute__((ext_vector_type(4)));
typedef unsigned u32x4 __attribute__((ext_vector_type(4)));
constexpr int BM = 256, BK = 64, HALF = 128, HTB = HALF * BK * 2  , STAGE_BYTES = 8 * HTB, NXCD = 8, WGM = 8;

__host__ __device__ __forceinline__ int lds_byte(int r, int c) { const int st = (r >> 4) * 2 + (c >> 5), rr = r & 15, cc = c & 31, ob = rr * 64 + cc * 2; return st * 1024 + (ob ^ (((ob >> 9) & 1) << 5)); }
__host__ __device__ __forceinline__ void stage_rc(int b, int& R, int& C) { const int st = b / 1024, sb = b % 1024, swz = sb ^ (((sb >> 9) & 1) << 5); R = (st >> 1) * 16 + swz / 64; C = (st & 1) * 32 + (swz % 64) / 2; }
__host__ __device__ __forceinline__ int perm32(int rho) { const int n = rho >> 4, i = rho & 15; return 8 * (i >> 2) + 4 * n + (i & 3); }

struct Unit { int pm, pn; };
struct Gemm { const bf16_t* A; const bf16_t* Bt; int M, N, K; };

struct StaticOrder {
    int nM, nN, nwg, G, c;
    __host__ __device__ void init(int M, int N, int G_, int c_) { nM = M / BM; nN = N / BM; nwg = nM * nN; G = G_; c = c_; }
    __host__ __device__ bool next(int i, Unit& u) const {
        const long L = (long)i * G + c; if (L >= nwg) return false;
        int wgid = (int)L; { const int q = nwg / NXCD, r = nwg % NXCD, xcd = wgid % NXCD, off = wgid / NXCD; wgid = (xcd < r ? xcd * (q + 1) : r * (q + 1) + (xcd - r) * q) + off; }
        const int nig = WGM * nN, gid = wgid / nig, fm = gid * WGM, gsz = (nM - fm) < WGM ? (nM - fm) : WGM;
        u.pm = fm + ((wgid % nig) % gsz); u.pn = (wgid % nig) / gsz; return true;
    }
    __device__ __forceinline__ void a_ready(const Unit&) const {}
    __device__ __forceinline__ void done(const Unit&) const {}
};

typedef float f32x2_t __attribute__((ext_vector_type(2))); typedef __bf16 bf16x2_t __attribute__((ext_vector_type(2)));
__device__ __forceinline__ unsigned cvtpk(float lo, float hi) { f32x2_t v = {lo, hi}; bf16x2_t b = __builtin_convertvector(v, bf16x2_t); return __builtin_bit_cast(unsigned, b); }
typedef _Float16 f16x8 __attribute__((ext_vector_type(8))); typedef _Float16 f16x2_t __attribute__((ext_vector_type(2)));
template <bool F16> __device__ __forceinline__ f32x4 mma16(bf16x8 a, bf16x8 b, f32x4 c) {
    if constexpr (F16) return __builtin_amdgcn_mfma_f32_16x16x32_f16(__builtin_bit_cast(f16x8, a), __builtin_bit_cast(f16x8, b), c, 0, 0, 0);
    else return __builtin_amdgcn_mfma_f32_16x16x32_bf16(a, b, c, 0, 0, 0);
}
__device__ __forceinline__ unsigned cvtpk_h(float lo, float hi) { f16x2_t v = {(_Float16)lo, (_Float16)hi}; return __builtin_bit_cast(unsigned, v); }
__device__ __forceinline__ float silu_f(float g) { return g * __builtin_amdgcn_rcpf(1.0f + __builtin_amdgcn_exp2f(-1.4426950408889634f * g)); }

typedef float f32x2v __attribute__((ext_vector_type(2)));
struct RowLN {
    const float* st; const float* cs; const float* bw;
    __device__ __forceinline__ void row(int r, float& a, float& c) const {
        if (st) { const f32x2v s = *(const f32x2v*)(st + 2 * (size_t)r); const float mu = s.x * (1.0f / 1024.0f), var = s.y * (1.0f / 1024.0f) - mu * mu; a = rsqrtf(var + 1e-5f); c = -a * mu; }
        else { a = 1.0f; c = 0.0f; }
    }
};
struct EpiSwiGLU {
    static constexpr bool PERM = true, AFTER_DRAIN = false, F16 = true;
    bf16_t* H; int ldh; RowLN ln;
    __device__ __forceinline__ void operator()(const f32x4 (&acc)[2][2][4][2], const Unit& u, int wr, int wc, int fr, int fq) const {
        const int row0 = u.pm * BM + wr * 64 + fr, col0 = u.pn * HALF + wc * 32 + 8 * fq, wrow0 = u.pn * BM + wc * 32 + 8 * fq;
        f32x4 cs[2][2], bw[2][2]; float ra[8], rc[8];
#pragma unroll
        for (int bj = 0; bj < 2; ++bj)
#pragma unroll
            for (int n = 0; n < 2; ++n) { const f32x4 z = (f32x4){0.f, 0.f, 0.f, 0.f}; cs[bj][n] = ln.st ? *(const f32x4*)(ln.cs + wrow0 + bj * HALF + 4 * n) : z; bw[bj][n] = ln.st ? *(const f32x4*)(ln.bw + wrow0 + bj * HALF + 4 * n) : z; }
#pragma unroll
        for (int i = 0; i < 8; ++i) ln.row(row0 + (i >> 2) * HALF + (i & 3) * 16, ra[i], rc[i]);
        asm volatile("" ::: "memory");
#pragma unroll
        for (int ai = 0; ai < 2; ++ai)
#pragma unroll
            for (int m = 0; m < 4; ++m) {
                const int row = row0 + ai * HALF + m * 16; const float a = ra[ai * 4 + m], c = rc[ai * 4 + m];
                const f32x4 g0 = acc[ai][0][m][0] * a + cs[0][0] * c + bw[0][0], g1 = acc[ai][0][m][1] * a + cs[0][1] * c + bw[0][1];
                const f32x4 u0 = acc[ai][1][m][0] * a + cs[1][0] * c + bw[1][0], u1 = acc[ai][1][m][1] * a + cs[1][1] * c + bw[1][1];
                u32x4 w;
                w.x = cvtpk(silu_f(g0[0]) * u0[0], silu_f(g0[1]) * u0[1]); w.y = cvtpk(silu_f(g0[2]) * u0[2], silu_f(g0[3]) * u0[3]);
                w.z = cvtpk(silu_f(g1[0]) * u1[0], silu_f(g1[1]) * u1[1]); w.w = cvtpk(silu_f(g1[2]) * u1[2], silu_f(g1[3]) * u1[3]);
                __builtin_nontemporal_store(w, (u32x4*)(H + (size_t)row * ldh + col0));
            }
    }
};
struct EpiRes {
    static constexpr bool PERM = true, AFTER_DRAIN = false, F16 = false;
    const float* x0; bf16_t* yh; const float* st; const float* g; const float* b; float* st_new; float alpha, s;
    __device__ __forceinline__ void operator()(const f32x4 (&acc)[2][2][4][2], const Unit& u, int wr, int wc, int fr, int fq) const {
        const int row0 = u.pm * BM + wr * 64 + fr, col0 = u.pn * BM + wc * 64 + 8 * fq;
        f32x4 gv[2][2], bv[2][2];
#pragma unroll
        for (int bj = 0; bj < 2; ++bj)
#pragma unroll
            for (int n = 0; n < 2; ++n) { gv[bj][n] = st ? *(const f32x4*)(g + col0 + bj * 32 + 4 * n) : (f32x4){1.f, 1.f, 1.f, 1.f}; bv[bj][n] = st ? *(const f32x4*)(b + col0 + bj * 32 + 4 * n) : (f32x4){0.f, 0.f, 0.f, 0.f}; }
#pragma unroll
        for (int ai = 0; ai < 2; ++ai) {
            f16x8 hv[4][2]; float ra[4], rmu[4];
#pragma unroll
            for (int m = 0; m < 4; ++m) {
                const int row = row0 + ai * HALF + m * 16; const size_t off = (size_t)row * 1024 + col0;
                ra[m] = 1.0f; rmu[m] = 0.0f;
                if (st) {
                    const f32x2v sv = *(const f32x2v*)(st + 2 * (size_t)row); rmu[m] = sv.x * (1.0f / 1024.0f); ra[m] = rsqrtf(sv.y * (1.0f / 1024.0f) - rmu[m] * rmu[m] + 1e-5f);
                    hv[m][0] = *(const f16x8*)(yh + off); hv[m][1] = *(const f16x8*)(yh + off + 32);
                }
            }
            asm volatile("" ::: "memory");
#pragma unroll
            for (int m = 0; m < 4; ++m) {
                const int row = row0 + ai * HALF + m * 16; const size_t off = (size_t)row * 1024 + col0;
                float s1 = 0.f, s2 = 0.f;
#pragma unroll
                for (int bj = 0; bj < 2; ++bj) {
                    f32x4 yp[2];
                    if (st) { const f16x8 h = hv[m][bj]; yp[0] = (f32x4){(float)h[0], (float)h[1], (float)h[2], (float)h[3]}; yp[1] = (f32x4){(float)h[4], (float)h[5], (float)h[6], (float)h[7]}; }
                    else { yp[0] = *(const f32x4*)(x0 + off + bj * 32); yp[1] = *(const f32x4*)(x0 + off + bj * 32 + 4); }
                    f32x4 y[2];
#pragma unroll
                    for (int n = 0; n < 2; ++n) { const f32x4 x = (yp[n] - rmu[m]) * ra[m] * gv[bj][n] + bv[bj][n];
                        y[n] = x * alpha + acc[ai][bj][m][n] * s;
                        s1 += (y[n][0] + y[n][1]) + (y[n][2] + y[n][3]); s2 += (y[n][0] * y[n][0] + y[n][1] * y[n][1]) + (y[n][2] * y[n][2] + y[n][3] * y[n][3]); }
                    u32x4 w; w.x = cvtpk_h(y[0][0], y[0][1]); w.y = cvtpk_h(y[0][2], y[0][3]); w.z = cvtpk_h(y[1][0], y[1][1]); w.w = cvtpk_h(y[1][2], y[1][3]);
                    *(u32x4*)(yh + off + bj * 32) = w;
                }
                s1 += __shfl_xor(s1, 16); s1 += __shfl_xor(s1, 32); s2 += __shfl_xor(s2, 16); s2 += __shfl_xor(s2, 32);
                if (fq == 0) { atomicAdd(st_new + 2 * (size_t)row, s1); atomicAdd(st_new + 2 * (size_t)row + 1, s2); }
            }
            asm volatile("" ::: "memory");
        }
    }
};
struct EpiNull {
    static constexpr bool PERM = true, AFTER_DRAIN = false, F16 = false;
    float* sink;
    __device__ __forceinline__ void operator()(const f32x4 (&acc)[2][2][4][2], const Unit& u, int wr, int wc, int fr, int fq) const {
        f32x4 t = (f32x4){0.f, 0.f, 0.f, 0.f};
#pragma unroll
        for (int ai = 0; ai < 2; ++ai)
#pragma unroll
            for (int bj = 0; bj < 2; ++bj)
#pragma unroll
                for (int m = 0; m < 4; ++m) { t += acc[ai][bj][m][0]; t += acc[ai][bj][m][1]; }
        if (t[0] + t[1] + t[2] + t[3] == 12345.678f) *sink = t[0];
    }
};
struct EpiQKV {
    static constexpr bool PERM = true, AFTER_DRAIN = false, F16 = true;
    bf16_t* O; const unsigned* rope; float qscale; RowLN ln;
    __device__ __forceinline__ void operator()(const f32x4 (&acc)[2][2][4][2], const Unit& u, int wr, int wc, int fr, int fq) const {
        const int pn = u.pn, row0 = u.pm * BM + wr * 64 + fr, col0 = pn * BM + wc * 32 + 8 * fq, i0 = 16 * (wc & 1) + 4 * fq;
        const bool anyrope = (pn != 4 && pn != 5);
        const float sc = (pn < 2 || pn == 6 || pn == 7) ? qscale : 1.0f;
        f32x4 cs[2][2], bw[2][2];
#pragma unroll
        for (int bj = 0; bj < 2; ++bj)
#pragma unroll
            for (int n = 0; n < 2; ++n) { cs[bj][n] = *(const f32x4*)(ln.cs + col0 + bj * HALF + 4 * n); bw[bj][n] = *(const f32x4*)(ln.bw + col0 + bj * HALF + 4 * n); }
#pragma unroll
        for (int ai = 0; ai < 2; ++ai) {
            f16x8 rp4[4]; float ra[4], rc[4];
#pragma unroll
            for (int m = 0; m < 4; ++m) ln.row(row0 + ai * HALF + m * 16, ra[m], rc[m]);
#pragma unroll
            for (int m = 0; m < 4; ++m) { const int row = row0 + ai * HALF + m * 16;
                if (anyrope) rp4[m] = *(const f16x8*)(rope + (size_t)row * 32 + i0); else rp4[m] = (f16x8){1, 0, 1, 0, 1, 0, 1, 0}; }
            asm volatile("" ::: "memory");
#pragma unroll
            for (int m = 0; m < 4; ++m) {
                const int row = row0 + ai * HALF + m * 16; const float a = ra[m], c = rc[m];
                const f16x8 h = rp4[m];
                const float c0 = (float)h[0], s0 = (float)h[1], c1 = (float)h[2], s1 = (float)h[3], c2 = (float)h[4], s2 = (float)h[5], c3 = (float)h[6], s3 = (float)h[7];
#pragma unroll
                for (int bj = 0; bj < 2; ++bj) {
                    const bool rp = anyrope && !(pn == 8 && bj == 1);
                    f32x4 v0 = acc[ai][bj][m][0] * a + cs[bj][0] * c + bw[bj][0], v1 = acc[ai][bj][m][1] * a + cs[bj][1] * c + bw[bj][1];
                    if (rp) {
                        const f32x4 a0 = v0, a1 = v1;
                        v0[0] = a0[0] * c0 - a0[1] * s0; v0[1] = a0[1] * c0 + a0[0] * s0;
                        v0[2] = a0[2] * c1 - a0[3] * s1; v0[3] = a0[3] * c1 + a0[2] * s1;
                        v1[0] = a1[0] * c2 - a1[1] * s2; v1[1] = a1[1] * c2 + a1[0] * s2;
                        v1[2] = a1[2] * c3 - a1[3] * s3; v1[3] = a1[3] * c3 + a1[2] * s3;
                    }
                    v0 = v0 * sc; v1 = v1 * sc;
                    u32x4 w; w.x = cvtpk(v0[0], v0[1]); w.y = cvtpk(v0[2], v0[3]); w.z = cvtpk(v1[0], v1[1]); w.w = cvtpk(v1[2], v1[3]);
                    *(u32x4*)(O + (size_t)row * 2304 + col0 + bj * HALF) = w;
                }
            }
            asm volatile("" ::: "memory");
        }
    }
};

template <class Epi, class Sched, bool ALIGN_EPI = false, bool SP2 = false>
__device__ __forceinline__ void gemm_phase(PG8_LAS unsigned char* lds, const Gemm g, const Sched& S, const Epi& E, const int wave_in) {
    int tid_; asm volatile("v_mbcnt_lo_u32_b32 %0, -1, 0\n\tv_mbcnt_hi_u32_b32 %0, -1, %0" : "=v"(tid_)); tid_ += 64 * wave_in;
    const int tid = tid_, wid = __builtin_amdgcn_readfirstlane(tid >> 6), lane = tid & 63, wr = wid >> 2, wc = wid & 3, fr = lane & 15, fq = lane >> 4;
    const int K = g.K, nt = K / BK;
    unsigned voffA[2], voffB[2];
#pragma unroll
    for (int i = 0; i < 2; ++i) { int R, C; stage_rc(tid * 16 + i * 8192, R, C); const int Rb = Epi::PERM ? ((R & ~31) + perm32(R & 31)) : R;
        voffA[i] = (unsigned)(R * K + C) * 2u; voffB[i] = (unsigned)(Rb * K + C) * 2u; }
    const size_t kstep = (size_t)(BK * 2);
    const size_t hstep = (size_t)HALF * K * 2;
    const size_t tstep = 2 * hstep;
    const unsigned ldsw = (unsigned)wid * 1024u;
    const int aoff = lds_byte(wr * 64 + fr, fq * 8), boff = lds_byte(wc * 32 + fr, fq * 8);
#define PG8_SA(b, h) (((b) * 2 + (h)) * HTB)
#define PG8_SB(b, h) ((4 + (b) * 2 + (h)) * HTB)
#define PG8_STAGE(bufoff, gbase, voff) do { _Pragma("unroll") for (int _i = 0; _i < 2; ++_i) \
        __builtin_amdgcn_global_load_lds((const unsigned*)((const char*)(gbase) + (voff)[_i]), (PG8_LAS unsigned*)(lds + (bufoff) + ldsw + _i * 8192), 16, 0, 0); } while (0)
#define PG8_LDA(dst, b, h) do { _Pragma("unroll") for (int m = 0; m < 4; ++m) _Pragma("unroll") for (int k = 0; k < 2; ++k) dst[m][k] = *(const PG8_LAS bf16x8*)(lds + PG8_SA(b, h) + aoff + m * 2048 + k * 1024); } while (0)
#define PG8_LDB(dst, b, h) do { _Pragma("unroll") for (int n = 0; n < 2; ++n) _Pragma("unroll") for (int k = 0; k < 2; ++k) dst[n][k] = *(const PG8_LAS bf16x8*)(lds + PG8_SB(b, h) + boff + n * 2048 + k * 1024); } while (0)
#define PG8_MMA(ai, bj, At, Bt) do { __builtin_amdgcn_s_setprio(1); _Pragma("unroll") for (int m = 0; m < 4; ++m) _Pragma("unroll") for (int n = 0; n < 2; ++n) _Pragma("unroll") for (int k = 0; k < 2; ++k) \
        acc[ai][bj][m][n] = mma16<Epi::F16>(Bt[n][k], At[m][k], acc[ai][bj][m][n]); __builtin_amdgcn_s_setprio(0); } while (0)
#define PG8_WAIT_V(n) asm volatile("s_waitcnt vmcnt(" #n ")" ::: "memory")
#define PG8_WAIT_L(n) asm volatile("s_waitcnt lgkmcnt(" #n ")" ::: "memory")
#define PG8_BAR __builtin_amdgcn_s_barrier()
#define PG8_SCHED __builtin_amdgcn_sched_barrier(0)
    Unit cur, nxt; int ui = 0;
    if (!S.next(0, cur)) return;
    f32x4 acc[2][2][4][2];
#pragma unroll
    for (int a = 0; a < 2; ++a)
#pragma unroll
        for (int b = 0; b < 2; ++b)
#pragma unroll
            for (int m = 0; m < 4; ++m)
#pragma unroll
                for (int n = 0; n < 2; ++n) acc[a][b][m][n] = (f32x4){0.f, 0.f, 0.f, 0.f};
    bf16x8 At[4][2], B0[2][2], B1[2][2];
    const char* cA = (const char*)g.A + (size_t)cur.pm * tstep; const char* cB = (const char*)g.Bt + (size_t)cur.pn * tstep;
    S.a_ready(cur);
    if constexpr (SP2) {
        PG8_STAGE(PG8_SB(0, 0), cB, voffB); PG8_STAGE(PG8_SB(0, 1), cB + hstep, voffB); PG8_STAGE(PG8_SA(0, 0), cA, voffA); PG8_STAGE(PG8_SA(0, 1), cA + hstep, voffA);
        if (wr == 1) PG8_BAR;
        PG8_WAIT_V(2); PG8_BAR;
        PG8_STAGE(PG8_SB(1, 0), cB + kstep, voffB); PG8_STAGE(PG8_SA(1, 0), cA + kstep, voffA); PG8_STAGE(PG8_SB(1, 1), cB + hstep + kstep, voffB);
        PG8_WAIT_V(6); PG8_BAR;
    } else {
        PG8_STAGE(PG8_SB(0, 0), cB, voffB); PG8_STAGE(PG8_SA(0, 0), cA, voffA); PG8_STAGE(PG8_SB(0, 1), cB + hstep, voffB); PG8_STAGE(PG8_SA(0, 1), cA + hstep, voffA);
        if (wr == 1) PG8_BAR;
        PG8_WAIT_V(4); PG8_BAR;
        PG8_STAGE(PG8_SB(1, 0), cB + kstep, voffB); PG8_STAGE(PG8_SA(1, 0), cA + kstep, voffA); PG8_STAGE(PG8_SB(1, 1), cB + hstep + kstep, voffB);
        PG8_WAIT_V(6); PG8_BAR;
    }
    for (;;) {
        const bool has_next = S.next(ui + 1, nxt);
        const char* nA = has_next ? (const char*)g.A + (size_t)nxt.pm * tstep : cA; const char* nB = has_next ? (const char*)g.Bt + (size_t)nxt.pn * tstep : cB;
        for (int t = 0; t < nt; t += 2) {
            const bool last = (t == nt - 2);
            const char* a1 = cA + (size_t)(t + 1) * kstep;
            const char* a2 = last ? nA : cA + (size_t)(t + 2) * kstep; const char* b2 = last ? nB : cB + (size_t)(t + 2) * kstep;
            const char* a3 = a2 + kstep; const char* b3 = b2 + kstep;
            if (last && has_next) S.a_ready(nxt);
            if constexpr (SP2) {
            PG8_LDB(B0, 0, 0); PG8_LDB(B1, 0, 1); PG8_SCHED; PG8_LDA(At, 0, 0); PG8_STAGE(PG8_SA(1, 1), a1 + hstep, voffA);
            PG8_WAIT_V(8); PG8_WAIT_L(0); PG8_BAR; PG8_MMA(0, 0, At, B0); PG8_MMA(0, 1, At, B1); PG8_BAR; PG8_SCHED;
            PG8_LDA(At, 0, 1); PG8_STAGE(PG8_SB(0, 0), b2, voffB); PG8_STAGE(PG8_SB(0, 1), b2 + hstep, voffB); PG8_STAGE(PG8_SA(0, 0), a2, voffA);
            PG8_WAIT_V(8); PG8_WAIT_L(0); PG8_BAR; PG8_MMA(1, 0, At, B0); PG8_MMA(1, 1, At, B1); PG8_BAR; PG8_SCHED;
            PG8_LDB(B0, 1, 0); PG8_LDB(B1, 1, 1); PG8_SCHED; PG8_LDA(At, 1, 0); PG8_STAGE(PG8_SA(0, 1), a2 + hstep, voffA);
            PG8_WAIT_V(8); PG8_WAIT_L(0); PG8_BAR; PG8_MMA(0, 0, At, B0); PG8_MMA(0, 1, At, B1); PG8_BAR; PG8_SCHED;
            PG8_LDA(At, 1, 1); PG8_STAGE(PG8_SB(1, 0), b3, voffB); PG8_STAGE(PG8_SB(1, 1), b3 + hstep, voffB); PG8_STAGE(PG8_SA(1, 0), a3, voffA);
            PG8_WAIT_V(8); PG8_WAIT_L(0); PG8_BAR; PG8_MMA(1, 0, At, B0); PG8_MMA(1, 1, At, B1); PG8_BAR; PG8_SCHED;
            } else {
            PG8_LDB(B0, 0, 0); PG8_SCHED; PG8_LDA(At, 0, 0); PG8_STAGE(PG8_SA(1, 1), a1 + hstep, voffA);
            PG8_WAIT_L(8); PG8_BAR; PG8_WAIT_L(0); PG8_MMA(0, 0, At, B0); PG8_BAR; PG8_SCHED;
            PG8_LDB(B1, 0, 1); PG8_STAGE(PG8_SB(0, 0), b2, voffB);
            PG8_BAR; PG8_WAIT_L(0); PG8_MMA(0, 1, At, B1); PG8_BAR;
            PG8_LDA(At, 0, 1); PG8_STAGE(PG8_SA(0, 0), a2, voffA);
            PG8_BAR; PG8_WAIT_L(0); PG8_MMA(1, 0, At, B0); PG8_BAR; PG8_SCHED;
            PG8_STAGE(PG8_SB(0, 1), b2 + hstep, voffB);
            PG8_WAIT_V(6); PG8_BAR; PG8_MMA(1, 1, At, B1); PG8_BAR;
            PG8_LDB(B0, 1, 0); PG8_SCHED; PG8_LDA(At, 1, 0); PG8_STAGE(PG8_SA(0, 1), a2 + hstep, voffA);
            PG8_WAIT_L(8); PG8_BAR; PG8_WAIT_L(0); PG8_MMA(0, 0, At, B0); PG8_BAR; PG8_SCHED;
            PG8_LDB(B1, 1, 1); PG8_STAGE(PG8_SB(1, 0), b3, voffB);
            PG8_BAR; PG8_WAIT_L(0); PG8_MMA(0, 1, At, B1); PG8_BAR;
            PG8_LDA(At, 1, 1); PG8_STAGE(PG8_SA(1, 0), a3, voffA);
            PG8_BAR; PG8_WAIT_L(0); PG8_MMA(1, 0, At, B0); PG8_BAR; PG8_SCHED;
            PG8_STAGE(PG8_SB(1, 1), b3 + hstep, voffB);
            PG8_WAIT_V(6); PG8_BAR; PG8_MMA(1, 1, At, B1); PG8_BAR;
            }
        }
        if constexpr (ALIGN_EPI) { if (wr == 0) PG8_BAR; }
        if constexpr (!Epi::AFTER_DRAIN) { E(acc, cur, wr, wc, fr, fq); S.done(cur); }
        if (!has_next) break;
#pragma unroll
        for (int a = 0; a < 2; ++a)
#pragma unroll
            for (int b = 0; b < 2; ++b)
#pragma unroll
                for (int m = 0; m < 4; ++m)
#pragma unroll
                    for (int n = 0; n < 2; ++n) acc[a][b][m][n] = (f32x4){0.f, 0.f, 0.f, 0.f};
        cur = nxt; cA = nA; cB = nB; ++ui;
        if constexpr (ALIGN_EPI) { if (wr == 1) PG8_BAR; }
    }
    PG8_WAIT_V(0);
    if constexpr (!ALIGN_EPI) { if (wr == 0) PG8_BAR; }
    PG8_BAR;
    if constexpr (Epi::AFTER_DRAIN) { E.fused(acc, cur, wr, wc, fr, fq, lds, wid, lane); S.done(cur); }
#undef PG8_SA
#undef PG8_SB
#undef PG8_STAGE
#undef PG8_LDA
#undef PG8_LDB
#undef PG8_MMA
#undef PG8_WAIT_V
#undef PG8_WAIT_L
#undef PG8_BAR
#undef PG8_SCHED
}
}

namespace att {
using pg8::bf16_t; using pg8::bf16x8; using pg8::f32x4; using pg8::u32x4; using pg8::cvtpk;
#define ALDS __attribute__((address_space(3)))
typedef float f32x16 __attribute__((ext_vector_type(16)));
typedef short s16x4 __attribute__((ext_vector_type(4)));
typedef unsigned u32x2 __attribute__((ext_vector_type(2)));
constexpr int PITCH = 2304;
constexpr float THR = 8.0f;
__device__ __forceinline__ void glds16(const void* gsrc, unsigned lds_dst) { unsigned keep;
    asm volatile("s_mov_b32 %0, m0\n\ts_mov_b32 m0, %2\n\ts_nop 0\n\tglobal_load_lds_dwordx4 %1, off\n\ts_mov_b32 m0, %0" : "=&s"(keep) : "v"(gsrc), "s"(lds_dst) : "memory"); }
__device__ __forceinline__ void glds16s(unsigned voff, const void* sbase_, unsigned lds_dst) { unsigned keep;
    const unsigned long long sbase = ((unsigned long long)(unsigned)__builtin_amdgcn_readfirstlane((int)((unsigned long long)(uintptr_t)sbase_ >> 32)) << 32) | (unsigned)__builtin_amdgcn_readfirstlane((int)(unsigned)(uintptr_t)sbase_);
    asm volatile("s_mov_b32 %0, m0\n\ts_mov_b32 m0, %3\n\ts_nop 0\n\tglobal_load_lds_dwordx4 %1, %2\n\ts_mov_b32 m0, %0" : "=&s"(keep) : "v"(voff), "s"(sbase), "s"(lds_dst) : "memory"); }
__device__ __forceinline__ unsigned rfl(unsigned v) { return (unsigned)__builtin_amdgcn_readfirstlane((int)v); }
__device__ __forceinline__ int pi23(int x) { return (x & ~12) | ((x & 4) << 1) | ((x & 8) >> 1); }
__device__ __forceinline__ s16x4 vtr(const ALDS unsigned char* p) { return __builtin_bit_cast(s16x4, __builtin_amdgcn_ds_read_tr16_b64_v4i16((ALDS s16x4*)p)); }
__device__ __forceinline__ float halfswap_max(float v) { auto rr = __builtin_amdgcn_permlane32_swap(__float_as_uint(v), __float_as_uint(v), false, false); return fmaxf(__uint_as_float(rr[0]), __uint_as_float(rr[1])); }
__device__ __forceinline__ float halfswap_sum(float v) { auto rr = __builtin_amdgcn_permlane32_swap(__float_as_uint(v), __float_as_uint(v), false, false); return __uint_as_float(rr[0]) + __uint_as_float(rr[1]); }

template <int DV, bool BAND>
__device__ __forceinline__ float attn_core(ALDS unsigned char* ring, const int wid, const int lane,
                                           const bf16_t* Qw, const bf16_t* gbase, const unsigned koffb, const unsigned voffb, const int koff,
                                           const int t0, const int t1, const int tq, const int qpos, const float m_init, float l, f32x16 (&o)[DV / 32]) {
    constexpr int NDB = DV / 32, SLOT = (DV == 128) ? 32768 : 16384, VOFF = (DV == 128) ? 16384 : 8192, ROWB = DV * 2, NP = (DV == 128) ? 4 : 2;
    const int r32 = lane & 31, hi = lane >> 5;
    const unsigned ring_a = (unsigned)(uintptr_t)ring;
    bf16x8 qr[4];
#pragma unroll
    for (int d0 = 0; d0 < 4; ++d0) qr[d0] = *(const bf16x8*)(Qw + (size_t)r32 * PITCH + d0 * 16 + hi * 8);
#define ATT_PIECE(i_, t_, so_) do { const char* sb_ = (const char*)gbase + (size_t)(t_) * (64 * PITCH * 2); const unsigned d_ = ring_a + (unsigned)(so_) + (unsigned)wid * 1024u; \
        if (DV == 128) { if ((i_) == 0) glds16s(koffb, sb_, d_); else if ((i_) == 1) glds16s(koffb, sb_ + 128, d_ + 8192u); \
                         else if ((i_) == 2) glds16s(voffb, sb_, ring_a + (unsigned)(so_) + (unsigned)VOFF + (unsigned)wid * 2048u); \
                         else glds16s(voffb, sb_ + 4 * PITCH * 2, ring_a + (unsigned)(so_) + (unsigned)VOFF + (unsigned)wid * 2048u + 1024u); } \
        else { if ((i_) == 0) glds16s(koffb, sb_, d_); else if ((i_) == 2) glds16s(voffb, sb_, d_ + (unsigned)VOFF); } } while (0)
#define ATT_ISSUE(t_, so_) do { ATT_PIECE(0, t_, so_); ATT_PIECE(1, t_, so_); ATT_PIECE(2, t_, so_); ATT_PIECE(3, t_, so_); } while (0)
    ATT_ISSUE(t0, 0);
    { const int tn = (t0 + 1 < t1) ? t0 + 1 : t1 - 1; ATT_ISSUE(tn, SLOT); }
    const int g = (lane >> 4) & 1, q4 = (lane & 15) >> 2, p = lane & 3, sw = (DV == 128) ? q4 : (q4 >> 1);
    int va[NDB];
#pragma unroll
    for (int db = 0; db < NDB; ++db) va[db] = VOFF + (8 * hi + q4) * ROWB + ((db ^ sw) << 6) + (2 * g + (p >> 1)) * 16 + 8 * (p & 1);
    const int ka = koff + hi * 1024 + r32 * 16;
    float m = m_init;
    f32x16 negm;
#pragma unroll
    for (int r = 0; r < 16; ++r) negm[r] = -m;
#pragma unroll
    for (int db = 0; db < NDB; ++db)
#pragma unroll
        for (int r = 0; r < 16; ++r) o[db][r] = 0.f;
    if (wid >= 4) __builtin_amdgcn_s_setprio(1);
    int s_cur = 0, s_n2 = 2 * SLOT;
    for (int t = t0; t < t1; ++t) {
        asm volatile("s_waitcnt vmcnt(%0)" :: "n"(NP) : "memory");
        asm volatile("s_waitcnt lgkmcnt(0)\n\ts_barrier" ::: "memory");
        const int tn = (t + 2 < t1) ? t + 2 : t1 - 1;
        const ALDS unsigned char* sb = ring + s_cur;
        f32x16 p0 = negm, p1 = negm;
        bf16x8 kf[8];
#pragma unroll
        for (int d0 = 0; d0 < 4; ++d0) { kf[2 * d0] = *(const ALDS bf16x8*)(sb + ka + d0 * 2048); kf[2 * d0 + 1] = *(const ALDS bf16x8*)(sb + ka + d0 * 2048 + 512); }
        s16x4 vlo[2][NDB], vhh[2][NDB];
#pragma unroll
        for (int db = 0; db < NDB; ++db) { vlo[0][db] = vtr(sb + va[db]); vhh[0][db] = vtr(sb + va[db] + 4 * ROWB); }
        __builtin_amdgcn_sched_barrier(0);
#pragma unroll
        for (int d0 = 0; d0 < 4; ++d0) {
            p0 = __builtin_amdgcn_mfma_f32_32x32x16_bf16(kf[2 * d0], qr[d0], p0, 0, 0, 0);
            p1 = __builtin_amdgcn_mfma_f32_32x32x16_bf16(kf[2 * d0 + 1], qr[d0], p1, 0, 0, 0);
            __builtin_amdgcn_sched_barrier(0);
            ATT_PIECE(d0, tn, s_n2);
            __builtin_amdgcn_sched_barrier(0);
        }
        if (BAND) {
            if (t == tq - 2 || t == tq + 2) {
                const int rel0 = t * 64 + 8 * hi - qpos;
#pragma unroll
                for (int r = 0; r < 16; ++r) { const int rel = rel0 + 16 * (r >> 3) + (r & 7);
                    if (rel < -128 || rel > 128) p0[r] = -INFINITY;
                    if (rel + 32 < -128 || rel + 32 > 128) p1[r] = -INFINITY; }
            }
        }
        float mx = fmaxf(p0[0], p1[0]);
#pragma unroll
        for (int r = 1; r < 16; ++r) mx = fmaxf(fmaxf(mx, p0[r]), p1[r]);
        mx = halfswap_max(mx);
        const bool first = (!BAND) && (t == t0);
        const float dl = first ? mx : ((mx > THR) ? mx : 0.f);
        if (__any(dl != 0.f)) {
            m += dl;
#pragma unroll
            for (int r = 0; r < 16; ++r) { p0[r] -= dl; p1[r] -= dl; negm[r] = -m; }
            const float f = first ? 1.f : __builtin_amdgcn_exp2f(-dl);
            l *= f;
#pragma unroll
            for (int db = 0; db < NDB; ++db)
#pragma unroll
                for (int r = 0; r < 16; ++r) o[db][r] *= f;
        }
        float ssum = 0.f;
        bf16x8 pfs[4];
#define ATT_EXP_SLICE(P_, B_, DST_) do { u32x4 w_; \
        P_[B_ + 0] = __builtin_amdgcn_exp2f(P_[B_ + 0]); P_[B_ + 1] = __builtin_amdgcn_exp2f(P_[B_ + 1]); P_[B_ + 2] = __builtin_amdgcn_exp2f(P_[B_ + 2]); P_[B_ + 3] = __builtin_amdgcn_exp2f(P_[B_ + 3]); \
        P_[B_ + 4] = __builtin_amdgcn_exp2f(P_[B_ + 4]); P_[B_ + 5] = __builtin_amdgcn_exp2f(P_[B_ + 5]); P_[B_ + 6] = __builtin_amdgcn_exp2f(P_[B_ + 6]); P_[B_ + 7] = __builtin_amdgcn_exp2f(P_[B_ + 7]); \
        ssum += ((P_[B_ + 0] + P_[B_ + 1]) + (P_[B_ + 2] + P_[B_ + 3])) + ((P_[B_ + 4] + P_[B_ + 5]) + (P_[B_ + 6] + P_[B_ + 7])); \
        w_.x = cvtpk(P_[B_ + 0], P_[B_ + 1]); w_.y = cvtpk(P_[B_ + 2], P_[B_ + 3]); w_.z = cvtpk(P_[B_ + 4], P_[B_ + 5]); w_.w = cvtpk(P_[B_ + 6], P_[B_ + 7]); DST_ = __builtin_bit_cast(bf16x8, w_); } while (0)
        ATT_EXP_SLICE(p0, 0, pfs[0]);
        __builtin_amdgcn_sched_barrier(0);
#pragma unroll
        for (int ks = 0; ks < 4; ++ks) {
            if (ks + 1 < 4) {
#pragma unroll
                for (int db = 0; db < NDB; ++db) { vlo[(ks + 1) & 1][db] = vtr(sb + va[db] + (ks + 1) * (16 * ROWB)); vhh[(ks + 1) & 1][db] = vtr(sb + va[db] + (ks + 1) * (16 * ROWB) + 4 * ROWB); }
            }
#pragma unroll
            for (int db = 0; db < NDB; ++db) {
                const s16x4 lo = vlo[ks & 1][db], hh = vhh[ks & 1][db];
                const bf16x8 vf = (bf16x8){lo[0], lo[1], lo[2], lo[3], hh[0], hh[1], hh[2], hh[3]};
                o[db] = __builtin_amdgcn_mfma_f32_32x32x16_bf16(vf, pfs[ks], o[db], 0, 0, 0);
            }
            if (ks == 0) ATT_EXP_SLICE(p0, 8, pfs[1]);
            if (ks == 1) ATT_EXP_SLICE(p1, 0, pfs[2]);
            if (ks == 2) ATT_EXP_SLICE(p1, 8, pfs[3]);
            if (ks + 1 < 4) {
                __builtin_amdgcn_sched_group_barrier(0x100, 2 * NDB, 0);
#pragma unroll
                for (int db = 0; db < NDB; ++db) { __builtin_amdgcn_sched_group_barrier(0x008, 1, 0); __builtin_amdgcn_sched_group_barrier(0x002, 20 / NDB, 0); }
            }
            __builtin_amdgcn_sched_barrier(0);
        }
#undef ATT_EXP_SLICE
        l += ssum;
        s_cur = (s_cur == 2 * SLOT) ? 0 : s_cur + SLOT; s_n2 = (s_n2 == 2 * SLOT) ? 0 : s_n2 + SLOT;
    }
    __builtin_amdgcn_s_setprio(0);
    asm volatile("s_waitcnt vmcnt(0) lgkmcnt(0)\n\ts_barrier" ::: "memory");
#undef ATT_ISSUE
#undef ATT_PIECE
    return l;
}

__device__ __forceinline__ void diff_unit(ALDS unsigned char* ring, const int wid, int lane, const bf16_t* qkv, bf16_t* ymix, const int u, const float lam, const float post, const float* subg) {
    asm volatile("" : "+v"(lane));
    const int bh = u >> 5, qb = u & 31, b = bh >> 2, h = bh & 3, comp = wid >> 2, wq = wid & 3, r32 = lane & 31, hi = lane >> 5;
    const size_t rowbase = (size_t)b * 4096;
    const int q0 = qb * 128 + wq * 32;
    const bf16_t* Qw = qkv + (rowbase + q0) * PITCH + h * 128 + comp * 64;
    const bf16_t* gbase = qkv + rowbase * PITCH;
    const unsigned koffb = (unsigned)((pi23(lane) * PITCH + 512 + h * 128 + wid * 8) * 2);
    const unsigned voffb = (unsigned)(((8 * wid + (lane >> 4)) * PITCH + 1024 + h * 128 + (((lane & 15) ^ ((lane >> 4) << 2)) * 8)) * 2);
    f32x16 o[4];
    float l = attn_core<128, false>(ring, wid, lane, Qw, gbase, koffb, voffb, comp * 8192, 0, 64, 0, 0, 0.f, 0.f, o);
    l = halfswap_sum(l);
    const float inv = 1.0f / l;
    ALDS f32x4* X = (ALDS f32x4*)ring + (size_t)wq * (16 * 64);
    if (comp == 1) {
#pragma unroll
        for (int db = 0; db < 4; ++db)
#pragma unroll
            for (int rq = 0; rq < 4; ++rq) X[(db * 4 + rq) * 64 + lane] = (f32x4){o[db][4 * rq] * inv, o[db][4 * rq + 1] * inv, o[db][4 * rq + 2] * inv, o[db][4 * rq + 3] * inv};
    }
    asm volatile("s_waitcnt lgkmcnt(0)\n\ts_barrier" ::: "memory");
    if (comp == 0) {
        float ss = 0.f;
#pragma unroll
        for (int db = 0; db < 4; ++db)
#pragma unroll
            for (int rq = 0; rq < 4; ++rq) { const f32x4 o2 = X[(db * 4 + rq) * 64 + lane];
#pragma unroll
                for (int e = 0; e < 4; ++e) { const float d = o[db][4 * rq + e] * inv - lam * o2[e]; o[db][4 * rq + e] = d; ss += d * d; } }
        ss = halfswap_sum(ss);
        const float rs = rsqrtf(ss * (1.0f / 128.0f) + 1e-5f) * post;
        bf16_t* orow = ymix + (rowbase + q0 + r32) * 1024 + h * 128 + 4 * hi;
#pragma unroll
        for (int db = 0; db < 4; ++db)
#pragma unroll
            for (int rq = 0; rq < 4; ++rq) { const f32x4 gv = *(const f32x4*)(subg + 32 * db + 8 * rq + 4 * hi);
                u32x2 w; w.x = cvtpk(o[db][4 * rq] * rs * gv[0], o[db][4 * rq + 1] * rs * gv[1]); w.y = cvtpk(o[db][4 * rq + 2] * rs * gv[2], o[db][4 * rq + 3] * rs * gv[3]);
                *(u32x2*)(orow + 32 * db + 8 * rq) = w; }
    }
    asm volatile("s_waitcnt lgkmcnt(0)\n\ts_barrier" ::: "memory");
}

__device__ __forceinline__ void swa_unit(ALDS unsigned char* ring, const int wid, int lane, const bf16_t* qkv, bf16_t* ymix, const int u, const float* sink) {
    asm volatile("" : "+v"(lane));
    const int bkv = u >> 6, qblk = u & 63, b = bkv >> 1, kvh = bkv & 1, head = kvh * 4 + (wid >> 1), r32 = lane & 31, hi = lane >> 5;
    const size_t rowbase = (size_t)b * 4096;
    const int q0 = qblk * 64 + (wid & 1) * 32;
    const bf16_t* Qw = qkv + (rowbase + q0) * PITCH + 1536 + head * 64;
    const bf16_t* gbase = qkv + rowbase * PITCH;
    const unsigned koffb = (unsigned)((pi23(lane) * PITCH + 2048 + kvh * 64 + wid * 8) * 2);
    const unsigned voffb = (unsigned)(((8 * wid + (lane >> 3)) * PITCH + 2176 + kvh * 64 + (((lane & 7) ^ (((lane >> 4) & 1) << 2)) * 8)) * 2);
    const int t0 = (qblk - 2 > 0) ? qblk - 2 : 0, t1 = ((qblk + 2 < 63) ? qblk + 2 : 63) + 1;
    f32x16 o[2];
    float l = attn_core<64, true>(ring, wid, lane, Qw, gbase, koffb, voffb, 0, t0, t1, qblk, q0 + r32, sink[head] * 1.4426950408889634f, (hi == 0) ? 1.0f : 0.0f, o);
    l = halfswap_sum(l);
    const float inv = 1.0f / l;
    bf16_t* orow = ymix + (rowbase + q0 + r32) * 1024 + 512 + head * 64 + 4 * hi;
#pragma unroll
    for (int db = 0; db < 2; ++db)
#pragma unroll
        for (int rq = 0; rq < 4; ++rq) { u32x2 w; w.x = cvtpk(o[db][4 * rq] * inv, o[db][4 * rq + 1] * inv); w.y = cvtpk(o[db][4 * rq + 2] * inv, o[db][4 * rq + 3] * inv);
            *(u32x2*)(orow + 32 * db + 8 * rq) = w; }
}
}

#ifndef REP_DIFF
#define REP_DIFF 1
#endif
#ifndef VARP
#define VARP 0
#endif
#ifndef REP_SWA
#define REP_SWA 1
#endif
#ifndef REP_G3
#define REP_G3 1
#endif
#ifndef REP_FOUT
#define REP_FOUT 0
#endif
#ifndef REP_RES
#define REP_RES 0
#endif
#ifndef REP_OPROJ
#define REP_OPROJ 0
#endif
#ifndef REP_G1
#define REP_G1 1
#endif
#ifndef REP_SYNC
#define REP_SYNC 1
#endif
#ifndef REP_LN
#define REP_LN 1
#endif
#ifndef REP_PRO
#define REP_PRO 1
#endif
constexpr int NWAVES = 8;
constexpr int M = 65536, D = 1024, FF = 2816, NIN = 2304, SEQ = 4096, DEPTH = 4;
constexpr size_t MiB = 1u << 20;
constexpr size_t W1_OFF = 0, W1_B = (size_t)2 * FF * D * 2, W2_OFF = W1_OFF + W1_B, W2_B = (size_t)D * FF * 2, WIN_OFF = W2_OFF + W2_B, WIN_B = (size_t)NIN * D * 2,
                 WO_OFF = WIN_OFF + WIN_B, WO_B = (size_t)D * D * 2, W3_OFF = WO_OFF + WO_B, W4_OFF = W3_OFF + W1_B, WL_STRIDE = W4_OFF + W2_B;
constexpr size_t WS_W = 0, WS_ROPE = 160 * MiB, WS_XB = 176 * MiB, WS_H = 304 * MiB, WS_YM = 656 * MiB, WS_CSBW = 784 * MiB, WS_ST = 785 * MiB, WS_CTL = 786 * MiB, WS_END = 787 * MiB;
constexpr size_t CTL_ZERO_BYTES = 16384;
constexpr int CSBW_N = 2 * FF;
static_assert((size_t)DEPTH * 3 * 2 * CSBW_N * 4 <= MiB && (size_t)2 * M * 2 * 4 <= MiB, "aux map");
static_assert(WL_STRIDE * DEPTH <= WS_ROPE && WS_ROPE + (size_t)M * 64 * 4 <= WS_XB && WS_XB + (size_t)M * D * 2 <= WS_H && WS_H + (size_t)M * FF * 2 <= WS_YM && WS_YM + (size_t)M * D * 2 <= WS_END, "d_ws map");
constexpr int LDS_BYTES = 147456;
constexpr float ALPHA = 1.681792830507429f;
constexpr float QSCALE = 0.125f * 1.4426950408889634f;

typedef unsigned short bf16;
typedef float f32x4 __attribute__((ext_vector_type(4)));
typedef unsigned v4u __attribute__((ext_vector_type(4)));
typedef unsigned v2u __attribute__((ext_vector_type(2)));
using pg8::cvtpk;

struct Args { const float* in[13]; float* out; unsigned char* ws; float inv[32]; float lam_init[4]; };

__device__ __forceinline__ int cur_lane() { int l; asm volatile("v_mbcnt_lo_u32_b32 %0, -1, 0\n\tv_mbcnt_hi_u32_b32 %0, -1, %0" : "=v"(l)); return l; }
__device__ __forceinline__ float wave_sum(float v) {
#pragma unroll
    for (int o = 1; o < 64; o <<= 1) v += __shfl_xor(v, o);
    return v;
}
__device__ __forceinline__ int src_col(int type, int n) {
    if (type == 1) { const int pn = n >> 8, w = n & 255; return (w < 128) ? (128 * pn + w) : (FF + 128 * pn + (w - 128)); }
    if (type == 3) { const int w = n & 255, bj = w >> 7, wc = (w >> 5) & 3, c = w & 31; return (n & ~255) + 64 * wc + 32 * bj + c; }
    if (type == 2) { const bool rp = (n < 1024) || (n >= 1536 && n < 2176); return rp ? ((n & ~63) + ((n & 63) >> 1) + 32 * (n & 1)) : n; }
    return n;
}
template <bool F16> __device__ __forceinline__ void transpose_item(const float* W, int K, int N, int type, const float* gk, bf16* WT, ALDS float* scr, int item, int lane) {
    const int nblk = N / 32, kb = item / nblk, nb = item % nblk, k0 = 64 * kb, n0 = 32 * nb;
    const int sc = src_col(type, n0 + (lane & 31));
#pragma unroll
    for (int i = 0; i < 32; ++i) { const int kk = 2 * i + (lane >> 5); scr[kk * 33 + (lane & 31)] = W[(size_t)(k0 + kk) * N + sc] * (gk ? gk[k0 + kk] : 1.0f); }
    asm volatile("s_waitcnt lgkmcnt(0)" ::: "memory");
    const int c = lane & 7;
#pragma unroll
    for (int j = 0; j < 4; ++j) { const int n = (lane >> 3) + 8 * j; const ALDS float* s = scr + (8 * c) * 33 + n;
        v4u o; if (F16) { o.x = pg8::cvtpk_h(s[0 * 33], s[1 * 33]); o.y = pg8::cvtpk_h(s[2 * 33], s[3 * 33]); o.z = pg8::cvtpk_h(s[4 * 33], s[5 * 33]); o.w = pg8::cvtpk_h(s[6 * 33], s[7 * 33]); }
        else { o.x = cvtpk(s[0 * 33], s[1 * 33]); o.y = cvtpk(s[2 * 33], s[3 * 33]); o.z = cvtpk(s[4 * 33], s[5 * 33]); o.w = cvtpk(s[6 * 33], s[7 * 33]); }
        *(v4u*)(WT + (size_t)(n0 + n) * K + k0 + 8 * c) = o; }
    asm volatile("s_waitcnt lgkmcnt(0)" ::: "memory");
}
__device__ __forceinline__ void sincos_f32angle(float ang, float& c, float& s) {
    const double a = (double)ang, k = __builtin_rint(a * 0.63661977236758134308);
    double r = __builtin_fma(-k, 1.57079632679489655800e+00, a); r = __builtin_fma(-k, 6.12323399573676603587e-17, r);
    const double r2 = r * r;
    double sp = -1.0 / 1307674368000.0; sp = sp * r2 + 1.0 / 6227020800.0; sp = sp * r2 - 1.0 / 39916800.0; sp = sp * r2 + 1.0 / 362880.0; sp = sp * r2 - 1.0 / 5040.0; sp = sp * r2 + 1.0 / 120.0; sp = sp * r2 - 1.0 / 6.0;
    const double sn = r + r * r2 * sp;
    double cp = 1.0 / 20922789888000.0; cp = cp * r2 - 1.0 / 87178291200.0; cp = cp * r2 + 1.0 / 479001600.0; cp = cp * r2 - 1.0 / 3628800.0; cp = cp * r2 + 1.0 / 40320.0; cp = cp * r2 - 1.0 / 720.0; cp = cp * r2 + 1.0 / 24.0; cp = cp * r2 - 0.5;
    const double cn = 1.0 + r2 * cp;
    const int q = ((int)k) & 3;
    const double cc = (q == 0) ? cn : (q == 1) ? -sn : (q == 2) ? -cn : sn;
    const double ss = (q == 0) ? sn : (q == 1) ? cn : (q == 2) ? -sn : -cn;
    c = (float)cc; s = (float)ss;
}
__device__ __forceinline__ void ln_row(const float* xrow, const float* g, const float* bta, float* orow, bf16* brow, int lane) {
    asm volatile("" : "+v"(lane));
    const f32x4* xr = (const f32x4*)xrow + lane;
    f32x4 v[4]; float s = 0.f;
#pragma unroll
    for (int j = 0; j < 4; ++j) { v[j] = xr[64 * j]; s += (v[j][0] + v[j][1]) + (v[j][2] + v[j][3]); }
    const float mean = wave_sum(s) * (1.f / D); float s2 = 0.f;
#pragma unroll
    for (int j = 0; j < 4; ++j) { v[j] = v[j] - mean; s2 += (v[j][0] * v[j][0] + v[j][1] * v[j][1]) + (v[j][2] * v[j][2] + v[j][3] * v[j][3]); }
    const float rstd = 1.0f / sqrtf(wave_sum(s2) * (1.f / D) + 1e-5f);
#pragma unroll
    for (int j = 0; j < 4; ++j) { const f32x4 gg = *((const f32x4*)g + lane + 64 * j), bb = *((const f32x4*)bta + lane + 64 * j);
        const f32x4 y = v[j] * rstd * gg + bb;
        *((f32x4*)orow + lane + 64 * j) = y;
        v2u w; w.x = cvtpk(y[0], y[1]); w.y = cvtpk(y[2], y[3]); *((v2u*)brow + lane + 64 * j) = w; }
}

#define XB_TMO      128
#define XB_XCNT(j)  (256  + 64 * (j))
#define XB_XSUB(j)  (1280 + 64 * (j))
#define XB_XGEN(j)  (2304 + 64 * (j))
#define XB_TOP      3328
#define XB_TOPGEN   3392
#define XCD_BAR_WORDS 3456
#define XB_SPIN_CAP (1u << 18)

__device__ __forceinline__ unsigned xb_ld(unsigned* p)              { return __hip_atomic_load(p, __ATOMIC_RELAXED, __HIP_MEMORY_SCOPE_AGENT); }
__device__ __forceinline__ unsigned xb_add(unsigned* p, unsigned v) { return __hip_atomic_fetch_add(p, v, __ATOMIC_RELAXED, __HIP_MEMORY_SCOPE_AGENT); }
__device__ __forceinline__ unsigned xb_xcc_id() { return (unsigned)__builtin_amdgcn_s_getreg((3 << 11) | 20) & 0xFu; }
#define XB_SPIN(cond, bar) do { unsigned _sp = 0; while (cond) { __builtin_amdgcn_s_sleep(1); \
    if ((++_sp & 255u) == 0u) { if (xb_ld(&(bar)[XB_TMO])) break; if (_sp > XB_SPIN_CAP) { atomicAdd(&(bar)[XB_TMO], 1u); break; } } } } while (0)

struct XcdBarrier {
    unsigned* bar; unsigned x;
    volatile ALDS unsigned* st;
};

__device__ __forceinline__ XcdBarrier xcd_barrier_post(unsigned* bar, volatile ALDS unsigned* st) {
    XcdBarrier b; b.bar = bar; b.x = xb_xcc_id(); b.st = st;
    if (threadIdx.x == 0) (void)xb_add(&bar[XB_XCNT(b.x)], 1u);
    return b;
}
__device__ __forceinline__ void xcd_barrier_complete(unsigned* bar, unsigned x, unsigned& nloc, unsigned& nx) {
    const unsigned G = gridDim.x * gridDim.y * gridDim.z;
    unsigned sum, cnt, mine, sp = 0u;
    for (;;) {
        sum = 0u; cnt = 0u; mine = 0u;
#pragma unroll
        for (unsigned j = 0; j < 16; ++j) { const unsigned c = xb_ld(&bar[XB_XCNT(j)]); sum += c; cnt += (c > 0u) ? 1u : 0u; mine = (j == x) ? c : mine; }
        if (sum == G) break;
        __builtin_amdgcn_s_sleep(1);
        if ((++sp & 255u) == 0u) { if (xb_ld(&bar[XB_TMO])) break; if (sp > XB_SPIN_CAP) { atomicAdd(&bar[XB_TMO], 1u); break; } }
    }
    nloc = mine > 0u ? mine : 1u; nx = cnt > 0u ? cnt : 1u;
}

__device__ __forceinline__ void xcd_barrier(const XcdBarrier& b) {
    asm volatile("s_waitcnt vmcnt(0)" ::: "memory");
    __syncthreads();
    if (threadIdx.x == 0) {
        unsigned* bar = b.bar;
        __builtin_amdgcn_s_waitcnt(0);
        unsigned nloc = b.st[0], nx = b.st[1];
        if (nloc == 0u) { xcd_barrier_complete(bar, b.x, nloc, nx); b.st[0] = nloc; b.st[1] = nx; }
        const unsigned old = xb_add(&bar[XB_XSUB(b.x)], 1u);
        const unsigned gen = old / nloc;
        if (old + 1u == (gen + 1u) * nloc) {
            __builtin_amdgcn_fence(__ATOMIC_RELEASE, "agent");
            asm volatile("s_waitcnt vmcnt(0)" ::: "memory");
            const unsigned og = xb_add(&bar[XB_TOP], 1u);
            const unsigned tg = og / nx;
            if (og + 1u == (tg + 1u) * nx) xb_add(&bar[XB_TOPGEN], 1u);
            else XB_SPIN(xb_ld(&bar[XB_TOPGEN]) == tg, bar);
            __builtin_amdgcn_fence(__ATOMIC_ACQUIRE, "agent");
            xb_add(&bar[XB_XGEN(b.x)], 1u);
            asm volatile("s_waitcnt vmcnt(0)" ::: "memory");
        } else {
            XB_SPIN(xb_ld(&bar[XB_XGEN(b.x)]) == gen, bar);
            __builtin_amdgcn_fence(__ATOMIC_ACQUIRE, "agent");
            asm volatile("s_waitcnt vmcnt(0)" ::: "memory");
        }
    }
    __syncthreads();
}

__device__ __forceinline__ void ln_row_h(const bf16* hrow, const float* g, const float* bta, float* orow, int lane) {
    asm volatile("" : "+v"(lane));
    typedef _Float16 h4 __attribute__((ext_vector_type(4)));
    f32x4 v[4]; float s = 0.f;
#pragma unroll
    for (int j = 0; j < 4; ++j) { const h4 h = *((const h4*)hrow + lane + 64 * j); v[j] = (f32x4){(float)h[0], (float)h[1], (float)h[2], (float)h[3]}; s += (v[j][0] + v[j][1]) + (v[j][2] + v[j][3]); }
    const float mean = wave_sum(s) * (1.f / D); float s2 = 0.f;
#pragma unroll
    for (int j = 0; j < 4; ++j) { v[j] = v[j] - mean; s2 += (v[j][0] * v[j][0] + v[j][1] * v[j][1]) + (v[j][2] * v[j][2] + v[j][3] * v[j][3]); }
    const float rstd = 1.0f / sqrtf(wave_sum(s2) * (1.f / D) + 1e-5f);
#pragma unroll
    for (int j = 0; j < 4; ++j) { const f32x4 gg = *((const f32x4*)g + lane + 64 * j), bb = *((const f32x4*)bta + lane + 64 * j);
        *((f32x4*)orow + lane + 64 * j) = v[j] * rstd * gg + bb; }
}

__global__ void __launch_bounds__(NWAVES * 64, 2) fwd_megakernel(Args args) {
    extern __shared__ __attribute__((aligned(16))) unsigned char lds_raw[];
    cg::grid_group grid = cg::this_grid();
#define GSYNC() xcd_barrier(bar)
    ALDS unsigned char* lds = (ALDS unsigned char*)lds_raw;
    const int tid = threadIdx.x, lane = tid & 63, wave = __builtin_amdgcn_readfirstlane(tid >> 6);
    const int G = gridDim.x, bx = blockIdx.x, vcu = (G % 8 == 0) ? (bx % 8) * (G / 8) + bx / 8 : bx;
    unsigned char* ws = args.ws;
    const float* x_in = args.in[0]; const int* positions = (const int*)args.in[1];
    float* out = args.out;
    bf16* XB = (bf16*)(ws + WS_XB); bf16* HB = (bf16*)(ws + WS_H); bf16* QKV = (bf16*)(ws + WS_H); bf16* YM = (bf16*)(ws + WS_YM);
    unsigned* ROPEH = (unsigned*)(ws + WS_ROPE);
    float* ROPE = (float*)(ws + WS_ROPE); float* CSBW = (float*)(ws + WS_CSBW); float* ST = (float*)(ws + WS_ST); float* LAMV = (float*)(ws + WS_CSBW + 786432);
    const int gw = vcu * NWAVES + wave, NGW = G * NWAVES;
    volatile ALDS unsigned* bst = (volatile ALDS unsigned*)(lds + 131072 + 8192);
    if (tid < 2) bst[tid] = 0u;
    __syncthreads();
    XcdBarrier bar = xcd_barrier_post((unsigned*)(ws + WS_CTL), bst);

    for (int rep = 0; rep < REP_PRO; ++rep) {
        ALDS float* scr = (ALDS float*)(lds + wave * 16384);
        constexpr int I1 = (D / 64) * (2 * FF / 32), I2 = (FF / 64) * (D / 32), I3 = (D / 64) * (NIN / 32), I4 = (D / 64) * (D / 32), IL = 2 * I1 + 2 * I2 + I3 + I4;
        for (int it = gw; it < IL * DEPTH; it += NGW) {
            const int l = it / IL; int r = it % IL;
            unsigned char* wl = ws + WS_W + (size_t)l * WL_STRIDE;
            if (r < I1) { transpose_item<true>(args.in[7] + (size_t)l * D * 2 * FF, D, 2 * FF, 1, (l > 0) ? args.in[11] + (size_t)((l - 1) * 3 + 2) * D : nullptr, (bf16*)(wl + W1_OFF), scr, r, lane); continue; } r -= I1;
            if (r < I2) { transpose_item<false>(args.in[8] + (size_t)l * FF * D, FF, D, 3, nullptr, (bf16*)(wl + W2_OFF), scr, r, lane); continue; } r -= I2;
            if (r < I3) { transpose_item<true>(args.in[2] + (size_t)l * D * NIN, D, NIN, 2, args.in[11] + (size_t)(l * 3) * D, (bf16*)(wl + WIN_OFF), scr, r, lane); continue; } r -= I3;
            if (r < I4) { transpose_item<false>(args.in[3] + (size_t)l * D * D, D, D, 3, nullptr, (bf16*)(wl + WO_OFF), scr, r, lane); continue; } r -= I4;
            if (r < I1) { transpose_item<true>(args.in[9] + (size_t)l * D * 2 * FF, D, 2 * FF, 1, args.in[11] + (size_t)(l * 3 + 1) * D, (bf16*)(wl + W3_OFF), scr, r, lane); continue; } r -= I1;
            transpose_item<false>(args.in[10] + (size_t)l * FF * D, FF, D, 3, nullptr, (bf16*)(wl + W4_OFF), scr, r, lane);
        }
        const size_t gt = (size_t)vcu * (NWAVES * 64) + tid, GT = (size_t)G * NWAVES * 64;
        for (size_t i = gt; i < (size_t)M * D / 4; i += 8 * GT) {
            f32x4 v[8];
#pragma unroll
            for (int j = 0; j < 8; ++j) { const size_t ij = i + (size_t)j * GT; v[j] = (ij < (size_t)M * D / 4) ? *((const f32x4*)x_in + ij) : (f32x4){0.f, 0.f, 0.f, 0.f}; }
#pragma unroll
            for (int j = 0; j < 8; ++j) { const size_t ij = i + (size_t)j * GT; if (ij < (size_t)M * D / 4) { v2u w; w.x = pg8::cvtpk_h(v[j][0], v[j][1]); w.y = pg8::cvtpk_h(v[j][2], v[j][3]); *((v2u*)XB + ij) = w; } }
        }
        for (size_t i = gt; i < (size_t)M * 32; i += GT) { const int row = (int)(i >> 5), k = (int)(i & 31); float c, s; sincos_f32angle((float)positions[row] * args.inv[k], c, s);
            ROPEH[(size_t)row * 32 + k] = pg8::cvtpk_h(c, s); }
        if (vcu == 0 && wave < DEPTH) {
            const float* lv = args.in[4] + (size_t)wave * 256;
            const float a1 = wave_sum(lv[lane] * lv[64 + lane]), a2 = wave_sum(lv[128 + lane] * lv[192 + lane]);
            if (lane == 0) LAMV[wave] = expf(a1) - expf(a2) + args.lam_init[wave];
        }
        for (size_t i = gt; i < (size_t)M * 2; i += GT) ST[i] = 0.f;
        {
            ALDS float* red = (ALDS float*)(lds + 131072);
            constexpr int CG0 = 2 * FF / 64, CG1 = NIN / 64, CGL = 2 * CG0 + CG1;
            for (int cgi = vcu; cgi < CGL * DEPTH; cgi += G) {
                const int l = cgi / CGL; int r = cgi % CGL; int j = 0;
                if (r >= CG0) { r -= CG0; j = 1; if (r >= CG1) { r -= CG1; j = 2; } }
                const int lnidx = (j == 0) ? (l - 1) * 3 + 2 : (j == 1) ? l * 3 : l * 3 + 1;
                if (lnidx < 0) continue;
                const int N = (j == 1) ? NIN : 2 * FF, type = (j == 1) ? 2 : 1;
                const float* W = (j == 0) ? args.in[7] + (size_t)l * D * 2 * FF : (j == 1) ? args.in[2] + (size_t)l * D * NIN : args.in[9] + (size_t)l * D * 2 * FF;
                const float* gk = args.in[11] + (size_t)lnidx * D; const float* bk = args.in[12] + (size_t)lnidx * D;
                const int n = r * 64 + lane, sc = src_col(type, n);
                float c1 = 0.f, b1 = 0.f;
#pragma unroll 16
                for (int k = wave * 128; k < wave * 128 + 128; ++k) { const float w = W[(size_t)k * N + sc]; const float gw = gk[k] * w;
                    c1 += (float)(_Float16)gw; b1 += bk[k] * w; }
                red[(wave * 64 + lane) * 2] = c1; red[(wave * 64 + lane) * 2 + 1] = b1;
                __syncthreads();
                if (wave == 0) { float cc = 0.f, bb = 0.f;
#pragma unroll
                    for (int w8 = 0; w8 < 8; ++w8) { cc += red[(w8 * 64 + lane) * 2]; bb += red[(w8 * 64 + lane) * 2 + 1]; }
                    float* dst = CSBW + (size_t)((l * 3 + j) * 2) * CSBW_N; dst[n] = cc; dst[CSBW_N + n] = bb; }
                __syncthreads();
            }
        }
    }
    grid.sync();

#define ZERO_ST(buf_) do { int t_ = wave * 64 + cur_lane(); asm volatile("" : "+v"(t_)); float* z_ = ST + (size_t)(buf_) * M * 2; for (int i_ = vcu * (NWAVES * 64) + t_; i_ < M * 2; i_ += G * NWAVES * 64) { z_[i_] = 0.f; asm volatile("" : "+v"(i_)); } } while (0)
    for (int l = 0; l < DEPTH; ++l) {
        unsigned char* wl = ws + WS_W + (size_t)l * WL_STRIDE;
        const float* lng = args.in[11]; const float* lnb = args.in[12];
        { const int k = 3 * l; ZERO_ST(k & 1);
          const float* cb = CSBW + (size_t)((l * 3 + 0) * 2) * CSBW_N;
          pg8::Gemm g{XB, (const bf16*)(wl + W1_OFF), M, 2 * FF, D}; pg8::StaticOrder S; S.init(M, 2 * FF, G, bx);
          pg8::EpiSwiGLU E{HB, FF, pg8::RowLN{(k == 0) ? nullptr : ST + (size_t)((k - 1) & 1) * M * 2, cb, cb + CSBW_N}};
          for (int rep = 0; rep < REP_G1; ++rep) pg8::gemm_phase<pg8::EpiSwiGLU, pg8::StaticOrder, true, true>(lds, g, S, E, wave); }
        GSYNC();
        { const int k = 3 * l;
          pg8::Gemm g{HB, (const bf16*)(wl + W2_OFF), M, D, FF}; pg8::StaticOrder S; S.init(M, D, G, bx);
          for (int rep = 0; rep < REP_FOUT; ++rep) { pg8::EpiNull EN{ROPE}; pg8::gemm_phase<pg8::EpiNull, pg8::StaticOrder, true, true>(lds, g, S, EN, wave); }
          for (int rep = 0; rep < REP_RES; ++rep) { pg8::EpiRes ED{x_in, (bf16*)out, ST, lng, lnb, out + (size_t)48 * 1024 * 1024, ALPHA, 0.5f}; pg8::gemm_phase<pg8::EpiRes, pg8::StaticOrder, true, true>(lds, g, S, ED, wave); }
          pg8::EpiRes E{x_in, XB, (k == 0) ? nullptr : ST + (size_t)((k - 1) & 1) * M * 2, lng + (size_t)(k > 0 ? k - 1 : 0) * D, lnb + (size_t)(k > 0 ? k - 1 : 0) * D, ST + (size_t)(k & 1) * M * 2, ALPHA, 0.5f};
          pg8::gemm_phase<pg8::EpiRes, pg8::StaticOrder, true, true>(lds, g, S, E, wave); }
        GSYNC();
        { const int k = 3 * l + 1; ZERO_ST(k & 1);
          const float* cb = CSBW + (size_t)((l * 3 + 1) * 2) * CSBW_N;
          pg8::Gemm g{XB, (const bf16*)(wl + WIN_OFF), M, NIN, D}; pg8::StaticOrder S; S.init(M, NIN, G, bx);
          pg8::EpiQKV E{QKV, ROPEH, QSCALE, pg8::RowLN{ST + (size_t)((k - 1) & 1) * M * 2, cb, cb + CSBW_N}};
          for (int rep = 0; rep < REP_G3; ++rep) pg8::gemm_phase<pg8::EpiQKV, pg8::StaticOrder, true, true>(lds, g, S, E, wave); }
        GSYNC();
        {
            const float lam_init = args.lam_init[l], lam = LAMV[l];
            const float* subg = args.in[5] + (size_t)l * 128; const float* sink = args.in[6] + (size_t)l * 8;
            for (int rep = 0; rep < REP_DIFF; ++rep)
            for (int u = vcu; u < 2048; u += G) att::diff_unit(lds, wave, cur_lane(), QKV, YM, u, lam, 1.0f - lam_init, subg);
            for (int rep = 0; rep < REP_SWA; ++rep)
            for (int u = vcu; u < 2048; u += G) att::swa_unit(lds, wave, cur_lane(), QKV, YM, u, sink);
        }
        GSYNC();
        { const int k = 3 * l + 1;
          pg8::Gemm g{YM, (const bf16*)(wl + WO_OFF), M, D, D}; pg8::StaticOrder S; S.init(M, D, G, bx);
          for (int rep = 0; rep < REP_OPROJ; ++rep) { pg8::EpiNull EN{ROPE}; pg8::gemm_phase<pg8::EpiNull, pg8::StaticOrder, true, true>(lds, g, S, EN, wave); }
          pg8::EpiRes E{x_in, XB, ST + (size_t)((k - 1) & 1) * M * 2, lng + (size_t)(k - 1) * D, lnb + (size_t)(k - 1) * D, ST + (size_t)(k & 1) * M * 2, ALPHA, 1.0f};
          pg8::gemm_phase<pg8::EpiRes, pg8::StaticOrder, true, true>(lds, g, S, E, wave); }
        GSYNC();
        { const int k = 3 * l + 2; ZERO_ST(k & 1);
          const float* cb = CSBW + (size_t)((l * 3 + 2) * 2) * CSBW_N;
          pg8::Gemm g{XB, (const bf16*)(wl + W3_OFF), M, 2 * FF, D}; pg8::StaticOrder S; S.init(M, 2 * FF, G, bx);
          pg8::EpiSwiGLU E{HB, FF, pg8::RowLN{ST + (size_t)((k - 1) & 1) * M * 2, cb, cb + CSBW_N}};
          for (int rep = 0; rep < REP_G1; ++rep) pg8::gemm_phase<pg8::EpiSwiGLU, pg8::StaticOrder, true, true>(lds, g, S, E, wave); }
        GSYNC();
        { const int k = 3 * l + 2;
          pg8::Gemm g{HB, (const bf16*)(wl + W4_OFF), M, D, FF}; pg8::StaticOrder S; S.init(M, D, G, bx);
          for (int rep = 0; rep < REP_FOUT; ++rep) { pg8::EpiNull EN{ROPE}; pg8::gemm_phase<pg8::EpiNull, pg8::StaticOrder, true, true>(lds, g, S, EN, wave); }
          for (int rep = 0; rep < REP_RES; ++rep) { pg8::EpiRes ED{x_in, (bf16*)out, ST, lng, lnb, out + (size_t)48 * 1024 * 1024, ALPHA, 0.5f}; pg8::gemm_phase<pg8::EpiRes, pg8::StaticOrder, true, true>(lds, g, S, ED, wave); }
          pg8::EpiRes E{x_in, XB, ST + (size_t)((k - 1) & 1) * M * 2, lng + (size_t)(k - 1) * D, lnb + (size_t)(k - 1) * D, ST + (size_t)(k & 1) * M * 2, ALPHA, 0.5f};
          pg8::gemm_phase<pg8::EpiRes, pg8::StaticOrder, true, true>(lds, g, S, E, wave); }
        GSYNC();
    }
    for (int m = gw; m < M; m += NGW) ln_row_h(XB + (size_t)m * D, args.in[11] + (size_t)11 * D, args.in[12] + (size_t)11 * D, out + (size_t)m * D, cur_lane());
}

extern "C" void kernel_launch(void* const* d_in, const int* in_sizes, int n_in, void* d_out, int out_size, void* d_ws, size_t ws_size, hipStream_t stream) {
    static int grid = 0;
    if (grid == 0) {
        if (n_in != 13 || in_sizes[0] != M * D || out_size != M * D || ws_size < WS_END) { fprintf(stderr, "kernel_launch: unexpected shapes (n_in %d, in0 %d, out %d, ws %zu); nothing launched\n", n_in, n_in > 0 ? in_sizes[0] : -1, out_size, ws_size); grid = -1; return; }
        int dev = 0, cus = 0, per_cu = 0;
        if (hipGetDevice(&dev) != hipSuccess || hipDeviceGetAttribute(&cus, hipDeviceAttributeMultiprocessorCount, dev) != hipSuccess) { grid = -1; return; }
        if (hipFuncSetAttribute((const void*)fwd_megakernel, hipFuncAttributeMaxDynamicSharedMemorySize, LDS_BYTES) != hipSuccess) { fprintf(stderr, "kernel_launch: hipFuncSetAttribute failed\n"); grid = -1; return; }
        if (hipOccupancyMaxActiveBlocksPerMultiprocessor(&per_cu, (const void*)fwd_megakernel, NWAVES * 64, LDS_BYTES) != hipSuccess || per_cu < 1) { fprintf(stderr, "kernel_launch: occupancy query gives %d\n", per_cu); per_cu = 1; }
        (void)hipGetLastError();
        grid = cus * 1;
    }
    if (grid < 0) return;
    if (hipMemsetAsync((char*)d_ws + WS_CTL, 0, CTL_ZERO_BYTES, stream) != hipSuccess) { fprintf(stderr, "kernel_launch: memset of the barrier words failed\n"); return; }
    Args a{};
    for (int i = 0; i < 13; ++i) a.in[i] = (const float*)d_in[i];
    a.out = (float*)d_out; a.ws = (unsigned char*)d_ws;
    for (int i = 0; i < 32; ++i) a.inv[i] = (float)pow(10000.0, -(double)(2 * i) / 64.0);
    for (int l = 0; l < 4; ++l) a.lam_init[l] = (float)(0.8 - 0.6 * exp(-0.3 * (double)l));
    void* kargs[] = {&a};
    const hipError_t e = hipLaunchCooperativeKernel((const void*)fwd_megakernel, dim3(grid), dim3(NWAVES * 64), kargs, LDS_BYTES, stream);
    if (e != hipSuccess) fprintf(stderr, "kernel_launch: cooperative launch failed: %s (grid %d)\n", hipGetErrorString(e), grid);
}
```

```cpp
#include <hip/hip_runtime.h>
#include <hip/hip_cooperative_groups.h>
#include <cstdio>
#include <cstdint>
#include <cmath>
namespace cg = cooperative_groups;
namespace pg8 {
#define PG8_LAS __attribute__((address_space(3)))
typedef unsigned short bf16_t;
typedef short bf16x8 __attribute__((ext_vector_type(8)));
typedef float f32x4 __attribute__((ext_vector_type(4)));
typedef unsigned u32x4 __attribute__((ext_vector_type(4)));
constexpr int BM = 256, BK = 64, HALF = 128, HTB = HALF * BK * 2  , STAGE_BYTES = 8 * HTB, NXCD = 8, WGM = 8;

__host__ __device__ __forceinline__ int lds_byte(int r, int c) { const int st = (r >> 4) * 2 + (c >> 5), rr = r & 15, cc = c & 31, ob = rr * 64 + cc * 2; return st * 1024 + (ob ^ (((ob >> 9) & 1) << 5)); }
__host__ __device__ __forceinline__ void stage_rc(int b, int& R, int& C) { const int st = b / 1024, sb = b % 1024, swz = sb ^ (((sb >> 9) & 1) << 5); R = (st >> 1) * 16 + swz / 64; C = (st & 1) * 32 + (swz % 64) / 2; }
__host__ __device__ __forceinline__ int perm32(int rho) { const int n = rho >> 4, i = rho & 15; return 8 * (i >> 2) + 4 * n + (i & 3); }

struct Unit { int pm, pn; };
struct Gemm { const bf16_t* A; const bf16_t* Bt; int M, N, K; };

struct StaticOrder {
    int nM, nN, nwg, G, c;
    __host__ __device__ void init(int M, int N, int G_, int c_) { nM = M / BM; nN = N / BM; nwg = nM * nN; G = G_; c = c_; }
    __host__ __device__ bool next(int i, Unit& u) const {
        const long L = (long)i * G + c; if (L >= nwg) return false;
        int wgid = (int)L; { const int q = nwg / NXCD, r = nwg % NXCD, xcd = wgid % NXCD, off = wgid / NXCD; wgid = (xcd < r ? xcd * (q + 1) : r * (q + 1) + (xcd - r) * q) + off; }
        const int nig = WGM * nN, gid = wgid / nig, fm = gid * WGM, gsz = (nM - fm) < WGM ? (nM - fm) : WGM;
        u.pm = fm + ((wgid % nig) % gsz); u.pn = (wgid % nig) / gsz; return true;
    }
    __device__ __forceinline__ void a_ready(const Unit&) const {}
    __device__ __forceinline__ void done(const Unit&) const {}
};

typedef float f32x2_t __attribute__((ext_vector_type(2))); typedef __bf16 bf16x2_t __attribute__((ext_vector_type(2)));
__device__ __forceinline__ unsigned cvtpk(float lo, float hi) { f32x2_t v = {lo, hi}; bf16x2_t b = __builtin_convertvector(v, bf16x2_t); return __builtin_bit_cast(unsigned, b); }
typedef _Float16 f16x8 __attribute__((ext_vector_type(8))); typedef _Float16 f16x2_t __attribute__((ext_vector_type(2)));
template <bool F16> __device__ __forceinline__ f32x4 mma16(bf16x8 a, bf16x8 b, f32x4 c) {
    if constexpr (F16) return __builtin_amdgcn_mfma_f32_16x16x32_f16(__builtin_bit_cast(f16x8, a), __builtin_bit_cast(f16x8, b), c, 0, 0, 0);
    else return __builtin_amdgcn_mfma_f32_16x16x32_bf16(a, b, c, 0, 0, 0);
}
__device__ __forceinline__ unsigned cvtpk_h(float lo, float hi) { f16x2_t v = {(_Float16)lo, (_Float16)hi}; return __builtin_bit_cast(unsigned, v); }
__device__ __forceinline__ float silu_f(float g) { return g * __builtin_amdgcn_rcpf(1.0f + __builtin_amdgcn_exp2f(-1.4426950408889634f * g)); }

typedef float f32x2v __attribute__((ext_vector_type(2)));
struct RowLN {
    const float* st; const float* cs; const float* bw;
    __device__ __forceinline__ void row(int r, float& a, float& c) const {
        if (st) { const f32x2v s = *(const f32x2v*)(st + 2 * (size_t)r); const float mu = s.x * (1.0f / 1024.0f), var = s.y * (1.0f / 1024.0f) - mu * mu; a = rsqrtf(var + 1e-5f); c = -a * mu; }
        else { a = 1.0f; c = 0.0f; }
    }
};
struct EpiSwiGLU {
    static constexpr bool PERM = true, AFTER_DRAIN = false, F16 = true;
    bf16_t* H; int ldh; RowLN ln;
    __device__ __forceinline__ void operator()(const f32x4 (&acc)[2][2][4][2], const Unit& u, int wr, int wc, int fr, int fq) const {
        const int row0 = u.pm * BM + wr * 64 + fr, col0 = u.pn * HALF + wc * 32 + 8 * fq, wrow0 = u.pn * BM + wc * 32 + 8 * fq;
        f32x4 cs[2][2], bw[2][2]; float ra[8], rc[8];
#pragma unroll
        for (int bj = 0; bj < 2; ++bj)
#pragma unroll
            for (int n = 0; n < 2; ++n) { const f32x4 z = (f32x4){0.f, 0.f, 0.f, 0.f}; cs[bj][n] = ln.st ? *(const f32x4*)(ln.cs + wrow0 + bj * HALF + 4 * n) : z; bw[bj][n] = ln.st ? *(const f32x4*)(ln.bw + wrow0 + bj * HALF + 4 * n) : z; }
#pragma unroll
        for (int i = 0; i < 8; ++i) ln.row(row0 + (i >> 2) * HALF + (i & 3) * 16, ra[i], rc[i]);
        asm volatile("" ::: "memory");
#pragma unroll
        for (int ai = 0; ai < 2; ++ai)
#pragma unroll
            for (int m = 0; m < 4; ++m) {
                const int row = row0 + ai * HALF + m * 16; const float a = ra[ai * 4 + m], c = rc[ai * 4 + m];
                const f32x4 g0 = acc[ai][0][m][0] * a + cs[0][0] * c + bw[0][0], g1 = acc[ai][0][m][1] * a + cs[0][1] * c + bw[0][1];
                const f32x4 u0 = acc[ai][1][m][0] * a + cs[1][0] * c + bw[1][0], u1 = acc[ai][1][m][1] * a + cs[1][1] * c + bw[1][1];
                u32x4 w;
                w.x = cvtpk(silu_f(g0[0]) * u0[0], silu_f(g0[1]) * u0[1]); w.y = cvtpk(silu_f(g0[2]) * u0[2], silu_f(g0[3]) * u0[3]);
                w.z = cvtpk(silu_f(g1[0]) * u1[0], silu_f(g1[1]) * u1[1]); w.w = cvtpk(silu_f(g1[2]) * u1[2], silu_f(g1[3]) * u1[3]);
                __builtin_nontemporal_store(w, (u32x4*)(H + (size_t)row * ldh + col0));
            }
    }
};
struct EpiRes {
    static constexpr bool PERM = true, AFTER_DRAIN = false, F16 = false;
    const float* x0; bf16_t* yh; const float* st; const float* g; const float* b; float* st_new; float alpha, s;
    __device__ __forceinline__ void operator()(const f32x4 (&acc)[2][2][4][2], const Unit& u, int wr, int wc, int fr, int fq) const {
        const int row0 = u.pm * BM + wr * 64 + fr, col0 = u.pn * BM + wc * 64 + 8 * fq;
        f32x4 gv[2][2], bv[2][2];
#pragma unroll
        for (int bj = 0; bj < 2; ++bj)
#pragma unroll
            for (int n = 0; n < 2; ++n) { gv[bj][n] = st ? *(const f32x4*)(g + col0 + bj * 32 + 4 * n) : (f32x4){1.f, 1.f, 1.f, 1.f}; bv[bj][n] = st ? *(const f32x4*)(b + col0 + bj * 32 + 4 * n) : (f32x4){0.f, 0.f, 0.f, 0.f}; }
#pragma unroll
        for (int ai = 0; ai < 2; ++ai) {
            f16x8 hv[4][2]; float ra[4], rmu[4];
#pragma unroll
            for (int m = 0; m < 4; ++m) {
                const int row = row0 + ai * HALF + m * 16; const size_t off = (size_t)row * 1024 + col0;
                ra[m] = 1.0f; rmu[m] = 0.0f;
                if (st) {
                    const f32x2v sv = *(const f32x2v*)(st + 2 * (size_t)row); rmu[m] = sv.x * (1.0f / 1024.0f); ra[m] = rsqrtf(sv.y * (1.0f / 1024.0f) - rmu[m] * rmu[m] + 1e-5f);
                    hv[m][0] = *(const f16x8*)(yh + off); hv[m][1] = *(const f16x8*)(yh + off + 32);
                }
            }
            asm volatile("" ::: "memory");
#pragma unroll
            for (int m = 0; m < 4; ++m) {
                const int row = row0 + ai * HALF + m * 16; const size_t off = (size_t)row * 1024 + col0;
                float s1 = 0.f, s2 = 0.f;
#pragma unroll
                for (int bj = 0; bj < 2; ++bj) {
                    f32x4 yp[2];
                    if (st) { const f16x8 h = hv[m][bj]; yp[0] = (f32x4){(float)h[0], (float)h[1], (float)h[2], (float)h[3]}; yp[1] = (f32x4){(float)h[4], (float)h[5], (float)h[6], (float)h[7]}; }
                    else { yp[0] = *(const f32x4*)(x0 + off + bj * 32); yp[1] = *(const f32x4*)(x0 + off + bj * 32 + 4); }
                    f32x4 y[2];
#pragma unroll
                    for (int n = 0; n < 2; ++n) { const f32x4 x = (yp[n] - rmu[m]) * ra[m] * gv[bj][n] + bv[bj][n];
                        y[n] = x * alpha + acc[ai][bj][m][n] * s;
                        s1 += (y[n][0] + y[n][1]) + (y[n][2] + y[n][3]); s2 += (y[n][0] * y[n][0] + y[n][1] * y[n][1]) + (y[n][2] * y[n][2] + y[n][3] * y[n][3]); }
                    u32x4 w; w.x = cvtpk_h(y[0][0], y[0][1]); w.y = cvtpk_h(y[0][2], y[0][3]); w.z = cvtpk_h(y[1][0], y[1][1]); w.w = cvtpk_h(y[1][2], y[1][3]);
                    *(u32x4*)(yh + off + bj * 32) = w;
                }
                s1 += __shfl_xor(s1, 16); s1 += __shfl_xor(s1, 32); s2 += __shfl_xor(s2, 16); s2 += __shfl_xor(s2, 32);
                if (fq == 0) { atomicAdd(st_new + 2 * (size_t)row, s1); atomicAdd(st_new + 2 * (size_t)row + 1, s2); }
            }
            asm volatile("" ::: "memory");
        }
    }
};
struct EpiQKV {
    static constexpr bool PERM = true, AFTER_DRAIN = false, F16 = true;
    bf16_t* O; const unsigned* rope; float qscale; RowLN ln;
    __device__ __forceinline__ void operator()(const f32x4 (&acc)[2][2][4][2], const Unit& u, int wr, int wc, int fr, int fq) const {
        const int pn = u.pn, row0 = u.pm * BM + wr * 64 + fr, col0 = pn * BM + wc * 32 + 8 * fq, i0 = 16 * (wc & 1) + 4 * fq;
        const bool anyrope = (pn != 4 && pn != 5);
        const float sc = (pn < 2 || pn == 6 || pn == 7) ? qscale : 1.0f;
        f32x4 cs[2][2], bw[2][2];
#pragma unroll
        for (int bj = 0; bj < 2; ++bj)
#pragma unroll
            for (int n = 0; n < 2; ++n) { cs[bj][n] = *(const f32x4*)(ln.cs + col0 + bj * HALF + 4 * n); bw[bj][n] = *(const f32x4*)(ln.bw + col0 + bj * HALF + 4 * n); }
#pragma unroll
        for (int ai = 0; ai < 2; ++ai) {
            f16x8 rp4[4]; float ra[4], rc[4];
#pragma unroll
            for (int m = 0; m < 4; ++m) ln.row(row0 + ai * HALF + m * 16, ra[m], rc[m]);
#pragma unroll
            for (int m = 0; m < 4; ++m) { const int row = row0 + ai * HALF + m * 16;
                if (anyrope) rp4[m] = *(const f16x8*)(rope + (size_t)row * 32 + i0); else rp4[m] = (f16x8){1, 0, 1, 0, 1, 0, 1, 0}; }
            asm volatile("" ::: "memory");
#pragma unroll
            for (int m = 0; m < 4; ++m) {
                const int row = row0 + ai * HALF + m * 16; const float a = ra[m], c = rc[m];
                const f16x8 h = rp4[m];
                const float c0 = (float)h[0], s0 = (float)h[1], c1 = (float)h[2], s1 = (float)h[3], c2 = (float)h[4], s2 = (float)h[5], c3 = (float)h[6], s3 = (float)h[7];
#pragma unroll
                for (int bj = 0; bj < 2; ++bj) {
                    const bool rp = anyrope && !(pn == 8 && bj == 1);
                    f32x4 v0 = acc[ai][bj][m][0] * a + cs[bj][0] * c + bw[bj][0], v1 = acc[ai][bj][m][1] * a + cs[bj][1] * c + bw[bj][1];
                    if (rp) {
                        const f32x4 a0 = v0, a1 = v1;
                        v0[0] = a0[0] * c0 - a0[1] * s0; v0[1] = a0[1] * c0 + a0[0] * s0;
                        v0[2] = a0[2] * c1 - a0[3] * s1; v0[3] = a0[3] * c1 + a0[2] * s1;
                        v1[0] = a1[0] * c2 - a1[1] * s2; v1[1] = a1[1] * c2 + a1[0] * s2;
                        v1[2] = a1[2] * c3 - a1[3] * s3; v1[3] = a1[3] * c3 + a1[2] * s3;
                    }
                    v0 = v0 * sc; v1 = v1 * sc;
                    u32x4 w; w.x = cvtpk(v0[0], v0[1]); w.y = cvtpk(v0[2], v0[3]); w.z = cvtpk(v1[0], v1[1]); w.w = cvtpk(v1[2], v1[3]);
                    *(u32x4*)(O + (size_t)row * 2304 + col0 + bj * HALF) = w;
                }
            }
            asm volatile("" ::: "memory");
        }
    }
};

template <class Epi, class Sched, bool ALIGN_EPI = false, bool SP2 = false>
__device__ __forceinline__ void gemm_phase(PG8_LAS unsigned char* lds, const Gemm g, const Sched& S, const Epi& E, const int wave_in) {
    int tid_; asm volatile("v_mbcnt_lo_u32_b32 %0, -1, 0\n\tv_mbcnt_hi_u32_b32 %0, -1, %0" : "=v"(tid_)); tid_ += 64 * wave_in;
    const int tid = tid_, wid = __builtin_amdgcn_readfirstlane(tid >> 6), lane = tid & 63, wr = wid >> 2, wc = wid & 3, fr = lane & 15, fq = lane >> 4;
    const int K = g.K, nt = K / BK;
    unsigned voffA[2], voffB[2];
#pragma unroll
    for (int i = 0; i < 2; ++i) { int R, C; stage_rc(tid * 16 + i * 8192, R, C); const int Rb = Epi::PERM ? ((R & ~31) + perm32(R & 31)) : R;
        voffA[i] = (unsigned)(R * K + C) * 2u; voffB[i] = (unsigned)(Rb * K + C) * 2u; }
    const size_t kstep = (size_t)(BK * 2);
    const size_t hstep = (size_t)HALF * K * 2;
    const size_t tstep = 2 * hstep;
    const unsigned ldsw = (unsigned)wid * 1024u;
    const int aoff = lds_byte(wr * 64 + fr, fq * 8), boff = lds_byte(wc * 32 + fr, fq * 8);
#define PG8_SA(b, h) (((b) * 2 + (h)) * HTB)
#define PG8_SB(b, h) ((4 + (b) * 2 + (h)) * HTB)
#define PG8_STAGE(bufoff, gbase, voff) do { _Pragma("unroll") for (int _i = 0; _i < 2; ++_i) \
        __builtin_amdgcn_global_load_lds((const unsigned*)((const char*)(gbase) + (voff)[_i]), (PG8_LAS unsigned*)(lds + (bufoff) + ldsw + _i * 8192), 16, 0, 0); } while (0)
#define PG8_LDA(dst, b, h) do { _Pragma("unroll") for (int m = 0; m < 4; ++m) _Pragma("unroll") for (int k = 0; k < 2; ++k) dst[m][k] = *(const PG8_LAS bf16x8*)(lds + PG8_SA(b, h) + aoff + m * 2048 + k * 1024); } while (0)
#define PG8_LDB(dst, b, h) do { _Pragma("unroll") for (int n = 0; n < 2; ++n) _Pragma("unroll") for (int k = 0; k < 2; ++k) dst[n][k] = *(const PG8_LAS bf16x8*)(lds + PG8_SB(b, h) + boff + n * 2048 + k * 1024); } while (0)
#define PG8_MMA(ai, bj, At, Bt) do { __builtin_amdgcn_s_setprio(1); _Pragma("unroll") for (int m = 0; m < 4; ++m) _Pragma("unroll") for (int n = 0; n < 2; ++n) _Pragma("unroll") for (int k = 0; k < 2; ++k) \
        acc[ai][bj][m][n] = mma16<Epi::F16>(Bt[n][k], At[m][k], acc[ai][bj][m][n]); __builtin_amdgcn_s_setprio(0); } while (0)
#define PG8_WAIT_V(n) asm volatile("s_waitcnt vmcnt(" #n ")" ::: "memory")
#define PG8_WAIT_L(n) asm volatile("s_waitcnt lgkmcnt(" #n ")" ::: "memory")
#define PG8_BAR __builtin_amdgcn_s_barrier()
#define PG8_SCHED __builtin_amdgcn_sched_barrier(0)
    Unit cur, nxt; int ui = 0;
    if (!S.next(0, cur)) return;
    f32x4 acc[2][2][4][2];
#pragma unroll
    for (int a = 0; a < 2; ++a)
#pragma unroll
        for (int b = 0; b < 2; ++b)
#pragma unroll
            for (int m = 0; m < 4; ++m)
#pragma unroll
                for (int n = 0; n < 2; ++n) acc[a][b][m][n] = (f32x4){0.f, 0.f, 0.f, 0.f};
    bf16x8 At[4][2], B0[2][2], B1[2][2];
    const char* cA = (const char*)g.A + (size_t)cur.pm * tstep; const char* cB = (const char*)g.Bt + (size_t)cur.pn * tstep;
    S.a_ready(cur);
    if constexpr (SP2) {
        PG8_STAGE(PG8_SB(0, 0), cB, voffB); PG8_STAGE(PG8_SB(0, 1), cB + hstep, voffB); PG8_STAGE(PG8_SA(0, 0), cA, voffA); PG8_STAGE(PG8_SA(0, 1), cA + hstep, voffA);
        if (wr == 1) PG8_BAR;
        PG8_WAIT_V(2); PG8_BAR;
        PG8_STAGE(PG8_SB(1, 0), cB + kstep, voffB); PG8_STAGE(PG8_SA(1, 0), cA + kstep, voffA); PG8_STAGE(PG8_SB(1, 1), cB + hstep + kstep, voffB);
        PG8_WAIT_V(6); PG8_BAR;
    } else {
        PG8_STAGE(PG8_SB(0, 0), cB, voffB); PG8_STAGE(PG8_SA(0, 0), cA, voffA); PG8_STAGE(PG8_SB(0, 1), cB + hstep, voffB); PG8_STAGE(PG8_SA(0, 1), cA + hstep, voffA);
        if (wr == 1) PG8_BAR;
        PG8_WAIT_V(4); PG8_BAR;
        PG8_STAGE(PG8_SB(1, 0), cB + kstep, voffB); PG8_STAGE(PG8_SA(1, 0), cA + kstep, voffA); PG8_STAGE(PG8_SB(1, 1), cB + hstep + kstep, voffB);
        PG8_WAIT_V(6); PG8_BAR;
    }
    for (;;) {
        const bool has_next = S.next(ui + 1, nxt);
        const char* nA = has_next ? (const char*)g.A + (size_t)nxt.pm * tstep : cA; const char* nB = has_next ? (const char*)g.Bt + (size_t)nxt.pn * tstep : cB;
        for (int t = 0; t < nt; t += 2) {
            const bool last = (t == nt - 2);
            const char* a1 = cA + (size_t)(t + 1) * kstep;
            const char* a2 = last ? nA : cA + (size_t)(t + 2) * kstep; const char* b2 = last ? nB : cB + (size_t)(t + 2) * kstep;
            const char* a3 = a2 + kstep; const char* b3 = b2 + kstep;
            if (last && has_next) S.a_ready(nxt);
            if constexpr (SP2) {
            PG8_LDB(B0, 0, 0); PG8_LDB(B1, 0, 1); PG8_SCHED; PG8_LDA(At, 0, 0); PG8_STAGE(PG8_SA(1, 1), a1 + hstep, voffA);
            PG8_WAIT_V(8); PG8_WAIT_L(0); PG8_BAR; PG8_MMA(0, 0, At, B0); PG8_MMA(0, 1, At, B1); PG8_BAR; PG8_SCHED;
            PG8_LDA(At, 0, 1); PG8_STAGE(PG8_SB(0, 0), b2, voffB); PG8_STAGE(PG8_SB(0, 1), b2 + hstep, voffB); PG8_STAGE(PG8_SA(0, 0), a2, voffA);
            PG8_WAIT_V(8); PG8_WAIT_L(0); PG8_BAR; PG8_MMA(1, 0, At, B0); PG8_MMA(1, 1, At, B1); PG8_BAR; PG8_SCHED;
            PG8_LDB(B0, 1, 0); PG8_LDB(B1, 1, 1); PG8_SCHED; PG8_LDA(At, 1, 0); PG8_STAGE(PG8_SA(0, 1), a2 + hstep, voffA);
            PG8_WAIT_V(8); PG8_WAIT_L(0); PG8_BAR; PG8_MMA(0, 0, At, B0); PG8_MMA(0, 1, At, B1); PG8_BAR; PG8_SCHED;
            PG8_LDA(At, 1, 1); PG8_STAGE(PG8_SB(1, 0), b3, voffB); PG8_STAGE(PG8_SB(1, 1), b3 + hstep, voffB); PG8_STAGE(PG8_SA(1, 0), a3, voffA);
            PG8_WAIT_V(8); PG8_WAIT_L(0); PG8_BAR; PG8_MMA(1, 0, At, B0); PG8_MMA(1, 1, At, B1); PG8_BAR; PG8_SCHED;
            } else {
            PG8_LDB(B0, 0, 0); PG8_SCHED; PG8_LDA(At, 0, 0); PG8_STAGE(PG8_SA(1, 1), a1 + hstep, voffA);
            PG8_WAIT_L(8); PG8_BAR; PG8_WAIT_L(0); PG8_MMA(0, 0, At, B0); PG8_BAR; PG8_SCHED;
            PG8_LDB(B1, 0, 1); PG8_STAGE(PG8_SB(0, 0), b2, voffB);
            PG8_BAR; PG8_WAIT_L(0); PG8_MMA(0, 1, At, B1); PG8_BAR;
            PG8_LDA(At, 0, 1); PG8_STAGE(PG8_SA(0, 0), a2, voffA);
            PG8_BAR; PG8_WAIT_L(0); PG8_MMA(1, 0, At, B0); PG8_BAR; PG8_SCHED;
            PG8_STAGE(PG8_SB(0, 1), b2 + hstep, voffB);
            PG8_WAIT_V(6); PG8_BAR; PG8_MMA(1, 1, At, B1); PG8_BAR;
            PG8_LDB(B0, 1, 0); PG8_SCHED; PG8_LDA(At, 1, 0); PG8_STAGE(PG8_SA(0, 1), a2 + hstep, voffA);
            PG8_WAIT_L(8); PG8_BAR; PG8_WAIT_L(0); PG8_MMA(0, 0, At, B0); PG8_BAR; PG8_SCHED;
            PG8_LDB(B1, 1, 1); PG8_STAGE(PG8_SB(1, 0), b3, voffB);
            PG8_BAR; PG8_WAIT_L(0); PG8_MMA(0, 1, At, B1); PG8_BAR;
            PG8_LDA(At, 1, 1); PG8_STAGE(PG8_SA(1, 0), a3, voffA);
            PG8_BAR; PG8_WAIT_L(0); PG8_MMA(1, 0, At, B0); PG8_BAR; PG8_SCHED;
            PG8_STAGE(PG8_SB(1, 1), b3 + hstep, voffB);
            PG8_WAIT_V(6); PG8_BAR; PG8_MMA(1, 1, At, B1); PG8_BAR;
            }
        }
        if constexpr (ALIGN_EPI) { if (wr == 0) PG8_BAR; }
        if constexpr (!Epi::AFTER_DRAIN) { E(acc, cur, wr, wc, fr, fq); S.done(cur); }
        if (!has_next) break;
#pragma unroll
        for (int a = 0; a < 2; ++a)
#pragma unroll
            for (int b = 0; b < 2; ++b)
#pragma unroll
                for (int m = 0; m < 4; ++m)
#pragma unroll
                    for (int n = 0; n < 2; ++n) acc[a][b][m][n] = (f32x4){0.f, 0.f, 0.f, 0.f};
        cur = nxt; cA = nA; cB = nB; ++ui;
        if constexpr (ALIGN_EPI) { if (wr == 1) PG8_BAR; }
    }
    PG8_WAIT_V(0);
    if constexpr (!ALIGN_EPI) { if (wr == 0) PG8_BAR; }
    PG8_BAR;
    if constexpr (Epi::AFTER_DRAIN) { E.fused(acc, cur, wr, wc, fr, fq, lds, wid, lane); S.done(cur); }
#undef PG8_SA
#undef PG8_SB
#undef PG8_STAGE
#undef PG8_LDA
#undef PG8_LDB
#undef PG8_MMA
#undef PG8_WAIT_V
#undef PG8_WAIT_L
#undef PG8_BAR
#undef PG8_SCHED
}
}

namespace att {
using pg8::bf16_t; using pg8::bf16x8; using pg8::f32x4; using pg8::u32x4; using pg8::cvtpk;
#define ALDS __attribute__((address_space(3)))
typedef float f32x16 __attribute__((ext_vector_type(16)));
typedef short s16x4 __attribute__((ext_vector_type(4)));
typedef unsigned u32x2 __attribute__((ext_vector_type(2)));
constexpr int PITCH = 2304;
constexpr float THR = 8.0f;
__device__ __forceinline__ void glds16(const void* gsrc, unsigned lds_dst) { unsigned keep;
    asm volatile("s_mov_b32 %0, m0\n\ts_mov_b32 m0, %2\n\ts_nop 0\n\tglobal_load_lds_dwordx4 %1, off\n\ts_mov_b32 m0, %0" : "=&s"(keep) : "v"(gsrc), "s"(lds_dst) : "memory"); }
__device__ __forceinline__ void glds16s(unsigned voff, const void* sbase_, unsigned lds_dst) { unsigned keep;
    const unsigned long long sbase = ((unsigned long long)(unsigned)__builtin_amdgcn_readfirstlane((int)((unsigned long long)(uintptr_t)sbase_ >> 32)) << 32) | (unsigned)__builtin_amdgcn_readfirstlane((int)(unsigned)(uintptr_t)sbase_);
    asm volatile("s_mov_b32 %0, m0\n\ts_mov_b32 m0, %3\n\ts_nop 0\n\tglobal_load_lds_dwordx4 %1, %2\n\ts_mov_b32 m0, %0" : "=&s"(keep) : "v"(voff), "s"(sbase), "s"(lds_dst) : "memory"); }
__device__ __forceinline__ unsigned rfl(unsigned v) { return (unsigned)__builtin_amdgcn_readfirstlane((int)v); }
__device__ __forceinline__ int pi23(int x) { return (x & ~12) | ((x & 4) << 1) | ((x & 8) >> 1); }
__device__ __forceinline__ s16x4 vtr(const ALDS unsigned char* p) { return __builtin_bit_cast(s16x4, __builtin_amdgcn_ds_read_tr16_b64_v4i16((ALDS s16x4*)p)); }
__device__ __forceinline__ float halfswap_max(float v) { auto rr = __builtin_amdgcn_permlane32_swap(__float_as_uint(v), __float_as_uint(v), false, false); return fmaxf(__uint_as_float(rr[0]), __uint_as_float(rr[1])); }
__device__ __forceinline__ float halfswap_sum(float v) { auto rr = __builtin_amdgcn_permlane32_swap(__float_as_uint(v), __float_as_uint(v), false, false); return __uint_as_float(rr[0]) + __uint_as_float(rr[1]); }

template <int DV, bool BAND>
__device__ __forceinline__ float attn_core(ALDS unsigned char* ring, const int wid, const int lane,
                                           const bf16_t* Qw, const bf16_t* gbase, const unsigned koffb, const unsigned voffb, const int koff,
                                           const int t0, const int t1, const int tq, const int qpos, const float m_init, float l, f32x16 (&o)[DV / 32]) {
    constexpr int NDB = DV / 32, SLOT = (DV == 128) ? 32768 : 16384, VOFF = (DV == 128) ? 16384 : 8192, ROWB = DV * 2, NP = (DV == 128) ? 4 : 2;
    const int r32 = lane & 31, hi = lane >> 5;
    const unsigned ring_a = (unsigned)(uintptr_t)ring;
    bf16x8 qr[4];
#pragma unroll
    for (int d0 = 0; d0 < 4; ++d0) qr[d0] = *(const bf16x8*)(Qw + (size_t)r32 * PITCH + d0 * 16 + hi * 8);
#define ATT_PIECE(i_, t_, so_) do { const char* sb_ = (const char*)gbase + (size_t)(t_) * (64 * PITCH * 2); const unsigned d_ = ring_a + (unsigned)(so_) + (unsigned)wid * 1024u; \
        if (DV == 128) { if ((i_) == 0) glds16s(koffb, sb_, d_); else if ((i_) == 1) glds16s(koffb, sb_ + 128, d_ + 8192u); \
                         else if ((i_) == 2) glds16s(voffb, sb_, ring_a + (unsigned)(so_) + (unsigned)VOFF + (unsigned)wid * 2048u); \
                         else glds16s(voffb, sb_ + 4 * PITCH * 2, ring_a + (unsigned)(so_) + (unsigned)VOFF + (unsigned)wid * 2048u + 1024u); } \
        else { if ((i_) == 0) glds16s(koffb, sb_, d_); else if ((i_) == 2) glds16s(voffb, sb_, d_ + (unsigned)VOFF); } } while (0)
#define ATT_ISSUE(t_, so_) do { ATT_PIECE(0, t_, so_); ATT_PIECE(1, t_, so_); ATT_PIECE(2, t_, so_); ATT_PIECE(3, t_, so_); } while (0)
    ATT_ISSUE(t0, 0);
    { const int tn = (t0 + 1 < t1) ? t0 + 1 : t1 - 1; ATT_ISSUE(tn, SLOT); }
    const int g = (lane >> 4) & 1, q4 = (lane & 15) >> 2, p = lane & 3, sw = (DV == 128) ? q4 : (q4 >> 1);
    int va[NDB];
#pragma unroll
    for (int db = 0; db < NDB; ++db) va[db] = VOFF + (8 * hi + q4) * ROWB + ((db ^ sw) << 6) + (2 * g + (p >> 1)) * 16 + 8 * (p & 1);
    const int ka = koff + hi * 1024 + r32 * 16;
    float m = m_init;
    f32x16 negm;
#pragma unroll
    for (int r = 0; r < 16; ++r) negm[r] = -m;
#pragma unroll
    for (int db = 0; db < NDB; ++db)
#pragma unroll
        for (int r = 0; r < 16; ++r) o[db][r] = 0.f;
    if (wid >= 4) __builtin_amdgcn_s_setprio(1);
    int s_cur = 0, s_n2 = 2 * SLOT;
    for (int t = t0; t < t1; ++t) {
        asm volatile("s_waitcnt vmcnt(%0)" :: "n"(NP) : "memory");
        asm volatile("s_waitcnt lgkmcnt(0)\n\ts_barrier" ::: "memory");
        const int tn = (t + 2 < t1) ? t + 2 : t1 - 1;
        const ALDS unsigned char* sb = ring + s_cur;
        f32x16 p0 = negm, p1 = negm;
        bf16x8 kf[8];
#pragma unroll
        for (int d0 = 0; d0 < 4; ++d0) { kf[2 * d0] = *(const ALDS bf16x8*)(sb + ka + d0 * 2048); kf[2 * d0 + 1] = *(const ALDS bf16x8*)(sb + ka + d0 * 2048 + 512); }
        s16x4 vlo[2][NDB], vhh[2][NDB];
#pragma unroll
        for (int db = 0; db < NDB; ++db) { vlo[0][db] = vtr(sb + va[db]); vhh[0][db] = vtr(sb + va[db] + 4 * ROWB); }
        __builtin_amdgcn_sched_barrier(0);
#pragma unroll
        for (int d0 = 0; d0 < 4; ++d0) {
            p0 = __builtin_amdgcn_mfma_f32_32x32x16_bf16(kf[2 * d0], qr[d0], p0, 0, 0, 0);
            p1 = __builtin_amdgcn_mfma_f32_32x32x16_bf16(kf[2 * d0 + 1], qr[d0], p1, 0, 0, 0);
            __builtin_amdgcn_sched_barrier(0);
            ATT_PIECE(d0, tn, s_n2);
            __builtin_amdgcn_sched_barrier(0);
        }
        if (BAND) {
            if (t == tq - 2 || t == tq + 2) {
                const int rel0 = t * 64 + 8 * hi - qpos;
#pragma unroll
                for (int r = 0; r < 16; ++r) { const int rel = rel0 + 16 * (r >> 3) + (r & 7);
                    if (rel < -128 || rel > 128) p0[r] = -INFINITY;
                    if (rel + 32 < -128 || rel + 32 > 128) p1[r] = -INFINITY; }
            }
        }
        float mx = fmaxf(p0[0], p1[0]);
#pragma unroll
        for (int r = 1; r < 16; ++r) mx = fmaxf(fmaxf(mx, p0[r]), p1[r]);
        mx = halfswap_max(mx);
        const bool first = (!BAND) && (t == t0);
        const float dl = first ? mx : ((mx > THR) ? mx : 0.f);
        if (__any(dl != 0.f)) {
            m += dl;
#pragma unroll
            for (int r = 0; r < 16; ++r) { p0[r] -= dl; p1[r] -= dl; negm[r] = -m; }
            const float f = first ? 1.f : __builtin_amdgcn_exp2f(-dl);
            l *= f;
#pragma unroll
            for (int db = 0; db < NDB; ++db)
#pragma unroll
                for (int r = 0; r < 16; ++r) o[db][r] *= f;
        }
        float ssum = 0.f;
        bf16x8 pfs[4];
#define ATT_EXP_SLICE(P_, B_, DST_) do { u32x4 w_; \
        P_[B_ + 0] = __builtin_amdgcn_exp2f(P_[B_ + 0]); P_[B_ + 1] = __builtin_amdgcn_exp2f(P_[B_ + 1]); P_[B_ + 2] = __builtin_amdgcn_exp2f(P_[B_ + 2]); P_[B_ + 3] = __builtin_amdgcn_exp2f(P_[B_ + 3]); \
        P_[B_ + 4] = __builtin_amdgcn_exp2f(P_[B_ + 4]); P_[B_ + 5] = __builtin_amdgcn_exp2f(P_[B_ + 5]); P_[B_ + 6] = __builtin_amdgcn_exp2f(P_[B_ + 6]); P_[B_ + 7] = __builtin_amdgcn_exp2f(P_[B_ + 7]); \
        ssum += ((P_[B_ + 0] + P_[B_ + 1]) + (P_[B_ + 2] + P_[B_ + 3])) + ((P_[B_ + 4] + P_[B_ + 5]) + (P_[B_ + 6] + P_[B_ + 7])); \
        w_.x = cvtpk(P_[B_ + 0], P_[B_ + 1]); w_.y = cvtpk(P_[B_ + 2], P_[B_ + 3]); w_.z = cvtpk(P_[B_ + 4], P_[B_ + 5]); w_.w = cvtpk(P_[B_ + 6], P_[B_ + 7]); DST_ = __builtin_bit_cast(bf16x8, w_); } while (0)
        ATT_EXP_SLICE(p0, 0, pfs[0]);
        __builtin_amdgcn_sched_barrier(0);
#pragma unroll
        for (int ks = 0; ks < 4; ++ks) {
            if (ks + 1 < 4) {
#pragma unroll
                for (int db = 0; db < NDB; ++db) { vlo[(ks + 1) & 1][db] = vtr(sb + va[db] + (ks + 1) * (16 * ROWB)); vhh[(ks + 1) & 1][db] = vtr(sb + va[db] + (ks + 1) * (16 * ROWB) + 4 * ROWB); }
            }
#pragma unroll
            for (int db = 0; db < NDB; ++db) {
                const s16x4 lo = vlo[ks & 1][db], hh = vhh[ks & 1][db];
                const bf16x8 vf = (bf16x8){lo[0], lo[1], lo[2], lo[3], hh[0], hh[1], hh[2], hh[3]};
                o[db] = __builtin_amdgcn_mfma_f32_32x32x16_bf16(vf, pfs[ks], o[db], 0, 0, 0);
            }
            if (ks == 0) ATT_EXP_SLICE(p0, 8, pfs[1]);
            if (ks == 1) ATT_EXP_SLICE(p1, 0, pfs[2]);
            if (ks == 2) ATT_EXP_SLICE(p1, 8, pfs[3]);
            if (ks + 1 < 4) {
                __builtin_amdgcn_sched_group_barrier(0x100, 2 * NDB, 0);
#pragma unroll
                for (int db = 0; db < NDB; ++db) { __builtin_amdgcn_sched_group_barrier(0x008, 1, 0); __builtin_amdgcn_sched_group_barrier(0x002, 20 / NDB, 0); }
            }
            __builtin_amdgcn_sched_barrier(0);
        }
#undef ATT_EXP_SLICE
        l += ssum;
        s_cur = (s_cur == 2 * SLOT) ? 0 : s_cur + SLOT; s_n2 = (s_n2 == 2 * SLOT) ? 0 : s_n2 + SLOT;
    }
    __builtin_amdgcn_s_setprio(0);
    asm volatile("s_waitcnt vmcnt(0) lgkmcnt(0)\n\ts_barrier" ::: "memory");
#undef ATT_ISSUE
#undef ATT_PIECE
    return l;
}

__device__ __forceinline__ void diff_unit(ALDS unsigned char* ring, const int wid, int lane, const bf16_t* qkv, bf16_t* ymix, const int u, const float lam, const float post, const float* subg) {
    asm volatile("" : "+v"(lane));
    const int bh = u >> 5, qb = u & 31, b = bh >> 2, h = bh & 3, comp = wid >> 2, wq = wid & 3, r32 = lane & 31, hi = lane >> 5;
    const size_t rowbase = (size_t)b * 4096;
    const int q0 = qb * 128 + wq * 32;
    const bf16_t* Qw = qkv + (rowbase + q0) * PITCH + h * 128 + comp * 64;
    const bf16_t* gbase = qkv + rowbase * PITCH;
    const unsigned koffb = (unsigned)((pi23(lane) * PITCH + 512 + h * 128 + wid * 8) * 2);
    const unsigned voffb = (unsigned)(((8 * wid + (lane >> 4)) * PITCH + 1024 + h * 128 + (((lane & 15) ^ ((lane >> 4) << 2)) * 8)) * 2);
    f32x16 o[4];
    float l = attn_core<128, false>(ring, wid, lane, Qw, gbase, koffb, voffb, comp * 8192, 0, 64, 0, 0, 0.f, 0.f, o);
    l = halfswap_sum(l);
    const float inv = 1.0f / l;
    ALDS f32x4* X = (ALDS f32x4*)ring + (size_t)wq * (16 * 64);
    if (comp == 1) {
#pragma unroll
        for (int db = 0; db < 4; ++db)
#pragma unroll
            for (int rq = 0; rq < 4; ++rq) X[(db * 4 + rq) * 64 + lane] = (f32x4){o[db][4 * rq] * inv, o[db][4 * rq + 1] * inv, o[db][4 * rq + 2] * inv, o[db][4 * rq + 3] * inv};
    }
    asm volatile("s_waitcnt lgkmcnt(0)\n\ts_barrier" ::: "memory");
    if (comp == 0) {
        float ss = 0.f;
#pragma unroll
        for (int db = 0; db < 4; ++db)
#pragma unroll
            for (int rq = 0; rq < 4; ++rq) { const f32x4 o2 = X[(db * 4 + rq) * 64 + lane];
#pragma unroll
                for (int e = 0; e < 4; ++e) { const float d = o[db][4 * rq + e] * inv - lam * o2[e]; o[db][4 * rq + e] = d; ss += d * d; } }
        ss = halfswap_sum(ss);
        const float rs = rsqrtf(ss * (1.0f / 128.0f) + 1e-5f) * post;
        bf16_t* orow = ymix + (rowbase + q0 + r32) * 1024 + h * 128 + 4 * hi;
#pragma unroll
        for (int db = 0; db < 4; ++db)
#pragma unroll
            for (int rq = 0; rq < 4; ++rq) { const f32x4 gv = *(const f32x4*)(subg + 32 * db + 8 * rq + 4 * hi);
                u32x2 w; w.x = cvtpk(o[db][4 * rq] * rs * gv[0], o[db][4 * rq + 1] * rs * gv[1]); w.y = cvtpk(o[db][4 * rq + 2] * rs * gv[2], o[db][4 * rq + 3] * rs * gv[3]);
                *(u32x2*)(orow + 32 * db + 8 * rq) = w; }
    }
    asm volatile("s_waitcnt lgkmcnt(0)\n\ts_barrier" ::: "memory");
}

__device__ __forceinline__ void swa_unit(ALDS unsigned char* ring, const int wid, int lane, const bf16_t* qkv, bf16_t* ymix, const int u, const float* sink) {
    asm volatile("" : "+v"(lane));
    const int bkv = u >> 6, qblk = u & 63, b = bkv >> 1, kvh = bkv & 1, head = kvh * 4 + (wid >> 1), r32 = lane & 31, hi = lane >> 5;
    const size_t rowbase = (size_t)b * 4096;
    const int q0 = qblk * 64 + (wid & 1) * 32;
    const bf16_t* Qw = qkv + (rowbase + q0) * PITCH + 1536 + head * 64;
    const bf16_t* gbase = qkv + rowbase * PITCH;
    const unsigned koffb = (unsigned)((pi23(lane) * PITCH + 2048 + kvh * 64 + wid * 8) * 2);
    const unsigned voffb = (unsigned)(((8 * wid + (lane >> 3)) * PITCH + 2176 + kvh * 64 + (((lane & 7) ^ (((lane >> 4) & 1) << 2)) * 8)) * 2);
    const int t0 = (qblk - 2 > 0) ? qblk - 2 : 0, t1 = ((qblk + 2 < 63) ? qblk + 2 : 63) + 1;
    f32x16 o[2];
    float l = attn_core<64, true>(ring, wid, lane, Qw, gbase, koffb, voffb, 0, t0, t1, qblk, q0 + r32, sink[head] * 1.4426950408889634f, (hi == 0) ? 1.0f : 0.0f, o);
    l = halfswap_sum(l);
    const float inv = 1.0f / l;
    bf16_t* orow = ymix + (rowbase + q0 + r32) * 1024 + 512 + head * 64 + 4 * hi;
#pragma unroll
    for (int db = 0; db < 2; ++db)
#pragma unroll
        for (int rq = 0; rq < 4; ++rq) { u32x2 w; w.x = cvtpk(o[db][4 * rq] * inv, o[db][4 * rq + 1] * inv); w.y = cvtpk(o[db][4 * rq + 2] * inv, o[db][4 * rq + 3] * inv);
            *(u32x2*)(orow + 32 * db + 8 * rq) = w; }
}
}

constexpr int NWAVES = 8;
constexpr int M = 65536, D = 1024, FF = 2816, NIN = 2304, SEQ = 4096, DEPTH = 4;
constexpr size_t MiB = 1u << 20;
constexpr size_t W1_OFF = 0, W1_B = (size_t)2 * FF * D * 2, W2_OFF = W1_OFF + W1_B, W2_B = (size_t)D * FF * 2, WIN_OFF = W2_OFF + W2_B, WIN_B = (size_t)NIN * D * 2,
                 WO_OFF = WIN_OFF + WIN_B, WO_B = (size_t)D * D * 2, W3_OFF = WO_OFF + WO_B, W4_OFF = W3_OFF + W1_B, WL_STRIDE = W4_OFF + W2_B;
constexpr size_t WS_W = 0, WS_ROPE = 160 * MiB, WS_XB = 176 * MiB, WS_H = 304 * MiB, WS_YM = 656 * MiB, WS_CSBW = 784 * MiB, WS_ST = 785 * MiB, WS_CTL = 786 * MiB, WS_END = 787 * MiB;
constexpr size_t CTL_ZERO_BYTES = 16384;
constexpr int CSBW_N = 2 * FF;
static_assert((size_t)DEPTH * 3 * 2 * CSBW_N * 4 <= MiB && (size_t)2 * M * 2 * 4 <= MiB, "aux map");
static_assert(WL_STRIDE * DEPTH <= WS_ROPE && WS_ROPE + (size_t)M * 64 * 4 <= WS_XB && WS_XB + (size_t)M * D * 2 <= WS_H && WS_H + (size_t)M * FF * 2 <= WS_YM && WS_YM + (size_t)M * D * 2 <= WS_END, "d_ws map");
constexpr int LDS_BYTES = 147456;
constexpr float ALPHA = 1.681792830507429f;
constexpr float QSCALE = 0.125f * 1.4426950408889634f;

typedef unsigned short bf16;
typedef float f32x4 __attribute__((ext_vector_type(4)));
typedef unsigned v4u __attribute__((ext_vector_type(4)));
typedef unsigned v2u __attribute__((ext_vector_type(2)));
using pg8::cvtpk;

struct Args { const float* in[13]; float* out; unsigned char* ws; float inv[32]; float lam_init[4]; };

__device__ __forceinline__ int cur_lane() { int l; asm volatile("v_mbcnt_lo_u32_b32 %0, -1, 0\n\tv_mbcnt_hi_u32_b32 %0, -1, %0" : "=v"(l)); return l; }
__device__ __forceinline__ float wave_sum(float v) {
#pragma unroll
    for (int o = 1; o < 64; o <<= 1) v += __shfl_xor(v, o);
    return v;
}
__device__ __forceinline__ int src_col(int type, int n) {
    if (type == 1) { const int pn = n >> 8, w = n & 255; return (w < 128) ? (128 * pn + w) : (FF + 128 * pn + (w - 128)); }
    if (type == 3) { const int w = n & 255, bj = w >> 7, wc = (w >> 5) & 3, c = w & 31; return (n & ~255) + 64 * wc + 32 * bj + c; }
    if (type == 2) { const bool rp = (n < 1024) || (n >= 1536 && n < 2176); return rp ? ((n & ~63) + ((n & 63) >> 1) + 32 * (n & 1)) : n; }
    return n;
}
template <bool F16> __device__ __forceinline__ void transpose_item(const float* W, int K, int N, int type, const float* gk, bf16* WT, ALDS float* scr, int item, int lane) {
    const int nblk = N / 32, kb = item / nblk, nb = item % nblk, k0 = 64 * kb, n0 = 32 * nb;
    const int sc = src_col(type, n0 + (lane & 31));
#pragma unroll
    for (int i = 0; i < 32; ++i) { const int kk = 2 * i + (lane >> 5); scr[kk * 33 + (lane & 31)] = W[(size_t)(k0 + kk) * N + sc] * (gk ? gk[k0 + kk] : 1.0f); }
    asm volatile("s_waitcnt lgkmcnt(0)" ::: "memory");
    const int c = lane & 7;
#pragma unroll
    for (int j = 0; j < 4; ++j) { const int n = (lane >> 3) + 8 * j; const ALDS float* s = scr + (8 * c) * 33 + n;
        v4u o; if (F16) { o.x = pg8::cvtpk_h(s[0 * 33], s[1 * 33]); o.y = pg8::cvtpk_h(s[2 * 33], s[3 * 33]); o.z = pg8::cvtpk_h(s[4 * 33], s[5 * 33]); o.w = pg8::cvtpk_h(s[6 * 33], s[7 * 33]); }
        else { o.x = cvtpk(s[0 * 33], s[1 * 33]); o.y = cvtpk(s[2 * 33], s[3 * 33]); o.z = cvtpk(s[4 * 33], s[5 * 33]); o.w = cvtpk(s[6 * 33], s[7 * 33]); }
        *(v4u*)(WT + (size_t)(n0 + n) * K + k0 + 8 * c) = o; }
    asm volatile("s_waitcnt lgkmcnt(0)" ::: "memory");
}
__device__ __forceinline__ void sincos_f32angle(float ang, float& c, float& s) {
    const double a = (double)ang, k = __builtin_rint(a * 0.63661977236758134308);
    double r = __builtin_fma(-k, 1.57079632679489655800e+00, a); r = __builtin_fma(-k, 6.12323399573676603587e-17, r);
    const double r2 = r * r;
    double sp = -1.0 / 1307674368000.0; sp = sp * r2 + 1.0 / 6227020800.0; sp = sp * r2 - 1.0 / 39916800.0; sp = sp * r2 + 1.0 / 362880.0; sp = sp * r2 - 1.0 / 5040.0; sp = sp * r2 + 1.0 / 120.0; sp = sp * r2 - 1.0 / 6.0;
    const double sn = r + r * r2 * sp;
    double cp = 1.0 / 20922789888000.0; cp = cp * r2 - 1.0 / 87178291200.0; cp = cp * r2 + 1.0 / 479001600.0; cp = cp * r2 - 1.0 / 3628800.0; cp = cp * r2 + 1.0 / 40320.0; cp = cp * r2 - 1.0 / 720.0; cp = cp * r2 + 1.0 / 24.0; cp = cp * r2 - 0.5;
    const double cn = 1.0 + r2 * cp;
    const int q = ((int)k) & 3;
    const double cc = (q == 0) ? cn : (q == 1) ? -sn : (q == 2) ? -cn : sn;
    const double ss = (q == 0) ? sn : (q == 1) ? cn : (q == 2) ? -sn : -cn;
    c = (float)cc; s = (float)ss;
}
__device__ __forceinline__ void ln_row(const float* xrow, const float* g, const float* bta, float* orow, bf16* brow, int lane) {
    asm volatile("" : "+v"(lane));
    const f32x4* xr = (const f32x4*)xrow + lane;
    f32x4 v[4]; float s = 0.f;
#pragma unroll
    for (int j = 0; j < 4; ++j) { v[j] = xr[64 * j]; s += (v[j][0] + v[j][1]) + (v[j][2] + v[j][3]); }
    const float mean = wave_sum(s) * (1.f / D); float s2 = 0.f;
#pragma unroll
    for (int j = 0; j < 4; ++j) { v[j] = v[j] - mean; s2 += (v[j][0] * v[j][0] + v[j][1] * v[j][1]) + (v[j][2] * v[j][2] + v[j][3] * v[j][3]); }
    const float rstd = 1.0f / sqrtf(wave_sum(s2) * (1.f / D) + 1e-5f);
#pragma unroll
    for (int j = 0; j < 4; ++j) { const f32x4 gg = *((const f32x4*)g + lane + 64 * j), bb = *((const f32x4*)bta + lane + 64 * j);
        const f32x4 y = v[j] * rstd * gg + bb;
        *((f32x4*)orow + lane + 64 * j) = y;
        v2u w; w.x = cvtpk(y[0], y[1]); w.y = cvtpk(y[2], y[3]); *((v2u*)brow + lane + 64 * j) = w; }
}

#define XB_TMO      128
#define XB_XCNT(j)  (256  + 64 * (j))
#define XB_XSUB(j)  (1280 + 64 * (j))
#define XB_XGEN(j)  (2304 + 64 * (j))
#define XB_TOP      3328
#define XB_TOPGEN   3392
#define XCD_BAR_WORDS 3456
#define XB_SPIN_CAP (1u << 18)

__device__ __forceinline__ unsigned xb_ld(unsigned* p)              { return __hip_atomic_load(p, __ATOMIC_RELAXED, __HIP_MEMORY_SCOPE_AGENT); }
__device__ __forceinline__ unsigned xb_add(unsigned* p, unsigned v) { return __hip_atomic_fetch_add(p, v, __ATOMIC_RELAXED, __HIP_MEMORY_SCOPE_AGENT); }
__device__ __forceinline__ unsigned xb_xcc_id() { return (unsigned)__builtin_amdgcn_s_getreg((3 << 11) | 20) & 0xFu; }
#define XB_SPIN(cond, bar) do { unsigned _sp = 0; while (cond) { __builtin_amdgcn_s_sleep(1); \
    if ((++_sp & 255u) == 0u) { if (xb_ld(&(bar)[XB_TMO])) break; if (_sp > XB_SPIN_CAP) { atomicAdd(&(bar)[XB_TMO], 1u); break; } } } } while (0)

struct XcdBarrier {
    unsigned* bar; unsigned x;
    volatile ALDS unsigned* st;
};

__device__ __forceinline__ XcdBarrier xcd_barrier_post(unsigned* bar, volatile ALDS unsigned* st) {
    XcdBarrier b; b.bar = bar; b.x = xb_xcc_id(); b.st = st;
    if (threadIdx.x == 0) (void)xb_add(&bar[XB_XCNT(b.x)], 1u);
    return b;
}
__device__ __forceinline__ void xcd_barrier_complete(unsigned* bar, unsigned x, unsigned& nloc, unsigned& nx) {
    const unsigned G = gridDim.x * gridDim.y * gridDim.z;
    unsigned sum, cnt, mine, sp = 0u;
    for (;;) {
        sum = 0u; cnt = 0u; mine = 0u;
#pragma unroll
        for (unsigned j = 0; j < 16; ++j) { const unsigned c = xb_ld(&bar[XB_XCNT(j)]); sum += c; cnt += (c > 0u) ? 1u : 0u; mine = (j == x) ? c : mine; }
        if (sum == G) break;
        __builtin_amdgcn_s_sleep(1);
        if ((++sp & 255u) == 0u) { if (xb_ld(&bar[XB_TMO])) break; if (sp > XB_SPIN_CAP) { atomicAdd(&bar[XB_TMO], 1u); break; } }
    }
    nloc = mine > 0u ? mine : 1u; nx = cnt > 0u ? cnt : 1u;
}

__device__ __forceinline__ void xcd_barrier(const XcdBarrier& b) {
    asm volatile("s_waitcnt vmcnt(0)" ::: "memory");
    __syncthreads();
    if (threadIdx.x == 0) {
        unsigned* bar = b.bar;
        __builtin_amdgcn_s_waitcnt(0);
        unsigned nloc = b.st[0], nx = b.st[1];
        if (nloc == 0u) { xcd_barrier_complete(bar, b.x, nloc, nx); b.st[0] = nloc; b.st[1] = nx; }
        const unsigned old = xb_add(&bar[XB_XSUB(b.x)], 1u);
        const unsigned gen = old / nloc;
        if (old + 1u == (gen + 1u) * nloc) {
            __builtin_amdgcn_fence(__ATOMIC_RELEASE, "agent");
            asm volatile("s_waitcnt vmcnt(0)" ::: "memory");
            const unsigned og = xb_add(&bar[XB_TOP], 1u);
            const unsigned tg = og / nx;
            if (og + 1u == (tg + 1u) * nx) xb_add(&bar[XB_TOPGEN], 1u);
            else XB_SPIN(xb_ld(&bar[XB_TOPGEN]) == tg, bar);
            __builtin_amdgcn_fence(__ATOMIC_ACQUIRE, "agent");
            xb_add(&bar[XB_XGEN(b.x)], 1u);
            asm volatile("s_waitcnt vmcnt(0)" ::: "memory");
        } else {
            XB_SPIN(xb_ld(&bar[XB_XGEN(b.x)]) == gen, bar);
            __builtin_amdgcn_fence(__ATOMIC_ACQUIRE, "agent");
            asm volatile("s_waitcnt vmcnt(0)" ::: "memory");
        }
    }
    __syncthreads();
}

__device__ __forceinline__ void ln_row_h(const bf16* hrow, const float* g, const float* bta, float* orow, int lane) {
    asm volatile("" : "+v"(lane));
    typedef _Float16 h4 __attribute__((ext_vector_type(4)));
    f32x4 v[4]; float s = 0.f;
#pragma unroll
    for (int j = 0; j < 4; ++j) { const h4 h = *((const h4*)hrow + lane + 64 * j); v[j] = (f32x4){(float)h[0], (float)h[1], (float)h[2], (float)h[3]}; s += (v[j][0] + v[j][1]) + (v[j][2] + v[j][3]); }
    const float mean = wave_sum(s) * (1.f / D); float s2 = 0.f;
#pragma unroll
    for (int j = 0; j < 4; ++j) { v[j] = v[j] - mean; s2 += (v[j][0] * v[j][0] + v[j][1] * v[j][1]) + (v[j][2] * v[j][2] + v[j][3] * v[j][3]); }
    const float rstd = 1.0f / sqrtf(wave_sum(s2) * (1.f / D) + 1e-5f);
#pragma unroll
    for (int j = 0; j < 4; ++j) { const f32x4 gg = *((const f32x4*)g + lane + 64 * j), bb = *((const f32x4*)bta + lane + 64 * j);
        *((f32x4*)orow + lane + 64 * j) = v[j] * rstd * gg + bb; }
}

__global__ void __launch_bounds__(NWAVES * 64, 2) fwd_megakernel(Args args) {
    extern __shared__ __attribute__((aligned(16))) unsigned char lds_raw[];
    cg::grid_group grid = cg::this_grid();
#define GSYNC() xcd_barrier(bar)
    ALDS unsigned char* lds = (ALDS unsigned char*)lds_raw;
    const int tid = threadIdx.x, lane = tid & 63, wave = __builtin_amdgcn_readfirstlane(tid >> 6);
    const int G = gridDim.x, bx = blockIdx.x & 1023,                                          vcu = (G % 8 == 0) ? (bx % 8) * (G / 8) + bx / 8 : bx;
    unsigned char* ws = args.ws;
    const float* x_in = args.in[0]; const int* positions = (const int*)args.in[1];
    float* out = args.out;
    bf16* XB = (bf16*)(ws + WS_XB); bf16* HB = (bf16*)(ws + WS_H); bf16* QKV = (bf16*)(ws + WS_H); bf16* YM = (bf16*)(ws + WS_YM);
    unsigned* ROPEH = (unsigned*)(ws + WS_ROPE);
    float* ROPE = (float*)(ws + WS_ROPE); float* CSBW = (float*)(ws + WS_CSBW); float* ST = (float*)(ws + WS_ST); float* LAMV = (float*)(ws + WS_CSBW + 786432);
    const int gw = vcu * NWAVES + wave, NGW = G * NWAVES;
    volatile ALDS unsigned* bst = (volatile ALDS unsigned*)(lds + 131072 + 8192);
    if (tid < 2) bst[tid] = 0u;
    __syncthreads();
    XcdBarrier bar = xcd_barrier_post((unsigned*)(ws + WS_CTL), bst);

    {
        ALDS float* scr = (ALDS float*)(lds + wave * 16384);
        constexpr int I1 = (D / 64) * (2 * FF / 32), I2 = (FF / 64) * (D / 32), I3 = (D / 64) * (NIN / 32), I4 = (D / 64) * (D / 32), IL = 2 * I1 + 2 * I2 + I3 + I4;
        for (int it = gw; it < IL * DEPTH; it += NGW) {
            const int l = it / IL; int r = it % IL;
            unsigned char* wl = ws + WS_W + (size_t)l * WL_STRIDE;
            if (r < I1) { transpose_item<true>(args.in[7] + (size_t)l * D * 2 * FF, D, 2 * FF, 1, (l > 0) ? args.in[11] + (size_t)((l - 1) * 3 + 2) * D : nullptr, (bf16*)(wl + W1_OFF), scr, r, lane); continue; } r -= I1;
            if (r < I2) { transpose_item<false>(args.in[8] + (size_t)l * FF * D, FF, D, 3, nullptr, (bf16*)(wl + W2_OFF), scr, r, lane); continue; } r -= I2;
            if (r < I3) { transpose_item<true>(args.in[2] + (size_t)l * D * NIN, D, NIN, 2, args.in[11] + (size_t)(l * 3) * D, (bf16*)(wl + WIN_OFF), scr, r, lane); continue; } r -= I3;
            if (r < I4) { transpose_item<false>(args.in[3] + (size_t)l * D * D, D, D, 3, nullptr, (bf16*)(wl + WO_OFF), scr, r, lane); continue; } r -= I4;
            if (r < I1) { transpose_item<true>(args.in[9] + (size_t)l * D * 2 * FF, D, 2 * FF, 1, args.in[11] + (size_t)(l * 3 + 1) * D, (bf16*)(wl + W3_OFF), scr, r, lane); continue; } r -= I1;
            transpose_item<false>(args.in[10] + (size_t)l * FF * D, FF, D, 3, nullptr, (bf16*)(wl + W4_OFF), scr, r, lane);
        }
        const size_t gt = (size_t)vcu * (NWAVES * 64) + tid, GT = (size_t)G * NWAVES * 64;
        for (size_t i = gt; i < (size_t)M * D / 4; i += 8 * GT) {
            f32x4 v[8];
#pragma unroll
            for (int j = 0; j < 8; ++j) { const size_t ij = i + (size_t)j * GT; v[j] = (ij < (size_t)M * D / 4) ? *((const f32x4*)x_in + ij) : (f32x4){0.f, 0.f, 0.f, 0.f}; }
#pragma unroll
            for (int j = 0; j < 8; ++j) { const size_t ij = i + (size_t)j * GT; if (ij < (size_t)M * D / 4) { v2u w; w.x = pg8::cvtpk_h(v[j][0], v[j][1]); w.y = pg8::cvtpk_h(v[j][2], v[j][3]); *((v2u*)XB + ij) = w; } }
        }
        for (size_t i = gt; i < (size_t)M * 32; i += GT) { const int row = (int)(i >> 5), k = (int)(i & 31); float c, s; sincos_f32angle((float)positions[row] * args.inv[k], c, s);
            ROPEH[(size_t)row * 32 + k] = pg8::cvtpk_h(c, s); }
        if (vcu == 0 && wave < DEPTH) {
            const float* lv = args.in[4] + (size_t)wave * 256;
            const float a1 = wave_sum(lv[lane] * lv[64 + lane]), a2 = wave_sum(lv[128 + lane] * lv[192 + lane]);
            if (lane == 0) LAMV[wave] = expf(a1) - expf(a2) + args.lam_init[wave];
        }
        for (size_t i = gt; i < (size_t)M * 2; i += GT) ST[i] = 0.f;
        {
            ALDS float* red = (ALDS float*)(lds + 131072);
            constexpr int CG0 = 2 * FF / 64, CG1 = NIN / 64, CGL = 2 * CG0 + CG1;
            for (int cgi = vcu; cgi < CGL * DEPTH; cgi += G) {
                const int l = cgi / CGL; int r = cgi % CGL; int j = 0;
                if (r >= CG0) { r -= CG0; j = 1; if (r >= CG1) { r -= CG1; j = 2; } }
                const int lnidx = (j == 0) ? (l - 1) * 3 + 2 : (j == 1) ? l * 3 : l * 3 + 1;
                if (lnidx < 0) continue;
                const int N = (j == 1) ? NIN : 2 * FF, type = (j == 1) ? 2 : 1;
                const float* W = (j == 0) ? args.in[7] + (size_t)l * D * 2 * FF : (j == 1) ? args.in[2] + (size_t)l * D * NIN : args.in[9] + (size_t)l * D * 2 * FF;
                const float* gk = args.in[11] + (size_t)lnidx * D; const float* bk = args.in[12] + (size_t)lnidx * D;
                const int n = r * 64 + lane, sc = src_col(type, n);
                float c1 = 0.f, b1 = 0.f;
#pragma unroll 16
                for (int k = wave * 128; k < wave * 128 + 128; ++k) { const float w = W[(size_t)k * N + sc]; const float gw = gk[k] * w;
                    c1 += (float)(_Float16)gw; b1 += bk[k] * w; }
                red[(wave * 64 + lane) * 2] = c1; red[(wave * 64 + lane) * 2 + 1] = b1;
                __syncthreads();
                if (wave == 0) { float cc = 0.f, bb = 0.f;
#pragma unroll
                    for (int w8 = 0; w8 < 8; ++w8) { cc += red[(w8 * 64 + lane) * 2]; bb += red[(w8 * 64 + lane) * 2 + 1]; }
                    float* dst = CSBW + (size_t)((l * 3 + j) * 2) * CSBW_N; dst[n] = cc; dst[CSBW_N + n] = bb; }
                __syncthreads();
            }
        }
    }
    grid.sync();

#define ZERO_ST(buf_) do { int t_ = wave * 64 + cur_lane(); asm volatile("" : "+v"(t_)); float* z_ = ST + (size_t)(buf_) * M * 2; for (int i_ = vcu * (NWAVES * 64) + t_; i_ < M * 2; i_ += G * NWAVES * 64) { z_[i_] = 0.f; asm volatile("" : "+v"(i_)); } } while (0)
    for (int l = 0; l < DEPTH; ++l) {
        unsigned char* wl = ws + WS_W + (size_t)l * WL_STRIDE;
        const float* lng = args.in[11]; const float* lnb = args.in[12];
        { const int k = 3 * l; ZERO_ST(k & 1);
          const float* cb = CSBW + (size_t)((l * 3 + 0) * 2) * CSBW_N;
          pg8::Gemm g{XB, (const bf16*)(wl + W1_OFF), M, 2 * FF, D}; pg8::StaticOrder S; S.init(M, 2 * FF, G, bx);
          pg8::EpiSwiGLU E{HB, FF, pg8::RowLN{(k == 0) ? nullptr : ST + (size_t)((k - 1) & 1) * M * 2, cb, cb + CSBW_N}};
          pg8::gemm_phase<pg8::EpiSwiGLU, pg8::StaticOrder, true, true>(lds, g, S, E, wave); }
        GSYNC();
        { const int k = 3 * l;
          pg8::Gemm g{HB, (const bf16*)(wl + W2_OFF), M, D, FF}; pg8::StaticOrder S; S.init(M, D, G, bx);
          pg8::EpiRes E{x_in, XB, (k == 0) ? nullptr : ST + (size_t)((k - 1) & 1) * M * 2, lng + (size_t)(k > 0 ? k - 1 : 0) * D, lnb + (size_t)(k > 0 ? k - 1 : 0) * D, ST + (size_t)(k & 1) * M * 2, ALPHA, 0.5f};
          pg8::gemm_phase<pg8::EpiRes, pg8::StaticOrder, true, true>(lds, g, S, E, wave); }
        GSYNC();
        { const int k = 3 * l + 1; ZERO_ST(k & 1);
          const float* cb = CSBW + (size_t)((l * 3 + 1) * 2) * CSBW_N;
          pg8::Gemm g{XB, (const bf16*)(wl + WIN_OFF), M, NIN, D}; pg8::StaticOrder S; S.init(M, NIN, G, bx);
          pg8::EpiQKV E{QKV, ROPEH, QSCALE, pg8::RowLN{ST + (size_t)((k - 1) & 1) * M * 2, cb, cb + CSBW_N}};
          pg8::gemm_phase<pg8::EpiQKV, pg8::StaticOrder, true, true>(lds, g, S, E, wave); }
        GSYNC();
        {
            const float lam_init = args.lam_init[l], lam = LAMV[l];
            const float* subg = args.in[5] + (size_t)l * 128; const float* sink = args.in[6] + (size_t)l * 8;
            for (int u = vcu; u < 2048; u += G) att::diff_unit(lds, wave, cur_lane(), QKV, YM, u, lam, 1.0f - lam_init, subg);
            for (int u = vcu; u < 2048; u += G) att::swa_unit(lds, wave, cur_lane(), QKV, YM, u, sink);
        }
        GSYNC();
        { const int k = 3 * l + 1;
          pg8::Gemm g{YM, (const bf16*)(wl + WO_OFF), M, D, D}; pg8::StaticOrder S; S.init(M, D, G, bx);
          pg8::EpiRes E{x_in, XB, ST + (size_t)((k - 1) & 1) * M * 2, lng + (size_t)(k - 1) * D, lnb + (size_t)(k - 1) * D, ST + (size_t)(k & 1) * M * 2, ALPHA, 1.0f};
          pg8::gemm_phase<pg8::EpiRes, pg8::StaticOrder, true, true>(lds, g, S, E, wave); }
        GSYNC();
        { const int k = 3 * l + 2; ZERO_ST(k & 1);
          const float* cb = CSBW + (size_t)((l * 3 + 2) * 2) * CSBW_N;
          pg8::Gemm g{XB, (const bf16*)(wl + W3_OFF), M, 2 * FF, D}; pg8::StaticOrder S; S.init(M, 2 * FF, G, bx);
          pg8::EpiSwiGLU E{HB, FF, pg8::RowLN{ST + (size_t)((k - 1) & 1) * M * 2, cb, cb + CSBW_N}};
          pg8::gemm_phase<pg8::EpiSwiGLU, pg8::StaticOrder, true, true>(lds, g, S, E, wave); }
        GSYNC();
        { const int k = 3 * l + 2;
          pg8::Gemm g{HB, (const bf16*)(wl + W4_OFF), M, D, FF}; pg8::StaticOrder S; S.init(M, D, G, bx);
          pg8::EpiRes E{x_in, XB, ST + (size_t)((k - 1) & 1) * M * 2, lng + (size_t)(k - 1) * D, lnb + (size_t)(k - 1) * D, ST + (size_t)(k & 1) * M * 2, ALPHA, 0.5f};
          pg8::gemm_phase<pg8::EpiRes, pg8::StaticOrder, true, true>(lds, g, S, E, wave); }
        GSYNC();
    }
    for (int m = gw; m < M; m += NGW) ln_row_h(XB + (size_t)m * D, args.in[11] + (size_t)11 * D, args.in[12] + (size_t)11 * D, out + (size_t)m * D, cur_lane());
}

extern "C" void kernel_launch(void* const* d_in, const int* in_sizes, int n_in, void* d_out, int out_size, void* d_ws, size_t ws_size, hipStream_t stream) {
    static int grid = 0;
    if (grid == 0) {
        if (n_in != 13 || in_sizes[0] != M * D || out_size != M * D || ws_size < WS_END) { fprintf(stderr, "kernel_launch: unexpected shapes (n_in %d, in0 %d, out %d, ws %zu); nothing launched\n", n_in, n_in > 0 ? in_sizes[0] : -1, out_size, ws_size); grid = -1; return; }
        int dev = 0, cus = 0, per_cu = 0;
        if (hipGetDevice(&dev) != hipSuccess || hipDeviceGetAttribute(&cus, hipDeviceAttributeMultiprocessorCount, dev) != hipSuccess) { grid = -1; return; }
        if (hipFuncSetAttribute((const void*)fwd_megakernel, hipFuncAttributeMaxDynamicSharedMemorySize, LDS_BYTES) != hipSuccess) { fprintf(stderr, "kernel_launch: hipFuncSetAttribute failed\n"); grid = -1; return; }
        if (hipOccupancyMaxActiveBlocksPerMultiprocessor(&per_cu, (const void*)fwd_megakernel, NWAVES * 64, LDS_BYTES) != hipSuccess || per_cu < 1) { fprintf(stderr, "kernel_launch: occupancy query gives %d\n", per_cu); per_cu = 1; }
        (void)hipGetLastError();
        grid = (cus < 1024) ? cus : 1024;
    }
    if (grid < 0) return;
    if (hipMemsetAsync((char*)d_ws + WS_CTL, 0, CTL_ZERO_BYTES, stream) != hipSuccess) { fprintf(stderr, "kernel_launch: memset of the barrier words failed\n"); return; }
    Args a{};
    for (int i = 0; i < 13; ++i) a.in[i] = (const float*)d_in[i];
    a.out = (float*)d_out; a.ws = (unsigned char*)d_ws;
    for (int i = 0; i < 32; ++i) a.inv[i] = (float)pow(10000.0, -(double)(2 * i) / 64.0);
    for (int l = 0; l < 4; ++l) a.lam_init[l] = (float)(0.8 - 0.6 * exp(-0.3 * (double)l));
    void* kargs[] = {&a};
    const hipError_t e = hipLaunchCooperativeKernel((const void*)fwd_megakernel, dim3(grid), dim3(NWAVES * 64), kargs, LDS_BYTES, stream);
    if (e != hipSuccess) fprintf(stderr, "kernel_launch: cooperative launch failed: %s (grid %d)\n", hipGetErrorString(e), grid);
}
```

```cpp
#include <hip/hip_runtime.h>
#include <hip/hip_cooperative_groups.h>
#include <cstdio>
#include <cstdint>
#include <cmath>
namespace cg = cooperative_groups;
namespace pg8 {
#define PG8_LAS __attribute__((address_space(3)))
typedef unsigned short bf16_t;
typedef short bf16x8 __attribute__((ext_vector_type(8)));
typedef float f32x4 __attribute__((ext_vector_type(4)));
typedef unsigned u32x4 __attribute__((ext_vector_type(4)));
constexpr int BM = 256, BK = 64, HALF = 128, HTB = HALF * BK * 2  , STAGE_BYTES = 8 * HTB, NXCD = 8, WGM = 8;

__host__ __device__ __forceinline__ int lds_byte(int r, int c) { const int st = (r >> 4) * 2 + (c >> 5), rr = r & 15, cc = c & 31, ob = rr * 64 + cc * 2; return st * 1024 + (ob ^ (((ob >> 9) & 1) << 5)); }
__host__ __device__ __forceinline__ void stage_rc(int b, int& R, int& C) { const int st = b / 1024, sb = b % 1024, swz = sb ^ (((sb >> 9) & 1) << 5); R = (st >> 1) * 16 + swz / 64; C = (st & 1) * 32 + (swz % 64) / 2; }
__host__ __device__ __forceinline__ int perm32(int rho) { const int n = rho >> 4, i = rho & 15; return 8 * (i >> 2) + 4 * n + (i & 3); }

struct Unit { int pm, pn; };
struct Gemm { const bf16_t* A; const bf16_t* Bt; int M, N, K; };

struct StaticOrder {
    int nM, nN, nwg, G, c;
    __host__ __device__ void init(int M, int N, int G_, int c_) { nM = M / BM; nN = N / BM; nwg = nM * nN; G = G_; c = c_; }
    __host__ __device__ bool next(int i, Unit& u) const {
        const long L = (long)i * G + c; if (L >= nwg) return false;
        int wgid = (int)L; { const int q = nwg / NXCD, r = nwg % NXCD, xcd = wgid % NXCD, off = wgid / NXCD; wgid = (xcd < r ? xcd * (q + 1) : r * (q + 1) + (xcd - r) * q) + off; }
        const int nig = WGM * nN, gid = wgid / nig, fm = gid * WGM, gsz = (nM - fm) < WGM ? (nM - fm) : WGM;
        u.pm = fm + ((wgid % nig) % gsz); u.pn = (wgid % nig) / gsz; return true;
    }
    __device__ __forceinline__ void a_ready(const Unit&) const {}
    __device__ __forceinline__ void done(const Unit&) const {}
};

typedef float f32x2_t __attribute__((ext_vector_type(2))); typedef __bf16 bf16x2_t __attribute__((ext_vector_type(2)));
__device__ __forceinline__ unsigned cvtpk(float lo, float hi) { f32x2_t v = {lo, hi}; bf16x2_t b = __builtin_convertvector(v, bf16x2_t); return __builtin_bit_cast(unsigned, b); }
typedef _Float16 f16x8 __attribute__((ext_vector_type(8))); typedef _Float16 f16x2_t __attribute__((ext_vector_type(2)));
template <bool F16> __device__ __forceinline__ f32x4 mma16(bf16x8 a, bf16x8 b, f32x4 c) {
    if constexpr (F16) return __builtin_amdgcn_mfma_f32_16x16x32_f16(__builtin_bit_cast(f16x8, a), __builtin_bit_cast(f16x8, b), c, 0, 0, 0);
    else return __builtin_amdgcn_mfma_f32_16x16x32_bf16(a, b, c, 0, 0, 0);
}
__device__ __forceinline__ unsigned cvtpk_h(float lo, float hi) { f16x2_t v = {(_Float16)lo, (_Float16)hi}; return __builtin_bit_cast(unsigned, v); }
__device__ __forceinline__ float silu_f(float g) { return g * __builtin_amdgcn_rcpf(1.0f + __builtin_amdgcn_exp2f(-1.4426950408889634f * g)); }

typedef float f32x2v __attribute__((ext_vector_type(2)));
struct RowLN {
    const float* st; const float* cs; const float* bw;
    __device__ __forceinline__ void row(int r, float& a, float& c) const {
        if (st) { const f32x2v s = *(const f32x2v*)(st + 2 * (size_t)r); const float mu = s.x * (1.0f / 1024.0f), var = s.y * (1.0f / 1024.0f) - mu * mu; a = rsqrtf(var + 1e-5f); c = -a * mu; }
        else { a = 1.0f; c = 0.0f; }
    }
};
struct EpiSwiGLU {
    static constexpr bool PERM = true, AFTER_DRAIN = false, F16 = true;
    bf16_t* H; int ldh; RowLN ln;
    __device__ __forceinline__ void operator()(const f32x4 (&acc)[2][2][4][2], const Unit& u, int wr, int wc, int fr, int fq) const {
        const int row0 = u.pm * BM + wr * 64 + fr, col0 = u.pn * HALF + wc * 32 + 8 * fq, wrow0 = u.pn * BM + wc * 32 + 8 * fq;
        f32x4 cs[2][2], bw[2][2]; float ra[8], rc[8];
#pragma unroll
        for (int bj = 0; bj < 2; ++bj)
#pragma unroll
            for (int n = 0; n < 2; ++n) { const f32x4 z = (f32x4){0.f, 0.f, 0.f, 0.f}; cs[bj][n] = ln.st ? *(const f32x4*)(ln.cs + wrow0 + bj * HALF + 4 * n) : z; bw[bj][n] = ln.st ? *(const f32x4*)(ln.bw + wrow0 + bj * HALF + 4 * n) : z; }
#pragma unroll
        for (int i = 0; i < 8; ++i) ln.row(row0 + (i >> 2) * HALF + (i & 3) * 16, ra[i], rc[i]);
        asm volatile("" ::: "memory");
#pragma unroll
        for (int ai = 0; ai < 2; ++ai)
#pragma unroll
            for (int m = 0; m < 4; ++m) {
                const int row = row0 + ai * HALF + m * 16; const float a = ra[ai * 4 + m], c = rc[ai * 4 + m];
                const f32x4 g0 = acc[ai][0][m][0] * a + cs[0][0] * c + bw[0][0], g1 = acc[ai][0][m][1] * a + cs[0][1] * c + bw[0][1];
                const f32x4 u0 = acc[ai][1][m][0] * a + cs[1][0] * c + bw[1][0], u1 = acc[ai][1][m][1] * a + cs[1][1] * c + bw[1][1];
                u32x4 w;
                w.x = cvtpk(silu_f(g0[0]) * u0[0], silu_f(g0[1]) * u0[1]); w.y = cvtpk(silu_f(g0[2]) * u0[2], silu_f(g0[3]) * u0[3]);
                w.z = cvtpk(silu_f(g1[0]) * u1[0], silu_f(g1[1]) * u1[1]); w.w = cvtpk(silu_f(g1[2]) * u1[2], silu_f(g1[3]) * u1[3]);
                __builtin_nontemporal_store(w, (u32x4*)(H + (size_t)row * ldh + col0));
            }
    }
};
struct EpiRes {
    static constexpr bool PERM = true, AFTER_DRAIN = false, F16 = false;
    const float* x0; bf16_t* yh; const float* st; const float* g; const float* b; float* st_new; float alpha, s;
    __device__ __forceinline__ void operator()(const f32x4 (&acc)[2][2][4][2], const Unit& u, int wr, int wc, int fr, int fq) const {
        const int row0 = u.pm * BM + wr * 64 + fr, col0 = u.pn * BM + wc * 64 + 8 * fq;
        f32x4 gv[2][2], bv[2][2];
#pragma unroll
        for (int bj = 0; bj < 2; ++bj)
#pragma unroll
            for (int n = 0; n < 2; ++n) { gv[bj][n] = st ? *(const f32x4*)(g + col0 + bj * 32 + 4 * n) : (f32x4){1.f, 1.f, 1.f, 1.f}; bv[bj][n] = st ? *(const f32x4*)(b + col0 + bj * 32 + 4 * n) : (f32x4){0.f, 0.f, 0.f, 0.f}; }
#pragma unroll
        for (int ai = 0; ai < 2; ++ai) {
            f16x8 hv[4][2]; float ra[4], rmu[4];
#pragma unroll
            for (int m = 0; m < 4; ++m) {
                const int row = row0 + ai * HALF + m * 16; const size_t off = (size_t)row * 1024 + col0;
                ra[m] = 1.0f; rmu[m] = 0.0f;
                if (st) {
                    const f32x2v sv = *(const f32x2v*)(st + 2 * (size_t)row); rmu[m] = sv.x * (1.0f / 1024.0f); ra[m] = rsqrtf(sv.y * (1.0f / 1024.0f) - rmu[m] * rmu[m] + 1e-5f);
                    hv[m][0] = *(const f16x8*)(yh + off); hv[m][1] = *(const f16x8*)(yh + off + 32);
                }
            }
            asm volatile("" ::: "memory");
#pragma unroll
            for (int m = 0; m < 4; ++m) {
                const int row = row0 + ai * HALF + m * 16; const size_t off = (size_t)row * 1024 + col0;
                float s1 = 0.f, s2 = 0.f;
#pragma unroll
                for (int bj = 0; bj < 2; ++bj) {
                    f32x4 yp[2];
                    if (st) { const f16x8 h = hv[m][bj]; yp[0] = (f32x4){(float)h[0], (float)h[1], (float)h[2], (float)h[3]}; yp[1] = (f32x4){(float)h[4], (float)h[5], (float)h[6], (float)h[7]}; }
                    else { yp[0] = *(const f32x4*)(x0 + off + bj * 32); yp[1] = *(const f32x4*)(x0 + off + bj * 32 + 4); }
                    f32x4 y[2];
#pragma unroll
                    for (int n = 0; n < 2; ++n) { const f32x4 x = (yp[n] - rmu[m]) * ra[m] * gv[bj][n] + bv[bj][n];
                        y[n] = x * alpha + acc[ai][bj][m][n] * s;
                        s1 += (y[n][0] + y[n][1]) + (y[n][2] + y[n][3]); s2 += (y[n][0] * y[n][0] + y[n][1] * y[n][1]) + (y[n][2] * y[n][2] + y[n][3] * y[n][3]); }
                    u32x4 w; w.x = cvtpk_h(y[0][0], y[0][1]); w.y = cvtpk_h(y[0][2], y[0][3]); w.z = cvtpk_h(y[1][0], y[1][1]); w.w = cvtpk_h(y[1][2], y[1][3]);
                    *(u32x4*)(yh + off + bj * 32) = w;
                }
                s1 += __shfl_xor(s1, 16); s1 += __shfl_xor(s1, 32); s2 += __shfl_xor(s2, 16); s2 += __shfl_xor(s2, 32);
                if (fq == 0) { atomicAdd(st_new + 2 * (size_t)row, s1); atomicAdd(st_new + 2 * (size_t)row + 1, s2); }
            }
            asm volatile("" ::: "memory");
        }
    }
};
struct EpiQKV {
    static constexpr bool PERM = true, AFTER_DRAIN = false, F16 = true;
    bf16_t* O; const unsigned* rope; float qscale; RowLN ln;
    __device__ __forceinline__ void operator()(const f32x4 (&acc)[2][2][4][2], const Unit& u, int wr, int wc, int fr, int fq) const {
        const int pn = u.pn, row0 = u.pm * BM + wr * 64 + fr, col0 = pn * BM + wc * 32 + 8 * fq, i0 = 16 * (wc & 1) + 4 * fq;
        const bool anyrope = (pn != 4 && pn != 5);
        const float sc = (pn < 2 || pn == 6 || pn == 7) ? qscale : 1.0f;
        f32x4 cs[2][2], bw[2][2];
#pragma unroll
        for (int bj = 0; bj < 2; ++bj)
#pragma unroll
            for (int n = 0; n < 2; ++n) { cs[bj][n] = *(const f32x4*)(ln.cs + col0 + bj * HALF + 4 * n); bw[bj][n] = *(const f32x4*)(ln.bw + col0 + bj * HALF + 4 * n); }
#pragma unroll
        for (int ai = 0; ai < 2; ++ai) {
            f16x8 rp4[4]; float ra[4], rc[4];
#pragma unroll
            for (int m = 0; m < 4; ++m) ln.row(row0 + ai * HALF + m * 16, ra[m], rc[m]);
#pragma unroll
            for (int m = 0; m < 4; ++m) { const int row = row0 + ai * HALF + m * 16;
                if (anyrope) rp4[m] = *(const f16x8*)(rope + (size_t)row * 32 + i0); else rp4[m] = (f16x8){1, 0, 1, 0, 1, 0, 1, 0}; }
            asm volatile("" ::: "memory");
#pragma unroll
            for (int m = 0; m < 4; ++m) {
                const int row = row0 + ai * HALF + m * 16; const float a = ra[m], c = rc[m];
                const f16x8 h = rp4[m];
                const float c0 = (float)h[0], s0 = (float)h[1], c1 = (float)h[2], s1 = (float)h[3], c2 = (float)h[4], s2 = (float)h[5], c3 = (float)h[6], s3 = (float)h[7];
#pragma unroll
                for (int bj = 0; bj < 2; ++bj) {
                    const bool rp = anyrope && !(pn == 8 && bj == 1);
                    f32x4 v0 = acc[ai][bj][m][0] * a + cs[bj][0] * c + bw[bj][0], v1 = acc[ai][bj][m][1] * a + cs[bj][1] * c + bw[bj][1];
                    if (rp) {
                        const f32x4 a0 = v0, a1 = v1;
                        v0[0] = a0[0] * c0 - a0[1] * s0; v0[1] = a0[1] * c0 + a0[0] * s0;
                        v0[2] = a0[2] * c1 - a0[3] * s1; v0[3] = a0[3] * c1 + a0[2] * s1;
                        v1[0] = a1[0] * c2 - a1[1] * s2; v1[1] = a1[1] * c2 + a1[0] * s2;
                        v1[2] = a1[2] * c3 - a1[3] * s3; v1[3] = a1[3] * c3 + a1[2] * s3;
                    }
                    v0 = v0 * sc; v1 = v1 * sc;
                    u32x4 w; w.x = cvtpk(v0[0], v0[1]); w.y = cvtpk(v0[2], v0[3]); w.z = cvtpk(v1[0], v1[1]); w.w = cvtpk(v1[2], v1[3]);
                    *(u32x4*)(O + (size_t)row * 2304 + col0 + bj * HALF) = w;
                }
            }
            asm volatile("" ::: "memory");
        }
    }
};

template <class Epi, class Sched, bool ALIGN_EPI = false, bool SP2 = false>
__device__ __forceinline__ void gemm_phase(PG8_LAS unsigned char* lds, const Gemm g, const Sched& S, const Epi& E, const int wave_in) {
    int tid_; asm volatile("v_mbcnt_lo_u32_b32 %0, -1, 0\n\tv_mbcnt_hi_u32_b32 %0, -1, %0" : "=v"(tid_)); tid_ += 64 * wave_in;
    const int tid = tid_, wid = __builtin_amdgcn_readfirstlane(tid >> 6), lane = tid & 63, wr = wid >> 2, wc = wid & 3, fr = lane & 15, fq = lane >> 4;
    const int K = g.K, nt = K / BK;
    unsigned voffA[2], voffB[2];
#pragma unroll
    for (int i = 0; i < 2; ++i) { int R, C; stage_rc(tid * 16 + i * 8192, R, C); const int Rb = Epi::PERM ? ((R & ~31) + perm32(R & 31)) : R;
        voffA[i] = (unsigned)(R * K + C) * 2u; voffB[i] = (unsigned)(Rb * K + C) * 2u; }
    const size_t kstep = (size_t)(BK * 2);
    const size_t hstep = (size_t)HALF * K * 2;
    const size_t tstep = 2 * hstep;
    const unsigned ldsw = (unsigned)wid * 1024u;
    const int aoff = lds_byte(wr * 64 + fr, fq * 8), boff = lds_byte(wc * 32 + fr, fq * 8);
#define PG8_SA(b, h) (((b) * 2 + (h)) * HTB)
#define PG8_SB(b, h) ((4 + (b) * 2 + (h)) * HTB)
#define PG8_STAGE(bufoff, gbase, voff) do { _Pragma("unroll") for (int _i = 0; _i < 2; ++_i) \
        __builtin_amdgcn_global_load_lds((const unsigned*)((const char*)(gbase) + (voff)[_i]), (PG8_LAS unsigned*)(lds + (bufoff) + ldsw + _i * 8192), 16, 0, 0); } while (0)
#define PG8_LDA(dst, b, h) do { _Pragma("unroll") for (int m = 0; m < 4; ++m) _Pragma("unroll") for (int k = 0; k < 2; ++k) dst[m][k] = *(const PG8_LAS bf16x8*)(lds + PG8_SA(b, h) + aoff + m * 2048 + k * 1024); } while (0)
#define PG8_LDB(dst, b, h) do { _Pragma("unroll") for (int n = 0; n < 2; ++n) _Pragma("unroll") for (int k = 0; k < 2; ++k) dst[n][k] = *(const PG8_LAS bf16x8*)(lds + PG8_SB(b, h) + boff + n * 2048 + k * 1024); } while (0)
#define PG8_MMA(ai, bj, At, Bt) do { __builtin_amdgcn_s_setprio(1); _Pragma("unroll") for (int m = 0; m < 4; ++m) _Pragma("unroll") for (int n = 0; n < 2; ++n) _Pragma("unroll") for (int k = 0; k < 2; ++k) \
        acc[ai][bj][m][n] = mma16<Epi::F16>(Bt[n][k], At[m][k], acc[ai][bj][m][n]); __builtin_amdgcn_s_setprio(0); } while (0)
#define PG8_WAIT_V(n) asm volatile("s_waitcnt vmcnt(" #n ")" ::: "memory")
#define PG8_WAIT_L(n) asm volatile("s_waitcnt lgkmcnt(" #n ")" ::: "memory")
#define PG8_BAR __builtin_amdgcn_s_barrier()
#define PG8_SCHED __builtin_amdgcn_sched_barrier(0)
    Unit cur, nxt; int ui = 0;
    if (!S.next(0, cur)) return;
    f32x4 acc[2][2][4][2];
#pragma unroll
    for (int a = 0; a < 2; ++a)
#pragma unroll
        for (int b = 0; b < 2; ++b)
#pragma unroll
            for (int m = 0; m < 4; ++m)
#pragma unroll
                for (int n = 0; n < 2; ++n) acc[a][b][m][n] = (f32x4){0.f, 0.f, 0.f, 0.f};
    bf16x8 At[4][2], B0[2][2], B1[2][2];
    const char* cA = (const char*)g.A + (size_t)cur.pm * tstep; const char* cB = (const char*)g.Bt + (size_t)cur.pn * tstep;
    S.a_ready(cur);
    if constexpr (SP2) {
        PG8_STAGE(PG8_SB(0, 0), cB, voffB); PG8_STAGE(PG8_SB(0, 1), cB + hstep, voffB); PG8_STAGE(PG8_SA(0, 0), cA, voffA); PG8_STAGE(PG8_SA(0, 1), cA + hstep, voffA);
        if (wr == 1) PG8_BAR;
        PG8_WAIT_V(2); PG8_BAR;
        PG8_STAGE(PG8_SB(1, 0), cB + kstep, voffB); PG8_STAGE(PG8_SA(1, 0), cA + kstep, voffA); PG8_STAGE(PG8_SB(1, 1), cB + hstep + kstep, voffB);
        PG8_WAIT_V(6); PG8_BAR;
    } else {
        PG8_STAGE(PG8_SB(0, 0), cB, voffB); PG8_STAGE(PG8_SA(0, 0), cA, voffA); PG8_STAGE(PG8_SB(0, 1), cB + hstep, voffB); PG8_STAGE(PG8_SA(0, 1), cA + hstep, voffA);
        if (wr == 1) PG8_BAR;
        PG8_WAIT_V(4); PG8_BAR;
        PG8_STAGE(PG8_SB(1, 0), cB + kstep, voffB); PG8_STAGE(PG8_SA(1, 0), cA + kstep, voffA); PG8_STAGE(PG8_SB(1, 1), cB + hstep + kstep, voffB);
        PG8_WAIT_V(6); PG8_BAR;
    }
    for (;;) {
        const bool has_next = S.next(ui + 1, nxt);
        const char* nA = has_next ? (const char*)g.A + (size_t)nxt.pm * tstep : cA; const char* nB = has_next ? (const char*)g.Bt + (size_t)nxt.pn * tstep : cB;
        for (int t = 0; t < nt; t += 2) {
            const bool last = (t == nt - 2);
            const char* a1 = cA + (size_t)(t + 1) * kstep;
            const char* a2 = last ? nA : cA + (size_t)(t + 2) * kstep; const char* b2 = last ? nB : cB + (size_t)(t + 2) * kstep;
            const char* a3 = a2 + kstep; const char* b3 = b2 + kstep;
            if (last && has_next) S.a_ready(nxt);
            if constexpr (SP2) {
            PG8_LDB(B0, 0, 0); PG8_LDB(B1, 0, 1); PG8_SCHED; PG8_LDA(At, 0, 0); PG8_STAGE(PG8_SA(1, 1), a1 + hstep, voffA);
            PG8_WAIT_V(8); PG8_WAIT_L(0); PG8_BAR; PG8_MMA(0, 0, At, B0); PG8_MMA(0, 1, At, B1); PG8_BAR; PG8_SCHED;
            PG8_LDA(At, 0, 1); PG8_STAGE(PG8_SB(0, 0), b2, voffB); PG8_STAGE(PG8_SB(0, 1), b2 + hstep, voffB); PG8_STAGE(PG8_SA(0, 0), a2, voffA);
            PG8_WAIT_V(8); PG8_WAIT_L(0); PG8_BAR; PG8_MMA(1, 0, At, B0); PG8_MMA(1, 1, At, B1); PG8_BAR; PG8_SCHED;
            PG8_LDB(B0, 1, 0); PG8_LDB(B1, 1, 1); PG8_SCHED; PG8_LDA(At, 1, 0); PG8_STAGE(PG8_SA(0, 1), a2 + hstep, voffA);
            PG8_WAIT_V(8); PG8_WAIT_L(0); PG8_BAR; PG8_MMA(0, 0, At, B0); PG8_MMA(0, 1, At, B1); PG8_BAR; PG8_SCHED;
            PG8_LDA(At, 1, 1); PG8_STAGE(PG8_SB(1, 0), b3, voffB); PG8_STAGE(PG8_SB(1, 1), b3 + hstep, voffB); PG8_STAGE(PG8_SA(1, 0), a3, voffA);
            PG8_WAIT_V(8); PG8_WAIT_L(0); PG8_BAR; PG8_MMA(1, 0, At, B0); PG8_MMA(1, 1, At, B1); PG8_BAR; PG8_SCHED;
            } else {
            PG8_LDB(B0, 0, 0); PG8_SCHED; PG8_LDA(At, 0, 0); PG8_STAGE(PG8_SA(1, 1), a1 + hstep, voffA);
            PG8_WAIT_L(8); PG8_BAR; PG8_WAIT_L(0); PG8_MMA(0, 0, At, B0); PG8_BAR; PG8_SCHED;
            PG8_LDB(B1, 0, 1); PG8_STAGE(PG8_SB(0, 0), b2, voffB);
            PG8_BAR; PG8_WAIT_L(0); PG8_MMA(0, 1, At, B1); PG8_BAR;
            PG8_LDA(At, 0, 1); PG8_STAGE(PG8_SA(0, 0), a2, voffA);
            PG8_BAR; PG8_WAIT_L(0); PG8_MMA(1, 0, At, B0); PG8_BAR; PG8_SCHED;
            PG8_STAGE(PG8_SB(0, 1), b2 + hstep, voffB);
            PG8_WAIT_V(6); PG8_BAR; PG8_MMA(1, 1, At, B1); PG8_BAR;
            PG8_LDB(B0, 1, 0); PG8_SCHED; PG8_LDA(At, 1, 0); PG8_STAGE(PG8_SA(0, 1), a2 + hstep, voffA);
            PG8_WAIT_L(8); PG8_BAR; PG8_WAIT_L(0); PG8_MMA(0, 0, At, B0); PG8_BAR; PG8_SCHED;
            PG8_LDB(B1, 1, 1); PG8_STAGE(PG8_SB(1, 0), b3, voffB);
            PG8_BAR; PG8_WAIT_L(0); PG8_MMA(0, 1, At, B1); PG8_BAR;
            PG8_LDA(At, 1, 1); PG8_STAGE(PG8_SA(1, 0), a3, voffA);
            PG8_BAR; PG8_WAIT_L(0); PG8_MMA(1, 0, At, B0); PG8_BAR; PG8_SCHED;
            PG8_STAGE(PG8_SB(1, 1), b3 + hstep, voffB);
            PG8_WAIT_V(6); PG8_BAR; PG8_MMA(1, 1, At, B1); PG8_BAR;
            }
        }
        if constexpr (ALIGN_EPI) { if (wr == 0) PG8_BAR; }
        if constexpr (!Epi::AFTER_DRAIN) { E(acc, cur, wr, wc, fr, fq); S.done(cur); }
        if (!has_next) break;
#pragma unroll
        for (int a = 0; a < 2; ++a)
#pragma unroll
            for (int b = 0; b < 2; ++b)
#pragma unroll
                for (int m = 0; m < 4; ++m)
#pragma unroll
                    for (int n = 0; n < 2; ++n) acc[a][b][m][n] = (f32x4){0.f, 0.f, 0.f, 0.f};
        cur = nxt; cA = nA; cB = nB; ++ui;
        if constexpr (ALIGN_EPI) { if (wr == 1) PG8_BAR; }
    }
    PG8_WAIT_V(0);
    if constexpr (!ALIGN_EPI) { if (wr == 0) PG8_BAR; }
    PG8_BAR;
    if constexpr (Epi::AFTER_DRAIN) { E.fused(acc, cur, wr, wc, fr, fq, lds, wid, lane); S.done(cur); }
#undef PG8_SA
#undef PG8_SB
#undef PG8_STAGE
#undef PG8_LDA
#undef PG8_LDB
#undef PG8_MMA
#undef PG8_WAIT_V
#undef PG8_WAIT_L
#undef PG8_BAR
#undef PG8_SCHED
}
}

namespace att {
using pg8::bf16_t; using pg8::bf16x8; using pg8::f32x4; using pg8::u32x4; using pg8::cvtpk;
#define ALDS __attribute__((address_space(3)))
typedef float f32x16 __attribute__((ext_vector_type(16)));
typedef short s16x4 __attribute__((ext_vector_type(4)));
typedef unsigned u32x2 __attribute__((ext_vector_type(2)));
constexpr int PITCH = 2304;
constexpr float THR = 8.0f;
__device__ __forceinline__ void glds16(const void* gsrc, unsigned lds_dst) { unsigned keep;
    asm volatile("s_mov_b32 %0, m0\n\ts_mov_b32 m0, %2\n\ts_nop 0\n\tglobal_load_lds_dwordx4 %1, off\n\ts_mov_b32 m0, %0" : "=&s"(keep) : "v"(gsrc), "s"(lds_dst) : "memory"); }
__device__ __forceinline__ void glds16s(unsigned voff, const void* sbase_, unsigned lds_dst) { unsigned keep;
    const unsigned long long sbase = ((unsigned long long)(unsigned)__builtin_amdgcn_readfirstlane((int)((unsigned long long)(uintptr_t)sbase_ >> 32)) << 32) | (unsigned)__builtin_amdgcn_readfirstlane((int)(unsigned)(uintptr_t)sbase_);
    asm volatile("s_mov_b32 %0, m0\n\ts_mov_b32 m0, %3\n\ts_nop 0\n\tglobal_load_lds_dwordx4 %1, %2\n\ts_mov_b32 m0, %0" : "=&s"(keep) : "v"(voff), "s"(sbase), "s"(lds_dst) : "memory"); }
__device__ __forceinline__ unsigned rfl(unsigned v) { return (unsigned)__builtin_amdgcn_readfirstlane((int)v); }
__device__ __forceinline__ int pi23(int x) { return (x & ~12) | ((x & 4) << 1) | ((x & 8) >> 1); }
__device__ __forceinline__ s16x4 vtr(const ALDS unsigned char* p) { return __builtin_bit_cast(s16x4, __builtin_amdgcn_ds_read_tr16_b64_v4i16((ALDS s16x4*)p)); }
__device__ __forceinline__ float halfswap_max(float v) { auto rr = __builtin_amdgcn_permlane32_swap(__float_as_uint(v), __float_as_uint(v), false, false); return fmaxf(__uint_as_float(rr[0]), __uint_as_float(rr[1])); }
__device__ __forceinline__ float halfswap_sum(float v) { auto rr = __builtin_amdgcn_permlane32_swap(__float_as_uint(v), __float_as_uint(v), false, false); return __uint_as_float(rr[0]) + __uint_as_float(rr[1]); }

template <int DV, bool BAND>
__device__ __forceinline__ float attn_core(ALDS unsigned char* ring, const int wid, const int lane,
                                           const bf16_t* Qw, const bf16_t* gbase, const unsigned koffb, const unsigned voffb, const int koff,
                                           const int t0, const int t1, const int tq, const int qpos, const float m_init, float l, f32x16 (&o)[DV / 32]) {
    constexpr int NDB = DV / 32, SLOT = (DV == 128) ? 32768 : 16384, VOFF = (DV == 128) ? 16384 : 8192, ROWB = DV * 2, NP = (DV == 128) ? 4 : 2;
    const int r32 = lane & 31, hi = lane >> 5;
    const unsigned ring_a = (unsigned)(uintptr_t)ring;
    bf16x8 qr[4];
#pragma unroll
    for (int d0 = 0; d0 < 4; ++d0) qr[d0] = *(const bf16x8*)(Qw + (size_t)r32 * PITCH + d0 * 16 + hi * 8);
#define ATT_PIECE(i_, t_, so_) do { const char* sb_ = (const char*)gbase + (size_t)(t_) * (64 * PITCH * 2); const unsigned d_ = ring_a + (unsigned)(so_) + (unsigned)wid * 1024u; \
        if (DV == 128) { if ((i_) == 0) glds16s(koffb, sb_, d_); else if ((i_) == 1) glds16s(koffb, sb_ + 128, d_ + 8192u); \
                         else if ((i_) == 2) glds16s(voffb, sb_, ring_a + (unsigned)(so_) + (unsigned)VOFF + (unsigned)wid * 2048u); \
                         else glds16s(voffb, sb_ + 4 * PITCH * 2, ring_a + (unsigned)(so_) + (unsigned)VOFF + (unsigned)wid * 2048u + 1024u); } \
        else { if ((i_) == 0) glds16s(koffb, sb_, d_); else if ((i_) == 2) glds16s(voffb, sb_, d_ + (unsigned)VOFF); } } while (0)
#define ATT_ISSUE(t_, so_) do { ATT_PIECE(0, t_, so_); ATT_PIECE(1, t_, so_); ATT_PIECE(2, t_, so_); ATT_PIECE(3, t_, so_); } while (0)
    ATT_ISSUE(t0, 0);
    { const int tn = (t0 + 1 < t1) ? t0 + 1 : t1 - 1; ATT_ISSUE(tn, SLOT); }
    const int g = (lane >> 4) & 1, q4 = (lane & 15) >> 2, p = lane & 3, sw = (DV == 128) ? q4 : (q4 >> 1);
    int va[NDB];
#pragma unroll
    for (int db = 0; db < NDB; ++db) va[db] = VOFF + (8 * hi + q4) * ROWB + ((db ^ sw) << 6) + (2 * g + (p >> 1)) * 16 + 8 * (p & 1);
    const int ka = koff + hi * 1024 + r32 * 16;
    float m = m_init;
    f32x16 negm;
#pragma unroll
    for (int r = 0; r < 16; ++r) negm[r] = -m;
#pragma unroll
    for (int db = 0; db < NDB; ++db)
#pragma unroll
        for (int r = 0; r < 16; ++r) o[db][r] = 0.f;
    if (wid >= 4) __builtin_amdgcn_s_setprio(1);
    int s_cur = 0, s_n2 = 2 * SLOT;
    for (int t = t0; t < t1; ++t) {
        asm volatile("s_waitcnt vmcnt(%0)" :: "n"(NP) : "memory");
        asm volatile("s_waitcnt lgkmcnt(0)\n\ts_barrier" ::: "memory");
        const int tn = (t + 2 < t1) ? t + 2 : t1 - 1;
        const ALDS unsigned char* sb = ring + s_cur;
        f32x16 p0 = negm, p1 = negm;
        bf16x8 kf[8];
#pragma unroll
        for (int d0 = 0; d0 < 4; ++d0) { kf[2 * d0] = *(const ALDS bf16x8*)(sb + ka + d0 * 2048); kf[2 * d0 + 1] = *(const ALDS bf16x8*)(sb + ka + d0 * 2048 + 512); }
        s16x4 vlo[2][NDB], vhh[2][NDB];
#pragma unroll
        for (int db = 0; db < NDB; ++db) { vlo[0][db] = vtr(sb + va[db]); vhh[0][db] = vtr(sb + va[db] + 4 * ROWB); }
#pragma unroll
        for (int d0 = 0; d0 < 4; ++d0) {
            p0 = __builtin_amdgcn_mfma_f32_32x32x16_bf16(kf[2 * d0], qr[d0], p0, 0, 0, 0);
            p1 = __builtin_amdgcn_mfma_f32_32x32x16_bf16(kf[2 * d0 + 1], qr[d0], p1, 0, 0, 0);
            __builtin_amdgcn_sched_barrier(0);
            ATT_PIECE(d0, tn, s_n2);
            __builtin_amdgcn_sched_barrier(0);
        }
        if (BAND) {
            if (t == tq - 2 || t == tq + 2) {
                const int rel0 = t * 64 + 8 * hi - qpos;
#pragma unroll
                for (int r = 0; r < 16; ++r) { const int rel = rel0 + 16 * (r >> 3) + (r & 7);
                    if (rel < -128 || rel > 128) p0[r] = -INFINITY;
                    if (rel + 32 < -128 || rel + 32 > 128) p1[r] = -INFINITY; }
            }
        }
        float mx = fmaxf(p0[0], p1[0]);
#pragma unroll
        for (int r = 1; r < 16; ++r) mx = fmaxf(fmaxf(mx, p0[r]), p1[r]);
        mx = halfswap_max(mx);
        const bool first = (!BAND) && (t == t0);
        const float dl = first ? mx : ((mx > THR) ? mx : 0.f);
        if (__any(dl != 0.f)) {
            m += dl;
#pragma unroll
            for (int r = 0; r < 16; ++r) { p0[r] -= dl; p1[r] -= dl; negm[r] = -m; }
            const float f = first ? 1.f : __builtin_amdgcn_exp2f(-dl);
            l *= f;
#pragma unroll
            for (int db = 0; db < NDB; ++db)
#pragma unroll
                for (int r = 0; r < 16; ++r) o[db][r] *= f;
        }
        float ssum = 0.f;
        bf16x8 pfs[4];
#define ATT_EXP_SLICE(P_, B_, DST_) do { u32x4 w_; \
        P_[B_ + 0] = __builtin_amdgcn_exp2f(P_[B_ + 0]); P_[B_ + 1] = __builtin_amdgcn_exp2f(P_[B_ + 1]); P_[B_ + 2] = __builtin_amdgcn_exp2f(P_[B_ + 2]); P_[B_ + 3] = __builtin_amdgcn_exp2f(P_[B_ + 3]); \
        P_[B_ + 4] = __builtin_amdgcn_exp2f(P_[B_ + 4]); P_[B_ + 5] = __builtin_amdgcn_exp2f(P_[B_ + 5]); P_[B_ + 6] = __builtin_amdgcn_exp2f(P_[B_ + 6]); P_[B_ + 7] = __builtin_amdgcn_exp2f(P_[B_ + 7]); \
        ssum += ((P_[B_ + 0] + P_[B_ + 1]) + (P_[B_ + 2] + P_[B_ + 3])) + ((P_[B_ + 4] + P_[B_ + 5]) + (P_[B_ + 6] + P_[B_ + 7])); \
        w_.x = cvtpk(P_[B_ + 0], P_[B_ + 1]); w_.y = cvtpk(P_[B_ + 2], P_[B_ + 3]); w_.z = cvtpk(P_[B_ + 4], P_[B_ + 5]); w_.w = cvtpk(P_[B_ + 6], P_[B_ + 7]); DST_ = __builtin_bit_cast(bf16x8, w_); } while (0)
        ATT_EXP_SLICE(p0, 0, pfs[0]);
#pragma unroll
        for (int ks = 0; ks < 4; ++ks) {
            if (ks + 1 < 4) {
#pragma unroll
                for (int db = 0; db < NDB; ++db) { vlo[(ks + 1) & 1][db] = vtr(sb + va[db] + (ks + 1) * (16 * ROWB)); vhh[(ks + 1) & 1][db] = vtr(sb + va[db] + (ks + 1) * (16 * ROWB) + 4 * ROWB); }
            }
#pragma unroll
            for (int db = 0; db < NDB; ++db) {
                const s16x4 lo = vlo[ks & 1][db], hh = vhh[ks & 1][db];
                const bf16x8 vf = (bf16x8){lo[0], lo[1], lo[2], lo[3], hh[0], hh[1], hh[2], hh[3]};
                o[db] = __builtin_amdgcn_mfma_f32_32x32x16_bf16(vf, pfs[ks], o[db], 0, 0, 0);
            }
            if (ks == 0) ATT_EXP_SLICE(p0, 8, pfs[1]);
            if (ks == 1) ATT_EXP_SLICE(p1, 0, pfs[2]);
            if (ks == 2) ATT_EXP_SLICE(p1, 8, pfs[3]);
        }
#undef ATT_EXP_SLICE
        l += ssum;
        s_cur = (s_cur == 2 * SLOT) ? 0 : s_cur + SLOT; s_n2 = (s_n2 == 2 * SLOT) ? 0 : s_n2 + SLOT;
    }
    __builtin_amdgcn_s_setprio(0);
    asm volatile("s_waitcnt vmcnt(0) lgkmcnt(0)\n\ts_barrier" ::: "memory");
#undef ATT_ISSUE
#undef ATT_PIECE
    return l;
}

__device__ __forceinline__ void diff_unit(ALDS unsigned char* ring, const int wid, int lane, const bf16_t* qkv, bf16_t* ymix, const int u, const float lam, const float post, const float* subg) {
    asm volatile("" : "+v"(lane));
    const int bh = u >> 5, qb = u & 31, b = bh >> 2, h = bh & 3, comp = wid >> 2, wq = wid & 3, r32 = lane & 31, hi = lane >> 5;
    const size_t rowbase = (size_t)b * 4096;
    const int q0 = qb * 128 + wq * 32;
    const bf16_t* Qw = qkv + (rowbase + q0) * PITCH + h * 128 + comp * 64;
    const bf16_t* gbase = qkv + rowbase * PITCH;
    const unsigned koffb = (unsigned)((pi23(lane) * PITCH + 512 + h * 128 + wid * 8) * 2);
    const unsigned voffb = (unsigned)(((8 * wid + (lane >> 4)) * PITCH + 1024 + h * 128 + (((lane & 15) ^ ((lane >> 4) << 2)) * 8)) * 2);
    f32x16 o[4];
    float l = attn_core<128, false>(ring, wid, lane, Qw, gbase, koffb, voffb, comp * 8192, 0, 64, 0, 0, 0.f, 0.f, o);
    l = halfswap_sum(l);
    const float inv = 1.0f / l;
    ALDS f32x4* X = (ALDS f32x4*)ring + (size_t)wq * (16 * 64);
    if (comp == 1) {
#pragma unroll
        for (int db = 0; db < 4; ++db)
#pragma unroll
            for (int rq = 0; rq < 4; ++rq) X[(db * 4 + rq) * 64 + lane] = (f32x4){o[db][4 * rq] * inv, o[db][4 * rq + 1] * inv, o[db][4 * rq + 2] * inv, o[db][4 * rq + 3] * inv};
    }
    asm volatile("s_waitcnt lgkmcnt(0)\n\ts_barrier" ::: "memory");
    if (comp == 0) {
        float ss = 0.f;
#pragma unroll
        for (int db = 0; db < 4; ++db)
#pragma unroll
            for (int rq = 0; rq < 4; ++rq) { const f32x4 o2 = X[(db * 4 + rq) * 64 + lane];
#pragma unroll
                for (int e = 0; e < 4; ++e) { const float d = o[db][4 * rq + e] * inv - lam * o2[e]; o[db][4 * rq + e] = d; ss += d * d; } }
        ss = halfswap_sum(ss);
        const float rs = rsqrtf(ss * (1.0f / 128.0f) + 1e-5f) * post;
        bf16_t* orow = ymix + (rowbase + q0 + r32) * 1024 + h * 128 + 4 * hi;
#pragma unroll
        for (int db = 0; db < 4; ++db)
#pragma unroll
            for (int rq = 0; rq < 4; ++rq) { const f32x4 gv = *(const f32x4*)(subg + 32 * db + 8 * rq + 4 * hi);
                u32x2 w; w.x = cvtpk(o[db][4 * rq] * rs * gv[0], o[db][4 * rq + 1] * rs * gv[1]); w.y = cvtpk(o[db][4 * rq + 2] * rs * gv[2], o[db][4 * rq + 3] * rs * gv[3]);
                *(u32x2*)(orow + 32 * db + 8 * rq) = w; }
    }
    asm volatile("s_waitcnt lgkmcnt(0)\n\ts_barrier" ::: "memory");
}

__device__ __forceinline__ void swa_unit(ALDS unsigned char* ring, const int wid, int lane, const bf16_t* qkv, bf16_t* ymix, const int u, const float* sink) {
    asm volatile("" : "+v"(lane));
    const int bkv = u >> 6, qblk = u & 63, b = bkv >> 1, kvh = bkv & 1, head = kvh * 4 + (wid >> 1), r32 = lane & 31, hi = lane >> 5;
    const size_t rowbase = (size_t)b * 4096;
    const int q0 = qblk * 64 + (wid & 1) * 32;
    const bf16_t* Qw = qkv + (rowbase + q0) * PITCH + 1536 + head * 64;
    const bf16_t* gbase = qkv + rowbase * PITCH;
    const unsigned koffb = (unsigned)((pi23(lane) * PITCH + 2048 + kvh * 64 + wid * 8) * 2);
    const unsigned voffb = (unsigned)(((8 * wid + (lane >> 3)) * PITCH + 2176 + kvh * 64 + (((lane & 7) ^ (((lane >> 4) & 1) << 2)) * 8)) * 2);
    const int t0 = (qblk - 2 > 0) ? qblk - 2 : 0, t1 = ((qblk + 2 < 63) ? qblk + 2 : 63) + 1;
    f32x16 o[2];
    float l = attn_core<64, true>(ring, wid, lane, Qw, gbase, koffb, voffb, 0, t0, t1, qblk, q0 + r32, sink[head] * 1.4426950408889634f, (hi == 0) ? 1.0f : 0.0f, o);
    l = halfswap_sum(l);
    const float inv = 1.0f / l;
    bf16_t* orow = ymix + (rowbase + q0 + r32) * 1024 + 512 + head * 64 + 4 * hi;
#pragma unroll
    for (int db = 0; db < 2; ++db)
#pragma unroll
        for (int rq = 0; rq < 4; ++rq) { u32x2 w; w.x = cvtpk(o[db][4 * rq] * inv, o[db][4 * rq + 1] * inv); w.y = cvtpk(o[db][4 * rq + 2] * inv, o[db][4 * rq + 3] * inv);
            *(u32x2*)(orow + 32 * db + 8 * rq) = w; }
}
}

constexpr int NWAVES = 8;
constexpr int M = 65536, D = 1024, FF = 2816, NIN = 2304, SEQ = 4096, DEPTH = 4;
constexpr size_t MiB = 1u << 20;
constexpr size_t W1_OFF = 0, W1_B = (size_t)2 * FF * D * 2, W2_OFF = W1_OFF + W1_B, W2_B = (size_t)D * FF * 2, WIN_OFF = W2_OFF + W2_B, WIN_B = (size_t)NIN * D * 2,
                 WO_OFF = WIN_OFF + WIN_B, WO_B = (size_t)D * D * 2, W3_OFF = WO_OFF + WO_B, W4_OFF = W3_OFF + W1_B, WL_STRIDE = W4_OFF + W2_B;
constexpr size_t WS_W = 0, WS_ROPE = 160 * MiB, WS_XB = 176 * MiB, WS_H = 304 * MiB, WS_YM = 656 * MiB, WS_CSBW = 784 * MiB, WS_ST = 785 * MiB, WS_CTL = 786 * MiB, WS_END = 787 * MiB;
constexpr size_t CTL_ZERO_BYTES = 16384;
constexpr int CSBW_N = 2 * FF;
static_assert((size_t)DEPTH * 3 * 2 * CSBW_N * 4 <= MiB && (size_t)2 * M * 2 * 4 <= MiB, "aux map");
static_assert(WL_STRIDE * DEPTH <= WS_ROPE && WS_ROPE + (size_t)M * 64 * 4 <= WS_XB && WS_XB + (size_t)M * D * 2 <= WS_H && WS_H + (size_t)M * FF * 2 <= WS_YM && WS_YM + (size_t)M * D * 2 <= WS_END, "d_ws map");
constexpr int LDS_BYTES = 147456;
constexpr float ALPHA = 1.681792830507429f;
constexpr float QSCALE = 0.125f * 1.4426950408889634f;

typedef unsigned short bf16;
typedef float f32x4 __attribute__((ext_vector_type(4)));
typedef unsigned v4u __attribute__((ext_vector_type(4)));
typedef unsigned v2u __attribute__((ext_vector_type(2)));
using pg8::cvtpk;

struct Args { const float* in[13]; float* out; unsigned char* ws; float inv[32]; float lam_init[4]; };

__device__ __forceinline__ int cur_lane() { int l; asm volatile("v_mbcnt_lo_u32_b32 %0, -1, 0\n\tv_mbcnt_hi_u32_b32 %0, -1, %0" : "=v"(l)); return l; }
__device__ __forceinline__ float wave_sum(float v) {
#pragma unroll
    for (int o = 1; o < 64; o <<= 1) v += __shfl_xor(v, o);
    return v;
}
__device__ __forceinline__ int src_col(int type, int n) {
    if (type == 1) { const int pn = n >> 8, w = n & 255; return (w < 128) ? (128 * pn + w) : (FF + 128 * pn + (w - 128)); }
    if (type == 3) { const int w = n & 255, bj = w >> 7, wc = (w >> 5) & 3, c = w & 31; return (n & ~255) + 64 * wc + 32 * bj + c; }
    if (type == 2) { const bool rp = (n < 1024) || (n >= 1536 && n < 2176); return rp ? ((n & ~63) + ((n & 63) >> 1) + 32 * (n & 1)) : n; }
    return n;
}
template <bool F16> __device__ __forceinline__ void transpose_item(const float* W, int K, int N, int type, const float* gk, bf16* WT, ALDS float* scr, int item, int lane) {
    const int nblk = N / 32, kb = item / nblk, nb = item % nblk, k0 = 64 * kb, n0 = 32 * nb;
    const int sc = src_col(type, n0 + (lane & 31));
#pragma unroll
    for (int i = 0; i < 32; ++i) { const int kk = 2 * i + (lane >> 5); scr[kk * 33 + (lane & 31)] = W[(size_t)(k0 + kk) * N + sc] * (gk ? gk[k0 + kk] : 1.0f); }
    asm volatile("s_waitcnt lgkmcnt(0)" ::: "memory");
    const int c = lane & 7;
#pragma unroll
    for (int j = 0; j < 4; ++j) { const int n = (lane >> 3) + 8 * j; const ALDS float* s = scr + (8 * c) * 33 + n;
        v4u o; if (F16) { o.x = pg8::cvtpk_h(s[0 * 33], s[1 * 33]); o.y = pg8::cvtpk_h(s[2 * 33], s[3 * 33]); o.z = pg8::cvtpk_h(s[4 * 33], s[5 * 33]); o.w = pg8::cvtpk_h(s[6 * 33], s[7 * 33]); }
        else { o.x = cvtpk(s[0 * 33], s[1 * 33]); o.y = cvtpk(s[2 * 33], s[3 * 33]); o.z = cvtpk(s[4 * 33], s[5 * 33]); o.w = cvtpk(s[6 * 33], s[7 * 33]); }
        *(v4u*)(WT + (size_t)(n0 + n) * K + k0 + 8 * c) = o; }
    asm volatile("s_waitcnt lgkmcnt(0)" ::: "memory");
}
__device__ __forceinline__ void sincos_f32angle(float ang, float& c, float& s) {
    const double a = (double)ang, k = __builtin_rint(a * 0.63661977236758134308);
    double r = __builtin_fma(-k, 1.57079632679489655800e+00, a); r = __builtin_fma(-k, 6.12323399573676603587e-17, r);
    const double r2 = r * r;
    double sp = -1.0 / 1307674368000.0; sp = sp * r2 + 1.0 / 6227020800.0; sp = sp * r2 - 1.0 / 39916800.0; sp = sp * r2 + 1.0 / 362880.0; sp = sp * r2 - 1.0 / 5040.0; sp = sp * r2 + 1.0 / 120.0; sp = sp * r2 - 1.0 / 6.0;
    const double sn = r + r * r2 * sp;
    double cp = 1.0 / 20922789888000.0; cp = cp * r2 - 1.0 / 87178291200.0; cp = cp * r2 + 1.0 / 479001600.0; cp = cp * r2 - 1.0 / 3628800.0; cp = cp * r2 + 1.0 / 40320.0; cp = cp * r2 - 1.0 / 720.0; cp = cp * r2 + 1.0 / 24.0; cp = cp * r2 - 0.5;
    const double cn = 1.0 + r2 * cp;
    const int q = ((int)k) & 3;
    const double cc = (q == 0) ? cn : (q == 1) ? -sn : (q == 2) ? -cn : sn;
    const double ss = (q == 0) ? sn : (q == 1) ? cn : (q == 2) ? -sn : -cn;
    c = (float)cc; s = (float)ss;
}
__device__ __forceinline__ void ln_row(const float* xrow, const float* g, const float* bta, float* orow, bf16* brow, int lane) {
    asm volatile("" : "+v"(lane));
    const f32x4* xr = (const f32x4*)xrow + lane;
    f32x4 v[4]; float s = 0.f;
#pragma unroll
    for (int j = 0; j < 4; ++j) { v[j] = xr[64 * j]; s += (v[j][0] + v[j][1]) + (v[j][2] + v[j][3]); }
    const float mean = wave_sum(s) * (1.f / D); float s2 = 0.f;
#pragma unroll
    for (int j = 0; j < 4; ++j) { v[j] = v[j] - mean; s2 += (v[j][0] * v[j][0] + v[j][1] * v[j][1]) + (v[j][2] * v[j][2] + v[j][3] * v[j][3]); }
    const float rstd = 1.0f / sqrtf(wave_sum(s2) * (1.f / D) + 1e-5f);
#pragma unroll
    for (int j = 0; j < 4; ++j) { const f32x4 gg = *((const f32x4*)g + lane + 64 * j), bb = *((const f32x4*)bta + lane + 64 * j);
        const f32x4 y = v[j] * rstd * gg + bb;
        *((f32x4*)orow + lane + 64 * j) = y;
        v2u w; w.x = cvtpk(y[0], y[1]); w.y = cvtpk(y[2], y[3]); *((v2u*)brow + lane + 64 * j) = w; }
}

#define XB_TMO      128
#define XB_XCNT(j)  (256  + 64 * (j))
#define XB_XSUB(j)  (1280 + 64 * (j))
#define XB_XGEN(j)  (2304 + 64 * (j))
#define XB_TOP      3328
#define XB_TOPGEN   3392
#define XCD_BAR_WORDS 3456
#define XB_SPIN_CAP (1u << 18)

__device__ __forceinline__ unsigned xb_ld(unsigned* p)              { return __hip_atomic_load(p, __ATOMIC_RELAXED, __HIP_MEMORY_SCOPE_AGENT); }
__device__ __forceinline__ unsigned xb_add(unsigned* p, unsigned v) { return __hip_atomic_fetch_add(p, v, __ATOMIC_RELAXED, __HIP_MEMORY_SCOPE_AGENT); }
__device__ __forceinline__ unsigned xb_xcc_id() { return (unsigned)__builtin_amdgcn_s_getreg((3 << 11) | 20) & 0xFu; }
#define XB_SPIN(cond, bar) do { unsigned _sp = 0; while (cond) { __builtin_amdgcn_s_sleep(1); \
    if ((++_sp & 255u) == 0u) { if (xb_ld(&(bar)[XB_TMO])) break; if (_sp > XB_SPIN_CAP) { atomicAdd(&(bar)[XB_TMO], 1u); break; } } } } while (0)

struct XcdBarrier {
    unsigned* bar; unsigned x;
    volatile ALDS unsigned* st;
};

__device__ __forceinline__ XcdBarrier xcd_barrier_post(unsigned* bar, volatile ALDS unsigned* st) {
    XcdBarrier b; b.bar = bar; b.x = xb_xcc_id(); b.st = st;
    if (threadIdx.x == 0) (void)xb_add(&bar[XB_XCNT(b.x)], 1u);
    return b;
}
__device__ __forceinline__ void xcd_barrier_complete(unsigned* bar, unsigned x, unsigned& nloc, unsigned& nx) {
    const unsigned G = gridDim.x * gridDim.y * gridDim.z;
    unsigned sum, cnt, mine, sp = 0u;
    for (;;) {
        sum = 0u; cnt = 0u; mine = 0u;
#pragma unroll
        for (unsigned j = 0; j < 16; ++j) { const unsigned c = xb_ld(&bar[XB_XCNT(j)]); sum += c; cnt += (c > 0u) ? 1u : 0u; mine = (j == x) ? c : mine; }
        if (sum == G) break;
        __builtin_amdgcn_s_sleep(1);
        if ((++sp & 255u) == 0u) { if (xb_ld(&bar[XB_TMO])) break; if (sp > XB_SPIN_CAP) { atomicAdd(&bar[XB_TMO], 1u); break; } }
    }
    nloc = mine > 0u ? mine : 1u; nx = cnt > 0u ? cnt : 1u;
}

__device__ __forceinline__ void xcd_barrier(const XcdBarrier& b) {
    asm volatile("s_waitcnt vmcnt(0)" ::: "memory");
    __syncthreads();
    if (threadIdx.x == 0) {
        unsigned* bar = b.bar;
        __builtin_amdgcn_s_waitcnt(0);
        unsigned nloc = b.st[0], nx = b.st[1];
        if (nloc == 0u) { xcd_barrier_complete(bar, b.x, nloc, nx); b.st[0] = nloc; b.st[1] = nx; }
        const unsigned old = xb_add(&bar[XB_XSUB(b.x)], 1u);
        const unsigned gen = old / nloc;
        if (old + 1u == (gen + 1u) * nloc) {
            __builtin_amdgcn_fence(__ATOMIC_RELEASE, "agent");
            asm volatile("s_waitcnt vmcnt(0)" ::: "memory");
            const unsigned og = xb_add(&bar[XB_TOP], 1u);
            const unsigned tg = og / nx;
            if (og + 1u == (tg + 1u) * nx) xb_add(&bar[XB_TOPGEN], 1u);
            else XB_SPIN(xb_ld(&bar[XB_TOPGEN]) == tg, bar);
            __builtin_amdgcn_fence(__ATOMIC_ACQUIRE, "agent");
            xb_add(&bar[XB_XGEN(b.x)], 1u);
            asm volatile("s_waitcnt vmcnt(0)" ::: "memory");
        } else {
            XB_SPIN(xb_ld(&bar[XB_XGEN(b.x)]) == gen, bar);
            __builtin_amdgcn_fence(__ATOMIC_ACQUIRE, "agent");
            asm volatile("s_waitcnt vmcnt(0)" ::: "memory");
        }
    }
    __syncthreads();
}

__device__ __forceinline__ void ln_row_h(const bf16* hrow, const float* g, const float* bta, float* orow, int lane) {
    asm volatile("" : "+v"(lane));
    typedef _Float16 h4 __attribute__((ext_vector_type(4)));
    f32x4 v[4]; float s = 0.f;
#pragma unroll
    for (int j = 0; j < 4; ++j) { const h4 h = *((const h4*)hrow + lane + 64 * j); v[j] = (f32x4){(float)h[0], (float)h[1], (float)h[2], (float)h[3]}; s += (v[j][0] + v[j][1]) + (v[j][2] + v[j][3]); }
    const float mean = wave_sum(s) * (1.f / D); float s2 = 0.f;
#pragma unroll
    for (int j = 0; j < 4; ++j) { v[j] = v[j] - mean; s2 += (v[j][0] * v[j][0] + v[j][1] * v[j][1]) + (v[j][2] * v[j][2] + v[j][3] * v[j][3]); }
    const float rstd = 1.0f / sqrtf(wave_sum(s2) * (1.f / D) + 1e-5f);
#pragma unroll
    for (int j = 0; j < 4; ++j) { const f32x4 gg = *((const f32x4*)g + lane + 64 * j), bb = *((const f32x4*)bta + lane + 64 * j);
        *((f32x4*)orow + lane + 64 * j) = v[j] * rstd * gg + bb; }
}

__global__ void __launch_bounds__(NWAVES * 64, 2) fwd_megakernel(Args args) {
    extern __shared__ __attribute__((aligned(16))) unsigned char lds_raw[];
    cg::grid_group grid = cg::this_grid();
#define GSYNC() xcd_barrier(bar)
    ALDS unsigned char* lds = (ALDS unsigned char*)lds_raw;
    const int tid = threadIdx.x, lane = tid & 63, wave = __builtin_amdgcn_readfirstlane(tid >> 6);
    const int G = gridDim.x, bx = blockIdx.x & 1023,                                          vcu = (G % 8 == 0) ? (bx % 8) * (G / 8) + bx / 8 : bx;
    unsigned char* ws = args.ws;
    const float* x_in = args.in[0]; const int* positions = (const int*)args.in[1];
    float* out = args.out;
    bf16* XB = (bf16*)(ws + WS_XB); bf16* HB = (bf16*)(ws + WS_H); bf16* QKV = (bf16*)(ws + WS_H); bf16* YM = (bf16*)(ws + WS_YM);
    unsigned* ROPEH = (unsigned*)(ws + WS_ROPE);
    float* ROPE = (float*)(ws + WS_ROPE); float* CSBW = (float*)(ws + WS_CSBW); float* ST = (float*)(ws + WS_ST); float* LAMV = (float*)(ws + WS_CSBW + 786432);
    const int gw = vcu * NWAVES + wave, NGW = G * NWAVES;
    volatile ALDS unsigned* bst = (volatile ALDS unsigned*)(lds + 131072 + 8192);
    if (tid < 2) bst[tid] = 0u;
    __syncthreads();
    XcdBarrier bar = xcd_barrier_post((unsigned*)(ws + WS_CTL), bst);

    {
        ALDS float* scr = (ALDS float*)(lds + wave * 16384);
        constexpr int I1 = (D / 64) * (2 * FF / 32), I2 = (FF / 64) * (D / 32), I3 = (D / 64) * (NIN / 32), I4 = (D / 64) * (D / 32), IL = 2 * I1 + 2 * I2 + I3 + I4;
        for (int it = gw; it < IL * DEPTH; it += NGW) {
            const int l = it / IL; int r = it % IL;
            unsigned char* wl = ws + WS_W + (size_t)l * WL_STRIDE;
            if (r < I1) { transpose_item<true>(args.in[7] + (size_t)l * D * 2 * FF, D, 2 * FF, 1, (l > 0) ? args.in[11] + (size_t)((l - 1) * 3 + 2) * D : nullptr, (bf16*)(wl + W1_OFF), scr, r, lane); continue; } r -= I1;
            if (r < I2) { transpose_item<false>(args.in[8] + (size_t)l * FF * D, FF, D, 3, nullptr, (bf16*)(wl + W2_OFF), scr, r, lane); continue; } r -= I2;
            if (r < I3) { transpose_item<true>(args.in[2] + (size_t)l * D * NIN, D, NIN, 2, args.in[11] + (size_t)(l * 3) * D, (bf16*)(wl + WIN_OFF), scr, r, lane); continue; } r -= I3;
            if (r < I4) { transpose_item<false>(args.in[3] + (size_t)l * D * D, D, D, 3, nullptr, (bf16*)(wl + WO_OFF), scr, r, lane); continue; } r -= I4;
            if (r < I1) { transpose_item<true>(args.in[9] + (size_t)l * D * 2 * FF, D, 2 * FF, 1, args.in[11] + (size_t)(l * 3 + 1) * D, (bf16*)(wl + W3_OFF), scr, r, lane); continue; } r -= I1;
            transpose_item<false>(args.in[10] + (size_t)l * FF * D, FF, D, 3, nullptr, (bf16*)(wl + W4_OFF), scr, r, lane);
        }
        const size_t gt = (size_t)vcu * (NWAVES * 64) + tid, GT = (size_t)G * NWAVES * 64;
        for (size_t i = gt; i < (size_t)M * D / 4; i += 8 * GT) {
            f32x4 v[8];
#pragma unroll
            for (int j = 0; j < 8; ++j) { const size_t ij = i + (size_t)j * GT; v[j] = (ij < (size_t)M * D / 4) ? *((const f32x4*)x_in + ij) : (f32x4){0.f, 0.f, 0.f, 0.f}; }
#pragma unroll
            for (int j = 0; j < 8; ++j) { const size_t ij = i + (size_t)j * GT; if (ij < (size_t)M * D / 4) { v2u w; w.x = pg8::cvtpk_h(v[j][0], v[j][1]); w.y = pg8::cvtpk_h(v[j][2], v[j][3]); *((v2u*)XB + ij) = w; } }
        }
        for (size_t i = gt; i < (size_t)M * 32; i += GT) { const int row = (int)(i >> 5), k = (int)(i & 31); float c, s; sincos_f32angle((float)positions[row] * args.inv[k], c, s);
            ROPEH[(size_t)row * 32 + k] = pg8::cvtpk_h(c, s); }
        if (vcu == 0 && wave < DEPTH) {
            const float* lv = args.in[4] + (size_t)wave * 256;
            const float a1 = wave_sum(lv[lane] * lv[64 + lane]), a2 = wave_sum(lv[128 + lane] * lv[192 + lane]);
            if (lane == 0) LAMV[wave] = expf(a1) - expf(a2) + args.lam_init[wave];
        }
        for (size_t i = gt; i < (size_t)M * 2; i += GT) ST[i] = 0.f;
        {
            ALDS float* red = (ALDS float*)(lds + 131072);
            constexpr int CG0 = 2 * FF / 64, CG1 = NIN / 64, CGL = 2 * CG0 + CG1;
            for (int cgi = vcu; cgi < CGL * DEPTH; cgi += G) {
                const int l = cgi / CGL; int r = cgi % CGL; int j = 0;
                if (r >= CG0) { r -= CG0; j = 1; if (r >= CG1) { r -= CG1; j = 2; } }
                const int lnidx = (j == 0) ? (l - 1) * 3 + 2 : (j == 1) ? l * 3 : l * 3 + 1;
                if (lnidx < 0) continue;
                const int N = (j == 1) ? NIN : 2 * FF, type = (j == 1) ? 2 : 1;
                const float* W = (j == 0) ? args.in[7] + (size_t)l * D * 2 * FF : (j == 1) ? args.in[2] + (size_t)l * D * NIN : args.in[9] + (size_t)l * D * 2 * FF;
                const float* gk = args.in[11] + (size_t)lnidx * D; const float* bk = args.in[12] + (size_t)lnidx * D;
                const int n = r * 64 + lane, sc = src_col(type, n);
                float c1 = 0.f, b1 = 0.f;
#pragma unroll 16
                for (int k = wave * 128; k < wave * 128 + 128; ++k) { const float w = W[(size_t)k * N + sc]; const float gw = gk[k] * w;
                    c1 += (float)(_Float16)gw; b1 += bk[k] * w; }
                red[(wave * 64 + lane) * 2] = c1; red[(wave * 64 + lane) * 2 + 1] = b1;
                __syncthreads();
                if (wave == 0) { float cc = 0.f, bb = 0.f;
#pragma unroll
                    for (int w8 = 0; w8 < 8; ++w8) { cc += red[(w8 * 64 + lane) * 2]; bb += red[(w8 * 64 + lane) * 2 + 1]; }
                    float* dst = CSBW + (size_t)((l * 3 + j) * 2) * CSBW_N; dst[n] = cc; dst[CSBW_N + n] = bb; }
                __syncthreads();
            }
        }
    }
    grid.sync();

#define ZERO_ST(buf_) do { int t_ = wave * 64 + cur_lane(); asm volatile("" : "+v"(t_)); float* z_ = ST + (size_t)(buf_) * M * 2; for (int i_ = vcu * (NWAVES * 64) + t_; i_ < M * 2; i_ += G * NWAVES * 64) { z_[i_] = 0.f; asm volatile("" : "+v"(i_)); } } while (0)
    for (int l = 0; l < DEPTH; ++l) {
        unsigned char* wl = ws + WS_W + (size_t)l * WL_STRIDE;
        const float* lng = args.in[11]; const float* lnb = args.in[12];
        { const int k = 3 * l; ZERO_ST(k & 1);
          const float* cb = CSBW + (size_t)((l * 3 + 0) * 2) * CSBW_N;
          pg8::Gemm g{XB, (const bf16*)(wl + W1_OFF), M, 2 * FF, D}; pg8::StaticOrder S; S.init(M, 2 * FF, G, bx);
          pg8::EpiSwiGLU E{HB, FF, pg8::RowLN{(k == 0) ? nullptr : ST + (size_t)((k - 1) & 1) * M * 2, cb, cb + CSBW_N}};
          pg8::gemm_phase<pg8::EpiSwiGLU, pg8::StaticOrder, true, true>(lds, g, S, E, wave); }
        GSYNC();
        { const int k = 3 * l;
          pg8::Gemm g{HB, (const bf16*)(wl + W2_OFF), M, D, FF}; pg8::StaticOrder S; S.init(M, D, G, bx);
          pg8::EpiRes E{x_in, XB, (k == 0) ? nullptr : ST + (size_t)((k - 1) & 1) * M * 2, lng + (size_t)(k > 0 ? k - 1 : 0) * D, lnb + (size_t)(k > 0 ? k - 1 : 0) * D, ST + (size_t)(k & 1) * M * 2, ALPHA, 0.5f};
          pg8::gemm_phase<pg8::EpiRes, pg8::StaticOrder, true, true>(lds, g, S, E, wave); }
        GSYNC();
        { const int k = 3 * l + 1; ZERO_ST(k & 1);
          const float* cb = CSBW + (size_t)((l * 3 + 1) * 2) * CSBW_N;
          pg8::Gemm g{XB, (const bf16*)(wl + WIN_OFF), M, NIN, D}; pg8::StaticOrder S; S.init(M, NIN, G, bx);
          pg8::EpiQKV E{QKV, ROPEH, QSCALE, pg8::RowLN{ST + (size_t)((k - 1) & 1) * M * 2, cb, cb + CSBW_N}};
          pg8::gemm_phase<pg8::EpiQKV, pg8::StaticOrder, true, true>(lds, g, S, E, wave); }
        GSYNC();
        {
            const float lam_init = args.lam_init[l], lam = LAMV[l];
            const float* subg = args.in[5] + (size_t)l * 128; const float* sink = args.in[6] + (size_t)l * 8;
            for (int u = vcu; u < 2048; u += G) att::diff_unit(lds, wave, cur_lane(), QKV, YM, u, lam, 1.0f - lam_init, subg);
            for (int u = vcu; u < 2048; u += G) att::swa_unit(lds, wave, cur_lane(), QKV, YM, u, sink);
        }
        GSYNC();
        { const int k = 3 * l + 1;
          pg8::Gemm g{YM, (const bf16*)(wl + WO_OFF), M, D, D}; pg8::StaticOrder S; S.init(M, D, G, bx);
          pg8::EpiRes E{x_in, XB, ST + (size_t)((k - 1) & 1) * M * 2, lng + (size_t)(k - 1) * D, lnb + (size_t)(k - 1) * D, ST + (size_t)(k & 1) * M * 2, ALPHA, 1.0f};
          pg8::gemm_phase<pg8::EpiRes, pg8::StaticOrder, true, true>(lds, g, S, E, wave); }
        GSYNC();
        { const int k = 3 * l + 2; ZERO_ST(k & 1);
          const float* cb = CSBW + (size_t)((l * 3 + 2) * 2) * CSBW_N;
          pg8::Gemm g{XB, (const bf16*)(wl + W3_OFF), M, 2 * FF, D}; pg8::StaticOrder S; S.init(M, 2 * FF, G, bx);
          pg8::EpiSwiGLU E{HB, FF, pg8::RowLN{ST + (size_t)((k - 1) & 1) * M * 2, cb, cb + CSBW_N}};
          pg8::gemm_phase<pg8::EpiSwiGLU, pg8::StaticOrder, true, true>(lds, g, S, E, wave); }
        GSYNC();
        { const int k = 3 * l + 2;
          pg8::Gemm g{HB, (const bf16*)(wl + W4_OFF), M, D, FF}; pg8::StaticOrder S; S.init(M, D, G, bx);
          pg8::EpiRes E{x_in, XB, ST + (size_t)((k - 1) & 1) * M * 2, lng + (size_t)(k - 1) * D, lnb + (size_t)(k - 1) * D, ST + (size_t)(k & 1) * M * 2, ALPHA, 0.5f};
          pg8::gemm_phase<pg8::EpiRes, pg8::StaticOrder, true, true>(lds, g, S, E, wave); }
        GSYNC();
    }
    for (int m = gw; m < M; m += NGW) ln_row_h(XB + (size_t)m * D, args.in[11] + (size_t)11 * D, args.in[12] + (size_t)11 * D, out + (size_t)m * D, cur_lane());
}

extern "C" void kernel_launch(void* const* d_in, const int* in_sizes, int n_in, void* d_out, int out_size, void* d_ws, size_t ws_size, hipStream_t stream) {
    static int grid = 0;
    if (grid == 0) {
        if (n_in != 13 || in_sizes[0] != M * D || out_size != M * D || ws_size < WS_END) { fprintf(stderr, "kernel_launch: unexpected shapes (n_in %d, in0 %d, out %d, ws %zu); nothing launched\n", n_in, n_in > 0 ? in_sizes[0] : -1, out_size, ws_size); grid = -1; return; }
        int dev = 0, cus = 0, per_cu = 0;
        if (hipGetDevice(&dev) != hipSuccess || hipDeviceGetAttribute(&cus, hipDeviceAttributeMultiprocessorCount, dev) != hipSuccess) { grid = -1; return; }
        if (hipFuncSetAttribute((const void*)fwd_megakernel, hipFuncAttributeMaxDynamicSharedMemorySize, LDS_BYTES) != hipSuccess) { fprintf(stderr, "kernel_launch: hipFuncSetAttribute failed\n"); grid = -1; return; }
        if (hipOccupancyMaxActiveBlocksPerMultiprocessor(&per_cu, (const void*)fwd_megakernel, NWAVES * 64, LDS_BYTES) != hipSuccess || per_cu < 1) { fprintf(stderr, "kernel_launch: occupancy query gives %d\n", per_cu); per_cu = 1; }
        (void)hipGetLastError();
        grid = (cus < 1024) ? cus : 1024;
    }
    if (grid < 0) return;
    if (hipMemsetAsync((char*)d_ws + WS_CTL, 0, CTL_ZERO_BYTES, stream) != hipSuccess) { fprintf(stderr, "kernel_launch: memset of the barrier words failed\n"); return; }
    Args a{};
    for (int i = 0; i < 13; ++i) a.in[i] = (const float*)d_in[i];
    a.out = (float*)d_out; a.ws = (unsigned char*)d_ws;
    for (int i = 0; i < 32; ++i) a.inv[i] = (float)pow(10000.0, -(double)(2 * i) / 64.0);
    for (int l = 0; l < 4; ++l) a.lam_init[l] = (float)(0.8 - 0.6 * exp(-0.3 * (double)l));
    void* kargs[] = {&a};
    const hipError_t e = hipLaunchCooperativeKernel((const void*)fwd_megakernel, dim3(grid), dim3(NWAVES * 64), kargs, LDS_BYTES, stream);
    if (e != hipSuccess) fprintf(stderr, "kernel_launch: cooperative launch failed: %s (grid %d)\n", hipGetErrorString(e), grid);
}
```
